# Optimizing an MI355X kernel written in HIP

```python
import math
import jax, jax.numpy as jnp
from jax import lax
import numpy as np

D_MODEL = 1024
BATCH = 32
SEQ = 2048
DEPTH = 1
DEC_BATCH = 32
DEC_SEQ = 16
PAST_LEN = 1024

CHUNK = 64
Q_BLOCK = 128
MIX_WIDTH = D_MODEL
ATTN_WIDTH = MIX_WIDTH // 2
CONV_WIDTH = MIX_WIDTH - ATTN_WIDTH
N_HEADS_A = 4
V_HEAD_DIM = ATTN_WIDTH // N_HEADS_A
QK_HEAD_DIM = V_HEAD_DIM // 2
ROT_DIM = QK_HEAD_DIM // 4
ROPE_THETA = 500000.0
SC_WIDTH = 3
N_MEM = 256
N_HEADS_X = 4
X_HEAD_DIM = D_MODEL // N_HEADS_X
D_FF = 2816
FFN_CONV_WIDTH = 3
EPS = 1e-6
Q_COLS = N_HEADS_A * 2 * QK_HEAD_DIM
K_COLS = N_HEADS_A * 2 * QK_HEAD_DIM
V_COLS = N_HEADS_A * V_HEAD_DIM
IN_PROJ = Q_COLS + K_COLS + V_COLS + 3 * CONV_WIDTH

kernel_name = "hybrid_diffattn_shortconv_streaming_step"


def lambda_init_fn(layer_idx):
    return 0.8 - 0.6 * math.exp(-0.3 * layer_idx)


def rms_norm(x, g):
    xf = x.astype(jnp.float32)
    y = xf * lax.rsqrt(jnp.mean(xf * xf, axis=-1, keepdims=True) + EPS)
    return (y * g.astype(jnp.float32)).astype(x.dtype)


def rope_partial(t, pos):
    half = ROT_DIM // 2
    inv = 1.0 / (ROPE_THETA ** (jnp.arange(half, dtype=jnp.float32) * 2.0 / ROT_DIM))
    ang = pos.astype(jnp.float32)[:, None] * inv[None, :]
    cos = jnp.cos(ang)[None, :, None, None, :]
    sin = jnp.sin(ang)[None, :, None, None, :]
    tr = t[..., :ROT_DIM].astype(jnp.float32)
    x1, x2 = tr[..., :half], tr[..., half:]
    rot = jnp.concatenate([x1 * cos - x2 * sin, x2 * cos + x1 * sin], axis=-1).astype(t.dtype)
    return jnp.concatenate([rot, t[..., ROT_DIM:]], axis=-1)


def causal_dwconv(u, state, w):
    k_w = w.shape[0]
    t_len = u.shape[1]
    full = jnp.concatenate([state.astype(u.dtype), u], axis=1)
    y = w[0] * full[:, 0:t_len]
    for j in range(1, k_w):
        y = y + w[j] * full[:, j:j + t_len]
    return y, full[:, -(k_w - 1):]


def diff_lambda(lq1, lk1, lq2, lk2, lam_init):
    f = jnp.float32
    return (jnp.exp(jnp.sum(lq1.astype(f) * lk1.astype(f)))
            - jnp.exp(jnp.sum(lq2.astype(f) * lk2.astype(f))) + lam_init)


def diff_combine(s, v, lam):
    p = jax.nn.softmax(s, axis=-1)
    a = p[:, :, 0] - lam * p[:, :, 1]
    return jnp.einsum('bhqk,bkhe->bqhe', a.astype(v.dtype), v)


def diff_attn_prompt(q, k, v, lam):
    b, s_len = q.shape[0], q.shape[1]
    nblk = s_len // Q_BLOCK
    scale = QK_HEAD_DIM ** -0.5
    key_chunk = jnp.arange(s_len) // CHUNK
    qb = q.reshape(b, nblk, Q_BLOCK, N_HEADS_A, 2, QK_HEAD_DIM).swapaxes(0, 1)

    def block(args):
        q_blk, i = args
        s = jnp.einsum('bqhmd,bkhmd->bhmqk', q_blk, k,
                       preferred_element_type=jnp.float32) * scale
        q_chunk = (i * Q_BLOCK + jnp.arange(Q_BLOCK)) // CHUNK
        mask = q_chunk[:, None] >= key_chunk[None, :]
        s = jnp.where(mask, s, -jnp.inf)
        return diff_combine(s, v, lam)

    out = lax.map(block, (qb, jnp.arange(nblk)))
    return out.swapaxes(0, 1).reshape(b, s_len, N_HEADS_A, V_HEAD_DIM)


def diff_attn_sample(q, k_all, v_all, lam):
    scale = QK_HEAD_DIM ** -0.5
    s = jnp.einsum('bqhmd,bkhmd->bhmqk', q, k_all,
                   preferred_element_type=jnp.float32) * scale
    return diff_combine(s, v_all, lam)


def mem_kv(mem, g_mem, w_xk, w_xv):
    b, n = mem.shape[0], mem.shape[1]
    m = rms_norm(mem, g_mem)
    mk = (m @ w_xk).reshape(b, n, N_HEADS_X, X_HEAD_DIM)
    mv = (m @ w_xv).reshape(b, n, N_HEADS_X, X_HEAD_DIM)
    return mk, mv


def layer(x, pos, past_k, past_v, sc_state, ffn_state, mem_k, mem_v, lam_init,
          g_mix, w_in, lq1, lk1, lq2, lk2, g_sub, w_sc, w_out,
          g_x, w_xq, w_xo, g_ffn, w_up, w_gate, w_ffconv, w_down):
    b, t_len = x.shape[0], x.shape[1]
    h = rms_norm(x, g_mix)
    proj = h @ w_in
    c1 = Q_COLS
    c2 = c1 + K_COLS
    c3 = c2 + V_COLS
    c4 = c3 + CONV_WIDTH
    c5 = c4 + CONV_WIDTH
    q, k, v, bg, cg, xh = jnp.split(proj, [c1, c2, c3, c4, c5], axis=-1)
    q = rope_partial(q.reshape(b, t_len, N_HEADS_A, 2, QK_HEAD_DIM), pos)
    k = rope_partial(k.reshape(b, t_len, N_HEADS_A, 2, QK_HEAD_DIM), pos)
    v = v.reshape(b, t_len, N_HEADS_A, V_HEAD_DIM)
    lam = diff_lambda(lq1, lk1, lq2, lk2, lam_init)
    if past_k is None:
        o = diff_attn_prompt(q, k, v, lam)
    else:
        k_all = jnp.concatenate([past_k.astype(k.dtype), k], axis=1)
        v_all = jnp.concatenate([past_v.astype(v.dtype), v], axis=1)
        o = diff_attn_sample(q, k_all, v_all, lam)
    o = (rms_norm(o, g_sub) * (1.0 - lam_init)).reshape(b, t_len, ATTN_WIDTH)
    conv_y, new_sc = causal_dwconv(cg * xh, sc_state, w_sc)
    y_sc = bg * conv_y
    x = x + jnp.concatenate([o, y_sc], axis=-1) @ w_out
    hq = (rms_norm(x, g_x) @ w_xq).reshape(b, t_len, N_HEADS_X, X_HEAD_DIM)
    s = jnp.einsum('bthd,bmhd->bhtm', hq, mem_k.astype(hq.dtype),
                   preferred_element_type=jnp.float32) * (X_HEAD_DIM ** -0.5)
    p = jax.nn.softmax(s, axis=-1)
    xo = jnp.einsum('bhtm,bmhd->bthd', p.astype(x.dtype), mem_v.astype(x.dtype))
    x = x + xo.reshape(b, t_len, D_MODEL) @ w_xo
    hf = rms_norm(x, g_ffn)
    u_c, new_ffn = causal_dwconv(hf @ w_up, ffn_state, w_ffconv)
    x = x + (jax.nn.silu(u_c) * (hf @ w_gate)) @ w_down
    return x, k, v, new_sc, new_ffn


def setup_inputs(seed: int = 0) -> dict:
    key = jax.random.key(seed)
    ks = jax.random.split(key, 40)
    f = jnp.float32

    def nrm(i, shape, scale=1.0):
        return jax.random.normal(ks[i], shape, f) * scale

    def gain(i, n):
        return 1.0 + 0.02 * jax.random.normal(ks[i], (DEPTH, n), f)

    return {
        "x_prompt": nrm(0, (BATCH, SEQ, D_MODEL)),
        "x_sample": nrm(1, (DEC_BATCH, DEC_SEQ, D_MODEL)),
        "cache_attn_k": nrm(2, (DEPTH, DEC_BATCH, PAST_LEN, N_HEADS_A, 2, QK_HEAD_DIM)),
        "cache_attn_v": nrm(3, (DEPTH, DEC_BATCH, PAST_LEN, N_HEADS_A, V_HEAD_DIM)),
        "state_short_conv": nrm(4, (DEPTH, DEC_BATCH, SC_WIDTH - 1, CONV_WIDTH)),
        "state_ffn_conv": nrm(5, (DEPTH, DEC_BATCH, FFN_CONV_WIDTH - 1, D_FF)),
        "cache_mem_k": nrm(6, (DEPTH, DEC_BATCH, N_MEM, N_HEADS_X, X_HEAD_DIM)),
        "cache_mem_v": nrm(7, (DEPTH, DEC_BATCH, N_MEM, N_HEADS_X, X_HEAD_DIM)),
        "mem_prompt": nrm(8, (BATCH, N_MEM, D_MODEL)),
        "g_mix": gain(9, D_MODEL),
        "w_in": nrm(10, (DEPTH, D_MODEL, IN_PROJ), D_MODEL ** -0.5),
        "lam_q1": nrm(11, (DEPTH, QK_HEAD_DIM), 0.1),
        "lam_k1": nrm(12, (DEPTH, QK_HEAD_DIM), 0.1),
        "lam_q2": nrm(13, (DEPTH, QK_HEAD_DIM), 0.1),
        "lam_k2": nrm(14, (DEPTH, QK_HEAD_DIM), 0.1),
        "g_sub": gain(15, V_HEAD_DIM),
        "w_sc": nrm(16, (DEPTH, SC_WIDTH, CONV_WIDTH), SC_WIDTH ** -0.5),
        "w_out": nrm(17, (DEPTH, MIX_WIDTH, D_MODEL), MIX_WIDTH ** -0.5),
        "g_mem": gain(18, D_MODEL),
        "g_x": gain(19, D_MODEL),
        "w_xq": nrm(20, (DEPTH, D_MODEL, D_MODEL), D_MODEL ** -0.5),
        "w_xk": nrm(21, (DEPTH, D_MODEL, D_MODEL), D_MODEL ** -0.5),
        "w_xv": nrm(22, (DEPTH, D_MODEL, D_MODEL), D_MODEL ** -0.5),
        "w_xo": nrm(23, (DEPTH, D_MODEL, D_MODEL), D_MODEL ** -0.5),
        "g_ffn": gain(24, D_MODEL),
        "w_up": nrm(25, (DEPTH, D_MODEL, D_FF), D_MODEL ** -0.5),
        "w_gate": nrm(26, (DEPTH, D_MODEL, D_FF), D_MODEL ** -0.5),
        "w_ffconv": nrm(27, (DEPTH, FFN_CONV_WIDTH, D_FF), FFN_CONV_WIDTH ** -0.5),
        "w_down": nrm(28, (DEPTH, D_FF, D_MODEL), D_FF ** -0.5),
        "g_final": 1.0 + 0.02 * jax.random.normal(ks[29], (D_MODEL,), f),
    }


def reference(x_prompt, x_sample, cache_attn_k, cache_attn_v, state_short_conv, state_ffn_conv,
              cache_mem_k, cache_mem_v, mem_prompt,
              g_mix, w_in, lam_q1, lam_k1, lam_q2, lam_k2, g_sub, w_sc, w_out,
              g_mem, g_x, w_xq, w_xk, w_xv, w_xo, g_ffn, w_up, w_gate, w_ffconv, w_down,
              g_final):
    b_p, s_len = x_prompt.shape[0], x_prompt.shape[1]
    b_s, t_len = x_sample.shape[0], x_sample.shape[1]
    past_len = cache_attn_k.shape[2]
    pos_p = jnp.arange(s_len, dtype=jnp.int32)
    pos_s = past_len + jnp.arange(t_len, dtype=jnp.int32)

    hp, hs = x_prompt, x_sample
    kp_l, vp_l, scp_l, ffp_l, mkp_l, mvp_l = [], [], [], [], [], []
    ks_l, vs_l, scs_l, ffs_l = [], [], [], []
    for l in range(DEPTH):
        lam_init = lambda_init_fn(l)
        shared = (g_mix[l], w_in[l], lam_q1[l], lam_k1[l], lam_q2[l], lam_k2[l], g_sub[l],
                  w_sc[l], w_out[l], g_x[l], w_xq[l], w_xo[l], g_ffn[l], w_up[l], w_gate[l],
                  w_ffconv[l], w_down[l])
        mk_p, mv_p = mem_kv(mem_prompt, g_mem[l], w_xk[l], w_xv[l])
        sc0 = jnp.zeros((b_p, SC_WIDTH - 1, CONV_WIDTH), hp.dtype)
        ff0 = jnp.zeros((b_p, FFN_CONV_WIDTH - 1, D_FF), hp.dtype)
        hp, k_p, v_p, sc_p, ff_p = layer(hp, pos_p, None, None, sc0, ff0, mk_p, mv_p,
                                         lam_init, *shared)
        kp_l.append(k_p); vp_l.append(v_p); scp_l.append(sc_p); ffp_l.append(ff_p)
        mkp_l.append(mk_p); mvp_l.append(mv_p)
        hs, k_s, v_s, sc_s, ff_s = layer(hs, pos_s, cache_attn_k[l], cache_attn_v[l],
                                         state_short_conv[l], state_ffn_conv[l],
                                         cache_mem_k[l], cache_mem_v[l], lam_init, *shared)
        ks_l.append(k_s); vs_l.append(v_s); scs_l.append(sc_s); ffs_l.append(ff_s)

    y_prompt = rms_norm(hp, g_final)
    y_sample = rms_norm(hs, g_final)
    return (y_prompt, y_sample,
            jnp.stack(kp_l), jnp.stack(vp_l), jnp.stack(scp_l), jnp.stack(ffp_l),
            jnp.stack(mkp_l), jnp.stack(mvp_l),
            jnp.stack(ks_l), jnp.stack(vs_l), jnp.stack(scs_l), jnp.stack(ffs_l))
```

```cpp
#include <hip/hip_runtime.h>
#include <hip/hip_cooperative_groups.h>
#include <cstdio>
#include <cstdint>
namespace cg = cooperative_groups;

#define LAS __attribute__((address_space(3)))
typedef unsigned short bf16_t;
typedef short bf16x8 __attribute__((ext_vector_type(8)));
typedef short s16x4 __attribute__((ext_vector_type(4)));
typedef float f32x4 __attribute__((ext_vector_type(4)));
typedef float f32x2 __attribute__((ext_vector_type(2)));
typedef float f32x16 __attribute__((ext_vector_type(16)));
typedef unsigned u32x4 __attribute__((ext_vector_type(4)));
typedef unsigned u32x2 __attribute__((ext_vector_type(2)));

constexpr int DM = 1024, NB = 32, SEQ = 2048, DECT = 16, PAST = 1024;
constexpr int MP = NB * SEQ, MS = NB * DECT, RT = MP + MS;
constexpr int NTILE_P = MP / 256, NTILE = RT / 256;
constexpr int NH = 4, QKD = 64, VD = 128, NMEM = 256, XD = 256, DFF = 2816, INP = 3072, CW = 512;
constexpr int MMEM = NB * NMEM;
constexpr float EPS = 1e-6f;
constexpr float LAM_INIT = 0.2f;
constexpr int P1W = 2560;

constexpr size_t O_Y = 0;
constexpr size_t O_KP = (size_t)RT * DM;
constexpr size_t O_VP = O_KP + (size_t)MP * 512;
constexpr size_t O_SCP = O_VP + (size_t)MP * 512;
constexpr size_t O_FFP = O_SCP + (size_t)NB * 2 * CW;
constexpr size_t O_MK = O_FFP + (size_t)NB * 2 * DFF;
constexpr size_t O_MV = O_MK + (size_t)MMEM * DM;
constexpr size_t O_KS = O_MV + (size_t)MMEM * DM;
constexpr size_t O_VS = O_KS + (size_t)MS * 512;
constexpr size_t O_SCS = O_VS + (size_t)MS * 512;
constexpr size_t O_FFS = O_SCS + (size_t)NB * 2 * CW;
constexpr size_t O_END = O_FFS + (size_t)NB * 2 * DFF;

__device__ __forceinline__ unsigned cvt_pk_bf16(float lo, float hi) { unsigned r; asm volatile("v_cvt_pk_bf16_f32 %0, %1, %2" : "=v"(r) : "v"(lo), "v"(hi)); return r; }
__device__ __forceinline__ float bf2f(unsigned short h) { return __uint_as_float((unsigned)h << 16); }
#define DPPF(v, ctrl) __int_as_float(__builtin_amdgcn_update_dpp(0, __float_as_int(v), (ctrl), 0xf, 0xf, true))
__device__ __forceinline__ float xor16_sum(float v) { auto r = __builtin_amdgcn_permlane16_swap(__float_as_uint(v), __float_as_uint(v), false, false); return __uint_as_float(r[0]) + __uint_as_float(r[1]); }
__device__ __forceinline__ float xor32_sum(float v) { auto r = __builtin_amdgcn_permlane32_swap(__float_as_uint(v), __float_as_uint(v), false, false); return __uint_as_float(r[0]) + __uint_as_float(r[1]); }
__device__ __forceinline__ float xor16_max(float v) { auto r = __builtin_amdgcn_permlane16_swap(__float_as_uint(v), __float_as_uint(v), false, false); return fmaxf(__uint_as_float(r[0]), __uint_as_float(r[1])); }
__device__ __forceinline__ float xor32_max(float v) { auto r = __builtin_amdgcn_permlane32_swap(__float_as_uint(v), __float_as_uint(v), false, false); return fmaxf(__uint_as_float(r[0]), __uint_as_float(r[1])); }
__device__ __forceinline__ float other16(float v, int odd) { auto r = __builtin_amdgcn_permlane16_swap(__float_as_uint(v), __float_as_uint(v), false, false); return __uint_as_float(odd ? r[0] : r[1]); }
__device__ __forceinline__ float wave_sum(float v) {
    v += DPPF(v, 0xB1); v += DPPF(v, 0x4E); v += DPPF(v, 0x141); v += DPPF(v, 0x140);
    return xor32_sum(xor16_sum(v));
}
__device__ __forceinline__ float wave_max(float v) {
    v = fmaxf(v, DPPF(v, 0xB1)); v = fmaxf(v, DPPF(v, 0x4E)); v = fmaxf(v, DPPF(v, 0x141)); v = fmaxf(v, DPPF(v, 0x140));
    return xor32_max(xor16_max(v));
}
__device__ __forceinline__ float row_shr1(float v) { return __int_as_float(__builtin_amdgcn_update_dpp(__float_as_int(v), __float_as_int(v), 0x111, 0xf, 0xf, false)); }
__device__ __forceinline__ float row_shr2(float v) { return __int_as_float(__builtin_amdgcn_update_dpp(__float_as_int(v), __float_as_int(v), 0x112, 0xf, 0xf, false)); }

namespace pg8 {
constexpr int BM = 256, BK = 64, HALF = 128, HTB = HALF * BK * 2, STAGE_BYTES = 8 * HTB;
__host__ __device__ __forceinline__ int lds_byte(int r, int c) { const int st = (r >> 4) * 2 + (c >> 5), rr = r & 15, cc = c & 31, ob = rr * 64 + cc * 2; return st * 1024 + (ob ^ (((ob >> 9) & 1) << 5)); }
__host__ __device__ __forceinline__ void stage_rc(int b, int& R, int& C) { const int st = b / 1024, sb = b % 1024, swz = sb ^ (((sb >> 9) & 1) << 5); R = (st >> 1) * 16 + swz / 64; C = (st & 1) * 32 + (swz % 64) / 2; }
__host__ __device__ __forceinline__ int perm32(int rho) { const int n = rho >> 4, i = rho & 15; return 8 * (i >> 2) + 4 * n + (i & 3); }

struct Unit { const char* A; const char* B; int pm, pn; };
struct Gemm { int lda, ldb, K; };

template <class Epi, class Sched>
__device__ __forceinline__ void gemm_phase(LAS unsigned char* lds, const Gemm g, const Sched& S, const Epi& E) {
    int tid = threadIdx.x; asm volatile("" : "+v"(tid));
    const int wid = __builtin_amdgcn_readfirstlane(tid >> 6), lane = tid & 63, wr = wid >> 2, wc = wid & 3, fr = lane & 15, fq = lane >> 4;
    const int K = g.K, nt = K / BK;
    unsigned voffA[2], voffB[2];
#pragma unroll
    for (int i = 0; i < 2; ++i) { int R, C; stage_rc(tid * 16 + i * 8192, R, C); const int Rb = Epi::PERM ? ((R & ~31) + perm32(R & 31)) : R;
        voffA[i] = (unsigned)(R * g.lda + C) * 2u; voffB[i] = (unsigned)(Rb * g.ldb + C) * 2u; }
    const size_t kstep = (size_t)(BK * 2);
    const size_t hstepA = (size_t)HALF * g.lda * 2, hstepB = (size_t)HALF * g.ldb * 2;
    const unsigned ldsw = (unsigned)wid * 1024u;
    const int aoff = lds_byte(wr * 64 + fr, fq * 8), boff = lds_byte(wc * 32 + fr, fq * 8);
#define PG8_SA(b, h) (((b) * 2 + (h)) * HTB)
#define PG8_SB(b, h) ((4 + (b) * 2 + (h)) * HTB)
#define PG8_STAGE(bufoff, gbase, voff) do { _Pragma("unroll") for (int _i = 0; _i < 2; ++_i) \
        __builtin_amdgcn_global_load_lds((const unsigned*)((const char*)(gbase) + (voff)[_i]), (LAS unsigned*)(lds + (bufoff) + ldsw + _i * 8192), 16, 0, 0); } while (0)
#define PG8_LDA(dst, b, h) do { _Pragma("unroll") for (int m = 0; m < 4; ++m) _Pragma("unroll") for (int k = 0; k < 2; ++k) dst[m][k] = *(const LAS bf16x8*)(lds + PG8_SA(b, h) + aoff + m * 2048 + k * 1024); } while (0)
#define PG8_LDB(dst, b, h) do { _Pragma("unroll") for (int n = 0; n < 2; ++n) _Pragma("unroll") for (int k = 0; k < 2; ++k) dst[n][k] = *(const LAS bf16x8*)(lds + PG8_SB(b, h) + boff + n * 2048 + k * 1024); } while (0)
#define PG8_MMA(ai, bj, At, Bt) do { __builtin_amdgcn_s_setprio(1); _Pragma("unroll") for (int m = 0; m < 4; ++m) _Pragma("unroll") for (int n = 0; n < 2; ++n) _Pragma("unroll") for (int k = 0; k < 2; ++k) \
        acc[ai][bj][m][n] = __builtin_amdgcn_mfma_f32_16x16x32_bf16(Bt[n][k], At[m][k], acc[ai][bj][m][n], 0, 0, 0); __builtin_amdgcn_s_setprio(0); } while (0)
#define PG8_WAIT_V(n) asm volatile("s_waitcnt vmcnt(" #n ")" ::: "memory")
#define PG8_WAIT_L(n) asm volatile("s_waitcnt lgkmcnt(" #n ")" ::: "memory")
#define PG8_BAR __builtin_amdgcn_s_barrier()
#define PG8_SCHED __builtin_amdgcn_sched_barrier(0)
    Unit cur, nxt; int ui = 0;
    if (!S.next(0, cur)) return;
    f32x4 acc[2][2][4][2];
#pragma unroll
    for (int a = 0; a < 2; ++a)
#pragma unroll
        for (int b = 0; b < 2; ++b)
#pragma unroll
            for (int m = 0; m < 4; ++m)
#pragma unroll
                for (int n = 0; n < 2; ++n) acc[a][b][m][n] = (f32x4){0.f, 0.f, 0.f, 0.f};
    bf16x8 At[4][2], B0[2][2], B1[2][2];
    typename Epi::Pre pre{};
    const char* cA = cur.A; const char* cB = cur.B;
    PG8_STAGE(PG8_SB(0, 0), cB, voffB); PG8_STAGE(PG8_SB(0, 1), cB + hstepB, voffB); PG8_STAGE(PG8_SA(0, 0), cA, voffA); PG8_STAGE(PG8_SA(0, 1), cA + hstepA, voffA);
    if (wr == 1) PG8_BAR;
    PG8_WAIT_V(2); PG8_BAR;
    PG8_STAGE(PG8_SB(1, 0), cB + kstep, voffB); PG8_STAGE(PG8_SA(1, 0), cA + kstep, voffA); PG8_STAGE(PG8_SB(1, 1), cB + hstepB + kstep, voffB);
    PG8_WAIT_V(6); PG8_BAR;
    for (;;) {
        const bool has_next = S.next(ui + 1, nxt);
        const char* nA = has_next ? nxt.A : cA; const char* nB = has_next ? nxt.B : cB;
        for (int t = 0; t < nt; t += 2) {
            const bool last = (t == nt - 2);
            if (Epi::EARLY && last) pre = E.prefetch(cur, wr, wc, fr, fq);
            const char* a1 = cA + (size_t)(t + 1) * kstep;
            const char* a2 = last ? nA : cA + (size_t)(t + 2) * kstep; const char* b2 = last ? nB : cB + (size_t)(t + 2) * kstep;
            const char* a3 = a2 + kstep; const char* b3 = b2 + kstep;
            PG8_LDB(B0, 0, 0); PG8_LDB(B1, 0, 1); PG8_SCHED; PG8_LDA(At, 0, 0); PG8_STAGE(PG8_SA(1, 1), a1 + hstepA, voffA);
            PG8_WAIT_V(8); PG8_WAIT_L(0); PG8_BAR; PG8_MMA(0, 0, At, B0); PG8_MMA(0, 1, At, B1); PG8_BAR; PG8_SCHED;
            PG8_LDA(At, 0, 1); PG8_STAGE(PG8_SB(0, 0), b2, voffB); PG8_STAGE(PG8_SB(0, 1), b2 + hstepB, voffB); PG8_STAGE(PG8_SA(0, 0), a2, voffA);
            PG8_WAIT_V(8); PG8_WAIT_L(0); PG8_BAR; PG8_MMA(1, 0, At, B0); PG8_MMA(1, 1, At, B1); PG8_BAR; PG8_SCHED;
            PG8_LDB(B0, 1, 0); PG8_LDB(B1, 1, 1); PG8_SCHED; PG8_LDA(At, 1, 0); PG8_STAGE(PG8_SA(0, 1), a2 + hstepA, voffA);
            PG8_WAIT_V(8); PG8_WAIT_L(0); PG8_BAR; PG8_MMA(0, 0, At, B0); PG8_MMA(0, 1, At, B1); PG8_BAR; PG8_SCHED;
            PG8_LDA(At, 1, 1); PG8_STAGE(PG8_SB(1, 0), b3, voffB); PG8_STAGE(PG8_SB(1, 1), b3 + hstepB, voffB); PG8_STAGE(PG8_SA(1, 0), a3, voffA);
            PG8_WAIT_V(8); PG8_WAIT_L(0); PG8_BAR; PG8_MMA(1, 0, At, B0); PG8_MMA(1, 1, At, B1); PG8_BAR; PG8_SCHED;
        }
        if (wr == 0) PG8_BAR;
        if (!Epi::EARLY) pre = E.prefetch(cur, wr, wc, fr, fq);
        E(acc, cur, pre, wr, wc, fr, fq);
        if (!has_next) break;
#pragma unroll
        for (int a = 0; a < 2; ++a)
#pragma unroll
            for (int b = 0; b < 2; ++b)
#pragma unroll
                for (int m = 0; m < 4; ++m)
#pragma unroll
                    for (int n = 0; n < 2; ++n) acc[a][b][m][n] = (f32x4){0.f, 0.f, 0.f, 0.f};
        cur = nxt; cA = nA; cB = nB; ++ui;
        if (wr == 1) PG8_BAR;
    }
    PG8_WAIT_V(0);
    PG8_BAR;
#undef PG8_SA
#undef PG8_SB
#undef PG8_STAGE
#undef PG8_LDA
#undef PG8_LDB
#undef PG8_MMA
}
}
namespace epi {
using pg8::Unit;
typedef f32x4 Acc[2][2][4][2];
#define EPI_BAR() do { asm volatile("s_waitcnt lgkmcnt(0)" ::: "memory"); __builtin_amdgcn_s_barrier(); asm volatile("" ::: "memory"); } while (0)

__device__ __forceinline__ u32x4 pack8(const f32x4 a, const f32x4 b) { u32x4 w; w.x = cvt_pk_bf16(a[0], a[1]); w.y = cvt_pk_bf16(a[2], a[3]); w.z = cvt_pk_bf16(b[0], b[1]); w.w = cvt_pk_bf16(b[2], b[3]); return w; }
__device__ __forceinline__ u32x2 pack4(const f32x4 a) { u32x2 w; w.x = cvt_pk_bf16(a[0], a[1]); w.y = cvt_pk_bf16(a[2], a[3]); return w; }
__device__ __forceinline__ int row_pos(int row) { return row < MP ? (row & (SEQ - 1)) : PAST + ((row - MP) & (DECT - 1)); }
__device__ __forceinline__ f32x4 oth4(const f32x4 v, int odd) { f32x4 r; r[0] = other16(v[0], odd); r[1] = other16(v[1], odd); r[2] = other16(v[2], odd); r[3] = other16(v[3], odd); return r; }
__device__ __forceinline__ void store8_f32(float* p  , const f32x4 v0, const f32x4 v1, int fq) {
    f32x4 x, y;
#pragma unroll
    for (int j = 0; j < 4; ++j) { auto r = __builtin_amdgcn_permlane16_swap(__float_as_uint(v0[j]), __float_as_uint(v1[j]), false, false); x[j] = __uint_as_float(r[0]); y[j] = __uint_as_float(r[1]); }
    float* q = p + 16 * (fq >> 1) + 4 * (fq & 1);
    __builtin_nontemporal_store(x, (f32x4*)q); __builtin_nontemporal_store(y, (f32x4*)(q + 8));
}
struct PreNone {};
struct Pre8 { float v[8]; };
__device__ __forceinline__ Pre8 load8rows(const float* __restrict__ p, int row0) {
    Pre8 r;
#pragma unroll
    for (int i = 0; i < 8; ++i) r.v[i] = p[row0 + (i >> 2) * 128 + (i & 3) * 16];
    return r;
}
__device__ __forceinline__ void rope_cs(int pos, int n, f32x4& c, f32x4& s) {
    const float fp = (float)pos;
    const f32x4 k = n == 0 ? (f32x4){1.5915494309e-01f, 3.0863763405e-02f, 5.9851857127e-03f, 1.1606636412e-03f} : (f32x4){2.2507907904e-04f, 4.3647952793e-05f, 8.4643308082e-06f, 1.6414262628e-06f};
#pragma unroll
    for (int j = 0; j < 4; ++j) { const float r = __builtin_amdgcn_fractf(fp * k[j]); c[j] = __builtin_amdgcn_cosf(r); s[j] = __builtin_amdgcn_sinf(r); }
}

struct EpiInProj {
    static constexpr bool PERM = true, EARLY = true;
    typedef Pre8 Pre;
    const float* ssq;
    bf16_t* p1;
    float* out;
    __device__ __forceinline__ Pre prefetch(const Unit& u, int wr, int wc, int fr, int fq) const { return load8rows(ssq, u.pm * 256 + wr * 64 + fr); }
    __device__ __forceinline__ void operator()(Acc& acc, const Unit& u, const Pre& pre, int wr, int wc, int fr, int fq) const {
        const int pn = u.pn, row0 = u.pm * 256 + wr * 64 + fr;
        const int cl = 32 * wc + 8 * fq;
#pragma unroll
        for (int ai = 0; ai < 2; ++ai)
#pragma unroll
            for (int m = 0; m < 4; ++m) {
                const int row = row0 + ai * 128 + m * 16;
                const float rs = rsqrtf(pre.v[ai * 4 + m] * (1.0f / DM) + EPS);
                bf16_t* prow = p1 + (size_t)row * P1W;
                if (pn < 4) {
                    f32x4 c0, c1, s0, s1; const int pos = row_pos(row);
                    if ((wc & 1) == 0) { rope_cs(pos, 0, c0, s0); rope_cs(pos, 1, c1, s1); }
                    float* orow = (pn >= 2) ? (row < MP ? out + O_KP + (size_t)row * 512 : out + O_KS + (size_t)(row - MP) * 512) : nullptr;
#pragma unroll
                    for (int bj = 0; bj < 2; ++bj) {
                        f32x4 v0 = acc[ai][bj][m][0] * rs, v1 = acc[ai][bj][m][1] * rs;
                        if ((wc & 1) == 0) {
                            const f32x4 o0 = oth4(v0, fq & 1), o1 = oth4(v1, fq & 1);
                            if (fq == 0) { v0 = v0 * c0 - o0 * s0; v1 = v1 * c1 - o1 * s1; }
                            else if (fq == 1) { v0 = v0 * c0 + o0 * s0; v1 = v1 * c1 + o1 * s1; }
                        }
                        const int c = (pn & 1) * 256 + bj * 128 + cl;
                        if (pn >= 2 && u.pm >= NTILE_P) store8_f32(orow + c - 8 * fq, v0, v1, fq);
                        *(u32x4*)(prow + (pn >> 1) * 512 + c) = pack8(v0, v1);
                    }
                } else if (pn < 6) {
                    float* orow = row < MP ? out + O_VP + (size_t)row * 512 : out + O_VS + (size_t)(row - MP) * 512;
#pragma unroll
                    for (int bj = 0; bj < 2; ++bj) {
                        const f32x4 v0 = acc[ai][bj][m][0] * rs, v1 = acc[ai][bj][m][1] * rs;
                        const int c = (pn & 1) * 256 + bj * 128 + cl;
                        if (u.pm >= NTILE_P) store8_f32(orow + c - 8 * fq, v0, v1, fq);
                        *(u32x4*)(prow + 1024 + c) = pack8(v0, v1);
                    }
                } else if (pn < 8) {
#pragma unroll
                    for (int bj = 0; bj < 2; ++bj) {
                        const f32x4 v0 = acc[ai][bj][m][0] * rs, v1 = acc[ai][bj][m][1] * rs;
                        const int c = (pn & 1) * 256 + bj * 128 + cl;
                        *(u32x4*)(prow + 1536 + c) = pack8(v0, v1);
                    }
                } else {
                    const float rs2 = rs * rs;
                    const f32x4 v0 = acc[ai][0][m][0] * acc[ai][1][m][0] * rs2, v1 = acc[ai][0][m][1] * acc[ai][1][m][1] * rs2;
                    const int c = (pn - 8) * 128 + cl;
                    *(u32x4*)(prow + 2048 + c) = pack8(v0, v1);
                    if (row < MP) { const int t = row & (SEQ - 1); if (t >= SEQ - 2) { float* o = out + O_SCP + ((size_t)(row >> 11) * 2 + (t - (SEQ - 2))) * CW + c; *(f32x4*)o = v0; *(f32x4*)(o + 4) = v1; } }
                    else { const int t = (row - MP) & (DECT - 1); if (t >= DECT - 2) { float* o = out + O_SCS + ((size_t)((row - MP) >> 4) * 2 + (t - (DECT - 2))) * CW + c; *(f32x4*)o = v0; *(f32x4*)(o + 4) = v1; } }
                }
            }
    }
};

struct EpiMemKV {
    static constexpr bool PERM = true, EARLY = true;
    typedef Pre8 Pre;
    const float* ssq; bf16_t* mk; bf16_t* mv; float* out;
    __device__ __forceinline__ Pre prefetch(const Unit& u, int wr, int wc, int fr, int fq) const { return load8rows(ssq, u.pm * 256 + wr * 64 + fr); }
    __device__ __forceinline__ void operator()(Acc& acc, const Unit& u, const Pre& pre, int wr, int wc, int fr, int fq) const {
        const int pn = u.pn, row0 = u.pm * 256 + wr * 64 + fr, cl = 32 * wc + 8 * fq;
        float* ob = out + (pn < 4 ? O_MK : O_MV); bf16_t* bb = pn < 4 ? mk : mv;
#pragma unroll
        for (int ai = 0; ai < 2; ++ai)
#pragma unroll
            for (int m = 0; m < 4; ++m) {
                const int row = row0 + ai * 128 + m * 16;
                const float rs = rsqrtf(pre.v[ai * 4 + m] * (1.0f / DM) + EPS);
#pragma unroll
                for (int bj = 0; bj < 2; ++bj) {
                    const f32x4 v0 = acc[ai][bj][m][0] * rs, v1 = acc[ai][bj][m][1] * rs;
                    const int c = (pn & 3) * 256 + bj * 128 + cl;
                    *(u32x4*)(bb + (size_t)row * DM + c) = pack8(v0, v1);
                }
            }
    }
};

struct EpiResidual {
    static constexpr bool PERM = true, EARLY = false;
    typedef PreNone Pre;
    bf16_t* XB; float* ssp;
    __device__ __forceinline__ Pre prefetch(const Unit&, int, int, int, int) const { return Pre{}; }
    __device__ __forceinline__ void operator()(Acc& acc, const Unit& u, const Pre&, int wr, int wc, int fr, int fq) const {
        const int row0 = u.pm * 256 + wr * 64 + fr, col0 = u.pn * 256 + wc * 32 + 8 * fq;
        bf16_t* xb = XB + (size_t)row0 * DM + col0;
        u32x4 old[8][2];
#pragma unroll
        for (int g = 0; g < 8; ++g)
#pragma unroll
            for (int bj = 0; bj < 2; ++bj) old[g][bj] = *(const u32x4*)(xb + (size_t)((g >> 2) * 128 + (g & 3) * 16) * DM + bj * 128);
#pragma unroll
        for (int g = 0; g < 8; ++g) {
            const int ai = g >> 2, m = g & 3, row = row0 + ai * 128 + m * 16; float ss = 0.f;
#pragma unroll
            for (int bj = 0; bj < 2; ++bj) {
                const u32x4 o = old[g][bj]; f32x4 v0, v1;
                v0[0] = __uint_as_float(o.x << 16) + acc[ai][bj][m][0][0]; v0[1] = __uint_as_float(o.x & 0xffff0000u) + acc[ai][bj][m][0][1]; v0[2] = __uint_as_float(o.y << 16) + acc[ai][bj][m][0][2]; v0[3] = __uint_as_float(o.y & 0xffff0000u) + acc[ai][bj][m][0][3];
                v1[0] = __uint_as_float(o.z << 16) + acc[ai][bj][m][1][0]; v1[1] = __uint_as_float(o.z & 0xffff0000u) + acc[ai][bj][m][1][1]; v1[2] = __uint_as_float(o.w << 16) + acc[ai][bj][m][1][2]; v1[3] = __uint_as_float(o.w & 0xffff0000u) + acc[ai][bj][m][1][3];
                ss += ((v0[0] * v0[0] + v0[1] * v0[1]) + (v0[2] * v0[2] + v0[3] * v0[3])) + ((v1[0] * v1[0] + v1[1] * v1[1]) + (v1[2] * v1[2] + v1[3] * v1[3]));
                *(u32x4*)(xb + (size_t)(ai * 128 + m * 16) * DM + bj * 128) = pack8(v0, v1);
            }
            ss = xor32_sum(xor16_sum(ss));
            if (fq == 0) ssp[(size_t)row * 16 + u.pn * 4 + wc] = ss;
        }
    }
};
struct EpiResidualOut {
    static constexpr bool PERM = false, EARLY = false;
    typedef PreNone Pre;
    const bf16_t* XB; float* X; float* ssp;
    __device__ __forceinline__ Pre prefetch(const Unit&, int, int, int, int) const { return Pre{}; }
    __device__ __forceinline__ void operator()(Acc& acc, const Unit& u, const Pre&, int wr, int wc, int fr, int fq) const {
        const int row0 = u.pm * 256 + wr * 64 + fr, col0 = u.pn * 256 + wc * 32 + 4 * fq;
        const bf16_t* xb = XB + (size_t)row0 * DM + col0;
        u32x2 old[8][2][2];
#pragma unroll
        for (int g = 0; g < 8; ++g)
#pragma unroll
            for (int bj = 0; bj < 2; ++bj)
#pragma unroll
                for (int n = 0; n < 2; ++n) old[g][bj][n] = *(const u32x2*)(xb + (size_t)((g >> 2) * 128 + (g & 3) * 16) * DM + bj * 128 + n * 16);
#pragma unroll
        for (int g = 0; g < 8; ++g) {
            const int ai = g >> 2, m = g & 3, row = row0 + ai * 128 + m * 16; float* xrow = X + (size_t)row * DM + col0; float ss = 0.f;
#pragma unroll
            for (int bj = 0; bj < 2; ++bj)
#pragma unroll
                for (int n = 0; n < 2; ++n) {
                    const u32x2 o = old[g][bj][n]; f32x4 v;
                    v[0] = __uint_as_float(o.x << 16) + acc[ai][bj][m][n][0]; v[1] = __uint_as_float(o.x & 0xffff0000u) + acc[ai][bj][m][n][1]; v[2] = __uint_as_float(o.y << 16) + acc[ai][bj][m][n][2]; v[3] = __uint_as_float(o.y & 0xffff0000u) + acc[ai][bj][m][n][3];
                    ss += (v[0] * v[0] + v[1] * v[1]) + (v[2] * v[2] + v[3] * v[3]);
                    *(f32x4*)(xrow + bj * 128 + n * 16) = v;
                }
            ss = xor32_sum(xor16_sum(ss));
            if (fq == 0) ssp[(size_t)row * 16 + u.pn * 4 + wc] = ss;
        }
    }
};
__device__ __forceinline__ float rstd16(const float* ssp, int row) {
    const f32x4* p = (const f32x4*)(ssp + (size_t)row * 16); const f32x4 a = p[0], b = p[1], c = p[2], d = p[3];
    const float s = ((a[0] + a[1]) + (a[2] + a[3])) + ((b[0] + b[1]) + (b[2] + b[3])) + ((c[0] + c[1]) + (c[2] + c[3])) + ((d[0] + d[1]) + (d[2] + d[3]));
    return rsqrtf(s * (1.0f / DM) + EPS);
}
struct EpiScaleBf16 {
    static constexpr bool PERM = true, EARLY = true;
    typedef Pre8 Pre;
    const float* rs; bf16_t* O; int ldo;
    __device__ __forceinline__ Pre prefetch(const Unit& u, int wr, int wc, int fr, int fq) const { return load8rows(rs, u.pm * 256 + wr * 64 + fr); }
    __device__ __forceinline__ void operator()(Acc& acc, const Unit& u, const Pre& pre, int wr, int wc, int fr, int fq) const {
        const int row0 = u.pm * 256 + wr * 64 + fr, col0 = u.pn * 256 + 32 * wc + 8 * fq;
#pragma unroll
        for (int ai = 0; ai < 2; ++ai)
#pragma unroll
            for (int m = 0; m < 4; ++m) {
                const int row = row0 + ai * 128 + m * 16; const float r = pre.v[ai * 4 + m];
#pragma unroll
                for (int bj = 0; bj < 2; ++bj) *(u32x4*)(O + (size_t)row * ldo + col0 + bj * 128) = pack8(acc[ai][bj][m][0] * r, acc[ai][bj][m][1] * r);
            }
    }
};
struct EpiXScores {
    static constexpr bool PERM = true, EARLY = false;
    typedef PreNone Pre;
    __device__ __forceinline__ Pre prefetch(const Unit&, int, int, int, int) const { return Pre{}; }
    bf16_t* P; float* lp; LAS float* red;
    __device__ __forceinline__ void operator()(Acc& acc, const Unit& u, const Pre&, int wr, int wc, int fr, int fq) const {
        constexpr float C = 0.0625f * 1.4426950408889634f;
        float mx[2][4];
#pragma unroll
        for (int ai = 0; ai < 2; ++ai)
#pragma unroll
            for (int m = 0; m < 4; ++m) {
                float a = -3.0e38f;
#pragma unroll
                for (int bj = 0; bj < 2; ++bj)
#pragma unroll
                    for (int n = 0; n < 2; ++n) { const f32x4 v = acc[ai][bj][m][n]; a = fmaxf(a, fmaxf(fmaxf(v[0], v[1]), fmaxf(v[2], v[3]))); }
                a = xor32_max(xor16_max(a));
                if (fq == 0) red[(ai * 128 + wr * 64 + m * 16 + fr) * 4 + wc] = a;
            }
        EPI_BAR();
#pragma unroll
        for (int ai = 0; ai < 2; ++ai)
#pragma unroll
            for (int m = 0; m < 4; ++m) { const f32x4 r = *(const LAS f32x4*)(red + (ai * 128 + wr * 64 + m * 16 + fr) * 4); mx[ai][m] = fmaxf(fmaxf(r[0], r[1]), fmaxf(r[2], r[3])); }
        const int row0 = u.pm * 256 + wr * 64 + fr, col0 = u.pn * 256 + 32 * wc + 8 * fq;
#pragma unroll
        for (int ai = 0; ai < 2; ++ai)
#pragma unroll
            for (int m = 0; m < 4; ++m) {
                const int row = row0 + ai * 128 + m * 16; const float mc = mx[ai][m] * C; float s = 0.f;
#pragma unroll
                for (int bj = 0; bj < 2; ++bj) {
#pragma unroll
                    for (int j = 0; j < 4; ++j) { acc[ai][bj][m][0][j] = __builtin_amdgcn_exp2f(acc[ai][bj][m][0][j] * C - mc); acc[ai][bj][m][1][j] = __builtin_amdgcn_exp2f(acc[ai][bj][m][1][j] * C - mc); }
                    const u32x4 w = pack8(acc[ai][bj][m][0], acc[ai][bj][m][1]);
                    s += (__uint_as_float(w.x << 16) + __uint_as_float(w.x & 0xffff0000u)) + (__uint_as_float(w.y << 16) + __uint_as_float(w.y & 0xffff0000u))
                       + (__uint_as_float(w.z << 16) + __uint_as_float(w.z & 0xffff0000u)) + (__uint_as_float(w.w << 16) + __uint_as_float(w.w & 0xffff0000u));
                    *(u32x4*)(P + (size_t)row * DM + col0 + bj * 128) = w;
                }
                s = xor32_sum(xor16_sum(s));
                if (fq == 0) lp[(size_t)row * 16 + u.pn * 4 + wc] = s;
                asm volatile("" ::: "memory");
            }
        EPI_BAR();
    }
};
struct EpiXPV {
    static constexpr bool PERM = true, EARLY = false;
    typedef PreNone Pre;
    __device__ __forceinline__ Pre prefetch(const Unit&, int, int, int, int) const { return Pre{}; }
    const float* lp; bf16_t* O;
    __device__ __forceinline__ void operator()(Acc& acc, const Unit& u, const Pre&, int wr, int wc, int fr, int fq) const {
        const int row0 = u.pm * 256 + wr * 64 + fr, col0 = u.pn * 256 + 32 * wc + 8 * fq;
#pragma unroll
        for (int ai = 0; ai < 2; ++ai)
#pragma unroll
            for (int m = 0; m < 4; ++m) {
                const int row = row0 + ai * 128 + m * 16; const f32x4 l4 = *(const f32x4*)(lp + (size_t)row * 16 + u.pn * 4);
                const float rl = 1.0f / ((l4[0] + l4[1]) + (l4[2] + l4[3]));
#pragma unroll
                for (int bj = 0; bj < 2; ++bj) *(u32x4*)(O + (size_t)row * DM + col0 + bj * 128) = pack8(acc[ai][bj][m][0] * rl, acc[ai][bj][m][1] * rl);
            }
    }
};
struct EpiUpGate {
    static constexpr bool PERM = true, EARLY = false;
    typedef Pre8 Pre;
    const float* rs; const float* wconv;
    const float* state;
    bf16_t* H; float* out;
    float* uh; float* u01; float* g01;
    LAS float* tail;
    __device__ __forceinline__ Pre prefetch(const Unit& u, int wr, int wc, int fr, int fq) const { return load8rows(rs, u.pm * 256 + wr * 64 + fr); }
    __device__ __forceinline__ void operator()(Acc& acc, const Unit& u, const Pre& pre, int wr, int wc, int fr, int fq) const {
        const int pm = u.pm, pn = u.pn, row0 = pm * 256 + wr * 64 + fr, cl = 32 * wc + 8 * fq, gc = pn * 128 + cl;
        const bool sample = pm >= NTILE_P;
        const f32x4 w00 = *(const f32x4*)(wconv + gc), w01 = *(const f32x4*)(wconv + gc + 4), w10 = *(const f32x4*)(wconv + DFF + gc), w11 = *(const f32x4*)(wconv + DFF + gc + 4),
                    w20 = *(const f32x4*)(wconv + 2 * DFF + gc), w21 = *(const f32x4*)(wconv + 2 * DFF + gc + 4);
#pragma unroll
        for (int ai = 0; ai < 2; ++ai)
#pragma unroll
            for (int m = 0; m < 4; ++m) {
                const int g = ai * 8 + wr * 4 + m; const float r = pre.v[ai * 4 + m];
#pragma unroll
                for (int bj = 0; bj < 2; ++bj)
#pragma unroll
                    for (int n = 0; n < 2; ++n) acc[ai][bj][m][n] *= r;
                if (fr >= 14) {
                    LAS float* t = tail + (g * 2 + (fr - 14)) * 128 + cl; *(LAS f32x4*)t = acc[ai][0][m][0]; *(LAS f32x4*)(t + 4) = acc[ai][0][m][1];
                    if (sample) { float* o = out + O_FFS + ((size_t)((pm - NTILE_P) * 16 + g) * 2 + (fr - 14)) * DFF + gc; *(f32x4*)o = acc[ai][0][m][0]; *(f32x4*)(o + 4) = acc[ai][0][m][1]; }
                    else if (g == 15) {
                        float* o = uh + ((size_t)pm * 2 + (fr - 14)) * DFF + gc; *(f32x4*)o = acc[ai][0][m][0]; *(f32x4*)(o + 4) = acc[ai][0][m][1];
                        if ((pm & 7) == 7) { float* q = out + O_FFP + ((size_t)(pm >> 3) * 2 + (fr - 14)) * DFF + gc; *(f32x4*)q = acc[ai][0][m][0]; *(f32x4*)(q + 4) = acc[ai][0][m][1]; }
                    }
                }
                if (!sample && g == 0 && fr < 2) {
                    float* o = u01 + ((size_t)pm * 2 + fr) * DFF + gc; *(f32x4*)o = acc[ai][0][m][0]; *(f32x4*)(o + 4) = acc[ai][0][m][1];
                    float* q = g01 + ((size_t)pm * 2 + fr) * DFF + gc; *(f32x4*)q = acc[ai][1][m][0]; *(f32x4*)(q + 4) = acc[ai][1][m][1];
                }
            }
        EPI_BAR();
#pragma unroll
        for (int ai = 0; ai < 2; ++ai)
#pragma unroll
            for (int m = 0; m < 4; ++m) {
                const int row = row0 + ai * 128 + m * 16, g = ai * 8 + wr * 4 + m;
                f32x4 h1[2] = {(f32x4){0.f, 0.f, 0.f, 0.f}, (f32x4){0.f, 0.f, 0.f, 0.f}}, h2[2] = {(f32x4){0.f, 0.f, 0.f, 0.f}, (f32x4){0.f, 0.f, 0.f, 0.f}};
                if (fr < 2) {
                    if (sample) { const float* s = state + (size_t)((pm - NTILE_P) * 16 + g) * 2 * DFF + gc; h2[0] = *(const f32x4*)(s + fr * DFF); h2[1] = *(const f32x4*)(s + fr * DFF + 4); h1[0] = *(const f32x4*)(s + DFF); h1[1] = *(const f32x4*)(s + DFF + 4); }
                    else if (g > 0) { const LAS float* t = tail + ((g - 1) * 2) * 128 + cl; h2[0] = *(const LAS f32x4*)(t + fr * 128); h2[1] = *(const LAS f32x4*)(t + fr * 128 + 4); h1[0] = *(const LAS f32x4*)(t + 128); h1[1] = *(const LAS f32x4*)(t + 132); }
                }
                f32x4 hv[2];
#pragma unroll
                for (int n = 0; n < 2; ++n) {
                    const f32x4 uc = acc[ai][0][m][n]; f32x4 p1, p2;
#pragma unroll
                    for (int j = 0; j < 4; ++j) {
                        p1[j] = __int_as_float(__builtin_amdgcn_update_dpp(__float_as_int(h1[n][j]), __float_as_int(uc[j]), 0x111, 0xf, 0xf, false));
                        p2[j] = __int_as_float(__builtin_amdgcn_update_dpp(__float_as_int(h2[n][j]), __float_as_int(uc[j]), 0x112, 0xf, 0xf, false)); }
                    const f32x4 y = (n == 0 ? w00 : w01) * p2 + (n == 0 ? w10 : w11) * p1 + (n == 0 ? w20 : w21) * uc;
                    const f32x4 t = y * (-1.4426950408889634f); f32x4 d;
#pragma unroll
                    for (int j = 0; j < 4; ++j) d[j] = __builtin_amdgcn_exp2f(t[j]);
                    d = d + 1.0f;
#pragma unroll
                    for (int j = 0; j < 4; ++j) d[j] = __builtin_amdgcn_rcpf(d[j]);
                    hv[n] = (y * d) * acc[ai][1][m][n];
                }
                *(u32x4*)(H + (size_t)row * DFF + gc) = pack8(hv[0], hv[1]);
            }
        EPI_BAR();
    }
};
struct EpiPartialF32 {
    static constexpr bool PERM = false, EARLY = false;
    typedef PreNone Pre;
    float* S;
    __device__ __forceinline__ Pre prefetch(const Unit&, int, int, int, int) const { return Pre{}; }
    __device__ __forceinline__ void operator()(Acc& acc, const Unit& u, const Pre&, int wr, int wc, int fr, int fq) const {
        const int kh = u.pn >> 4, pn = u.pn & 15, row0 = (u.pm - NTILE_P) * 256 + wr * 64 + fr, col0 = pn * 256 + wc * 32 + 4 * fq;
        float* b = S + (size_t)kh * MS * DM + (size_t)row0 * DM + col0;
#pragma unroll
        for (int ai = 0; ai < 2; ++ai)
#pragma unroll
            for (int m = 0; m < 4; ++m)
#pragma unroll
                for (int bj = 0; bj < 2; ++bj)
#pragma unroll
                    for (int n = 0; n < 2; ++n) *(f32x4*)(b + (size_t)(ai * 128 + m * 16) * DM + bj * 128 + n * 16) = acc[ai][bj][m][n];
    }
};
}
namespace dattn {
constexpr int NW = 8, QBLK = 32, KVBLK = 64;
constexpr float SCALE = 0.125f, THR = 8.f;
constexpr int SHM_V = KVBLK * 128 * 2, SHM_K = KVBLK * 128 * 2, SHM_ATTN = 2 * SHM_V + 2 * SHM_K + NW * 64 * 4;
#define KSWZ(row, colB) ((row) * 256 + ((colB) ^ (((row) & 7) << 4)))
#define SBAR() __builtin_amdgcn_sched_barrier(0)
__device__ __forceinline__ int crow(int r, int hi) { return (r & 3) + 8 * (r >> 2) + 4 * hi; }
__device__ __forceinline__ void partialSM(f32x16& p0, f32x16& p1, float& m_reg, float& mn, float& alpha) {
  constexpr float C = SCALE * 1.4426950408889634f;
  float pmax = p0[0];
#pragma unroll
  for (int r = 1; r < 16; ++r) pmax = fmaxf(pmax, p0[r]);
#pragma unroll
  for (int r = 0; r < 16; ++r) pmax = fmaxf(pmax, p1[r]);
  { auto rr = __builtin_amdgcn_permlane32_swap(__float_as_uint(pmax), __float_as_uint(pmax), false, false);
    pmax = fmaxf(__uint_as_float(rr[0]), __uint_as_float(rr[1])); }
  if (__builtin_expect(__all(pmax - m_reg <= THR / SCALE), 1)) { mn = m_reg; alpha = 1.f; }
  else { mn = fmaxf(m_reg, pmax); alpha = __builtin_amdgcn_exp2f((m_reg - mn) * C); m_reg = mn; }
  const float mnC = -mn * C;
#pragma unroll
  for (int r = 0; r < 16; ++r) p0[r] = fmaf(p0[r], C, mnC);
#pragma unroll
  for (int r = 0; r < 16; ++r) p1[r] = fmaf(p1[r], C, mnC);
#pragma unroll
  for (int r = 0; r < 16; ++r) p0[r] = __builtin_amdgcn_exp2f(p0[r]);
}
__device__ __forceinline__ void finishSM(f32x16& p0, f32x16& p1, float alpha, float& l_reg, bf16x8& pa0, bf16x8& pa1, bf16x8& pa2, bf16x8& pa3) {
#pragma unroll
  for (int r = 0; r < 16; ++r) p1[r] = __builtin_amdgcn_exp2f(p1[r]);
  float ps = 0;
#pragma unroll
  for (int r = 0; r < 16; ++r) ps += p0[r];
#pragma unroll
  for (int r = 0; r < 16; ++r) ps += p1[r];
  { auto rr = __builtin_amdgcn_permlane32_swap(__float_as_uint(ps), __float_as_uint(ps), false, false);
    ps = __uint_as_float(rr[0]) + __uint_as_float(rr[1]); }
  l_reg = l_reg * alpha + ps;
#define PK4(P, BASE, OUT) do { unsigned a0 = cvt_pk_bf16(P[BASE + 0], P[BASE + 1]), a1 = cvt_pk_bf16(P[BASE + 2], P[BASE + 3]);   \
    unsigned b0 = cvt_pk_bf16(P[BASE + 4], P[BASE + 5]), b1 = cvt_pk_bf16(P[BASE + 6], P[BASE + 7]);                              \
    auto r0 = __builtin_amdgcn_permlane32_swap(a0, b0, false, false); auto r1 = __builtin_amdgcn_permlane32_swap(a1, b1, false, false); \
    u32x4 w = {r0[0], r1[0], r0[1], r1[1]}; OUT = *reinterpret_cast<bf16x8*>(&w); } while (0)
  PK4(p0, 0, pa0); PK4(p0, 8, pa1); PK4(p1, 0, pa2); PK4(p1, 8, pa3);
#undef PK4
}
__device__ __forceinline__ void qkt(f32x16& p0, f32x16& p1, const char* Ks, const bf16x8* qr, int r32, int hi, int mp) {
  p0 = f32x16{}; p1 = f32x16{};
#pragma unroll
  for (int d0 = 0; d0 < 4; ++d0) { const int cb = (mp * 64 + d0 * 16 + hi * 8) * 2;
    const bf16x8 b0 = *reinterpret_cast<const bf16x8*>(Ks + KSWZ(r32, cb));
    const bf16x8 b1 = *reinterpret_cast<const bf16x8*>(Ks + KSWZ(32 + r32, cb));
    p0 = __builtin_amdgcn_mfma_f32_32x32x16_bf16(b0, qr[d0], p0, 0, 0, 0);
    p1 = __builtin_amdgcn_mfma_f32_32x32x16_bf16(b1, qr[d0], p1, 0, 0, 0); }
}
__device__ __forceinline__ int v_st(int k, int c) { const int kk = (k & ~0xC) | ((k & 4) << 1) | ((k & 8) >> 1); return ((kk >> 3) * 4 + (c >> 5)) * 512 + ((kk & 7) * 32 + (c & 31)) * 2; }
__device__ __forceinline__ int v_rd_base(int lane) { return ((lane & 3) << 3) | (((lane >> 2) & 3) << 6) | (((lane >> 4) & 1) << 5) | (((lane >> 5) & 1) << 8); }
constexpr int v_rd_off(int d0, int ks, int half) { return d0 * 512 + ks * 4096 + half * 2048; }
template <int OFF> __device__ __forceinline__ s16x4 tr_read(int vb) {
  s16x4 r; asm volatile("ds_read_b64_tr_b16 %0, %1 offset:%2" : "=&v"(r) : "v"(vb), "i"(OFF) : "memory"); return r;
}
template <int D0> __device__ __forceinline__ void pv_one(f32x16& od, int vb, bf16x8 pa0, bf16x8 pa1, bf16x8 pa2, bf16x8 pa3) {
  const s16x4 l0 = tr_read<v_rd_off(D0, 0, 0)>(vb), h0 = tr_read<v_rd_off(D0, 0, 1)>(vb), l1 = tr_read<v_rd_off(D0, 1, 0)>(vb), h1 = tr_read<v_rd_off(D0, 1, 1)>(vb);
  const s16x4 l2 = tr_read<v_rd_off(D0, 2, 0)>(vb), h2 = tr_read<v_rd_off(D0, 2, 1)>(vb), l3 = tr_read<v_rd_off(D0, 3, 0)>(vb), h3 = tr_read<v_rd_off(D0, 3, 1)>(vb);
  asm volatile("s_waitcnt lgkmcnt(0)" ::: "memory"); SBAR();
#define PK(L, H) (bf16x8){L[0], L[1], L[2], L[3], H[0], H[1], H[2], H[3]}
  od = __builtin_amdgcn_mfma_f32_32x32x16_bf16(pa0, PK(l0, h0), od, 0, 0, 0);
  od = __builtin_amdgcn_mfma_f32_32x32x16_bf16(pa1, PK(l1, h1), od, 0, 0, 0);
  od = __builtin_amdgcn_mfma_f32_32x32x16_bf16(pa2, PK(l2, h2), od, 0, 0, 0);
  od = __builtin_amdgcn_mfma_f32_32x32x16_bf16(pa3, PK(l3, h3), od, 0, 0, 0);
#undef PK
}
__device__ __forceinline__ void pv_d0(f32x16* o, int vb, bf16x8 pa0, bf16x8 pa1, bf16x8 pa2, bf16x8 pa3) {
  pv_one<0>(o[0], vb, pa0, pa1, pa2, pa3); pv_one<1>(o[1], vb, pa0, pa1, pa2, pa3); pv_one<2>(o[2], vb, pa0, pa1, pa2, pa3); pv_one<3>(o[3], vb, pa0, pa1, pa2, pa3);
}

__device__ __forceinline__ void qkt3(f32x16& p0, f32x16& p1, const LAS char* Ks, const bf16x8* qr, int r32, int hi, int mp) {
  p0 = f32x16{}; p1 = f32x16{};
#pragma unroll
  for (int d0 = 0; d0 < 4; ++d0) { const int cb = (mp * 64 + d0 * 16 + hi * 8) * 2;
    const bf16x8 b0 = *reinterpret_cast<const LAS bf16x8*>(Ks + KSWZ(r32, cb));
    const bf16x8 b1 = *reinterpret_cast<const LAS bf16x8*>(Ks + KSWZ(32 + r32, cb));
    p0 = __builtin_amdgcn_mfma_f32_32x32x16_bf16(b0, qr[d0], p0, 0, 0, 0);
    p1 = __builtin_amdgcn_mfma_f32_32x32x16_bf16(b1, qr[d0], p1, 0, 0, 0); }
}
__device__ __forceinline__ void unit(int b, int h, int qb, const bf16_t* __restrict__ p1, bf16_t* __restrict__ A2, float lam, const float* __restrict__ gsub, LAS char* lds3) {
  int tid = threadIdx.x; asm volatile("" : "+v"(tid));
  const int wid = __builtin_amdgcn_readfirstlane(tid >> 6), lane = tid & 63, r32 = lane & 31, hi = lane >> 5, wq = wid & 3, mp = wid >> 2;
  LAS float* ws = (LAS float*)(lds3 + 131072) + wid * 64; LAS float* li_l = ws; LAS float* al_l = ws + 32;
  float m_reg = -1e30f, l_reg = 0; f32x16 o[4] = {}; bf16x8 qr[4];
  const size_t rowb = (size_t)b * SEQ;
  const char* Kh = (const char*)(p1 + rowb * P1W + 512 + h * 128); const char* Vh = (const char*)(p1 + rowb * P1W + 1024 + h * 128);
  unsigned koff[2], voff[2];
#pragma unroll
  for (int i = 0; i < 2; ++i) {
    const int krow = wid * 8 + i * 4 + (lane >> 4), kch = (lane & 15) ^ (krow & 7); koff[i] = (unsigned)(krow * P1W * 2 + kch * 16);
    const int sub = wid * 4 + i * 2 + (lane >> 5), kk = (sub >> 2) * 8 + ((lane & 31) >> 2), key = (kk & ~0xC) | ((kk & 4) << 1) | ((kk & 8) >> 1), c = (sub & 3) * 32 + (lane & 3) * 8;
    voff[i] = (unsigned)(key * P1W * 2 + c * 2);
  }
  const unsigned dmaw = (unsigned)wid * 2048u;
#define DMA(t, slot) do { const char* kb_ = Kh + (size_t)(t) * (KVBLK * P1W * 2); const char* vb_ = Vh + (size_t)(t) * (KVBLK * P1W * 2); _Pragma("unroll") for (int i_ = 0; i_ < 2; ++i_) { \
    __builtin_amdgcn_global_load_lds((const unsigned*)(kb_ + koff[i_]), (LAS unsigned*)(lds3 + (slot) * 32768 + dmaw + i_ * 1024), 16, 0, 0); \
    __builtin_amdgcn_global_load_lds((const unsigned*)(vb_ + voff[i_]), (LAS unsigned*)(lds3 + (slot) * 32768 + 16384 + dmaw + i_ * 1024), 16, 0, 0); } } while (0)
#define WAITV(n) asm volatile("s_waitcnt vmcnt(" #n ")" ::: "memory")
#define LBAR() do { asm volatile("s_waitcnt lgkmcnt(0)" ::: "memory"); __builtin_amdgcn_s_barrier(); asm volatile("" ::: "memory"); } while (0)
#define KS(t) (lds3 + ((t) & 3) * 32768)
#define VB(t) (vrd + ((t) & 3) * 32768)
  const int NT = 2 * qb + 2;
  const bool vis_last = (wq >= 2);
  DMA(0, 0); DMA(1, 1);
  const bf16_t* Qw = p1 + (rowb + qb * 128 + wq * QBLK + r32) * P1W + h * 128 + mp * 64 + hi * 8;
#pragma unroll
  for (int d0 = 0; d0 < 4; ++d0) qr[d0] = *reinterpret_cast<const bf16x8*>(Qw + d0 * 16);
  const int vrd = (int)(uintptr_t)lds3 + 16384 + v_rd_base(lane);
#define RESC(a) do { if (__any((a) < 1.f)) { if (hi == 0) al_l[r32] = (a); asm volatile("s_waitcnt lgkmcnt(0)" ::: "memory"); \
    _Pragma("unroll") for (int d = 0; d < 4; ++d) _Pragma("unroll") for (int r = 0; r < 16; ++r) o[d][r] *= al_l[crow(r, hi)]; } } while (0)
  f32x16 pA0, pA1, pB0, pB1; float mnA, mnB, alA, alB; bf16x8 pa0, pa1, pa2, pa3;
  WAITV(4); LBAR();
  if (2 < NT) DMA(2, 2);
  qkt3(pA0, pA1, KS(0), qr, r32, hi, mp); partialSM(pA0, pA1, m_reg, mnA, alA);
  for (int j = 1; j + 1 < NT; j += 2) {
    WAITV(4); LBAR(); DMA(j + 2, (j + 2) & 3);
    SBAR(); qkt3(pB0, pB1, KS(j), qr, r32, hi, mp);
    finishSM(pA0, pA1, alA, l_reg, pa0, pa1, pa2, pa3); SBAR();
    pv_d0(o, VB(j - 1), pa0, pa1, pa2, pa3); partialSM(pB0, pB1, m_reg, mnB, alB);
    RESC(alB);
    WAITV(4); LBAR(); if (j + 3 < NT) DMA(j + 3, (j + 3) & 3);
    SBAR(); qkt3(pA0, pA1, KS(j + 1), qr, r32, hi, mp);
    finishSM(pB0, pB1, alB, l_reg, pa0, pa1, pa2, pa3); SBAR();
    pv_d0(o, VB(j), pa0, pa1, pa2, pa3); partialSM(pA0, pA1, m_reg, mnA, alA);
    RESC(alA);
  }
  WAITV(0); LBAR();
  SBAR();
  if (vis_last) qkt3(pB0, pB1, KS(NT - 1), qr, r32, hi, mp);
  finishSM(pA0, pA1, alA, l_reg, pa0, pa1, pa2, pa3); SBAR();
  pv_d0(o, VB(NT - 2), pa0, pa1, pa2, pa3);
  if (vis_last) {
    partialSM(pB0, pB1, m_reg, mnB, alB);
    RESC(alB);
    finishSM(pB0, pB1, alB, l_reg, pa0, pa1, pa2, pa3); SBAR();
    pv_d0(o, VB(NT - 1), pa0, pa1, pa2, pa3);
  }
  if (hi == 0) li_l[r32] = l_reg; asm volatile("s_waitcnt lgkmcnt(0)" ::: "memory");
  float rli[16];
#pragma unroll
  for (int r = 0; r < 16; ++r) rli[r] = __builtin_amdgcn_rcpf(li_l[crow(r, hi)]);
  LBAR();
  LAS float* X = (LAS float*)lds3 + wq * (32 * 132);
  if (mp == 1) {
#pragma unroll
    for (int r = 0; r < 16; ++r) { const int orow = crow(r, hi);
#pragma unroll
      for (int d0 = 0; d0 < 4; ++d0) X[orow * 132 + d0 * 32 + r32] = o[d0][r] * rli[r]; }
  }
  LBAR();
  if (mp == 0) {
#pragma unroll
    for (int r = 0; r < 16; ++r) { const int orow = crow(r, hi);
#pragma unroll
      for (int d0 = 0; d0 < 4; ++d0) { LAS float* p = &X[orow * 132 + d0 * 32 + r32]; *p = o[d0][r] * rli[r] - lam * (*p); } }
    asm volatile("s_waitcnt lgkmcnt(0)" ::: "memory");
    const int row = lane >> 1, half = lane & 1; const LAS float* xr = X + row * 132 + half * 64;
    f32x4 v[16]; float ss = 0.f;
#pragma unroll
    for (int i = 0; i < 16; ++i) { v[i] = *(const LAS f32x4*)(xr + 4 * i); ss += (v[i][0] * v[i][0] + v[i][1] * v[i][1]) + (v[i][2] * v[i][2] + v[i][3] * v[i][3]); }
    ss += DPPF(ss, 0xB1);
    const float rs = rsqrtf(ss * (1.0f / 128.0f) + EPS) * (1.0f - LAM_INIT);
    bf16_t* orow = A2 + (rowb + qb * 128 + wq * QBLK + row) * DM + h * 128 + half * 64; const float* g = gsub + half * 64;
#pragma unroll
    for (int i = 0; i < 16; i += 2) { const f32x4 g0 = *(const f32x4*)(g + 4 * i), g1 = *(const f32x4*)(g + 4 * i + 4);
      *(u32x4*)(orow + 4 * i) = epi::pack8(v[i] * g0 * rs, v[i + 1] * g1 * rs); }
  }
  asm volatile("s_waitcnt vmcnt(0)" ::: "memory");
  LBAR();
#undef DMA
#undef WAITV
#undef LBAR
#undef KS
#undef VB
#undef RESC
}
#undef KSWZ
#undef SBAR
}
namespace misc {
constexpr int SK = PAST + DECT;
__device__ __forceinline__ void sample_attn_unit(int b, int h, int qh, const bf16_t* __restrict__ p1, const float* __restrict__ ck, const float* __restrict__ cv,
                                                 const float* __restrict__ nk, const float* __restrict__ nv, bf16_t* __restrict__ A2, float lam, const float* __restrict__ gsub, char* lds) {
  int tid = threadIdx.x; asm volatile("" : "+v"(tid)); const int lane = tid & 63, wid = tid >> 6;
  float* S = (float*)lds; float* red = (float*)(lds + 66560); float* q = (float*)(lds + 132096); float* st = (float*)(lds + 136192);
  for (int i = tid; i < 1024; i += 512) { const int mp = i >> 9, r = (i >> 6) & 7, d = i & 63;
    q[i] = bf2f(p1[(size_t)(MP + b * DECT + qh * 8 + r) * P1W + h * 128 + mp * 64 + d]); }
  __syncthreads();
  for (int it = tid; it < 2 * SK; it += 512) {
    const int mp = it / SK, key = it - mp * SK;
    const float* kp = key < PAST ? ck + (((size_t)b * PAST + key) * NH + h) * 128 + mp * 64 : nk + ((size_t)(b * DECT + key - PAST)) * 512 + h * 128 + mp * 64;
    float a[8] = {0.f, 0.f, 0.f, 0.f, 0.f, 0.f, 0.f, 0.f};
#pragma unroll 4
    for (int d = 0; d < 64; d += 4) { const f32x4 kv = *(const f32x4*)(kp + d);
#pragma unroll
      for (int r = 0; r < 8; ++r) { const f32x4 qv = *(const f32x4*)(q + (mp * 8 + r) * 64 + d); a[r] += (kv[0] * qv[0] + kv[1] * qv[1]) + (kv[2] * qv[2] + kv[3] * qv[3]); } }
#pragma unroll
    for (int r = 0; r < 8; ++r) S[(mp * 8 + r) * SK + key] = a[r] * 0.125f;
  }
  __syncthreads();
  for (int rr = 0; rr < 2; ++rr) { const int row = wid * 2 + rr; float* s = S + row * SK;
    float mx = -3.0e38f; for (int k = lane; k < SK; k += 64) mx = fmaxf(mx, s[k]); mx = wave_max(mx);
    float sum = 0.f; for (int k = lane; k < SK; k += 64) { const float e = __expf(s[k] - mx); s[k] = e; sum += e; } sum = wave_sum(sum);
    if (lane == 0) st[row] = 1.0f / sum; }
  __syncthreads();
  for (int i = tid; i < 8 * SK; i += 512) { const int r = i / SK, k = i - r * SK; S[r * SK + k] = S[r * SK + k] * st[r] - lam * S[(8 + r) * SK + k] * st[8 + r]; }
  __syncthreads();
  { const int eg = tid & 31, ks = tid >> 5; f32x4 o[8];
#pragma unroll
    for (int r = 0; r < 8; ++r) o[r] = (f32x4){0.f, 0.f, 0.f, 0.f};
    for (int key = ks; key < SK; key += 16) {
      const float* vp = key < PAST ? cv + (((size_t)b * PAST + key) * NH + h) * 128 + eg * 4 : nv + ((size_t)(b * DECT + key - PAST)) * 512 + h * 128 + eg * 4;
      const f32x4 vv = *(const f32x4*)vp;
#pragma unroll
      for (int r = 0; r < 8; ++r) o[r] += vv * S[r * SK + key]; }
#pragma unroll
    for (int r = 0; r < 8; ++r) *(f32x4*)(red + (ks * 8 + r) * 128 + eg * 4) = o[r]; }
  __syncthreads();
  { const int r = wid; float x0 = 0.f, x1 = 0.f;
#pragma unroll
    for (int ks = 0; ks < 16; ++ks) { const f32x2 t = *(const f32x2*)(red + (ks * 8 + r) * 128 + 2 * lane); x0 += t[0]; x1 += t[1]; }
    const float ss = wave_sum(x0 * x0 + x1 * x1); const float rs = rsqrtf(ss * (1.0f / 128.0f) + EPS) * (1.0f - LAM_INIT);
    const unsigned w = cvt_pk_bf16(x0 * rs * gsub[2 * lane], x1 * rs * gsub[2 * lane + 1]);
    *(unsigned*)(A2 + (size_t)(MP + b * DECT + qh * 8 + r) * DM + h * 128 + 2 * lane) = w; }
  __syncthreads();
}

__device__ __forceinline__ void sample_xattn_unit(int b, int h, const bf16_t* __restrict__ HQ, const float* __restrict__ mk, const float* __restrict__ mv, bf16_t* __restrict__ XO, char* lds) {
  int tid = threadIdx.x; asm volatile("" : "+v"(tid)); const int lane = tid & 63, wid = tid >> 6;
  float* q = (float*)lds; float* S = (float*)(lds + 16384);
  for (int i = tid; i < 16 * 256; i += 512) { const int r = i >> 8, d = i & 255; q[i] = bf2f(HQ[(size_t)(MP + b * DECT + r) * DM + h * 256 + d]); }
  __syncthreads();
  { const int key = tid >> 1, qh = tid & 1; const float* kp = mk + (((size_t)b * NMEM + key) * NH + h) * 256;
    float a[8] = {0.f, 0.f, 0.f, 0.f, 0.f, 0.f, 0.f, 0.f};
#pragma unroll 4
    for (int d = 0; d < 256; d += 4) { const f32x4 kv = *(const f32x4*)(kp + d);
#pragma unroll
      for (int r = 0; r < 8; ++r) { const f32x4 qv = *(const f32x4*)(q + (qh * 8 + r) * 256 + d); a[r] += (kv[0] * qv[0] + kv[1] * qv[1]) + (kv[2] * qv[2] + kv[3] * qv[3]); } }
#pragma unroll
    for (int r = 0; r < 8; ++r) S[(qh * 8 + r) * 256 + key] = a[r] * 0.0625f; }
  __syncthreads();
  for (int rr = 0; rr < 2; ++rr) { const int row = wid * 2 + rr; float* s = S + row * 256;
    float v[4]; float mx = -3.0e38f;
#pragma unroll
    for (int i = 0; i < 4; ++i) { v[i] = s[lane + 64 * i]; mx = fmaxf(mx, v[i]); } mx = wave_max(mx);
    float sum = 0.f;
#pragma unroll
    for (int i = 0; i < 4; ++i) { v[i] = __expf(v[i] - mx); sum += v[i]; } sum = wave_sum(sum); const float rl = 1.0f / sum;
#pragma unroll
    for (int i = 0; i < 4; ++i) s[lane + 64 * i] = v[i] * rl; }
  __syncthreads();
  { const int r = tid >> 5, dg = tid & 31; const float* vp = mv + ((size_t)b * NMEM * NH + h) * 256 + dg * 8; f32x4 o0 = {0.f, 0.f, 0.f, 0.f}, o1 = {0.f, 0.f, 0.f, 0.f};
    for (int key = 0; key < NMEM; ++key) { const float p = S[r * 256 + key]; const f32x4 a = *(const f32x4*)(vp + (size_t)key * NH * 256), c = *(const f32x4*)(vp + (size_t)key * NH * 256 + 4); o0 += a * p; o1 += c * p; }
    *(u32x4*)(XO + (size_t)(MP + b * DECT + r) * DM + h * 256 + dg * 8) = epi::pack8(o0, o1); }
  __syncthreads();
}

__device__ __forceinline__ void shortconv_item(int item, const bf16_t* __restrict__ p1, const float* __restrict__ wsc, const float* __restrict__ state, bf16_t* __restrict__ A2) {
  const int cgp = item & 63, chunk = item >> 6, c = cgp * 8, r0 = chunk * 64;
  float w0[8], w1[8], w2[8], um2[8], um1[8];
#pragma unroll
  for (int j = 0; j < 8; ++j) { w0[j] = wsc[c + j]; w1[j] = wsc[CW + c + j]; w2[j] = wsc[2 * CW + c + j]; um2[j] = 0.f; um1[j] = 0.f; }
  const bool sample = r0 >= MP;
  if (!sample && (r0 & (SEQ - 1)) != 0) {
    const u32x4 a = *(const u32x4*)(p1 + (size_t)(r0 - 2) * P1W + 2048 + c), bq = *(const u32x4*)(p1 + (size_t)(r0 - 1) * P1W + 2048 + c);
#pragma unroll
    for (int j = 0; j < 4; ++j) { um2[2 * j] = __uint_as_float(a[j] << 16); um2[2 * j + 1] = __uint_as_float(a[j] & 0xffff0000u); um1[2 * j] = __uint_as_float(bq[j] << 16); um1[2 * j + 1] = __uint_as_float(bq[j] & 0xffff0000u); }
  }
  for (int r = 0; r < 64; ++r) {
    const int row = r0 + r;
    if (sample && ((row - MP) & (DECT - 1)) == 0) { const float* s = state + (size_t)((row - MP) >> 4) * 2 * CW + c;
#pragma unroll
      for (int j = 0; j < 8; ++j) { um2[j] = s[j]; um1[j] = s[CW + j]; } }
    const u32x4 uu = *(const u32x4*)(p1 + (size_t)row * P1W + 2048 + c), gg = *(const u32x4*)(p1 + (size_t)row * P1W + 1536 + c);
    float y[8];
#pragma unroll
    for (int j = 0; j < 4; ++j) {
      const float u0 = __uint_as_float(uu[j] << 16), u1 = __uint_as_float(uu[j] & 0xffff0000u), g0 = __uint_as_float(gg[j] << 16), g1 = __uint_as_float(gg[j] & 0xffff0000u);
      y[2 * j] = g0 * (w0[2 * j] * um2[2 * j] + w1[2 * j] * um1[2 * j] + w2[2 * j] * u0); y[2 * j + 1] = g1 * (w0[2 * j + 1] * um2[2 * j + 1] + w1[2 * j + 1] * um1[2 * j + 1] + w2[2 * j + 1] * u1);
      um2[2 * j] = um1[2 * j]; um2[2 * j + 1] = um1[2 * j + 1]; um1[2 * j] = u0; um1[2 * j + 1] = u1; }
    u32x4 w; w.x = cvt_pk_bf16(y[0], y[1]); w.y = cvt_pk_bf16(y[2], y[3]); w.z = cvt_pk_bf16(y[4], y[5]); w.w = cvt_pk_bf16(y[6], y[7]);
    *(u32x4*)(A2 + (size_t)row * DM + 512 + c) = w;
  }
}

__device__ __forceinline__ void expand8(const bf16_t* __restrict__ src, float* __restrict__ dst) {
  const u32x4 a = __builtin_nontemporal_load((const u32x4*)src);
  const f32x4 lo = {__uint_as_float(a.x << 16), __uint_as_float(a.x & 0xffff0000u), __uint_as_float(a.y << 16), __uint_as_float(a.y & 0xffff0000u)};
  const f32x4 hi = {__uint_as_float(a.z << 16), __uint_as_float(a.z & 0xffff0000u), __uint_as_float(a.w << 16), __uint_as_float(a.w & 0xffff0000u)};
  __builtin_nontemporal_store(lo, (f32x4*)dst); __builtin_nontemporal_store(hi, (f32x4*)dst + 1);
}
__device__ __forceinline__ void expand_outputs(int gt, int GT, const bf16_t* __restrict__ p1, const bf16_t* __restrict__ mk, const bf16_t* __restrict__ mv, float* __restrict__ out) {
  constexpr long NKV = (long)MP * 64, NM = (long)MMEM * 128;
  for (long it = gt; it < 2 * NKV + 2 * NM; it += GT) {
    if (it < NKV) { const long r = it >> 6; const int c = (int)(it & 63) * 8; expand8(p1 + r * P1W + 512 + c, out + O_KP + r * 512 + c); }
    else if (it < 2 * NKV) { const long j = it - NKV, r = j >> 6; const int c = (int)(j & 63) * 8; expand8(p1 + r * P1W + 1024 + c, out + O_VP + r * 512 + c); }
    else if (it < 2 * NKV + NM) { const long j = it - 2 * NKV; expand8(mk + j * 8, out + O_MK + j * 8); }
    else { const long j = it - 2 * NKV - NM; expand8(mv + j * 8, out + O_MV + j * 8); }
  }
}
__device__ __forceinline__ void transpose_item(int item, const bf16_t* __restrict__ src, bf16_t* __restrict__ dst, LAS bf16_t* scr, int lane) {
  const int bi = item >> 4, bj = item & 15, r0 = bi * 64, c0 = bj * 64;
  for (int i = 0; i < 64; ++i) scr[i * 66 + lane] = src[(size_t)(r0 + i) * DM + c0 + lane];
  asm volatile("s_waitcnt lgkmcnt(0)" ::: "memory");
  for (int i = 0; i < 64; ++i) dst[(size_t)(c0 + i) * MMEM + r0 + lane] = scr[lane * 66 + i];
  asm volatile("s_waitcnt lgkmcnt(0)" ::: "memory");
}
}
constexpr size_t MiB = 1u << 20;
constexpr size_t WS_SSQ0 = 1 * MiB, WS_SSQM = WS_SSQ0 + 288 * 1024, WS_RS1 = WS_SSQ0 + 320 * 1024, WS_RS2 = WS_SSQ0 + 640 * 1024;
constexpr size_t WS_SSP1 = 2 * MiB, WS_SSP2 = 7 * MiB, WS_SSP3 = 12 * MiB, WS_L4 = 17 * MiB;
constexpr size_t WS_UH = 22 * MiB, WS_U01 = 28 * MiB, WS_G01 = 34 * MiB;
constexpr size_t WS_WIN = 40 * MiB, WS_WOUT = 46 * MiB, WS_WXQ = 48 * MiB, WS_WXKV = 50 * MiB, WS_WXO = 54 * MiB, WS_WUG = 56 * MiB, WS_WDN = 67 * MiB;
constexpr size_t WS_MN = 74 * MiB, WS_MK = 90 * MiB, WS_MV = 106 * MiB, WS_MVT = 122 * MiB;
constexpr size_t WS_XA = 138 * MiB;
constexpr size_t WS_P1 = 268 * MiB;
constexpr size_t WS_A2 = 591 * MiB;
constexpr size_t WS_SPART = WS_MN;
constexpr size_t WS_HQ = WS_P1, WS_P = WS_P1 + 129 * MiB, WS_H = WS_P1;
constexpr size_t WS_END = 720 * MiB;
static_assert(WS_XA + (size_t)RT * DM * 2 <= WS_P1 && WS_P1 + (size_t)RT * P1W * 2 <= WS_A2 && WS_A2 + (size_t)RT * DM * 2 <= WS_END && WS_H + (size_t)RT * DFF * 2 <= WS_END, "ws map");
static_assert(WS_WDN + (size_t)DM * DFF * 2 <= WS_MN && WS_WUG + (size_t)2 * DFF * DM * 2 <= WS_WDN && WS_G01 + (size_t)NTILE_P * 2 * DFF * 4 <= WS_WIN && WS_L4 + (size_t)RT * 16 <= WS_UH && WS_RS2 + (size_t)RT * 4 <= WS_SSP1, "ws map 2");

constexpr int RING_BYTES = 131072, XTRA_OFF = RING_BYTES, BARST_OFF = XTRA_OFF + 20480, LDS_BYTES = 155648;

struct SchedGrid {
    const char* A; const char* B; size_t a_tile, b_tile; int nM, nN, nwg, G, c;
    __device__ __forceinline__ void init(const void* A_, size_t a_tile_, const void* B_, size_t b_tile_, int nM_, int nN_, int G_, int c_) { A = (const char*)A_; B = (const char*)B_; a_tile = a_tile_; b_tile = b_tile_; nM = nM_; nN = nN_; nwg = nM * nN; G = G_; c = c_; }
    __device__ __forceinline__ bool next(int i, pg8::Unit& u) const {
        const long L = (long)i * G + c; if (L >= nwg) return false;
        int wgid = (int)L; { const int q = nwg / 8, r = nwg % 8, xcd = wgid % 8, off = wgid / 8; wgid = (xcd < r ? xcd * (q + 1) : r * (q + 1) + (xcd - r) * q) + off; }
        const int nig = 8 * nN, gid = wgid / nig, fm = gid * 8, gsz = (nM - fm) < 8 ? (nM - fm) : 8;
        u.pm = fm + ((wgid % nig) % gsz); u.pn = (wgid % nig) / gsz; u.A = A + (size_t)u.pm * a_tile; u.B = B + (size_t)u.pn * b_tile; return true;
    }
};
struct SchedX {
    const char* A; const char* B; int G, c; bool pv;
    __device__ __forceinline__ bool next(int i, pg8::Unit& u) const {
        const long L = (long)i * G + c; if (L >= 4 * NTILE_P) return false;
        const int h = (int)(L >> 8), idx = (int)(L & 255), pm = (idx & 7) * 32 + (idx >> 3), b = pm >> 3;
        u.pm = pm; u.pn = h; u.A = A + ((size_t)pm * 256 * DM + h * 256) * 2;
        u.B = pv ? B + ((size_t)h * 256 * MMEM + b * 256) * 2 : B + ((size_t)b * 256 * DM + h * 256) * 2; return true;
    }
};

struct SchedSplitK {
    const char* A; const char* B; int G, c;
    __device__ __forceinline__ bool next(int i, pg8::Unit& u) const {
        const long L = (long)i * G + c; if (L >= 16) return false;
        const int t = (int)(L >> 3), pn = (int)(L >> 1) & 3, kh = (int)L & 1;
        u.pm = NTILE_P + t; u.pn = pn | (kh << 4);
        u.A = A + ((size_t)(NTILE_P + t) * 256 * DFF + kh * (DFF / 2)) * 2; u.B = B + ((size_t)pn * 256 * DFF + kh * (DFF / 2)) * 2; return true;
    }
};

__device__ __forceinline__ void p0_transpose_item(const float* __restrict__ W, int ldw, int K, int kb, int ns, bf16_t* __restrict__ WT, int nd, const float* __restrict__ gain, LAS float* scr, int lane) {
    const int k0 = 64 * kb;
    float wv[32];
#pragma unroll
    for (int i = 0; i < 32; ++i) wv[i] = W[(size_t)(k0 + 2 * i + (lane >> 5)) * ldw + ns + (lane & 31)];
    if (gain) {
#pragma unroll
        for (int i = 0; i < 32; ++i) wv[i] *= gain[k0 + 2 * i + (lane >> 5)]; }
#pragma unroll
    for (int i = 0; i < 32; ++i) scr[(2 * i + (lane >> 5)) * 33 + (lane & 31)] = wv[i];
    asm volatile("s_waitcnt lgkmcnt(0)" ::: "memory");
    const int cc = lane & 7;
#pragma unroll
    for (int j = 0; j < 4; ++j) { const int n = (lane >> 3) + 8 * j; const LAS float* s = scr + (8 * cc) * 33 + n;
        u32x4 o; o.x = cvt_pk_bf16(s[0 * 33], s[1 * 33]); o.y = cvt_pk_bf16(s[2 * 33], s[3 * 33]); o.z = cvt_pk_bf16(s[4 * 33], s[5 * 33]); o.w = cvt_pk_bf16(s[6 * 33], s[7 * 33]);
        *(u32x4*)(WT + (size_t)(nd + n) * K + k0 + 8 * cc) = o; }
    asm volatile("s_waitcnt lgkmcnt(0)" ::: "memory");
}
__device__ __forceinline__ void rows2_to_bf16(const float* __restrict__ x0, const float* __restrict__ x1, bf16_t* __restrict__ o0, bf16_t* __restrict__ o1, float* q0, float* q1, int lane) {
    const f32x4* r0 = (const f32x4*)x0 + lane; const f32x4* r1 = (const f32x4*)x1 + lane; f32x4 v[4], w[4]; float s = 0.f, t = 0.f;
#pragma unroll
    for (int j = 0; j < 4; ++j) { v[j] = __builtin_nontemporal_load(r0 + 64 * j); w[j] = __builtin_nontemporal_load(r1 + 64 * j); }
#pragma unroll
    for (int j = 0; j < 4; ++j) { s += (v[j][0] * v[j][0] + v[j][1] * v[j][1]) + (v[j][2] * v[j][2] + v[j][3] * v[j][3]); t += (w[j][0] * w[j][0] + w[j][1] * w[j][1]) + (w[j][2] * w[j][2] + w[j][3] * w[j][3]); }
    s = wave_sum(s); t = wave_sum(t);
    u32x2* p0 = (u32x2*)o0 + lane; u32x2* p1 = (u32x2*)o1 + lane;
#pragma unroll
    for (int j = 0; j < 4; ++j) { p0[64 * j] = epi::pack4(v[j]); p1[64 * j] = epi::pack4(w[j]); }
    if (lane == 0) { *q0 = s; *q1 = t; }
}

#define XB_TMO      128
#define XB_XCNT(j)  (256  + 64 * (j))
#define XB_XSUB(j)  (1280 + 64 * (j))
#define XB_XGEN(j)  (2304 + 64 * (j))
#define XB_TOP      3328
#define XB_TOPGEN   3392
#define XCD_BAR_WORDS 3456
#define XB_SPIN_CAP (1u << 22)
__device__ __forceinline__ unsigned xb_ld(unsigned* p)              { return __hip_atomic_load(p, __ATOMIC_RELAXED, __HIP_MEMORY_SCOPE_AGENT); }
__device__ __forceinline__ unsigned xb_add(unsigned* p, unsigned v) { return __hip_atomic_fetch_add(p, v, __ATOMIC_RELAXED, __HIP_MEMORY_SCOPE_AGENT); }
__device__ __forceinline__ unsigned xb_xcc_id() { return (unsigned)__builtin_amdgcn_s_getreg((3 << 11) | 20) & 0xFu; }
#define XB_SPIN(cond, bar) do { unsigned _sp = 0; while (cond) { __builtin_amdgcn_s_sleep(1); \
    if ((++_sp & 255u) == 0u) { if (xb_ld(&(bar)[XB_TMO])) break; if (_sp > XB_SPIN_CAP) { atomicAdd(&(bar)[XB_TMO], 1u); break; } } } } while (0)
__device__ __forceinline__ void xcd_barrier_complete(unsigned* bar, unsigned x, unsigned& nloc, unsigned& nx) {
    const unsigned G = gridDim.x * gridDim.y * gridDim.z;
    unsigned sum, cnt, mine, sp = 0u;
    for (;;) {
        sum = 0u; cnt = 0u; mine = 0u;
#pragma unroll
        for (unsigned j = 0; j < 16; ++j) { const unsigned c = xb_ld(&bar[XB_XCNT(j)]); sum += c; cnt += (c > 0u) ? 1u : 0u; mine = (j == x) ? c : mine; }
        if (sum == G) break;
        __builtin_amdgcn_s_sleep(1);
        if ((++sp & 255u) == 0u) { if (xb_ld(&bar[XB_TMO])) break; if (sp > XB_SPIN_CAP) { atomicAdd(&bar[XB_TMO], 1u); break; } }
    }
    nloc = mine > 0u ? mine : 1u; nx = cnt > 0u ? cnt : 1u;
}
__device__ __forceinline__ void xcd_barrier(unsigned* bar, volatile LAS unsigned* st) {
    asm volatile("s_waitcnt vmcnt(0)" ::: "memory");
    __syncthreads();
    if (threadIdx.x == 0) {
        const unsigned x = xb_xcc_id();
        __builtin_amdgcn_s_waitcnt(0);
        unsigned nloc = st[0], nx = st[1];
        if (nloc == 0u) { xcd_barrier_complete(bar, x, nloc, nx); st[0] = nloc; st[1] = nx; }
        const unsigned old = xb_add(&bar[XB_XSUB(x)], 1u);
        const unsigned gen = old / nloc;
        if (old + 1u == (gen + 1u) * nloc) {
            __builtin_amdgcn_fence(__ATOMIC_RELEASE, "agent");
            asm volatile("s_waitcnt vmcnt(0)" ::: "memory");
            const unsigned og = xb_add(&bar[XB_TOP], 1u);
            const unsigned tg = og / nx;
            if (og + 1u == (tg + 1u) * nx) xb_add(&bar[XB_TOPGEN], 1u);
            else XB_SPIN(xb_ld(&bar[XB_TOPGEN]) == tg, bar);
            __builtin_amdgcn_fence(__ATOMIC_ACQUIRE, "agent");
            xb_add(&bar[XB_XGEN(x)], 1u);
            asm volatile("s_waitcnt vmcnt(0)" ::: "memory");
        } else {
            XB_SPIN(xb_ld(&bar[XB_XGEN(x)]) == gen, bar);
            __builtin_amdgcn_fence(__ATOMIC_ACQUIRE, "agent");
            asm volatile("s_waitcnt vmcnt(0)" ::: "memory");
        }
    }
    __syncthreads();
}

struct Args { const float* in[30]; float* out; unsigned char* ws; };
#define PHASE_ARGS() \
    const __attribute__((address_space(4))) Args* ap_ = (const __attribute__((address_space(4))) Args*)__builtin_amdgcn_kernarg_segment_ptr(); asm volatile("" : "+s"(ap_)); \
    unsigned char* const ws = ap_->ws; float* const out = ap_->out; (void)ws; (void)out; \
    int tid = threadIdx.x; asm volatile("" : "+v"(tid)); const int lane = tid & 63, wave = __builtin_amdgcn_readfirstlane(tid >> 6); (void)lane; (void)wave; \
    const int G = gridDim.x, bx = blockIdx.x, vcu = (G % 8 == 0) ? (bx % 8) * (G / 8) + bx / 8 : bx; (void)vcu; \
    const int gw = vcu * 8 + wave, NGW = G * 8; (void)gw; (void)NGW
#define IN(k) (ap_->in[k])
#define WSF(off) ((float*)(ws + (off)))
#define WSB(off) ((bf16_t*)(ws + (off)))

__global__ void __launch_bounds__(512, 2) fwd_kernel(Args a) {
    extern __shared__ __attribute__((aligned(16))) unsigned char lds_raw[];
    LAS unsigned char* const lds = (LAS unsigned char*)lds_raw;
    volatile LAS unsigned* const bst = (volatile LAS unsigned*)(lds + BARST_OFF);
    if (threadIdx.x < 2) bst[threadIdx.x] = 0u;
    __syncthreads();
    { PHASE_ARGS(); if (threadIdx.x == 0) (void)xb_add(&((unsigned*)ws)[XB_XCNT(xb_xcc_id())], 1u); }
#define GRID_BAR() do { PHASE_ARGS(); xcd_barrier((unsigned*)ws, bst); } while (0)

    {
        PHASE_ARGS();
        LAS float* scr = (LAS float*)(lds + wave * 16384);
        constexpr int I_IN = 16 * 96, I_SQ = 16 * 32, I_FF = 16 * 88, I_DN = 44 * 32;
        constexpr int NITEMS = I_IN + 5 * I_SQ + 2 * I_FF + I_DN;
        for (int it = gw; it < NITEMS; it += NGW) {
            int r = it;
            if (r < I_IN) { const int kb = r / 96, nb = r % 96, nd = nb * 32; int ns = nd;
                if (nd >= 2048) { const int T = (nd - 2048) >> 8, w = (nd - 2048) & 255; ns = (w < 128) ? 2048 + 128 * T + w : 2560 + 128 * T + (w - 128); }
                p0_transpose_item(IN(10), INP, DM, kb, ns, WSB(WS_WIN), nd, IN(9), scr, lane); continue; } r -= I_IN;
            if (r < I_SQ) { p0_transpose_item(IN(17), DM, DM, r / 32, (r % 32) * 32, WSB(WS_WOUT), (r % 32) * 32, nullptr, scr, lane); continue; } r -= I_SQ;
            if (r < I_SQ) { p0_transpose_item(IN(20), DM, DM, r / 32, (r % 32) * 32, WSB(WS_WXQ), (r % 32) * 32, IN(19), scr, lane); continue; } r -= I_SQ;
            if (r < I_SQ) { p0_transpose_item(IN(21), DM, DM, r / 32, (r % 32) * 32, WSB(WS_WXKV), (r % 32) * 32, IN(18), scr, lane); continue; } r -= I_SQ;
            if (r < I_SQ) { p0_transpose_item(IN(22), DM, DM, r / 32, (r % 32) * 32, WSB(WS_WXKV), 1024 + (r % 32) * 32, IN(18), scr, lane); continue; } r -= I_SQ;
            if (r < I_SQ) { p0_transpose_item(IN(23), DM, DM, r / 32, (r % 32) * 32, WSB(WS_WXO), (r % 32) * 32, nullptr, scr, lane); continue; } r -= I_SQ;
            if (r < I_FF) { const int kb = r / 88, nb = r % 88; p0_transpose_item(IN(25), DFF, DM, kb, nb * 32, WSB(WS_WUG), 256 * (nb >> 2) + (nb & 3) * 32, IN(24), scr, lane); continue; } r -= I_FF;
            if (r < I_FF) { const int kb = r / 88, nb = r % 88; p0_transpose_item(IN(26), DFF, DM, kb, nb * 32, WSB(WS_WUG), 256 * (nb >> 2) + 128 + (nb & 3) * 32, IN(24), scr, lane); continue; } r -= I_FF;
            p0_transpose_item(IN(28), DM, DFF, r / 32, (r % 32) * 32, WSB(WS_WDN), (r % 32) * 32, nullptr, scr, lane);
        }
        for (int m = 2 * gw; m < RT + MMEM; m += 2 * NGW) {
            const float* src; bf16_t* dst; float* sq;
            if (m < MP) { src = IN(0) + (size_t)m * DM; dst = WSB(WS_XA) + (size_t)m * DM; sq = WSF(WS_SSQ0) + m; }
            else if (m < RT) { src = IN(1) + (size_t)(m - MP) * DM; dst = WSB(WS_XA) + (size_t)m * DM; sq = WSF(WS_SSQ0) + m; }
            else { src = IN(8) + (size_t)(m - RT) * DM; dst = WSB(WS_MN) + (size_t)(m - RT) * DM; sq = WSF(WS_SSQM) + (m - RT); }
            rows2_to_bf16(src, src + DM, dst, dst + DM, sq, sq + 1, lane);
        }
    }
    GRID_BAR();

    {
        PHASE_ARGS();
        pg8::Gemm g{DM, DM, DM};
        { SchedGrid S; S.init(WSB(WS_XA), (size_t)256 * DM * 2, WSB(WS_WIN), (size_t)256 * DM * 2, NTILE, INP / 256, G, bx);
          epi::EpiInProj E{WSF(WS_SSQ0), WSB(WS_P1), out};
          pg8::gemm_phase(lds, g, S, E); }
        { SchedGrid S; S.init(WSB(WS_MN), (size_t)256 * DM * 2, WSB(WS_WXKV), (size_t)256 * DM * 2, MMEM / 256, 8, G, bx);
          epi::EpiMemKV E{WSF(WS_SSQM), WSB(WS_MK), WSB(WS_MV), out};
          pg8::gemm_phase(lds, g, S, E); }
    }
    GRID_BAR();

    {
        PHASE_ARGS();
        float lam;
        { const float a1 = wave_sum(IN(11)[lane] * IN(12)[lane]), a2 = wave_sum(IN(13)[lane] * IN(14)[lane]); lam = __expf(a1) - __expf(a2) + LAM_INIT; }
        for (long L = bx; L < 2048; L += G) {
            const int s = (int)(L >> 8), cc = (int)(L & 255), cv = (cc & 7) * 32 + (cc >> 3), bh = cv >> 1, par = cv & 1, p = 2 * (s >> 1) + par, qb = (s & 1) ? 15 - p : p;
            dattn::unit(bh >> 2, bh & 3, qb, WSB(WS_P1), WSB(WS_A2), lam, IN(15), (LAS char*)lds);
        }
        for (int L = bx; L < 256; L += G) misc::sample_attn_unit(L >> 3, (L >> 1) & 3, L & 1, WSB(WS_P1), IN(2), IN(3), out + O_KS, out + O_VS, WSB(WS_A2), lam, IN(15), (char*)lds_raw);
        for (int it = (vcu * 512 + tid); it < 64 * (RT / 64); it += G * 512) misc::shortconv_item(it, WSB(WS_P1), IN(16), IN(4), WSB(WS_A2));
        misc::expand_outputs(vcu * 512 + tid, G * 512, WSB(WS_P1), WSB(WS_MK), WSB(WS_MV), out);
        __syncthreads();
        { LAS bf16_t* scr = (LAS bf16_t*)(lds + wave * 16384); for (int it = gw; it < 2048; it += NGW) misc::transpose_item(it, WSB(WS_MV), WSB(WS_MVT), scr, lane); }
    }
    GRID_BAR();

    {
        PHASE_ARGS();
        pg8::Gemm g{DM, DM, DM}; SchedGrid S; S.init(WSB(WS_A2), (size_t)256 * DM * 2, WSB(WS_WOUT), (size_t)256 * DM * 2, NTILE, 4, G, bx);
        epi::EpiResidual E{WSB(WS_XA), WSF(WS_SSP1)};
        pg8::gemm_phase(lds, g, S, E);
    }
    GRID_BAR();
    {
        PHASE_ARGS();
        for (int r = bx * 512 + tid; r < RT; r += G * 512) WSF(WS_RS1)[r] = epi::rstd16(WSF(WS_SSP1), r);
    }
    GRID_BAR();
    {
        PHASE_ARGS();
        pg8::Gemm g{DM, DM, DM}; SchedGrid S; S.init(WSB(WS_XA), (size_t)256 * DM * 2, WSB(WS_WXQ), (size_t)256 * DM * 2, NTILE, 4, G, bx);
        epi::EpiScaleBf16 E{WSF(WS_RS1), WSB(WS_HQ), DM};
        pg8::gemm_phase(lds, g, S, E);
    }
    GRID_BAR();
    {
        PHASE_ARGS();
        pg8::Gemm g{DM, DM, 256}; SchedX S{(const char*)WSB(WS_HQ), (const char*)WSB(WS_MK), G, bx, false};
        epi::EpiXScores E{WSB(WS_P), WSF(WS_L4), (LAS float*)(lds + XTRA_OFF)};
        pg8::gemm_phase(lds, g, S, E);
    }
    GRID_BAR();
    {
        PHASE_ARGS();
        pg8::Gemm g{DM, MMEM, 256}; SchedX S{(const char*)WSB(WS_P), (const char*)WSB(WS_MVT), G, bx, true};
        epi::EpiXPV E{WSF(WS_L4), WSB(WS_HQ)};
        pg8::gemm_phase(lds, g, S, E);
        __syncthreads();
        for (int L = G - 1 - bx; L < NB * NH; L += G) misc::sample_xattn_unit(L >> 2, L & 3, WSB(WS_HQ), IN(6), IN(7), WSB(WS_HQ), (char*)lds_raw);
    }
    GRID_BAR();
    {
        PHASE_ARGS();
        pg8::Gemm g{DM, DM, DM}; SchedGrid S; S.init(WSB(WS_HQ), (size_t)256 * DM * 2, WSB(WS_WXO), (size_t)256 * DM * 2, NTILE, 4, G, bx);
        epi::EpiResidual E{WSB(WS_XA), WSF(WS_SSP2)};
        pg8::gemm_phase(lds, g, S, E);
    }
    GRID_BAR();
    {
        PHASE_ARGS();
        for (int r = bx * 512 + tid; r < RT; r += G * 512) WSF(WS_RS2)[r] = epi::rstd16(WSF(WS_SSP2), r);
    }
    GRID_BAR();
    {
        PHASE_ARGS();
        pg8::Gemm g{DM, DM, DM}; SchedGrid S; S.init(WSB(WS_XA), (size_t)256 * DM * 2, WSB(WS_WUG), (size_t)256 * DM * 2, NTILE, 22, G, bx);
        epi::EpiUpGate E{WSF(WS_RS2), IN(27), IN(5), WSB(WS_H), out, WSF(WS_UH), WSF(WS_U01), WSF(WS_G01), (LAS float*)(lds + XTRA_OFF)};
        pg8::gemm_phase(lds, g, S, E);
    }
    GRID_BAR();
    {
        PHASE_ARGS();
        pg8::Gemm g{DFF, DFF, DFF}; SchedGrid S; S.init(WSB(WS_H), (size_t)256 * DFF * 2, WSB(WS_WDN), (size_t)256 * DFF * 2, NTILE_P, 4, G, bx);
        { const float* UH = WSF(WS_UH); const float* U01 = WSF(WS_U01); const float* G01 = WSF(WS_G01); const float* w_ffc = IN(27); bf16_t* HB = WSB(WS_H); pg8::Unit uu;
          for (int i = 0; S.next(i, uu); ++i) { const int pm = uu.pm; if (pm >= NTILE_P || (pm & 7) == 0) continue;
            for (int it = tid; it < 2 * DFF; it += 512) {
                const int r = it / DFF, c = it - r * DFF;
                const float um2 = UH[((size_t)(pm - 1) * 2 + r) * DFF + c];
                const float um1 = (r == 0) ? UH[((size_t)(pm - 1) * 2 + 1) * DFF + c] : U01[((size_t)pm * 2) * DFF + c];
                const float u0 = U01[((size_t)pm * 2 + r) * DFF + c];
                const float y = w_ffc[c] * um2 + w_ffc[DFF + c] * um1 + w_ffc[2 * DFF + c] * u0;
                const float hv = y * __builtin_amdgcn_rcpf(1.0f + __builtin_amdgcn_exp2f(-1.4426950408889634f * y)) * G01[((size_t)pm * 2 + r) * DFF + c];
                HB[(size_t)(pm * 256 + r) * DFF + c] = (bf16_t)(cvt_pk_bf16(hv, 0.f) & 0xffffu);
            } }
          asm volatile("s_waitcnt vmcnt(0)" ::: "memory"); __syncthreads(); }
        epi::EpiResidual E{WSB(WS_XA), WSF(WS_SSP3)};
        pg8::gemm_phase(lds, g, S, E);
        { pg8::Gemm g2{DFF, DFF, DFF / 2}; SchedSplitK S2{(const char*)WSB(WS_H), (const char*)WSB(WS_WDN), G, bx};
          epi::EpiPartialF32 E2{WSF(WS_SPART)};
          pg8::gemm_phase(lds, g2, S2, E2); }
    }
    GRID_BAR();
    {
        PHASE_ARGS();
        const float* g_fin = IN(29); const bf16_t* XB = WSB(WS_XA);
        f32x4 gg[4];
#pragma unroll
        for (int j = 0; j < 4; ++j) gg[j] = *((const f32x4*)g_fin + lane + 64 * j);
        for (int m = 2 * gw; m < MP; m += 2 * NGW) {
            const float rs0 = epi::rstd16(WSF(WS_SSP3), m), rs1 = epi::rstd16(WSF(WS_SSP3), m + 1);
            const u32x2* x0 = (const u32x2*)(XB + (size_t)m * DM) + lane; const u32x2* x1 = x0 + DM / 4;
            u32x2 a[4], b[4];
#pragma unroll
            for (int j = 0; j < 4; ++j) { a[j] = __builtin_nontemporal_load(x0 + 64 * j); b[j] = __builtin_nontemporal_load(x1 + 64 * j); }
            f32x4* y0 = (f32x4*)(out + O_Y + (size_t)m * DM) + lane; f32x4* y1 = y0 + DM / 4;
#pragma unroll
            for (int j = 0; j < 4; ++j) {
                f32x4 v = {__uint_as_float(a[j].x << 16), __uint_as_float(a[j].x & 0xffff0000u), __uint_as_float(a[j].y << 16), __uint_as_float(a[j].y & 0xffff0000u)};
                f32x4 w = {__uint_as_float(b[j].x << 16), __uint_as_float(b[j].x & 0xffff0000u), __uint_as_float(b[j].y << 16), __uint_as_float(b[j].y & 0xffff0000u)};
                __builtin_nontemporal_store(v * gg[j] * rs0, y0 + 64 * j); __builtin_nontemporal_store(w * gg[j] * rs1, y1 + 64 * j);
            }
        }
        for (int r = gw; r < MS; r += NGW) {
            const u32x2* x0 = (const u32x2*)(XB + (size_t)(MP + r) * DM) + lane; const f32x4* sa = (const f32x4*)(WSF(WS_SPART) + (size_t)r * DM) + lane; const f32x4* sb = sa + (size_t)MS * DM / 4;
            f32x4 v[4]; float ss = 0.f;
#pragma unroll
            for (int j = 0; j < 4; ++j) { const u32x2 a = x0[64 * j];
                v[j] = (f32x4){__uint_as_float(a.x << 16), __uint_as_float(a.x & 0xffff0000u), __uint_as_float(a.y << 16), __uint_as_float(a.y & 0xffff0000u)} + sa[64 * j] + sb[64 * j];
                ss += (v[j][0] * v[j][0] + v[j][1] * v[j][1]) + (v[j][2] * v[j][2] + v[j][3] * v[j][3]); }
            const float rs = rsqrtf(wave_sum(ss) * (1.0f / DM) + EPS);
            f32x4* y0 = (f32x4*)(out + O_Y + (size_t)(MP + r) * DM) + lane;
#pragma unroll
            for (int j = 0; j < 4; ++j) y0[64 * j] = v[j] * gg[j] * rs;
        }
    }
}

extern "C" void kernel_launch(void* const* d_in, const int* in_sizes, int n_in, void* d_out, int out_size, void* d_ws, size_t ws_size, hipStream_t stream) {
    static int grid = 0;
    if (grid == 0) {
        if (n_in != 30 || (size_t)out_size != O_END || ws_size < WS_END) { fprintf(stderr, "kernel_launch: unexpected shapes: n_in %d out %d ws %zu (need %zu, %zu)\n", n_in, out_size, ws_size, (size_t)O_END, (size_t)WS_END); grid = -1; return; }
        int dev = 0, cus = 0, per_cu = 0;
        if (hipGetDevice(&dev) != hipSuccess || hipDeviceGetAttribute(&cus, hipDeviceAttributeMultiprocessorCount, dev) != hipSuccess) { grid = -1; return; }
        if (hipFuncSetAttribute((const void*)fwd_kernel, hipFuncAttributeMaxDynamicSharedMemorySize, LDS_BYTES) != hipSuccess) { fprintf(stderr, "kernel_launch: hipFuncSetAttribute failed\n"); grid = -1; return; }
        if (hipOccupancyMaxActiveBlocksPerMultiprocessor(&per_cu, (const void*)fwd_kernel, 512, LDS_BYTES) != hipSuccess || per_cu < 1) { fprintf(stderr, "kernel_launch: occupancy query says %d\n", per_cu); grid = -1; return; }
        grid = cus;
        fprintf(stderr, "kernel_launch: %d CUs, %d blocks/CU by the occupancy query, grid %d\n", cus, per_cu, grid);
    }
    if (grid < 0) return;
    if (hipMemsetAsync(d_ws, 0, 16384, stream) != hipSuccess) { fprintf(stderr, "kernel_launch: memset failed\n"); return; }
    Args a{};
    for (int i = 0; i < 30; ++i) a.in[i] = (const float*)d_in[i];
    a.out = (float*)d_out; a.ws = (unsigned char*)d_ws;
    void* args[] = {&a};
    const hipError_t e = hipLaunchCooperativeKernel((const void*)fwd_kernel, dim3(grid), dim3(512), args, LDS_BYTES, stream);
    if (e != hipSuccess) fprintf(stderr, "kernel_launch: cooperative launch failed: %s (grid %d)\n", hipGetErrorString(e), grid);
}
```

```cpp
#include <hip/hip_runtime.h>
#include <hip/hip_cooperative_groups.h>
#include <cstdio>
#include <cstdint>
namespace cg = cooperative_groups;

#define LAS __attribute__((address_space(3)))
typedef unsigned short bf16_t;
typedef short bf16x8 __attribute__((ext_vector_type(8)));
typedef short s16x4 __attribute__((ext_vector_type(4)));
typedef float f32x4 __attribute__((ext_vector_type(4)));
typedef float f32x2 __attribute__((ext_vector_type(2)));
typedef float f32x16 __attribute__((ext_vector_type(16)));
typedef unsigned u32x4 __attribute__((ext_vector_type(4)));
typedef unsigned u32x2 __attribute__((ext_vector_type(2)));

constexpr int DM = 1024, NB = 32, SEQ = 2048, DECT = 16, PAST = 1024;
constexpr int MP = NB * SEQ, MS = NB * DECT, RT = MP + MS;
constexpr int NTILE_P = MP / 256, NTILE = RT / 256;
constexpr int NH = 4, QKD = 64, VD = 128, NMEM = 256, XD = 256, DFF = 2816, INP = 3072, CW = 512;
constexpr int MMEM = NB * NMEM;
constexpr float EPS = 1e-6f;
constexpr float LAM_INIT = 0.2f;
constexpr int P1W = 2560;

constexpr size_t O_Y = 0;
constexpr size_t O_KP = (size_t)RT * DM;
constexpr size_t O_VP = O_KP + (size_t)MP * 512;
constexpr size_t O_SCP = O_VP + (size_t)MP * 512;
constexpr size_t O_FFP = O_SCP + (size_t)NB * 2 * CW;
constexpr size_t O_MK = O_FFP + (size_t)NB * 2 * DFF;
constexpr size_t O_MV = O_MK + (size_t)MMEM * DM;
constexpr size_t O_KS = O_MV + (size_t)MMEM * DM;
constexpr size_t O_VS = O_KS + (size_t)MS * 512;
constexpr size_t O_SCS = O_VS + (size_t)MS * 512;
constexpr size_t O_FFS = O_SCS + (size_t)NB * 2 * CW;
constexpr size_t O_END = O_FFS + (size_t)NB * 2 * DFF;

__device__ __forceinline__ unsigned cvt_pk_bf16(float lo, float hi) { unsigned r; asm volatile("v_cvt_pk_bf16_f32 %0, %1, %2" : "=v"(r) : "v"(lo), "v"(hi)); return r; }
__device__ __forceinline__ float bf2f(unsigned short h) { return __uint_as_float((unsigned)h << 16); }
#define DPPF(v, ctrl) __int_as_float(__builtin_amdgcn_update_dpp(0, __float_as_int(v), (ctrl), 0xf, 0xf, true))
__device__ __forceinline__ float xor16_sum(float v) { auto r = __builtin_amdgcn_permlane16_swap(__float_as_uint(v), __float_as_uint(v), false, false); return __uint_as_float(r[0]) + __uint_as_float(r[1]); }
__device__ __forceinline__ float xor32_sum(float v) { auto r = __builtin_amdgcn_permlane32_swap(__float_as_uint(v), __float_as_uint(v), false, false); return __uint_as_float(r[0]) + __uint_as_float(r[1]); }
__device__ __forceinline__ float xor16_max(float v) { auto r = __builtin_amdgcn_permlane16_swap(__float_as_uint(v), __float_as_uint(v), false, false); return fmaxf(__uint_as_float(r[0]), __uint_as_float(r[1])); }
__device__ __forceinline__ float xor32_max(float v) { auto r = __builtin_amdgcn_permlane32_swap(__float_as_uint(v), __float_as_uint(v), false, false); return fmaxf(__uint_as_float(r[0]), __uint_as_float(r[1])); }
__device__ __forceinline__ float other16(float v, int odd) { auto r = __builtin_amdgcn_permlane16_swap(__float_as_uint(v), __float_as_uint(v), false, false); return __uint_as_float(odd ? r[0] : r[1]); }
__device__ __forceinline__ float wave_sum(float v) {
    v += DPPF(v, 0xB1); v += DPPF(v, 0x4E); v += DPPF(v, 0x141); v += DPPF(v, 0x140);
    return xor32_sum(xor16_sum(v));
}
__device__ __forceinline__ float wave_max(float v) {
    v = fmaxf(v, DPPF(v, 0xB1)); v = fmaxf(v, DPPF(v, 0x4E)); v = fmaxf(v, DPPF(v, 0x141)); v = fmaxf(v, DPPF(v, 0x140));
    return xor32_max(xor16_max(v));
}
__device__ __forceinline__ float row_shr1(float v) { return __int_as_float(__builtin_amdgcn_update_dpp(__float_as_int(v), __float_as_int(v), 0x111, 0xf, 0xf, false)); }
__device__ __forceinline__ float row_shr2(float v) { return __int_as_float(__builtin_amdgcn_update_dpp(__float_as_int(v), __float_as_int(v), 0x112, 0xf, 0xf, false)); }

namespace pg8 {
constexpr int BM = 256, BK = 64, HALF = 128, HTB = HALF * BK * 2, STAGE_BYTES = 8 * HTB;
__host__ __device__ __forceinline__ int lds_byte(int r, int c) { const int st = (r >> 4) * 2 + (c >> 5), rr = r & 15, cc = c & 31, ob = rr * 64 + cc * 2; return st * 1024 + (ob ^ (((ob >> 9) & 1) << 5)); }
__host__ __device__ __forceinline__ void stage_rc(int b, int& R, int& C) { const int st = b / 1024, sb = b % 1024, swz = sb ^ (((sb >> 9) & 1) << 5); R = (st >> 1) * 16 + swz / 64; C = (st & 1) * 32 + (swz % 64) / 2; }
__host__ __device__ __forceinline__ int perm32(int rho) { const int n = rho >> 4, i = rho & 15; return 8 * (i >> 2) + 4 * n + (i & 3); }

struct Unit { const char* A; const char* B; int pm, pn; };
struct Gemm { int lda, ldb, K; };

template <class Epi, class Sched>
__device__ __forceinline__ void gemm_phase(LAS unsigned char* lds, const Gemm g, const Sched& S, const Epi& E) {
    int tid = threadIdx.x; asm volatile("" : "+v"(tid));
    const int wid = __builtin_amdgcn_readfirstlane(tid >> 6), lane = tid & 63, wr = wid >> 2, wc = wid & 3, fr = lane & 15, fq = lane >> 4;
    const int K = g.K, nt = K / BK;
    unsigned voffA[2], voffB[2];
#pragma unroll
    for (int i = 0; i < 2; ++i) { int R, C; stage_rc(tid * 16 + i * 8192, R, C); const int Rb = Epi::PERM ? ((R & ~31) + perm32(R & 31)) : R;
        voffA[i] = (unsigned)(R * g.lda + C) * 2u; voffB[i] = (unsigned)(Rb * g.ldb + C) * 2u; }
    const size_t kstep = (size_t)(BK * 2);
    const size_t hstepA = (size_t)HALF * g.lda * 2, hstepB = (size_t)HALF * g.ldb * 2;
    const unsigned ldsw = (unsigned)wid * 1024u;
    const int aoff = lds_byte(wr * 64 + fr, fq * 8), boff = lds_byte(wc * 32 + fr, fq * 8);
#define PG8_SA(b, h) (((b) * 2 + (h)) * HTB)
#define PG8_SB(b, h) ((4 + (b) * 2 + (h)) * HTB)
#define PG8_STAGE(bufoff, gbase, voff) do { _Pragma("unroll") for (int _i = 0; _i < 2; ++_i) \
        __builtin_amdgcn_global_load_lds((const unsigned*)((const char*)(gbase) + (voff)[_i]), (LAS unsigned*)(lds + (bufoff) + ldsw + _i * 8192), 16, 0, 0); } while (0)
#define PG8_LDA(dst, b, h) do { _Pragma("unroll") for (int m = 0; m < 4; ++m) _Pragma("unroll") for (int k = 0; k < 2; ++k) dst[m][k] = *(const LAS bf16x8*)(lds + PG8_SA(b, h) + aoff + m * 2048 + k * 1024); } while (0)
#define PG8_LDB(dst, b, h) do { _Pragma("unroll") for (int n = 0; n < 2; ++n) _Pragma("unroll") for (int k = 0; k < 2; ++k) dst[n][k] = *(const LAS bf16x8*)(lds + PG8_SB(b, h) + boff + n * 2048 + k * 1024); } while (0)
#define PG8_MMA(ai, bj, At, Bt) do { __builtin_amdgcn_s_setprio(1); _Pragma("unroll") for (int m = 0; m < 4; ++m) _Pragma("unroll") for (int n = 0; n < 2; ++n) _Pragma("unroll") for (int k = 0; k < 2; ++k) \
        acc[ai][bj][m][n] = __builtin_amdgcn_mfma_f32_16x16x32_bf16(Bt[n][k], At[m][k], acc[ai][bj][m][n], 0, 0, 0); __builtin_amdgcn_s_setprio(0); } while (0)
#define PG8_WAIT_V(n) asm volatile("s_waitcnt vmcnt(" #n ")" ::: "memory")
#define PG8_WAIT_L(n) asm volatile("s_waitcnt lgkmcnt(" #n ")" ::: "memory")
#define PG8_BAR __builtin_amdgcn_s_barrier()
#define PG8_SCHED __builtin_amdgcn_sched_barrier(0)
    Unit cur, nxt; int ui = 0;
    if (!S.next(0, cur)) return;
    f32x4 acc[2][2][4][2];
#pragma unroll
    for (int a = 0; a < 2; ++a)
#pragma unroll
        for (int b = 0; b < 2; ++b)
#pragma unroll
            for (int m = 0; m < 4; ++m)
#pragma unroll
                for (int n = 0; n < 2; ++n) acc[a][b][m][n] = (f32x4){0.f, 0.f, 0.f, 0.f};
    bf16x8 At[4][2], B0[2][2], B1[2][2];
    typename Epi::Pre pre{};
    const char* cA = cur.A; const char* cB = cur.B;
    PG8_STAGE(PG8_SB(0, 0), cB, voffB); PG8_STAGE(PG8_SB(0, 1), cB + hstepB, voffB); PG8_STAGE(PG8_SA(0, 0), cA, voffA); PG8_STAGE(PG8_SA(0, 1), cA + hstepA, voffA);
    if (wr == 1) PG8_BAR;
    PG8_WAIT_V(2); PG8_BAR;
    PG8_STAGE(PG8_SB(1, 0), cB + kstep, voffB); PG8_STAGE(PG8_SA(1, 0), cA + kstep, voffA); PG8_STAGE(PG8_SB(1, 1), cB + hstepB + kstep, voffB);
    PG8_WAIT_V(6); PG8_BAR;
    for (;;) {
        const bool has_next = S.next(ui + 1, nxt);
        const char* nA = has_next ? nxt.A : cA; const char* nB = has_next ? nxt.B : cB;
        for (int t = 0; t < nt; t += 2) {
            const bool last = (t == nt - 2);
            if (Epi::EARLY && last) pre = E.prefetch(cur, wr, wc, fr, fq);
            const char* a1 = cA + (size_t)(t + 1) * kstep;
            const char* a2 = last ? nA : cA + (size_t)(t + 2) * kstep; const char* b2 = last ? nB : cB + (size_t)(t + 2) * kstep;
            const char* a3 = a2 + kstep; const char* b3 = b2 + kstep;
            PG8_LDB(B0, 0, 0); PG8_LDB(B1, 0, 1); PG8_SCHED; PG8_LDA(At, 0, 0); PG8_STAGE(PG8_SA(1, 1), a1 + hstepA, voffA);
            PG8_WAIT_V(8); PG8_WAIT_L(0); PG8_BAR; PG8_MMA(0, 0, At, B0); PG8_MMA(0, 1, At, B1); PG8_BAR; PG8_SCHED;
            PG8_LDA(At, 0, 1); PG8_STAGE(PG8_SB(0, 0), b2, voffB); PG8_STAGE(PG8_SB(0, 1), b2 + hstepB, voffB); PG8_STAGE(PG8_SA(0, 0), a2, voffA);
            PG8_WAIT_V(8); PG8_WAIT_L(0); PG8_BAR; PG8_MMA(1, 0, At, B0); PG8_MMA(1, 1, At, B1); PG8_BAR; PG8_SCHED;
            PG8_LDB(B0, 1, 0); PG8_LDB(B1, 1, 1); PG8_SCHED; PG8_LDA(At, 1, 0); PG8_STAGE(PG8_SA(0, 1), a2 + hstepA, voffA);
            PG8_WAIT_V(8); PG8_WAIT_L(0); PG8_BAR; PG8_MMA(0, 0, At, B0); PG8_MMA(0, 1, At, B1); PG8_BAR; PG8_SCHED;
            PG8_LDA(At, 1, 1); PG8_STAGE(PG8_SB(1, 0), b3, voffB); PG8_STAGE(PG8_SB(1, 1), b3 + hstepB, voffB); PG8_STAGE(PG8_SA(1, 0), a3, voffA);
            PG8_WAIT_V(8); PG8_WAIT_L(0); PG8_BAR; PG8_MMA(1, 0, At, B0); PG8_MMA(1, 1, At, B1); PG8_BAR; PG8_SCHED;
        }
        if (wr == 0) PG8_BAR;
        if (!Epi::EARLY) pre = E.prefetch(cur, wr, wc, fr, fq);
        E(acc, cur, pre, wr, wc, fr, fq);
        if (!has_next) break;
#pragma unroll
        for (int a = 0; a < 2; ++a)
#pragma unroll
            for (int b = 0; b < 2; ++b)
#pragma unroll
                for (int m = 0; m < 4; ++m)
#pragma unroll
                    for (int n = 0; n < 2; ++n) acc[a][b][m][n] = (f32x4){0.f, 0.f, 0.f, 0.f};
        cur = nxt; cA = nA; cB = nB; ++ui;
        if (wr == 1) PG8_BAR;
    }
    PG8_WAIT_V(0);
    PG8_BAR;
#undef PG8_SA
#undef PG8_SB
#undef PG8_STAGE
#undef PG8_LDA
#undef PG8_LDB
#undef PG8_MMA
}
}
namespace epi {
using pg8::Unit;
typedef f32x4 Acc[2][2][4][2];
#define EPI_BAR() do { asm volatile("s_waitcnt lgkmcnt(0)" ::: "memory"); __builtin_amdgcn_s_barrier(); asm volatile("" ::: "memory"); } while (0)

__device__ __forceinline__ u32x4 pack8(const f32x4 a, const f32x4 b) { u32x4 w; w.x = cvt_pk_bf16(a[0], a[1]); w.y = cvt_pk_bf16(a[2], a[3]); w.z = cvt_pk_bf16(b[0], b[1]); w.w = cvt_pk_bf16(b[2], b[3]); return w; }
__device__ __forceinline__ u32x2 pack4(const f32x4 a) { u32x2 w; w.x = cvt_pk_bf16(a[0], a[1]); w.y = cvt_pk_bf16(a[2], a[3]); return w; }
__device__ __forceinline__ int row_pos(int row) { return row < MP ? (row & (SEQ - 1)) : PAST + ((row - MP) & (DECT - 1)); }
__device__ __forceinline__ f32x4 oth4(const f32x4 v, int odd) { f32x4 r; r[0] = other16(v[0], odd); r[1] = other16(v[1], odd); r[2] = other16(v[2], odd); r[3] = other16(v[3], odd); return r; }
__device__ __forceinline__ void store8_f32(float* p  , const f32x4 v0, const f32x4 v1, int fq) {
    f32x4 x, y;
#pragma unroll
    for (int j = 0; j < 4; ++j) { auto r = __builtin_amdgcn_permlane16_swap(__float_as_uint(v0[j]), __float_as_uint(v1[j]), false, false); x[j] = __uint_as_float(r[0]); y[j] = __uint_as_float(r[1]); }
    float* q = p + 16 * (fq >> 1) + 4 * (fq & 1);
    __builtin_nontemporal_store(x, (f32x4*)q); __builtin_nontemporal_store(y, (f32x4*)(q + 8));
}
struct PreNone {};
struct Pre8 { float v[8]; };
__device__ __forceinline__ Pre8 load8rows(const float* __restrict__ p, int row0) {
    Pre8 r;
#pragma unroll
    for (int i = 0; i < 8; ++i) r.v[i] = p[row0 + (i >> 2) * 128 + (i & 3) * 16];
    return r;
}
__device__ __forceinline__ void rope_cs(int pos, int n, f32x4& c, f32x4& s) {
    const float fp = (float)pos;
    const f32x4 k = n == 0 ? (f32x4){1.5915494309e-01f, 3.0863763405e-02f, 5.9851857127e-03f, 1.1606636412e-03f} : (f32x4){2.2507907904e-04f, 4.3647952793e-05f, 8.4643308082e-06f, 1.6414262628e-06f};
#pragma unroll
    for (int j = 0; j < 4; ++j) { const float r = __builtin_amdgcn_fractf(fp * k[j]); c[j] = __builtin_amdgcn_cosf(r); s[j] = __builtin_amdgcn_sinf(r); }
}

struct EpiInProj {
    static constexpr bool PERM = true, EARLY = true;
    typedef Pre8 Pre;
    const float* ssq;
    bf16_t* p1;
    float* out;
    __device__ __forceinline__ Pre prefetch(const Unit& u, int wr, int wc, int fr, int fq) const { return load8rows(ssq, u.pm * 256 + wr * 64 + fr); }
    __device__ __forceinline__ void operator()(Acc& acc, const Unit& u, const Pre& pre, int wr, int wc, int fr, int fq) const {
        const int pn = u.pn, row0 = u.pm * 256 + wr * 64 + fr;
        const int cl = 32 * wc + 8 * fq;
#pragma unroll
        for (int ai = 0; ai < 2; ++ai)
#pragma unroll
            for (int m = 0; m < 4; ++m) {
                const int row = row0 + ai * 128 + m * 16;
                const float rs = rsqrtf(pre.v[ai * 4 + m] * (1.0f / DM) + EPS);
                bf16_t* prow = p1 + (size_t)row * P1W;
                if (pn < 4) {
                    f32x4 c0, c1, s0, s1; const int pos = row_pos(row);
                    if ((wc & 1) == 0) { rope_cs(pos, 0, c0, s0); rope_cs(pos, 1, c1, s1); }
                    float* orow = (pn >= 2) ? (row < MP ? out + O_KP + (size_t)row * 512 : out + O_KS + (size_t)(row - MP) * 512) : nullptr;
#pragma unroll
                    for (int bj = 0; bj < 2; ++bj) {
                        f32x4 v0 = acc[ai][bj][m][0] * rs, v1 = acc[ai][bj][m][1] * rs;
                        if ((wc & 1) == 0) {
                            const f32x4 o0 = oth4(v0, fq & 1), o1 = oth4(v1, fq & 1);
                            if (fq == 0) { v0 = v0 * c0 - o0 * s0; v1 = v1 * c1 - o1 * s1; }
                            else if (fq == 1) { v0 = v0 * c0 + o0 * s0; v1 = v1 * c1 + o1 * s1; }
                        }
                        const int c = (pn & 1) * 256 + bj * 128 + cl;
                        if (pn >= 2 && u.pm >= NTILE_P) store8_f32(orow + c - 8 * fq, v0, v1, fq);
                        *(u32x4*)(prow + (pn >> 1) * 512 + c) = pack8(v0, v1);
                    }
                } else if (pn < 6) {
                    float* orow = row < MP ? out + O_VP + (size_t)row * 512 : out + O_VS + (size_t)(row - MP) * 512;
#pragma unroll
                    for (int bj = 0; bj < 2; ++bj) {
                        const f32x4 v0 = acc[ai][bj][m][0] * rs, v1 = acc[ai][bj][m][1] * rs;
                        const int c = (pn & 1) * 256 + bj * 128 + cl;
                        if (u.pm >= NTILE_P) store8_f32(orow + c - 8 * fq, v0, v1, fq);
                        *(u32x4*)(prow + 1024 + c) = pack8(v0, v1);
                    }
                } else if (pn < 8) {
#pragma unroll
                    for (int bj = 0; bj < 2; ++bj) {
                        const f32x4 v0 = acc[ai][bj][m][0] * rs, v1 = acc[ai][bj][m][1] * rs;
                        const int c = (pn & 1) * 256 + bj * 128 + cl;
                        *(u32x4*)(prow + 1536 + c) = pack8(v0, v1);
                    }
                } else {
                    const float rs2 = rs * rs;
                    const f32x4 v0 = acc[ai][0][m][0] * acc[ai][1][m][0] * rs2, v1 = acc[ai][0][m][1] * acc[ai][1][m][1] * rs2;
                    const int c = (pn - 8) * 128 + cl;
                    *(u32x4*)(prow + 2048 + c) = pack8(v0, v1);
                    if (row < MP) { const int t = row & (SEQ - 1); if (t >= SEQ - 2) { float* o = out + O_SCP + ((size_t)(row >> 11) * 2 + (t - (SEQ - 2))) * CW + c; *(f32x4*)o = v0; *(f32x4*)(o + 4) = v1; } }
                    else { const int t = (row - MP) & (DECT - 1); if (t >= DECT - 2) { float* o = out + O_SCS + ((size_t)((row - MP) >> 4) * 2 + (t - (DECT - 2))) * CW + c; *(f32x4*)o = v0; *(f32x4*)(o + 4) = v1; } }
                }
            }
    }
};

struct EpiMemKV {
    static constexpr bool PERM = true, EARLY = true;
    typedef Pre8 Pre;
    const float* ssq; bf16_t* mk; bf16_t* mv; float* out;
    __device__ __forceinline__ Pre prefetch(const Unit& u, int wr, int wc, int fr, int fq) const { return load8rows(ssq, u.pm * 256 + wr * 64 + fr); }
    __device__ __forceinline__ void operator()(Acc& acc, const Unit& u, const Pre& pre, int wr, int wc, int fr, int fq) const {
        const int pn = u.pn, row0 = u.pm * 256 + wr * 64 + fr, cl = 32 * wc + 8 * fq;
        float* ob = out + (pn < 4 ? O_MK : O_MV); bf16_t* bb = pn < 4 ? mk : mv;
#pragma unroll
        for (int ai = 0; ai < 2; ++ai)
#pragma unroll
            for (int m = 0; m < 4; ++m) {
                const int row = row0 + ai * 128 + m * 16;
                const float rs = rsqrtf(pre.v[ai * 4 + m] * (1.0f / DM) + EPS);
#pragma unroll
                for (int bj = 0; bj < 2; ++bj) {
                    const f32x4 v0 = acc[ai][bj][m][0] * rs, v1 = acc[ai][bj][m][1] * rs;
                    const int c = (pn & 3) * 256 + bj * 128 + cl;
                    *(u32x4*)(bb + (size_t)row * DM + c) = pack8(v0, v1);
                }
            }
    }
};

struct EpiResidual {
    static constexpr bool PERM = true, EARLY = false;
    typedef PreNone Pre;
    bf16_t* XB; float* ssp;
    __device__ __forceinline__ Pre prefetch(const Unit&, int, int, int, int) const { return Pre{}; }
    __device__ __forceinline__ void operator()(Acc& acc, const Unit& u, const Pre&, int wr, int wc, int fr, int fq) const {
        const int row0 = u.pm * 256 + wr * 64 + fr, col0 = u.pn * 256 + wc * 32 + 8 * fq;
        bf16_t* xb = XB + (size_t)row0 * DM + col0;
        u32x4 old[8][2];
#pragma unroll
        for (int g = 0; g < 8; ++g)
#pragma unroll
            for (int bj = 0; bj < 2; ++bj) old[g][bj] = *(const u32x4*)(xb + (size_t)((g >> 2) * 128 + (g & 3) * 16) * DM + bj * 128);
#pragma unroll
        for (int g = 0; g < 8; ++g) {
            const int ai = g >> 2, m = g & 3, row = row0 + ai * 128 + m * 16; float ss = 0.f;
#pragma unroll
            for (int bj = 0; bj < 2; ++bj) {
                const u32x4 o = old[g][bj]; f32x4 v0, v1;
                v0[0] = __uint_as_float(o.x << 16) + acc[ai][bj][m][0][0]; v0[1] = __uint_as_float(o.x & 0xffff0000u) + acc[ai][bj][m][0][1]; v0[2] = __uint_as_float(o.y << 16) + acc[ai][bj][m][0][2]; v0[3] = __uint_as_float(o.y & 0xffff0000u) + acc[ai][bj][m][0][3];
                v1[0] = __uint_as_float(o.z << 16) + acc[ai][bj][m][1][0]; v1[1] = __uint_as_float(o.z & 0xffff0000u) + acc[ai][bj][m][1][1]; v1[2] = __uint_as_float(o.w << 16) + acc[ai][bj][m][1][2]; v1[3] = __uint_as_float(o.w & 0xffff0000u) + acc[ai][bj][m][1][3];
                ss += ((v0[0] * v0[0] + v0[1] * v0[1]) + (v0[2] * v0[2] + v0[3] * v0[3])) + ((v1[0] * v1[0] + v1[1] * v1[1]) + (v1[2] * v1[2] + v1[3] * v1[3]));
                *(u32x4*)(xb + (size_t)(ai * 128 + m * 16) * DM + bj * 128) = pack8(v0, v1);
            }
            ss = xor32_sum(xor16_sum(ss));
            if (fq == 0) ssp[(size_t)row * 16 + u.pn * 4 + wc] = ss;
        }
    }
};
struct EpiResidualOut {
    static constexpr bool PERM = false, EARLY = false;
    typedef PreNone Pre;
    const bf16_t* XB; float* X; float* ssp;
    __device__ __forceinline__ Pre prefetch(const Unit&, int, int, int, int) const { return Pre{}; }
    __device__ __forceinline__ void operator()(Acc& acc, const Unit& u, const Pre&, int wr, int wc, int fr, int fq) const {
        const int row0 = u.pm * 256 + wr * 64 + fr, col0 = u.pn * 256 + wc * 32 + 4 * fq;
        const bf16_t* xb = XB + (size_t)row0 * DM + col0;
        u32x2 old[8][2][2];
#pragma unroll
        for (int g = 0; g < 8; ++g)
#pragma unroll
            for (int bj = 0; bj < 2; ++bj)
#pragma unroll
                for (int n = 0; n < 2; ++n) old[g][bj][n] = *(const u32x2*)(xb + (size_t)((g >> 2) * 128 + (g & 3) * 16) * DM + bj * 128 + n * 16);
#pragma unroll
        for (int g = 0; g < 8; ++g) {
            const int ai = g >> 2, m = g & 3, row = row0 + ai * 128 + m * 16; float* xrow = X + (size_t)row * DM + col0; float ss = 0.f;
#pragma unroll
            for (int bj = 0; bj < 2; ++bj)
#pragma unroll
                for (int n = 0; n < 2; ++n) {
                    const u32x2 o = old[g][bj][n]; f32x4 v;
                    v[0] = __uint_as_float(o.x << 16) + acc[ai][bj][m][n][0]; v[1] = __uint_as_float(o.x & 0xffff0000u) + acc[ai][bj][m][n][1]; v[2] = __uint_as_float(o.y << 16) + acc[ai][bj][m][n][2]; v[3] = __uint_as_float(o.y & 0xffff0000u) + acc[ai][bj][m][n][3];
                    ss += (v[0] * v[0] + v[1] * v[1]) + (v[2] * v[2] + v[3] * v[3]);
                    *(f32x4*)(xrow + bj * 128 + n * 16) = v;
                }
            ss = xor32_sum(xor16_sum(ss));
            if (fq == 0) ssp[(size_t)row * 16 + u.pn * 4 + wc] = ss;
        }
    }
};
__device__ __forceinline__ float rstd16(const float* ssp, int row) {
    const f32x4* p = (const f32x4*)(ssp + (size_t)row * 16); const f32x4 a = p[0], b = p[1], c = p[2], d = p[3];
    const float s = ((a[0] + a[1]) + (a[2] + a[3])) + ((b[0] + b[1]) + (b[2] + b[3])) + ((c[0] + c[1]) + (c[2] + c[3])) + ((d[0] + d[1]) + (d[2] + d[3]));
    return rsqrtf(s * (1.0f / DM) + EPS);
}
struct EpiScaleBf16 {
    static constexpr bool PERM = true, EARLY = true;
    typedef Pre8 Pre;
    const float* rs; bf16_t* O; int ldo;
    __device__ __forceinline__ Pre prefetch(const Unit& u, int wr, int wc, int fr, int fq) const { return load8rows(rs, u.pm * 256 + wr * 64 + fr); }
    __device__ __forceinline__ void operator()(Acc& acc, const Unit& u, const Pre& pre, int wr, int wc, int fr, int fq) const {
        const int row0 = u.pm * 256 + wr * 64 + fr, col0 = u.pn * 256 + 32 * wc + 8 * fq;
#pragma unroll
        for (int ai = 0; ai < 2; ++ai)
#pragma unroll
            for (int m = 0; m < 4; ++m) {
                const int row = row0 + ai * 128 + m * 16; const float r = pre.v[ai * 4 + m];
#pragma unroll
                for (int bj = 0; bj < 2; ++bj) *(u32x4*)(O + (size_t)row * ldo + col0 + bj * 128) = pack8(acc[ai][bj][m][0] * r, acc[ai][bj][m][1] * r);
            }
    }
};
struct EpiXScores {
    static constexpr bool PERM = true, EARLY = false;
    typedef PreNone Pre;
    __device__ __forceinline__ Pre prefetch(const Unit&, int, int, int, int) const { return Pre{}; }
    bf16_t* P; float* lp; LAS float* red;
    __device__ __forceinline__ void operator()(Acc& acc, const Unit& u, const Pre&, int wr, int wc, int fr, int fq) const {
        constexpr float C = 0.0625f * 1.4426950408889634f;
        float mx[2][4];
#pragma unroll
        for (int ai = 0; ai < 2; ++ai)
#pragma unroll
            for (int m = 0; m < 4; ++m) {
                float a = -3.0e38f;
#pragma unroll
                for (int bj = 0; bj < 2; ++bj)
#pragma unroll
                    for (int n = 0; n < 2; ++n) { const f32x4 v = acc[ai][bj][m][n]; a = fmaxf(a, fmaxf(fmaxf(v[0], v[1]), fmaxf(v[2], v[3]))); }
                a = xor32_max(xor16_max(a));
                if (fq == 0) red[(ai * 128 + wr * 64 + m * 16 + fr) * 4 + wc] = a;
            }
        EPI_BAR();
#pragma unroll
        for (int ai = 0; ai < 2; ++ai)
#pragma unroll
            for (int m = 0; m < 4; ++m) { const f32x4 r = *(const LAS f32x4*)(red + (ai * 128 + wr * 64 + m * 16 + fr) * 4); mx[ai][m] = fmaxf(fmaxf(r[0], r[1]), fmaxf(r[2], r[3])); }
        const int row0 = u.pm * 256 + wr * 64 + fr, col0 = u.pn * 256 + 32 * wc + 8 * fq;
#pragma unroll
        for (int ai = 0; ai < 2; ++ai)
#pragma unroll
            for (int m = 0; m < 4; ++m) {
                const int row = row0 + ai * 128 + m * 16; const float mc = mx[ai][m] * C; float s = 0.f;
#pragma unroll
                for (int bj = 0; bj < 2; ++bj) {
#pragma unroll
                    for (int j = 0; j < 4; ++j) { acc[ai][bj][m][0][j] = __builtin_amdgcn_exp2f(acc[ai][bj][m][0][j] * C - mc); acc[ai][bj][m][1][j] = __builtin_amdgcn_exp2f(acc[ai][bj][m][1][j] * C - mc); }
                    const u32x4 w = pack8(acc[ai][bj][m][0], acc[ai][bj][m][1]);
                    s += (__uint_as_float(w.x << 16) + __uint_as_float(w.x & 0xffff0000u)) + (__uint_as_float(w.y << 16) + __uint_as_float(w.y & 0xffff0000u))
                       + (__uint_as_float(w.z << 16) + __uint_as_float(w.z & 0xffff0000u)) + (__uint_as_float(w.w << 16) + __uint_as_float(w.w & 0xffff0000u));
                    *(u32x4*)(P + (size_t)row * DM + col0 + bj * 128) = w;
                }
                s = xor32_sum(xor16_sum(s));
                if (fq == 0) lp[(size_t)row * 16 + u.pn * 4 + wc] = s;
                asm volatile("" ::: "memory");
            }
        EPI_BAR();
    }
};
struct EpiXPV {
    static constexpr bool PERM = true, EARLY = false;
    typedef PreNone Pre;
    __device__ __forceinline__ Pre prefetch(const Unit&, int, int, int, int) const { return Pre{}; }
    const float* lp; bf16_t* O;
    __device__ __forceinline__ void operator()(Acc& acc, const Unit& u, const Pre&, int wr, int wc, int fr, int fq) const {
        const int row0 = u.pm * 256 + wr * 64 + fr, col0 = u.pn * 256 + 32 * wc + 8 * fq;
#pragma unroll
        for (int ai = 0; ai < 2; ++ai)
#pragma unroll
            for (int m = 0; m < 4; ++m) {
                const int row = row0 + ai * 128 + m * 16; const f32x4 l4 = *(const f32x4*)(lp + (size_t)row * 16 + u.pn * 4);
                const float rl = 1.0f / ((l4[0] + l4[1]) + (l4[2] + l4[3]));
#pragma unroll
                for (int bj = 0; bj < 2; ++bj) *(u32x4*)(O + (size_t)row * DM + col0 + bj * 128) = pack8(acc[ai][bj][m][0] * rl, acc[ai][bj][m][1] * rl);
            }
    }
};
struct EpiUpGate {
    static constexpr bool PERM = true, EARLY = false;
    typedef Pre8 Pre;
    const float* rs; const float* wconv;
    const float* state;
    bf16_t* H; float* out;
    float* uh; float* u01; float* g01;
    LAS float* tail;
    __device__ __forceinline__ Pre prefetch(const Unit& u, int wr, int wc, int fr, int fq) const { return load8rows(rs, u.pm * 256 + wr * 64 + fr); }
    __device__ __forceinline__ void operator()(Acc& acc, const Unit& u, const Pre& pre, int wr, int wc, int fr, int fq) const {
        const int pm = u.pm, pn = u.pn, row0 = pm * 256 + wr * 64 + fr, cl = 32 * wc + 8 * fq, gc = pn * 128 + cl;
        const bool sample = pm >= NTILE_P;
        const f32x4 w00 = *(const f32x4*)(wconv + gc), w01 = *(const f32x4*)(wconv + gc + 4), w10 = *(const f32x4*)(wconv + DFF + gc), w11 = *(const f32x4*)(wconv + DFF + gc + 4),
                    w20 = *(const f32x4*)(wconv + 2 * DFF + gc), w21 = *(const f32x4*)(wconv + 2 * DFF + gc + 4);
#pragma unroll
        for (int ai = 0; ai < 2; ++ai)
#pragma unroll
            for (int m = 0; m < 4; ++m) {
                const int g = ai * 8 + wr * 4 + m; const float r = pre.v[ai * 4 + m];
#pragma unroll
                for (int bj = 0; bj < 2; ++bj)
#pragma unroll
                    for (int n = 0; n < 2; ++n) acc[ai][bj][m][n] *= r;
                if (fr >= 14) {
                    LAS float* t = tail + (g * 2 + (fr - 14)) * 128 + cl; *(LAS f32x4*)t = acc[ai][0][m][0]; *(LAS f32x4*)(t + 4) = acc[ai][0][m][1];
                    if (sample) { float* o = out + O_FFS + ((size_t)((pm - NTILE_P) * 16 + g) * 2 + (fr - 14)) * DFF + gc; *(f32x4*)o = acc[ai][0][m][0]; *(f32x4*)(o + 4) = acc[ai][0][m][1]; }
                    else if (g == 15) {
                        float* o = uh + ((size_t)pm * 2 + (fr - 14)) * DFF + gc; *(f32x4*)o = acc[ai][0][m][0]; *(f32x4*)(o + 4) = acc[ai][0][m][1];
                        if ((pm & 7) == 7) { float* q = out + O_FFP + ((size_t)(pm >> 3) * 2 + (fr - 14)) * DFF + gc; *(f32x4*)q = acc[ai][0][m][0]; *(f32x4*)(q + 4) = acc[ai][0][m][1]; }
                    }
                }
                if (!sample && g == 0 && fr < 2) {
                    float* o = u01 + ((size_t)pm * 2 + fr) * DFF + gc; *(f32x4*)o = acc[ai][0][m][0]; *(f32x4*)(o + 4) = acc[ai][0][m][1];
                    float* q = g01 + ((size_t)pm * 2 + fr) * DFF + gc; *(f32x4*)q = acc[ai][1][m][0]; *(f32x4*)(q + 4) = acc[ai][1][m][1];
                }
            }
        EPI_BAR();
#pragma unroll
        for (int ai = 0; ai < 2; ++ai)
#pragma unroll
            for (int m = 0; m < 4; ++m) {
                const int row = row0 + ai * 128 + m * 16, g = ai * 8 + wr * 4 + m;
                f32x4 h1[2] = {(f32x4){0.f, 0.f, 0.f, 0.f}, (f32x4){0.f, 0.f, 0.f, 0.f}}, h2[2] = {(f32x4){0.f, 0.f, 0.f, 0.f}, (f32x4){0.f, 0.f, 0.f, 0.f}};
                if (fr < 2) {
                    if (sample) { const float* s = state + (size_t)((pm - NTILE_P) * 16 + g) * 2 * DFF + gc; h2[0] = *(const f32x4*)(s + fr * DFF); h2[1] = *(const f32x4*)(s + fr * DFF + 4); h1[0] = *(const f32x4*)(s + DFF); h1[1] = *(const f32x4*)(s + DFF + 4); }
                    else if (g > 0) { const LAS float* t = tail + ((g - 1) * 2) * 128 + cl; h2[0] = *(const LAS f32x4*)(t + fr * 128); h2[1] = *(const LAS f32x4*)(t + fr * 128 + 4); h1[0] = *(const LAS f32x4*)(t + 128); h1[1] = *(const LAS f32x4*)(t + 132); }
                }
                f32x4 hv[2];
#pragma unroll
                for (int n = 0; n < 2; ++n) {
                    const f32x4 uc = acc[ai][0][m][n]; f32x4 p1, p2;
#pragma unroll
                    for (int j = 0; j < 4; ++j) {
                        p1[j] = __int_as_float(__builtin_amdgcn_update_dpp(__float_as_int(h1[n][j]), __float_as_int(uc[j]), 0x111, 0xf, 0xf, false));
                        p2[j] = __int_as_float(__builtin_amdgcn_update_dpp(__float_as_int(h2[n][j]), __float_as_int(uc[j]), 0x112, 0xf, 0xf, false)); }
                    const f32x4 y = (n == 0 ? w00 : w01) * p2 + (n == 0 ? w10 : w11) * p1 + (n == 0 ? w20 : w21) * uc;
                    const f32x4 t = y * (-1.4426950408889634f); f32x4 d;
#pragma unroll
                    for (int j = 0; j < 4; ++j) d[j] = __builtin_amdgcn_exp2f(t[j]);
                    d = d + 1.0f;
#pragma unroll
                    for (int j = 0; j < 4; ++j) d[j] = __builtin_amdgcn_rcpf(d[j]);
                    hv[n] = (y * d) * acc[ai][1][m][n];
                }
                *(u32x4*)(H + (size_t)row * DFF + gc) = pack8(hv[0], hv[1]);
            }
        EPI_BAR();
    }
};
struct EpiPartialF32 {
    static constexpr bool PERM = false, EARLY = false;
    typedef PreNone Pre;
    float* S;
    __device__ __forceinline__ Pre prefetch(const Unit&, int, int, int, int) const { return Pre{}; }
    __device__ __forceinline__ void operator()(Acc& acc, const Unit& u, const Pre&, int wr, int wc, int fr, int fq) const {
        const int kh = u.pn >> 4, pn = u.pn & 15, row0 = (u.pm - NTILE_P) * 256 + wr * 64 + fr, col0 = pn * 256 + wc * 32 + 4 * fq;
        float* b = S + (size_t)kh * MS * DM + (size_t)row0 * DM + col0;
#pragma unroll
        for (int ai = 0; ai < 2; ++ai)
#pragma unroll
            for (int m = 0; m < 4; ++m)
#pragma unroll
                for (int bj = 0; bj < 2; ++bj)
#pragma unroll
                    for (int n = 0; n < 2; ++n) *(f32x4*)(b + (size_t)(ai * 128 + m * 16) * DM + bj * 128 + n * 16) = acc[ai][bj][m][n];
    }
};
}
namespace dattn {
constexpr int NW = 8, QBLK = 32, KVBLK = 64;
constexpr float SCALE = 0.125f, THR = 8.f;
constexpr int SHM_V = KVBLK * 128 * 2, SHM_K = KVBLK * 128 * 2, SHM_ATTN = 2 * SHM_V + 2 * SHM_K + NW * 64 * 4;
#define KSWZ(row, colB) ((row) * 256 + ((colB) ^ (((row) & 7) << 4)))
#define SBAR() __builtin_amdgcn_sched_barrier(0)
__device__ __forceinline__ int crow(int r, int hi) { return (r & 3) + 8 * (r >> 2) + 4 * hi; }
__device__ __forceinline__ void partialSM(f32x16& p0, f32x16& p1, float& m_reg, float& mn, float& alpha) {
  constexpr float C = SCALE * 1.4426950408889634f;
  float pmax = p0[0];
#pragma unroll
  for (int r = 1; r < 16; ++r) pmax = fmaxf(pmax, p0[r]);
#pragma unroll
  for (int r = 0; r < 16; ++r) pmax = fmaxf(pmax, p1[r]);
  { auto rr = __builtin_amdgcn_permlane32_swap(__float_as_uint(pmax), __float_as_uint(pmax), false, false);
    pmax = fmaxf(__uint_as_float(rr[0]), __uint_as_float(rr[1])); }
  if (__builtin_expect(__all(pmax - m_reg <= THR / SCALE), 1)) { mn = m_reg; alpha = 1.f; }
  else { mn = fmaxf(m_reg, pmax); alpha = __builtin_amdgcn_exp2f((m_reg - mn) * C); m_reg = mn; }
  const float mnC = -mn * C;
#pragma unroll
  for (int r = 0; r < 16; ++r) p0[r] = fmaf(p0[r], C, mnC);
#pragma unroll
  for (int r = 0; r < 16; ++r) p1[r] = fmaf(p1[r], C, mnC);
#pragma unroll
  for (int r = 0; r < 16; ++r) p0[r] = __builtin_amdgcn_exp2f(p0[r]);
}
__device__ __forceinline__ void finishSM(f32x16& p0, f32x16& p1, float alpha, float& l_reg, bf16x8& pa0, bf16x8& pa1, bf16x8& pa2, bf16x8& pa3) {
#pragma unroll
  for (int r = 0; r < 16; ++r) p1[r] = __builtin_amdgcn_exp2f(p1[r]);
  float ps = 0;
#pragma unroll
  for (int r = 0; r < 16; ++r) ps += p0[r];
#pragma unroll
  for (int r = 0; r < 16; ++r) ps += p1[r];
  { auto rr = __builtin_amdgcn_permlane32_swap(__float_as_uint(ps), __float_as_uint(ps), false, false);
    ps = __uint_as_float(rr[0]) + __uint_as_float(rr[1]); }
  l_reg = l_reg * alpha + ps;
#define PK4(P, BASE, OUT) do { unsigned a0 = cvt_pk_bf16(P[BASE + 0], P[BASE + 1]), a1 = cvt_pk_bf16(P[BASE + 2], P[BASE + 3]);   \
    unsigned b0 = cvt_pk_bf16(P[BASE + 4], P[BASE + 5]), b1 = cvt_pk_bf16(P[BASE + 6], P[BASE + 7]);                              \
    auto r0 = __builtin_amdgcn_permlane32_swap(a0, b0, false, false); auto r1 = __builtin_amdgcn_permlane32_swap(a1, b1, false, false); \
    u32x4 w = {r0[0], r1[0], r0[1], r1[1]}; OUT = *reinterpret_cast<bf16x8*>(&w); } while (0)
  PK4(p0, 0, pa0); PK4(p0, 8, pa1); PK4(p1, 0, pa2); PK4(p1, 8, pa3);
#undef PK4
}
__device__ __forceinline__ void qkt(f32x16& p0, f32x16& p1, const char* Ks, const bf16x8* qr, int r32, int hi, int mp) {
  p0 = f32x16{}; p1 = f32x16{};
#pragma unroll
  for (int d0 = 0; d0 < 4; ++d0) { const int cb = (mp * 64 + d0 * 16 + hi * 8) * 2;
    const bf16x8 b0 = *reinterpret_cast<const bf16x8*>(Ks + KSWZ(r32, cb));
    const bf16x8 b1 = *reinterpret_cast<const bf16x8*>(Ks + KSWZ(32 + r32, cb));
    p0 = __builtin_amdgcn_mfma_f32_32x32x16_bf16(b0, qr[d0], p0, 0, 0, 0);
    p1 = __builtin_amdgcn_mfma_f32_32x32x16_bf16(b1, qr[d0], p1, 0, 0, 0); }
}
__device__ __forceinline__ int v_st(int k, int c) { const int kk = (k & ~0xC) | ((k & 4) << 1) | ((k & 8) >> 1); return ((kk >> 3) * 4 + (c >> 5)) * 512 + ((kk & 7) * 32 + (c & 31)) * 2; }
__device__ __forceinline__ int v_rd_base(int lane) { return ((lane & 3) << 3) | (((lane >> 2) & 3) << 6) | (((lane >> 4) & 1) << 5) | (((lane >> 5) & 1) << 8); }
constexpr int v_rd_off(int d0, int ks, int half) { return d0 * 512 + ks * 4096 + half * 2048; }
template <int OFF> __device__ __forceinline__ s16x4 tr_read(int vb) {
  s16x4 r; asm volatile("ds_read_b64_tr_b16 %0, %1 offset:%2" : "=&v"(r) : "v"(vb), "i"(OFF) : "memory"); return r;
}
template <int D0> __device__ __forceinline__ void pv_one(f32x16& od, int vb, bf16x8 pa0, bf16x8 pa1, bf16x8 pa2, bf16x8 pa3) {
  const s16x4 l0 = tr_read<v_rd_off(D0, 0, 0)>(vb), h0 = tr_read<v_rd_off(D0, 0, 1)>(vb), l1 = tr_read<v_rd_off(D0, 1, 0)>(vb), h1 = tr_read<v_rd_off(D0, 1, 1)>(vb);
  const s16x4 l2 = tr_read<v_rd_off(D0, 2, 0)>(vb), h2 = tr_read<v_rd_off(D0, 2, 1)>(vb), l3 = tr_read<v_rd_off(D0, 3, 0)>(vb), h3 = tr_read<v_rd_off(D0, 3, 1)>(vb);
  asm volatile("s_waitcnt lgkmcnt(0)" ::: "memory"); SBAR();
#define PK(L, H) (bf16x8){L[0], L[1], L[2], L[3], H[0], H[1], H[2], H[3]}
  od = __builtin_amdgcn_mfma_f32_32x32x16_bf16(pa0, PK(l0, h0), od, 0, 0, 0);
  od = __builtin_amdgcn_mfma_f32_32x32x16_bf16(pa1, PK(l1, h1), od, 0, 0, 0);
  od = __builtin_amdgcn_mfma_f32_32x32x16_bf16(pa2, PK(l2, h2), od, 0, 0, 0);
  od = __builtin_amdgcn_mfma_f32_32x32x16_bf16(pa3, PK(l3, h3), od, 0, 0, 0);
#undef PK
}
__device__ __forceinline__ void pv_d0(f32x16* o, int vb, bf16x8 pa0, bf16x8 pa1, bf16x8 pa2, bf16x8 pa3) {
  pv_one<0>(o[0], vb, pa0, pa1, pa2, pa3); pv_one<1>(o[1], vb, pa0, pa1, pa2, pa3); pv_one<2>(o[2], vb, pa0, pa1, pa2, pa3); pv_one<3>(o[3], vb, pa0, pa1, pa2, pa3);
}

__device__ __forceinline__ void qkt3(f32x16& p0, f32x16& p1, const LAS char* Ks, const bf16x8* qr, int r32, int hi, int mp) {
  p0 = f32x16{}; p1 = f32x16{};
#pragma unroll
  for (int d0 = 0; d0 < 4; ++d0) { const int cb = (mp * 64 + d0 * 16 + hi * 8) * 2;
    const bf16x8 b0 = *reinterpret_cast<const LAS bf16x8*>(Ks + KSWZ(r32, cb));
    const bf16x8 b1 = *reinterpret_cast<const LAS bf16x8*>(Ks + KSWZ(32 + r32, cb));
    p0 = __builtin_amdgcn_mfma_f32_32x32x16_bf16(b0, qr[d0], p0, 0, 0, 0);
    p1 = __builtin_amdgcn_mfma_f32_32x32x16_bf16(b1, qr[d0], p1, 0, 0, 0); }
}
__device__ __forceinline__ void unit(int b, int h, int qb, const bf16_t* __restrict__ p1, bf16_t* __restrict__ A2, float lam, const float* __restrict__ gsub, LAS char* lds3) {
  int tid = threadIdx.x; asm volatile("" : "+v"(tid));
  const int wid = __builtin_amdgcn_readfirstlane(tid >> 6), lane = tid & 63, r32 = lane & 31, hi = lane >> 5, wq = wid & 3, mp = wid >> 2;
  LAS float* ws = (LAS float*)(lds3 + 131072) + wid * 64; LAS float* li_l = ws; LAS float* al_l = ws + 32;
  float m_reg = -1e30f, l_reg = 0; f32x16 o[4] = {}; bf16x8 qr[4];
  const size_t rowb = (size_t)b * SEQ;
  const char* Kh = (const char*)(p1 + rowb * P1W + 512 + h * 128); const char* Vh = (const char*)(p1 + rowb * P1W + 1024 + h * 128);
  unsigned koff[2], voff[2];
#pragma unroll
  for (int i = 0; i < 2; ++i) {
    const int krow = wid * 8 + i * 4 + (lane >> 4), kch = (lane & 15) ^ (krow & 7); koff[i] = (unsigned)(krow * P1W * 2 + kch * 16);
    const int sub = wid * 4 + i * 2 + (lane >> 5), kk = (sub >> 2) * 8 + ((lane & 31) >> 2), key = (kk & ~0xC) | ((kk & 4) << 1) | ((kk & 8) >> 1), c = (sub & 3) * 32 + (lane & 3) * 8;
    voff[i] = (unsigned)(key * P1W * 2 + c * 2);
  }
  const unsigned dmaw = (unsigned)wid * 2048u;
#define DMA(t, slot) do { const char* kb_ = Kh + (size_t)(t) * (KVBLK * P1W * 2); const char* vb_ = Vh + (size_t)(t) * (KVBLK * P1W * 2); _Pragma("unroll") for (int i_ = 0; i_ < 2; ++i_) { \
    __builtin_amdgcn_global_load_lds((const unsigned*)(kb_ + koff[i_]), (LAS unsigned*)(lds3 + (slot) * 32768 + dmaw + i_ * 1024), 16, 0, 0); \
    __builtin_amdgcn_global_load_lds((const unsigned*)(vb_ + voff[i_]), (LAS unsigned*)(lds3 + (slot) * 32768 + 16384 + dmaw + i_ * 1024), 16, 0, 0); } } while (0)
#define WAITV(n) asm volatile("s_waitcnt vmcnt(" #n ")" ::: "memory")
#define LBAR() do { asm volatile("s_waitcnt lgkmcnt(0)" ::: "memory"); __builtin_amdgcn_s_barrier(); asm volatile("" ::: "memory"); } while (0)
#define KS(t) (lds3 + ((t) & 3) * 32768)
#define VB(t) (vrd + ((t) & 3) * 32768)
  const int NT = 2 * qb + 2;
  const bool vis_last = (wq >= 2);
  DMA(0, 0); DMA(1, 1);
  const bf16_t* Qw = p1 + (rowb + qb * 128 + wq * QBLK + r32) * P1W + h * 128 + mp * 64 + hi * 8;
#pragma unroll
  for (int d0 = 0; d0 < 4; ++d0) qr[d0] = *reinterpret_cast<const bf16x8*>(Qw + d0 * 16);
  const int vrd = (int)(uintptr_t)lds3 + 16384 + v_rd_base(lane);
#define RESC(a) do { if (__any((a) < 1.f)) { if (hi == 0) al_l[r32] = (a); asm volatile("s_waitcnt lgkmcnt(0)" ::: "memory"); \
    _Pragma("unroll") for (int d = 0; d < 4; ++d) _Pragma("unroll") for (int r = 0; r < 16; ++r) o[d][r] *= al_l[crow(r, hi)]; } } while (0)
  f32x16 pA0, pA1, pB0, pB1; float mnA, mnB, alA, alB; bf16x8 pa0, pa1, pa2, pa3;
  WAITV(4); LBAR();
  if (2 < NT) DMA(2, 2);
  qkt3(pA0, pA1, KS(0), qr, r32, hi, mp); partialSM(pA0, pA1, m_reg, mnA, alA);
  for (int j = 1; j + 1 < NT; j += 2) {
    WAITV(4); LBAR(); DMA(j + 2, (j + 2) & 3);
    SBAR(); qkt3(pB0, pB1, KS(j), qr, r32, hi, mp);
    finishSM(pA0, pA1, alA, l_reg, pa0, pa1, pa2, pa3); SBAR();
    pv_d0(o, VB(j - 1), pa0, pa1, pa2, pa3); partialSM(pB0, pB1, m_reg, mnB, alB);
    RESC(alB);
    WAITV(4); LBAR(); if (j + 3 < NT) DMA(j + 3, (j + 3) & 3);
    SBAR(); qkt3(pA0, pA1, KS(j + 1), qr, r32, hi, mp);
    finishSM(pB0, pB1, alB, l_reg, pa0, pa1, pa2, pa3); SBAR();
    pv_d0(o, VB(j), pa0, pa1, pa2, pa3); partialSM(pA0, pA1, m_reg, mnA, alA);
    RESC(alA);
  }
  WAITV(0); LBAR();
  SBAR();
  if (vis_last) qkt3(pB0, pB1, KS(NT - 1), qr, r32, hi, mp);
  finishSM(pA0, pA1, alA, l_reg, pa0, pa1, pa2, pa3); SBAR();
  pv_d0(o, VB(NT - 2), pa0, pa1, pa2, pa3);
  if (vis_last) {
    partialSM(pB0, pB1, m_reg, mnB, alB);
    RESC(alB);
    finishSM(pB0, pB1, alB, l_reg, pa0, pa1, pa2, pa3); SBAR();
    pv_d0(o, VB(NT - 1), pa0, pa1, pa2, pa3);
  }
  if (hi == 0) li_l[r32] = l_reg; asm volatile("s_waitcnt lgkmcnt(0)" ::: "memory");
  float rli[16];
#pragma unroll
  for (int r = 0; r < 16; ++r) rli[r] = __builtin_amdgcn_rcpf(li_l[crow(r, hi)]);
  LBAR();
  LAS float* X = (LAS float*)lds3 + wq * (32 * 132);
  if (mp == 1) {
#pragma unroll
    for (int r = 0; r < 16; ++r) { const int orow = crow(r, hi);
#pragma unroll
      for (int d0 = 0; d0 < 4; ++d0) X[orow * 132 + d0 * 32 + r32] = o[d0][r] * rli[r]; }
  }
  LBAR();
  if (mp == 0) {
#pragma unroll
    for (int r = 0; r < 16; ++r) { const int orow = crow(r, hi);
#pragma unroll
      for (int d0 = 0; d0 < 4; ++d0) { LAS float* p = &X[orow * 132 + d0 * 32 + r32]; *p = o[d0][r] * rli[r] - lam * (*p); } }
    asm volatile("s_waitcnt lgkmcnt(0)" ::: "memory");
    const int row = lane >> 1, half = lane & 1; const LAS float* xr = X + row * 132 + half * 64;
    f32x4 v[16]; float ss = 0.f;
#pragma unroll
    for (int i = 0; i < 16; ++i) { v[i] = *(const LAS f32x4*)(xr + 4 * i); ss += (v[i][0] * v[i][0] + v[i][1] * v[i][1]) + (v[i][2] * v[i][2] + v[i][3] * v[i][3]); }
    ss += DPPF(ss, 0xB1);
    const float rs = rsqrtf(ss * (1.0f / 128.0f) + EPS) * (1.0f - LAM_INIT);
    bf16_t* orow = A2 + (rowb + qb * 128 + wq * QBLK + row) * DM + h * 128 + half * 64; const float* g = gsub + half * 64;
#pragma unroll
    for (int i = 0; i < 16; i += 2) { const f32x4 g0 = *(const f32x4*)(g + 4 * i), g1 = *(const f32x4*)(g + 4 * i + 4);
      *(u32x4*)(orow + 4 * i) = epi::pack8(v[i] * g0 * rs, v[i + 1] * g1 * rs); }
  }
  asm volatile("s_waitcnt vmcnt(0)" ::: "memory");
  LBAR();
#undef DMA
#undef WAITV
#undef LBAR
#undef KS
#undef VB
#undef RESC
}
#undef KSWZ
#undef SBAR
}
namespace misc {
constexpr int SK = PAST + DECT;
__device__ __forceinline__ void sample_attn_unit(int b, int h, int qh, const bf16_t* __restrict__ p1, const float* __restrict__ ck, const float* __restrict__ cv,
                                                 const float* __restrict__ nk, const float* __restrict__ nv, bf16_t* __restrict__ A2, float lam, const float* __restrict__ gsub, char* lds) {
  int tid = threadIdx.x; asm volatile("" : "+v"(tid)); const int lane = tid & 63, wid = tid >> 6;
  float* S = (float*)lds; float* red = (float*)(lds + 66560); float* q = (float*)(lds + 132096); float* st = (float*)(lds + 136192);
  for (int i = tid; i < 1024; i += 512) { const int mp = i >> 9, r = (i >> 6) & 7, d = i & 63;
    q[i] = bf2f(p1[(size_t)(MP + b * DECT + qh * 8 + r) * P1W + h * 128 + mp * 64 + d]); }
  __syncthreads();
  for (int it = tid; it < 2 * SK; it += 512) {
    const int mp = it / SK, key = it - mp * SK;
    const float* kp = key < PAST ? ck + (((size_t)b * PAST + key) * NH + h) * 128 + mp * 64 : nk + ((size_t)(b * DECT + key - PAST)) * 512 + h * 128 + mp * 64;
    float a[8] = {0.f, 0.f, 0.f, 0.f, 0.f, 0.f, 0.f, 0.f};
#pragma unroll 4
    for (int d = 0; d < 64; d += 4) { const f32x4 kv = *(const f32x4*)(kp + d);
#pragma unroll
      for (int r = 0; r < 8; ++r) { const f32x4 qv = *(const f32x4*)(q + (mp * 8 + r) * 64 + d); a[r] += (kv[0] * qv[0] + kv[1] * qv[1]) + (kv[2] * qv[2] + kv[3] * qv[3]); } }
#pragma unroll
    for (int r = 0; r < 8; ++r) S[(mp * 8 + r) * SK + key] = a[r] * 0.125f;
  }
  __syncthreads();
  for (int rr = 0; rr < 2; ++rr) { const int row = wid * 2 + rr; float* s = S + row * SK;
    float mx = -3.0e38f; for (int k = lane; k < SK; k += 64) mx = fmaxf(mx, s[k]); mx = wave_max(mx);
    float sum = 0.f; for (int k = lane; k < SK; k += 64) { const float e = __expf(s[k] - mx); s[k] = e; sum += e; } sum = wave_sum(sum);
    if (lane == 0) st[row] = 1.0f / sum; }
  __syncthreads();
  for (int i = tid; i < 8 * SK; i += 512) { const int r = i / SK, k = i - r * SK; S[r * SK + k] = S[r * SK + k] * st[r] - lam * S[(8 + r) * SK + k] * st[8 + r]; }
  __syncthreads();
  { const int eg = tid & 31, ks = tid >> 5; f32x4 o[8];
#pragma unroll
    for (int r = 0; r < 8; ++r) o[r] = (f32x4){0.f, 0.f, 0.f, 0.f};
    for (int key = ks; key < SK; key += 16) {
      const float* vp = key < PAST ? cv + (((size_t)b * PAST + key) * NH + h) * 128 + eg * 4 : nv + ((size_t)(b * DECT + key - PAST)) * 512 + h * 128 + eg * 4;
      const f32x4 vv = *(const f32x4*)vp;
#pragma unroll
      for (int r = 0; r < 8; ++r) o[r] += vv * S[r * SK + key]; }
#pragma unroll
    for (int r = 0; r < 8; ++r) *(f32x4*)(red + (ks * 8 + r) * 128 + eg * 4) = o[r]; }
  __syncthreads();
  { const int r = wid; float x0 = 0.f, x1 = 0.f;
#pragma unroll
    for (int ks = 0; ks < 16; ++ks) { const f32x2 t = *(const f32x2*)(red + (ks * 8 + r) * 128 + 2 * lane); x0 += t[0]; x1 += t[1]; }
    const float ss = wave_sum(x0 * x0 + x1 * x1); const float rs = rsqrtf(ss * (1.0f / 128.0f) + EPS) * (1.0f - LAM_INIT);
    const unsigned w = cvt_pk_bf16(x0 * rs * gsub[2 * lane], x1 * rs * gsub[2 * lane + 1]);
    *(unsigned*)(A2 + (size_t)(MP + b * DECT + qh * 8 + r) * DM + h * 128 + 2 * lane) = w; }
  __syncthreads();
}

__device__ __forceinline__ void sample_xattn_unit(int b, int h, const bf16_t* __restrict__ HQ, const float* __restrict__ mk, const float* __restrict__ mv, bf16_t* __restrict__ XO, char* lds) {
  int tid = threadIdx.x; asm volatile("" : "+v"(tid)); const int lane = tid & 63, wid = tid >> 6;
  float* q = (float*)lds; float* S = (float*)(lds + 16384);
  for (int i = tid; i < 16 * 256; i += 512) { const int r = i >> 8, d = i & 255; q[i] = bf2f(HQ[(size_t)(MP + b * DECT + r) * DM + h * 256 + d]); }
  __syncthreads();
  { const int key = tid >> 1, qh = tid & 1; const float* kp = mk + (((size_t)b * NMEM + key) * NH + h) * 256;
    float a[8] = {0.f, 0.f, 0.f, 0.f, 0.f, 0.f, 0.f, 0.f};
#pragma unroll 4
    for (int d = 0; d < 256; d += 4) { const f32x4 kv = *(const f32x4*)(kp + d);
#pragma unroll
      for (int r = 0; r < 8; ++r) { const f32x4 qv = *(const f32x4*)(q + (qh * 8 + r) * 256 + d); a[r] += (kv[0] * qv[0] + kv[1] * qv[1]) + (kv[2] * qv[2] + kv[3] * qv[3]); } }
#pragma unroll
    for (int r = 0; r < 8; ++r) S[(qh * 8 + r) * 256 + key] = a[r] * 0.0625f; }
  __syncthreads();
  for (int rr = 0; rr < 2; ++rr) { const int row = wid * 2 + rr; float* s = S + row * 256;
    float v[4]; float mx = -3.0e38f;
#pragma unroll
    for (int i = 0; i < 4; ++i) { v[i] = s[lane + 64 * i]; mx = fmaxf(mx, v[i]); } mx = wave_max(mx);
    float sum = 0.f;
#pragma unroll
    for (int i = 0; i < 4; ++i) { v[i] = __expf(v[i] - mx); sum += v[i]; } sum = wave_sum(sum); const float rl = 1.0f / sum;
#pragma unroll
    for (int i = 0; i < 4; ++i) s[lane + 64 * i] = v[i] * rl; }
  __syncthreads();
  { const int r = tid >> 5, dg = tid & 31; const float* vp = mv + ((size_t)b * NMEM * NH + h) * 256 + dg * 8; f32x4 o0 = {0.f, 0.f, 0.f, 0.f}, o1 = {0.f, 0.f, 0.f, 0.f};
    for (int key = 0; key < NMEM; ++key) { const float p = S[r * 256 + key]; const f32x4 a = *(const f32x4*)(vp + (size_t)key * NH * 256), c = *(const f32x4*)(vp + (size_t)key * NH * 256 + 4); o0 += a * p; o1 += c * p; }
    *(u32x4*)(XO + (size_t)(MP + b * DECT + r) * DM + h * 256 + dg * 8) = epi::pack8(o0, o1); }
  __syncthreads();
}

__device__ __forceinline__ void shortconv_item(int item, const bf16_t* __restrict__ p1, const float* __restrict__ wsc, const float* __restrict__ state, bf16_t* __restrict__ A2) {
  const int cgp = item & 63, chunk = item >> 6, c = cgp * 8, r0 = chunk * 64;
  float w0[8], w1[8], w2[8], um2[8], um1[8];
#pragma unroll
  for (int j = 0; j < 8; ++j) { w0[j] = wsc[c + j]; w1[j] = wsc[CW + c + j]; w2[j] = wsc[2 * CW + c + j]; um2[j] = 0.f; um1[j] = 0.f; }
  const bool sample = r0 >= MP;
  if (!sample && (r0 & (SEQ - 1)) != 0) {
    const u32x4 a = *(const u32x4*)(p1 + (size_t)(r0 - 2) * P1W + 2048 + c), bq = *(const u32x4*)(p1 + (size_t)(r0 - 1) * P1W + 2048 + c);
#pragma unroll
    for (int j = 0; j < 4; ++j) { um2[2 * j] = __uint_as_float(a[j] << 16); um2[2 * j + 1] = __uint_as_float(a[j] & 0xffff0000u); um1[2 * j] = __uint_as_float(bq[j] << 16); um1[2 * j + 1] = __uint_as_float(bq[j] & 0xffff0000u); }
  }
  for (int r = 0; r < 64; ++r) {
    const int row = r0 + r;
    if (sample && ((row - MP) & (DECT - 1)) == 0) { const float* s = state + (size_t)((row - MP) >> 4) * 2 * CW + c;
#pragma unroll
      for (int j = 0; j < 8; ++j) { um2[j] = s[j]; um1[j] = s[CW + j]; } }
    const u32x4 uu = *(const u32x4*)(p1 + (size_t)row * P1W + 2048 + c), gg = *(const u32x4*)(p1 + (size_t)row * P1W + 1536 + c);
    float y[8];
#pragma unroll
    for (int j = 0; j < 4; ++j) {
      const float u0 = __uint_as_float(uu[j] << 16), u1 = __uint_as_float(uu[j] & 0xffff0000u), g0 = __uint_as_float(gg[j] << 16), g1 = __uint_as_float(gg[j] & 0xffff0000u);
      y[2 * j] = g0 * (w0[2 * j] * um2[2 * j] + w1[2 * j] * um1[2 * j] + w2[2 * j] * u0); y[2 * j + 1] = g1 * (w0[2 * j + 1] * um2[2 * j + 1] + w1[2 * j + 1] * um1[2 * j + 1] + w2[2 * j + 1] * u1);
      um2[2 * j] = um1[2 * j]; um2[2 * j + 1] = um1[2 * j + 1]; um1[2 * j] = u0; um1[2 * j + 1] = u1; }
    u32x4 w; w.x = cvt_pk_bf16(y[0], y[1]); w.y = cvt_pk_bf16(y[2], y[3]); w.z = cvt_pk_bf16(y[4], y[5]); w.w = cvt_pk_bf16(y[6], y[7]);
    *(u32x4*)(A2 + (size_t)row * DM + 512 + c) = w;
  }
}

__device__ __forceinline__ void expand_store(const u32x4 a, float* __restrict__ dst) {
  const f32x4 lo = {__uint_as_float(a.x << 16), __uint_as_float(a.x & 0xffff0000u), __uint_as_float(a.y << 16), __uint_as_float(a.y & 0xffff0000u)};
  const f32x4 hi = {__uint_as_float(a.z << 16), __uint_as_float(a.z & 0xffff0000u), __uint_as_float(a.w << 16), __uint_as_float(a.w & 0xffff0000u)};
  __builtin_nontemporal_store(lo, (f32x4*)dst); __builtin_nontemporal_store(hi, (f32x4*)dst + 1);
}
template <int SH> __device__ __forceinline__ void expand_region(int gt, int GT, long n, const bf16_t* __restrict__ src, long pitch, float* __restrict__ dst) {
  for (long b = gt; b < n; b += 4L * GT) {
    u32x4 a[4];
#pragma unroll
    for (int u = 0; u < 4; ++u) { const long j = b + (long)u * GT; if (j < n) a[u] = __builtin_nontemporal_load((const u32x4*)(src + (j >> SH) * pitch + (j & ((1 << SH) - 1)) * 8)); }
#pragma unroll
    for (int u = 0; u < 4; ++u) { const long j = b + (long)u * GT; if (j < n) expand_store(a[u], dst + j * 8); }
  }
}
__device__ __forceinline__ void expand_outputs(int gt, int GT, const bf16_t* __restrict__ p1, const bf16_t* __restrict__ mk, const bf16_t* __restrict__ mv, float* __restrict__ out) {
  expand_region<6>(gt, GT, (long)MP * 64, p1 + 512, P1W, out + O_KP);
  expand_region<6>(gt, GT, (long)MP * 64, p1 + 1024, P1W, out + O_VP);
  expand_region<7>(gt, GT, (long)MMEM * 128, mk, DM, out + O_MK);
  expand_region<7>(gt, GT, (long)MMEM * 128, mv, DM, out + O_MV);
}
__device__ __forceinline__ void transpose_item(int item, const bf16_t* __restrict__ src, bf16_t* __restrict__ dst, LAS bf16_t* scr, int lane) {
  const int bi = item >> 4, bj = item & 15, r0 = bi * 64, c0 = bj * 64;
  for (int i = 0; i < 64; ++i) scr[i * 66 + lane] = src[(size_t)(r0 + i) * DM + c0 + lane];
  asm volatile("s_waitcnt lgkmcnt(0)" ::: "memory");
  for (int i = 0; i < 64; ++i) dst[(size_t)(c0 + i) * MMEM + r0 + lane] = scr[lane * 66 + i];
  asm volatile("s_waitcnt lgkmcnt(0)" ::: "memory");
}
}
constexpr size_t MiB = 1u << 20;
constexpr size_t WS_SSQ0 = 1 * MiB, WS_SSQM = WS_SSQ0 + 288 * 1024, WS_RS1 = WS_SSQ0 + 320 * 1024, WS_RS2 = WS_SSQ0 + 640 * 1024;
constexpr size_t WS_SSP1 = 2 * MiB, WS_SSP2 = 7 * MiB, WS_SSP3 = 12 * MiB, WS_L4 = 17 * MiB;
constexpr size_t WS_UH = 22 * MiB, WS_U01 = 28 * MiB, WS_G01 = 34 * MiB;
constexpr size_t WS_WIN = 40 * MiB, WS_WOUT = 46 * MiB, WS_WXQ = 48 * MiB, WS_WXKV = 50 * MiB, WS_WXO = 54 * MiB, WS_WUG = 56 * MiB, WS_WDN = 67 * MiB;
constexpr size_t WS_MN = 74 * MiB, WS_MK = 90 * MiB, WS_MV = 106 * MiB, WS_MVT = 122 * MiB;
constexpr size_t WS_XA = 138 * MiB;
constexpr size_t WS_P1 = 268 * MiB;
constexpr size_t WS_A2 = 591 * MiB;
constexpr size_t WS_SPART = WS_MN;
constexpr size_t WS_HQ = WS_P1, WS_P = WS_P1 + 129 * MiB, WS_H = WS_P1;
constexpr size_t WS_END = 720 * MiB;
static_assert(WS_XA + (size_t)RT * DM * 2 <= WS_P1 && WS_P1 + (size_t)RT * P1W * 2 <= WS_A2 && WS_A2 + (size_t)RT * DM * 2 <= WS_END && WS_H + (size_t)RT * DFF * 2 <= WS_END, "ws map");
static_assert(WS_WDN + (size_t)DM * DFF * 2 <= WS_MN && WS_WUG + (size_t)2 * DFF * DM * 2 <= WS_WDN && WS_G01 + (size_t)NTILE_P * 2 * DFF * 4 <= WS_WIN && WS_L4 + (size_t)RT * 16 <= WS_UH && WS_RS2 + (size_t)RT * 4 <= WS_SSP1, "ws map 2");

constexpr int RING_BYTES = 131072, XTRA_OFF = RING_BYTES, BARST_OFF = XTRA_OFF + 20480, LDS_BYTES = 155648;

struct SchedGrid {
    const char* A; const char* B; size_t a_tile, b_tile; int nM, nN, nwg, G, c;
    __device__ __forceinline__ void init(const void* A_, size_t a_tile_, const void* B_, size_t b_tile_, int nM_, int nN_, int G_, int c_) { A = (const char*)A_; B = (const char*)B_; a_tile = a_tile_; b_tile = b_tile_; nM = nM_; nN = nN_; nwg = nM * nN; G = G_; c = c_; }
    __device__ __forceinline__ bool next(int i, pg8::Unit& u) const {
        const long L = (long)i * G + c; if (L >= nwg) return false;
        int wgid = (int)L; { const int q = nwg / 8, r = nwg % 8, xcd = wgid % 8, off = wgid / 8; wgid = (xcd < r ? xcd * (q + 1) : r * (q + 1) + (xcd - r) * q) + off; }
        const int nig = 8 * nN, gid = wgid / nig, fm = gid * 8, gsz = (nM - fm) < 8 ? (nM - fm) : 8;
        u.pm = fm + ((wgid % nig) % gsz); u.pn = (wgid % nig) / gsz; u.A = A + (size_t)u.pm * a_tile; u.B = B + (size_t)u.pn * b_tile; return true;
    }
};
struct SchedX {
    const char* A; const char* B; int G, c; bool pv;
    __device__ __forceinline__ bool next(int i, pg8::Unit& u) const {
        const long L = (long)i * G + c; if (L >= 4 * NTILE_P) return false;
        const int h = (int)(L >> 8), idx = (int)(L & 255), pm = (idx & 7) * 32 + (idx >> 3), b = pm >> 3;
        u.pm = pm; u.pn = h; u.A = A + ((size_t)pm * 256 * DM + h * 256) * 2;
        u.B = pv ? B + ((size_t)h * 256 * MMEM + b * 256) * 2 : B + ((size_t)b * 256 * DM + h * 256) * 2; return true;
    }
};

struct SchedSplitK {
    const char* A; const char* B; int G, c;
    __device__ __forceinline__ bool next(int i, pg8::Unit& u) const {
        const long L = (long)i * G + c; if (L >= 16) return false;
        const int t = (int)(L >> 3), pn = (int)(L >> 1) & 3, kh = (int)L & 1;
        u.pm = NTILE_P + t; u.pn = pn | (kh << 4);
        u.A = A + ((size_t)(NTILE_P + t) * 256 * DFF + kh * (DFF / 2)) * 2; u.B = B + ((size_t)pn * 256 * DFF + kh * (DFF / 2)) * 2; return true;
    }
};

__device__ __forceinline__ void p0_transpose_item(const float* __restrict__ W, int ldw, int K, int kb, int ns, bf16_t* __restrict__ WT, int nd, const float* __restrict__ gain, LAS float* scr, int lane) {
    const int k0 = 64 * kb;
    float wv[32];
#pragma unroll
    for (int i = 0; i < 32; ++i) wv[i] = W[(size_t)(k0 + 2 * i + (lane >> 5)) * ldw + ns + (lane & 31)];
    if (gain) {
#pragma unroll
        for (int i = 0; i < 32; ++i) wv[i] *= gain[k0 + 2 * i + (lane >> 5)]; }
#pragma unroll
    for (int i = 0; i < 32; ++i) scr[(2 * i + (lane >> 5)) * 33 + (lane & 31)] = wv[i];
    asm volatile("s_waitcnt lgkmcnt(0)" ::: "memory");
    const int cc = lane & 7;
#pragma unroll
    for (int j = 0; j < 4; ++j) { const int n = (lane >> 3) + 8 * j; const LAS float* s = scr + (8 * cc) * 33 + n;
        u32x4 o; o.x = cvt_pk_bf16(s[0 * 33], s[1 * 33]); o.y = cvt_pk_bf16(s[2 * 33], s[3 * 33]); o.z = cvt_pk_bf16(s[4 * 33], s[5 * 33]); o.w = cvt_pk_bf16(s[6 * 33], s[7 * 33]);
        *(u32x4*)(WT + (size_t)(nd + n) * K + k0 + 8 * cc) = o; }
    asm volatile("s_waitcnt lgkmcnt(0)" ::: "memory");
}
__device__ __forceinline__ void rows2_to_bf16(const float* __restrict__ x0, const float* __restrict__ x1, bf16_t* __restrict__ o0, bf16_t* __restrict__ o1, float* q0, float* q1, int lane) {
    const f32x4* r0 = (const f32x4*)x0 + lane; const f32x4* r1 = (const f32x4*)x1 + lane; f32x4 v[4], w[4]; float s = 0.f, t = 0.f;
#pragma unroll
    for (int j = 0; j < 4; ++j) { v[j] = __builtin_nontemporal_load(r0 + 64 * j); w[j] = __builtin_nontemporal_load(r1 + 64 * j); }
#pragma unroll
    for (int j = 0; j < 4; ++j) { s += (v[j][0] * v[j][0] + v[j][1] * v[j][1]) + (v[j][2] * v[j][2] + v[j][3] * v[j][3]); t += (w[j][0] * w[j][0] + w[j][1] * w[j][1]) + (w[j][2] * w[j][2] + w[j][3] * w[j][3]); }
    s = wave_sum(s); t = wave_sum(t);
    u32x2* p0 = (u32x2*)o0 + lane; u32x2* p1 = (u32x2*)o1 + lane;
#pragma unroll
    for (int j = 0; j < 4; ++j) { p0[64 * j] = epi::pack4(v[j]); p1[64 * j] = epi::pack4(w[j]); }
    if (lane == 0) { *q0 = s; *q1 = t; }
}

#define XB_TMO      128
#define XB_XCNT(j)  (256  + 64 * (j))
#define XB_XSUB(j)  (1280 + 64 * (j))
#define XB_XGEN(j)  (2304 + 64 * (j))
#define XB_TOP      3328
#define XB_TOPGEN   3392
#define XCD_BAR_WORDS 3456
#define XB_SPIN_CAP (1u << 22)
__device__ __forceinline__ unsigned xb_ld(unsigned* p)              { return __hip_atomic_load(p, __ATOMIC_RELAXED, __HIP_MEMORY_SCOPE_AGENT); }
__device__ __forceinline__ unsigned xb_add(unsigned* p, unsigned v) { return __hip_atomic_fetch_add(p, v, __ATOMIC_RELAXED, __HIP_MEMORY_SCOPE_AGENT); }
__device__ __forceinline__ unsigned xb_xcc_id() { return (unsigned)__builtin_amdgcn_s_getreg((3 << 11) | 20) & 0xFu; }
#define XB_SPIN(cond, bar) do { unsigned _sp = 0; while (cond) { __builtin_amdgcn_s_sleep(1); \
    if ((++_sp & 255u) == 0u) { if (xb_ld(&(bar)[XB_TMO])) break; if (_sp > XB_SPIN_CAP) { atomicAdd(&(bar)[XB_TMO], 1u); break; } } } } while (0)
__device__ __forceinline__ void xcd_barrier_complete(unsigned* bar, unsigned x, unsigned& nloc, unsigned& nx) {
    const unsigned G = gridDim.x * gridDim.y * gridDim.z;
    unsigned sum, cnt, mine, sp = 0u;
    for (;;) {
        sum = 0u; cnt = 0u; mine = 0u;
#pragma unroll
        for (unsigned j = 0; j < 16; ++j) { const unsigned c = xb_ld(&bar[XB_XCNT(j)]); sum += c; cnt += (c > 0u) ? 1u : 0u; mine = (j == x) ? c : mine; }
        if (sum == G) break;
        __builtin_amdgcn_s_sleep(1);
        if ((++sp & 255u) == 0u) { if (xb_ld(&bar[XB_TMO])) break; if (sp > XB_SPIN_CAP) { atomicAdd(&bar[XB_TMO], 1u); break; } }
    }
    nloc = mine > 0u ? mine : 1u; nx = cnt > 0u ? cnt : 1u;
}
__device__ __forceinline__ void xcd_barrier(unsigned* bar, volatile LAS unsigned* st) {
    asm volatile("s_waitcnt vmcnt(0)" ::: "memory");
    __syncthreads();
    if (threadIdx.x == 0) {
        const unsigned x = xb_xcc_id();
        __builtin_amdgcn_s_waitcnt(0);
        unsigned nloc = st[0], nx = st[1];
        if (nloc == 0u) { xcd_barrier_complete(bar, x, nloc, nx); st[0] = nloc; st[1] = nx; }
        const unsigned old = xb_add(&bar[XB_XSUB(x)], 1u);
        const unsigned gen = old / nloc;
        if (old + 1u == (gen + 1u) * nloc) {
            __builtin_amdgcn_fence(__ATOMIC_RELEASE, "agent");
            asm volatile("s_waitcnt vmcnt(0)" ::: "memory");
            const unsigned og = xb_add(&bar[XB_TOP], 1u);
            const unsigned tg = og / nx;
            if (og + 1u == (tg + 1u) * nx) xb_add(&bar[XB_TOPGEN], 1u);
            else XB_SPIN(xb_ld(&bar[XB_TOPGEN]) == tg, bar);
            __builtin_amdgcn_fence(__ATOMIC_ACQUIRE, "agent");
            xb_add(&bar[XB_XGEN(x)], 1u);
            asm volatile("s_waitcnt vmcnt(0)" ::: "memory");
        } else {
            XB_SPIN(xb_ld(&bar[XB_XGEN(x)]) == gen, bar);
            __builtin_amdgcn_fence(__ATOMIC_ACQUIRE, "agent");
            asm volatile("s_waitcnt vmcnt(0)" ::: "memory");
        }
    }
    __syncthreads();
}

struct Args { const float* in[30]; float* out; unsigned char* ws; };
#define PHASE_ARGS() \
    const __attribute__((address_space(4))) Args* ap_ = (const __attribute__((address_space(4))) Args*)__builtin_amdgcn_kernarg_segment_ptr(); asm volatile("" : "+s"(ap_)); \
    unsigned char* const ws = ap_->ws; float* const out = ap_->out; (void)ws; (void)out; \
    int tid = threadIdx.x; asm volatile("" : "+v"(tid)); const int lane = tid & 63, wave = __builtin_amdgcn_readfirstlane(tid >> 6); (void)lane; (void)wave; \
    const int G = gridDim.x, bx = blockIdx.x, vcu = (G % 8 == 0) ? (bx % 8) * (G / 8) + bx / 8 : bx; (void)vcu; \
    const int gw = vcu * 8 + wave, NGW = G * 8; (void)gw; (void)NGW
#define IN(k) (ap_->in[k])
#define WSF(off) ((float*)(ws + (off)))
#define WSB(off) ((bf16_t*)(ws + (off)))

__global__ void __launch_bounds__(512, 2) fwd_kernel(Args a) {
    extern __shared__ __attribute__((aligned(16))) unsigned char lds_raw[];
    LAS unsigned char* const lds = (LAS unsigned char*)lds_raw;
    volatile LAS unsigned* const bst = (volatile LAS unsigned*)(lds + BARST_OFF);
    if (threadIdx.x < 2) bst[threadIdx.x] = 0u;
    __syncthreads();
    { PHASE_ARGS(); if (threadIdx.x == 0) (void)xb_add(&((unsigned*)ws)[XB_XCNT(xb_xcc_id())], 1u); }
#define GRID_BAR() do { PHASE_ARGS(); xcd_barrier((unsigned*)ws, bst); } while (0)

    {
        PHASE_ARGS();
        LAS float* scr = (LAS float*)(lds + wave * 16384);
        constexpr int I_IN = 16 * 96, I_SQ = 16 * 32, I_FF = 16 * 88, I_DN = 44 * 32;
        constexpr int NITEMS = I_IN + 5 * I_SQ + 2 * I_FF + I_DN;
        for (int it = gw; it < NITEMS; it += NGW) {
            int r = it;
            if (r < I_IN) { const int kb = r / 96, nb = r % 96, nd = nb * 32; int ns = nd;
                if (nd >= 2048) { const int T = (nd - 2048) >> 8, w = (nd - 2048) & 255; ns = (w < 128) ? 2048 + 128 * T + w : 2560 + 128 * T + (w - 128); }
                p0_transpose_item(IN(10), INP, DM, kb, ns, WSB(WS_WIN), nd, IN(9), scr, lane); continue; } r -= I_IN;
            if (r < I_SQ) { p0_transpose_item(IN(17), DM, DM, r / 32, (r % 32) * 32, WSB(WS_WOUT), (r % 32) * 32, nullptr, scr, lane); continue; } r -= I_SQ;
            if (r < I_SQ) { p0_transpose_item(IN(20), DM, DM, r / 32, (r % 32) * 32, WSB(WS_WXQ), (r % 32) * 32, IN(19), scr, lane); continue; } r -= I_SQ;
            if (r < I_SQ) { p0_transpose_item(IN(21), DM, DM, r / 32, (r % 32) * 32, WSB(WS_WXKV), (r % 32) * 32, IN(18), scr, lane); continue; } r -= I_SQ;
            if (r < I_SQ) { p0_transpose_item(IN(22), DM, DM, r / 32, (r % 32) * 32, WSB(WS_WXKV), 1024 + (r % 32) * 32, IN(18), scr, lane); continue; } r -= I_SQ;
            if (r < I_SQ) { p0_transpose_item(IN(23), DM, DM, r / 32, (r % 32) * 32, WSB(WS_WXO), (r % 32) * 32, nullptr, scr, lane); continue; } r -= I_SQ;
            if (r < I_FF) { const int kb = r / 88, nb = r % 88; p0_transpose_item(IN(25), DFF, DM, kb, nb * 32, WSB(WS_WUG), 256 * (nb >> 2) + (nb & 3) * 32, IN(24), scr, lane); continue; } r -= I_FF;
            if (r < I_FF) { const int kb = r / 88, nb = r % 88; p0_transpose_item(IN(26), DFF, DM, kb, nb * 32, WSB(WS_WUG), 256 * (nb >> 2) + 128 + (nb & 3) * 32, IN(24), scr, lane); continue; } r -= I_FF;
            p0_transpose_item(IN(28), DM, DFF, r / 32, (r % 32) * 32, WSB(WS_WDN), (r % 32) * 32, nullptr, scr, lane);
        }
        for (int m = 2 * gw; m < RT + MMEM; m += 2 * NGW) {
            const float* src; bf16_t* dst; float* sq;
            if (m < MP) { src = IN(0) + (size_t)m * DM; dst = WSB(WS_XA) + (size_t)m * DM; sq = WSF(WS_SSQ0) + m; }
            else if (m < RT) { src = IN(1) + (size_t)(m - MP) * DM; dst = WSB(WS_XA) + (size_t)m * DM; sq = WSF(WS_SSQ0) + m; }
            else { src = IN(8) + (size_t)(m - RT) * DM; dst = WSB(WS_MN) + (size_t)(m - RT) * DM; sq = WSF(WS_SSQM) + (m - RT); }
            rows2_to_bf16(src, src + DM, dst, dst + DM, sq, sq + 1, lane);
        }
    }
    GRID_BAR();

    {
        PHASE_ARGS();
        pg8::Gemm g{DM, DM, DM};
        { SchedGrid S; S.init(WSB(WS_XA), (size_t)256 * DM * 2, WSB(WS_WIN), (size_t)256 * DM * 2, NTILE, INP / 256, G, bx);
          epi::EpiInProj E{WSF(WS_SSQ0), WSB(WS_P1), out};
          pg8::gemm_phase(lds, g, S, E); }
        { SchedGrid S; S.init(WSB(WS_MN), (size_t)256 * DM * 2, WSB(WS_WXKV), (size_t)256 * DM * 2, MMEM / 256, 8, G, bx);
          epi::EpiMemKV E{WSF(WS_SSQM), WSB(WS_MK), WSB(WS_MV), out};
          pg8::gemm_phase(lds, g, S, E); }
    }
    GRID_BAR();

    {
        PHASE_ARGS();
        float lam;
        { const float a1 = wave_sum(IN(11)[lane] * IN(12)[lane]), a2 = wave_sum(IN(13)[lane] * IN(14)[lane]); lam = __expf(a1) - __expf(a2) + LAM_INIT; }
        for (long L = bx; L < 2048; L += G) {
            const int s = (int)(L >> 8), cc = (int)(L & 255), cv = (cc & 7) * 32 + (cc >> 3), bh = cv >> 1, par = cv & 1, p = 2 * (s >> 1) + par, qb = (s & 1) ? 15 - p : p;
            dattn::unit(bh >> 2, bh & 3, qb, WSB(WS_P1), WSB(WS_A2), lam, IN(15), (LAS char*)lds);
        }
        for (int L = bx; L < 256; L += G) misc::sample_attn_unit(L >> 3, (L >> 1) & 3, L & 1, WSB(WS_P1), IN(2), IN(3), out + O_KS, out + O_VS, WSB(WS_A2), lam, IN(15), (char*)lds_raw);
        for (int it = (vcu * 512 + tid); it < 64 * (RT / 64); it += G * 512) misc::shortconv_item(it, WSB(WS_P1), IN(16), IN(4), WSB(WS_A2));
        misc::expand_outputs(vcu * 512 + tid, G * 512, WSB(WS_P1), WSB(WS_MK), WSB(WS_MV), out);
        __syncthreads();
        { LAS bf16_t* scr = (LAS bf16_t*)(lds + wave * 16384); for (int it = gw; it < 2048; it += NGW) misc::transpose_item(it, WSB(WS_MV), WSB(WS_MVT), scr, lane); }
    }
    GRID_BAR();

    {
        PHASE_ARGS();
        pg8::Gemm g{DM, DM, DM}; SchedGrid S; S.init(WSB(WS_A2), (size_t)256 * DM * 2, WSB(WS_WOUT), (size_t)256 * DM * 2, NTILE, 4, G, bx);
        epi::EpiResidual E{WSB(WS_XA), WSF(WS_SSP1)};
        pg8::gemm_phase(lds, g, S, E);
    }
    GRID_BAR();
    {
        PHASE_ARGS();
        for (int r = bx * 512 + tid; r < RT; r += G * 512) WSF(WS_RS1)[r] = epi::rstd16(WSF(WS_SSP1), r);
    }
    GRID_BAR();
    {
        PHASE_ARGS();
        pg8::Gemm g{DM, DM, DM}; SchedGrid S; S.init(WSB(WS_XA), (size_t)256 * DM * 2, WSB(WS_WXQ), (size_t)256 * DM * 2, NTILE, 4, G, bx);
        epi::EpiScaleBf16 E{WSF(WS_RS1), WSB(WS_HQ), DM};
        pg8::gemm_phase(lds, g, S, E);
    }
    GRID_BAR();
    {
        PHASE_ARGS();
        pg8::Gemm g{DM, DM, 256}; SchedX S{(const char*)WSB(WS_HQ), (const char*)WSB(WS_MK), G, bx, false};
        epi::EpiXScores E{WSB(WS_P), WSF(WS_L4), (LAS float*)(lds + XTRA_OFF)};
        pg8::gemm_phase(lds, g, S, E);
    }
    GRID_BAR();
    {
        PHASE_ARGS();
        pg8::Gemm g{DM, MMEM, 256}; SchedX S{(const char*)WSB(WS_P), (const char*)WSB(WS_MVT), G, bx, true};
        epi::EpiXPV E{WSF(WS_L4), WSB(WS_HQ)};
        pg8::gemm_phase(lds, g, S, E);
        __syncthreads();
        for (int L = G - 1 - bx; L < NB * NH; L += G) misc::sample_xattn_unit(L >> 2, L & 3, WSB(WS_HQ), IN(6), IN(7), WSB(WS_HQ), (char*)lds_raw);
    }
    GRID_BAR();
    {
        PHASE_ARGS();
        pg8::Gemm g{DM, DM, DM}; SchedGrid S; S.init(WSB(WS_HQ), (size_t)256 * DM * 2, WSB(WS_WXO), (size_t)256 * DM * 2, NTILE, 4, G, bx);
        epi::EpiResidual E{WSB(WS_XA), WSF(WS_SSP2)};
        pg8::gemm_phase(lds, g, S, E);
    }
    GRID_BAR();
    {
        PHASE_ARGS();
        for (int r = bx * 512 + tid; r < RT; r += G * 512) WSF(WS_RS2)[r] = epi::rstd16(WSF(WS_SSP2), r);
    }
    GRID_BAR();
    {
        PHASE_ARGS();
        pg8::Gemm g{DM, DM, DM}; SchedGrid S; S.init(WSB(WS_XA), (size_t)256 * DM * 2, WSB(WS_WUG), (size_t)256 * DM * 2, NTILE, 22, G, bx);
        epi::EpiUpGate E{WSF(WS_RS2), IN(27), IN(5), WSB(WS_H), out, WSF(WS_UH), WSF(WS_U01), WSF(WS_G01), (LAS float*)(lds + XTRA_OFF)};
        pg8::gemm_phase(lds, g, S, E);
    }
    GRID_BAR();
    {
        PHASE_ARGS();
        pg8::Gemm g{DFF, DFF, DFF}; SchedGrid S; S.init(WSB(WS_H), (size_t)256 * DFF * 2, WSB(WS_WDN), (size_t)256 * DFF * 2, NTILE_P, 4, G, bx);
        { const float* UH = WSF(WS_UH); const float* U01 = WSF(WS_U01); const float* G01 = WSF(WS_G01); const float* w_ffc = IN(27); bf16_t* HB = WSB(WS_H); pg8::Unit uu;
          for (int i = 0; S.next(i, uu); ++i) { const int pm = uu.pm; if (pm >= NTILE_P || (pm & 7) == 0) continue;
            for (int it = tid; it < 2 * DFF; it += 512) {
                const int r = it / DFF, c = it - r * DFF;
                const float um2 = UH[((size_t)(pm - 1) * 2 + r) * DFF + c];
                const float um1 = (r == 0) ? UH[((size_t)(pm - 1) * 2 + 1) * DFF + c] : U01[((size_t)pm * 2) * DFF + c];
                const float u0 = U01[((size_t)pm * 2 + r) * DFF + c];
                const float y = w_ffc[c] * um2 + w_ffc[DFF + c] * um1 + w_ffc[2 * DFF + c] * u0;
                const float hv = y * __builtin_amdgcn_rcpf(1.0f + __builtin_amdgcn_exp2f(-1.4426950408889634f * y)) * G01[((size_t)pm * 2 + r) * DFF + c];
                HB[(size_t)(pm * 256 + r) * DFF + c] = (bf16_t)(cvt_pk_bf16(hv, 0.f) & 0xffffu);
            } }
          asm volatile("s_waitcnt vmcnt(0)" ::: "memory"); __syncthreads(); }
        epi::EpiResidual E{WSB(WS_XA), WSF(WS_SSP3)};
        pg8::gemm_phase(lds, g, S, E);
        { pg8::Gemm g2{DFF, DFF, DFF / 2}; SchedSplitK S2{(const char*)WSB(WS_H), (const char*)WSB(WS_WDN), G, bx};
          epi::EpiPartialF32 E2{WSF(WS_SPART)};
          pg8::gemm_phase(lds, g2, S2, E2); }
    }
    GRID_BAR();
    {
        PHASE_ARGS();
        const float* g_fin = IN(29); const bf16_t* XB = WSB(WS_XA);
        f32x4 gg[4];
#pragma unroll
        for (int j = 0; j < 4; ++j) gg[j] = *((const f32x4*)g_fin + lane + 64 * j);
        for (int m = 2 * gw; m < MP; m += 2 * NGW) {
            const float rs0 = epi::rstd16(WSF(WS_SSP3), m), rs1 = epi::rstd16(WSF(WS_SSP3), m + 1);
            const u32x2* x0 = (const u32x2*)(XB + (size_t)m * DM) + lane; const u32x2* x1 = x0 + DM / 4;
            u32x2 a[4], b[4];
#pragma unroll
            for (int j = 0; j < 4; ++j) { a[j] = __builtin_nontemporal_load(x0 + 64 * j); b[j] = __builtin_nontemporal_load(x1 + 64 * j); }
            f32x4* y0 = (f32x4*)(out + O_Y + (size_t)m * DM) + lane; f32x4* y1 = y0 + DM / 4;
#pragma unroll
            for (int j = 0; j < 4; ++j) {
                f32x4 v = {__uint_as_float(a[j].x << 16), __uint_as_float(a[j].x & 0xffff0000u), __uint_as_float(a[j].y << 16), __uint_as_float(a[j].y & 0xffff0000u)};
                f32x4 w = {__uint_as_float(b[j].x << 16), __uint_as_float(b[j].x & 0xffff0000u), __uint_as_float(b[j].y << 16), __uint_as_float(b[j].y & 0xffff0000u)};
                __builtin_nontemporal_store(v * gg[j] * rs0, y0 + 64 * j); __builtin_nontemporal_store(w * gg[j] * rs1, y1 + 64 * j);
            }
        }
        for (int r = gw; r < MS; r += NGW) {
            const u32x2* x0 = (const u32x2*)(XB + (size_t)(MP + r) * DM) + lane; const f32x4* sa = (const f32x4*)(WSF(WS_SPART) + (size_t)r * DM) + lane; const f32x4* sb = sa + (size_t)MS * DM / 4;
            f32x4 v[4]; float ss = 0.f;
#pragma unroll
            for (int j = 0; j < 4; ++j) { const u32x2 a = x0[64 * j];
                v[j] = (f32x4){__uint_as_float(a.x << 16), __uint_as_float(a.x & 0xffff0000u), __uint_as_float(a.y << 16), __uint_as_float(a.y & 0xffff0000u)} + sa[64 * j] + sb[64 * j];
                ss += (v[j][0] * v[j][0] + v[j][1] * v[j][1]) + (v[j][2] * v[j][2] + v[j][3] * v[j][3]); }
            const float rs = rsqrtf(wave_sum(ss) * (1.0f / DM) + EPS);
            f32x4* y0 = (f32x4*)(out + O_Y + (size_t)(MP + r) * DM) + lane;
#pragma unroll
            for (int j = 0; j < 4; ++j) y0[64 * j] = v[j] * gg[j] * rs;
        }
    }
}

extern "C" void kernel_launch(void* const* d_in, const int* in_sizes, int n_in, void* d_out, int out_size, void* d_ws, size_t ws_size, hipStream_t stream) {
    static int grid = 0;
    if (grid == 0) {
        if (n_in != 30 || (size_t)out_size != O_END || ws_size < WS_END) { fprintf(stderr, "kernel_launch: unexpected shapes: n_in %d out %d ws %zu (need %zu, %zu)\n", n_in, out_size, ws_size, (size_t)O_END, (size_t)WS_END); grid = -1; return; }
        int dev = 0, cus = 0, per_cu = 0;
        if (hipGetDevice(&dev) != hipSuccess || hipDeviceGetAttribute(&cus, hipDeviceAttributeMultiprocessorCount, dev) != hipSuccess) { grid = -1; return; }
        if (hipFuncSetAttribute((const void*)fwd_kernel, hipFuncAttributeMaxDynamicSharedMemorySize, LDS_BYTES) != hipSuccess) { fprintf(stderr, "kernel_launch: hipFuncSetAttribute failed\n"); grid = -1; return; }
        if (hipOccupancyMaxActiveBlocksPerMultiprocessor(&per_cu, (const void*)fwd_kernel, 512, LDS_BYTES) != hipSuccess || per_cu < 1) { fprintf(stderr, "kernel_launch: occupancy query says %d\n", per_cu); grid = -1; return; }
        grid = cus;
        fprintf(stderr, "kernel_launch: %d CUs, %d blocks/CU by the occupancy query, grid %d\n", cus, per_cu, grid);
    }
    if (grid < 0) return;
    if (hipMemsetAsync(d_ws, 0, 16384, stream) != hipSuccess) { fprintf(stderr, "kernel_launch: memset failed\n"); return; }
    Args a{};
    for (int i = 0; i < 30; ++i) a.in[i] = (const float*)d_in[i];
    a.out = (float*)d_out; a.ws = (unsigned char*)d_ws;
    void* args[] = {&a};
    const hipError_t e = hipLaunchCooperativeKernel((const void*)fwd_kernel, dim3(grid), dim3(512), args, LDS_BYTES, stream);
    if (e != hipSuccess) fprintf(stderr, "kernel_launch: cooperative launch failed: %s (grid %d)\n", hipGetErrorString(e), grid);
}
```

```cpp
#include <hip/hip_runtime.h>
#include <hip/hip_cooperative_groups.h>
#include <cstdio>
#include <cstdint>
namespace cg = cooperative_groups;

#define LAS __attribute__((address_space(3)))
typedef unsigned short bf16_t;
typedef short bf16x8 __attribute__((ext_vector_type(8)));
typedef short s16x4 __attribute__((ext_vector_type(4)));
typedef float f32x4 __attribute__((ext_vector_type(4)));
typedef float f32x2 __attribute__((ext_vector_type(2)));
typedef float f32x16 __attribute__((ext_vector_type(16)));
typedef unsigned u32x4 __attribute__((ext_vector_type(4)));
typedef unsigned u32x2 __attribute__((ext_vector_type(2)));

constexpr int DM = 1024, NB = 32, SEQ = 2048, DECT = 16, PAST = 1024;
constexpr int MP = NB * SEQ, MS = NB * DECT, RT = MP + MS;
constexpr int NTILE_P = MP / 256, NTILE = RT / 256;
constexpr int NH = 4, QKD = 64, VD = 128, NMEM = 256, XD = 256, DFF = 2816, INP = 3072, CW = 512;
constexpr int MMEM = NB * NMEM;
constexpr float EPS = 1e-6f;
constexpr float LAM_INIT = 0.2f;
constexpr int P1W = 2560;

constexpr size_t O_Y = 0;
constexpr size_t O_KP = (size_t)RT * DM;
constexpr size_t O_VP = O_KP + (size_t)MP * 512;
constexpr size_t O_SCP = O_VP + (size_t)MP * 512;
constexpr size_t O_FFP = O_SCP + (size_t)NB * 2 * CW;
constexpr size_t O_MK = O_FFP + (size_t)NB * 2 * DFF;
constexpr size_t O_MV = O_MK + (size_t)MMEM * DM;
constexpr size_t O_KS = O_MV + (size_t)MMEM * DM;
constexpr size_t O_VS = O_KS + (size_t)MS * 512;
constexpr size_t O_SCS = O_VS + (size_t)MS * 512;
constexpr size_t O_FFS = O_SCS + (size_t)NB * 2 * CW;
constexpr size_t O_END = O_FFS + (size_t)NB * 2 * DFF;

__device__ __forceinline__ unsigned cvt_pk_bf16(float lo, float hi) { unsigned r; asm volatile("v_cvt_pk_bf16_f32 %0, %1, %2" : "=v"(r) : "v"(lo), "v"(hi)); return r; }
__device__ __forceinline__ float bf2f(unsigned short h) { return __uint_as_float((unsigned)h << 16); }
#define DPPF(v, ctrl) __int_as_float(__builtin_amdgcn_update_dpp(0, __float_as_int(v), (ctrl), 0xf, 0xf, true))
__device__ __forceinline__ float xor16_sum(float v) { auto r = __builtin_amdgcn_permlane16_swap(__float_as_uint(v), __float_as_uint(v), false, false); return __uint_as_float(r[0]) + __uint_as_float(r[1]); }
__device__ __forceinline__ float xor32_sum(float v) { auto r = __builtin_amdgcn_permlane32_swap(__float_as_uint(v), __float_as_uint(v), false, false); return __uint_as_float(r[0]) + __uint_as_float(r[1]); }
__device__ __forceinline__ float xor16_max(float v) { auto r = __builtin_amdgcn_permlane16_swap(__float_as_uint(v), __float_as_uint(v), false, false); return fmaxf(__uint_as_float(r[0]), __uint_as_float(r[1])); }
__device__ __forceinline__ float xor32_max(float v) { auto r = __builtin_amdgcn_permlane32_swap(__float_as_uint(v), __float_as_uint(v), false, false); return fmaxf(__uint_as_float(r[0]), __uint_as_float(r[1])); }
__device__ __forceinline__ float other16(float v, int odd) { auto r = __builtin_amdgcn_permlane16_swap(__float_as_uint(v), __float_as_uint(v), false, false); return __uint_as_float(odd ? r[0] : r[1]); }
__device__ __forceinline__ float wave_sum(float v) {
    v += DPPF(v, 0xB1); v += DPPF(v, 0x4E); v += DPPF(v, 0x141); v += DPPF(v, 0x140);
    return xor32_sum(xor16_sum(v));
}
__device__ __forceinline__ float wave_max(float v) {
    v = fmaxf(v, DPPF(v, 0xB1)); v = fmaxf(v, DPPF(v, 0x4E)); v = fmaxf(v, DPPF(v, 0x141)); v = fmaxf(v, DPPF(v, 0x140));
    return xor32_max(xor16_max(v));
}
__device__ __forceinline__ float row_shr1(float v) { return __int_as_float(__builtin_amdgcn_update_dpp(__float_as_int(v), __float_as_int(v), 0x111, 0xf, 0xf, false)); }
__device__ __forceinline__ float row_shr2(float v) { return __int_as_float(__builtin_amdgcn_update_dpp(__float_as_int(v), __float_as_int(v), 0x112, 0xf, 0xf, false)); }

namespace pg8 {
constexpr int BM = 256, BK = 64, HALF = 128, HTB = HALF * BK * 2, STAGE_BYTES = 8 * HTB;
__host__ __device__ __forceinline__ int lds_byte(int r, int c) { const int st = (r >> 4) * 2 + (c >> 5), rr = r & 15, cc = c & 31, ob = rr * 64 + cc * 2; return st * 1024 + (ob ^ (((ob >> 9) & 1) << 5)); }
__host__ __device__ __forceinline__ void stage_rc(int b, int& R, int& C) { const int st = b / 1024, sb = b % 1024, swz = sb ^ (((sb >> 9) & 1) << 5); R = (st >> 1) * 16 + swz / 64; C = (st & 1) * 32 + (swz % 64) / 2; }
__host__ __device__ __forceinline__ int perm32(int rho) { const int n = rho >> 4, i = rho & 15; return 8 * (i >> 2) + 4 * n + (i & 3); }

struct Unit { const char* A; const char* B; int pm, pn; };
struct Gemm { int lda, ldb, K; };

template <class Epi, class Sched>
__device__ __forceinline__ void gemm_phase(LAS unsigned char* lds, const Gemm g, const Sched& S, const Epi& E) {
    int tid = threadIdx.x; asm volatile("" : "+v"(tid));
    const int wid = __builtin_amdgcn_readfirstlane(tid >> 6), lane = tid & 63, wr = wid >> 2, wc = wid & 3, fr = lane & 15, fq = lane >> 4;
    const int K = g.K, nt = K / BK;
    unsigned voffA[2], voffB[2];
#pragma unroll
    for (int i = 0; i < 2; ++i) { int R, C; stage_rc(tid * 16 + i * 8192, R, C); const int Rb = Epi::PERM ? ((R & ~31) + perm32(R & 31)) : R;
        voffA[i] = (unsigned)(R * g.lda + C) * 2u; voffB[i] = (unsigned)(Rb * g.ldb + C) * 2u; }
    const size_t kstep = (size_t)(BK * 2);
    const size_t hstepA = (size_t)HALF * g.lda * 2, hstepB = (size_t)HALF * g.ldb * 2;
    const unsigned ldsw = (unsigned)wid * 1024u;
    const int aoff = lds_byte(wr * 64 + fr, fq * 8), boff = lds_byte(wc * 32 + fr, fq * 8);
#define PG8_SA(b, h) (((b) * 2 + (h)) * HTB)
#define PG8_SB(b, h) ((4 + (b) * 2 + (h)) * HTB)
#define PG8_STAGE(bufoff, gbase, voff) do { _Pragma("unroll") for (int _i = 0; _i < 2; ++_i) \
        __builtin_amdgcn_global_load_lds((const unsigned*)((const char*)(gbase) + (voff)[_i]), (LAS unsigned*)(lds + (bufoff) + ldsw + _i * 8192), 16, 0, 0); } while (0)
#define PG8_LDA(dst, b, h) do { _Pragma("unroll") for (int m = 0; m < 4; ++m) _Pragma("unroll") for (int k = 0; k < 2; ++k) dst[m][k] = *(const LAS bf16x8*)(lds + PG8_SA(b, h) + aoff + m * 2048 + k * 1024); } while (0)
#define PG8_LDB(dst, b, h) do { _Pragma("unroll") for (int n = 0; n < 2; ++n) _Pragma("unroll") for (int k = 0; k < 2; ++k) dst[n][k] = *(const LAS bf16x8*)(lds + PG8_SB(b, h) + boff + n * 2048 + k * 1024); } while (0)
#define PG8_MMA(ai, bj, At, Bt) do { __builtin_amdgcn_s_setprio(1); _Pragma("unroll") for (int m = 0; m < 4; ++m) _Pragma("unroll") for (int n = 0; n < 2; ++n) _Pragma("unroll") for (int k = 0; k < 2; ++k) \
        acc[ai][bj][m][n] = __builtin_amdgcn_mfma_f32_16x16x32_bf16(Bt[n][k], At[m][k], acc[ai][bj][m][n], 0, 0, 0); __builtin_amdgcn_s_setprio(0); } while (0)
#define PG8_WAIT_V(n) asm volatile("s_waitcnt vmcnt(" #n ")" ::: "memory")
#define PG8_WAIT_L(n) asm volatile("s_waitcnt lgkmcnt(" #n ")" ::: "memory")
#define PG8_BAR __builtin_amdgcn_s_barrier()
#define PG8_SCHED __builtin_amdgcn_sched_barrier(0)
    Unit cur, nxt; int ui = 0;
    if (!S.next(0, cur)) return;
    f32x4 acc[2][2][4][2];
#pragma unroll
    for (int a = 0; a < 2; ++a)
#pragma unroll
        for (int b = 0; b < 2; ++b)
#pragma unroll
            for (int m = 0; m < 4; ++m)
#pragma unroll
                for (int n = 0; n < 2; ++n) acc[a][b][m][n] = (f32x4){0.f, 0.f, 0.f, 0.f};
    bf16x8 At[4][2], B0[2][2], B1[2][2];
    typename Epi::Pre pre{};
    const char* cA = cur.A; const char* cB = cur.B;
    PG8_STAGE(PG8_SB(0, 0), cB, voffB); PG8_STAGE(PG8_SB(0, 1), cB + hstepB, voffB); PG8_STAGE(PG8_SA(0, 0), cA, voffA); PG8_STAGE(PG8_SA(0, 1), cA + hstepA, voffA);
    if (wr == 1) PG8_BAR;
    PG8_WAIT_V(2); PG8_BAR;
    PG8_STAGE(PG8_SB(1, 0), cB + kstep, voffB); PG8_STAGE(PG8_SA(1, 0), cA + kstep, voffA); PG8_STAGE(PG8_SB(1, 1), cB + hstepB + kstep, voffB);
    PG8_WAIT_V(6); PG8_BAR;
    for (;;) {
        const bool has_next = S.next(ui + 1, nxt);
        const char* nA = has_next ? nxt.A : cA; const char* nB = has_next ? nxt.B : cB;
        for (int t = 0; t < nt; t += 2) {
            const bool last = (t == nt - 2);
            if (Epi::EARLY && last) pre = E.prefetch(cur, wr, wc, fr, fq);
            const char* a1 = cA + (size_t)(t + 1) * kstep;
            const char* a2 = last ? nA : cA + (size_t)(t + 2) * kstep; const char* b2 = last ? nB : cB + (size_t)(t + 2) * kstep;
            const char* a3 = a2 + kstep; const char* b3 = b2 + kstep;
            PG8_LDB(B0, 0, 0); PG8_LDB(B1, 0, 1); PG8_SCHED; PG8_LDA(At, 0, 0); PG8_STAGE(PG8_SA(1, 1), a1 + hstepA, voffA);
            PG8_WAIT_V(8); PG8_WAIT_L(0); PG8_BAR; PG8_MMA(0, 0, At, B0); PG8_MMA(0, 1, At, B1); PG8_BAR; PG8_SCHED;
            PG8_LDA(At, 0, 1); PG8_STAGE(PG8_SB(0, 0), b2, voffB); PG8_STAGE(PG8_SB(0, 1), b2 + hstepB, voffB); PG8_STAGE(PG8_SA(0, 0), a2, voffA);
            PG8_WAIT_V(8); PG8_WAIT_L(0); PG8_BAR; PG8_MMA(1, 0, At, B0); PG8_MMA(1, 1, At, B1); PG8_BAR; PG8_SCHED;
            PG8_LDB(B0, 1, 0); PG8_LDB(B1, 1, 1); PG8_SCHED; PG8_LDA(At, 1, 0); PG8_STAGE(PG8_SA(0, 1), a2 + hstepA, voffA);
            PG8_WAIT_V(8); PG8_WAIT_L(0); PG8_BAR; PG8_MMA(0, 0, At, B0); PG8_MMA(0, 1, At, B1); PG8_BAR; PG8_SCHED;
            PG8_LDA(At, 1, 1); PG8_STAGE(PG8_SB(1, 0), b3, voffB); PG8_STAGE(PG8_SB(1, 1), b3 + hstepB, voffB); PG8_STAGE(PG8_SA(1, 0), a3, voffA);
            PG8_WAIT_V(8); PG8_WAIT_L(0); PG8_BAR; PG8_MMA(1, 0, At, B0); PG8_MMA(1, 1, At, B1); PG8_BAR; PG8_SCHED;
        }
        if (wr == 0) PG8_BAR;
        if (!Epi::EARLY) pre = E.prefetch(cur, wr, wc, fr, fq);
        E(acc, cur, pre, wr, wc, fr, fq);
        if (!has_next) break;
#pragma unroll
        for (int a = 0; a < 2; ++a)
#pragma unroll
            for (int b = 0; b < 2; ++b)
#pragma unroll
                for (int m = 0; m < 4; ++m)
#pragma unroll
                    for (int n = 0; n < 2; ++n) acc[a][b][m][n] = (f32x4){0.f, 0.f, 0.f, 0.f};
        cur = nxt; cA = nA; cB = nB; ++ui;
        if (wr == 1) PG8_BAR;
    }
    PG8_WAIT_V(0);
    PG8_BAR;
#undef PG8_SA
#undef PG8_SB
#undef PG8_STAGE
#undef PG8_LDA
#undef PG8_LDB
#undef PG8_MMA
}
}
namespace epi {
using pg8::Unit;
typedef f32x4 Acc[2][2][4][2];
#define EPI_BAR() do { asm volatile("s_waitcnt lgkmcnt(0)" ::: "memory"); __builtin_amdgcn_s_barrier(); asm volatile("" ::: "memory"); } while (0)

__device__ __forceinline__ u32x4 pack8(const f32x4 a, const f32x4 b) { u32x4 w; w.x = cvt_pk_bf16(a[0], a[1]); w.y = cvt_pk_bf16(a[2], a[3]); w.z = cvt_pk_bf16(b[0], b[1]); w.w = cvt_pk_bf16(b[2], b[3]); return w; }
__device__ __forceinline__ u32x2 pack4(const f32x4 a) { u32x2 w; w.x = cvt_pk_bf16(a[0], a[1]); w.y = cvt_pk_bf16(a[2], a[3]); return w; }
__device__ __forceinline__ int row_pos(int row) { return row < MP ? (row & (SEQ - 1)) : PAST + ((row - MP) & (DECT - 1)); }
__device__ __forceinline__ f32x4 oth4(const f32x4 v, int odd) { f32x4 r; r[0] = other16(v[0], odd); r[1] = other16(v[1], odd); r[2] = other16(v[2], odd); r[3] = other16(v[3], odd); return r; }
__device__ __forceinline__ void store8_f32(float* p  , const f32x4 v0, const f32x4 v1, int fq) {
    f32x4 x, y;
#pragma unroll
    for (int j = 0; j < 4; ++j) { auto r = __builtin_amdgcn_permlane16_swap(__float_as_uint(v0[j]), __float_as_uint(v1[j]), false, false); x[j] = __uint_as_float(r[0]); y[j] = __uint_as_float(r[1]); }
    float* q = p + 16 * (fq >> 1) + 4 * (fq & 1);
    __builtin_nontemporal_store(x, (f32x4*)q); __builtin_nontemporal_store(y, (f32x4*)(q + 8));
}
struct PreNone {};
struct Pre8 { float v[8]; };
__device__ __forceinline__ Pre8 load8rows(const float* __restrict__ p, int row0) {
    Pre8 r;
#pragma unroll
    for (int i = 0; i < 8; ++i) r.v[i] = p[row0 + (i >> 2) * 128 + (i & 3) * 16];
    return r;
}
__device__ __forceinline__ void rope_cs(int pos, int n, f32x4& c, f32x4& s) {
    const float fp = (float)pos;
    const f32x4 k = n == 0 ? (f32x4){1.5915494309e-01f, 3.0863763405e-02f, 5.9851857127e-03f, 1.1606636412e-03f} : (f32x4){2.2507907904e-04f, 4.3647952793e-05f, 8.4643308082e-06f, 1.6414262628e-06f};
#pragma unroll
    for (int j = 0; j < 4; ++j) { const float r = __builtin_amdgcn_fractf(fp * k[j]); c[j] = __builtin_amdgcn_cosf(r); s[j] = __builtin_amdgcn_sinf(r); }
}

struct EpiInProj {
    static constexpr bool PERM = true, EARLY = true;
    typedef Pre8 Pre;
    const float* ssq;
    bf16_t* p1;
    float* out;
    __device__ __forceinline__ Pre prefetch(const Unit& u, int wr, int wc, int fr, int fq) const { return load8rows(ssq, u.pm * 256 + wr * 64 + fr); }
    __device__ __forceinline__ void operator()(Acc& acc, const Unit& u, const Pre& pre, int wr, int wc, int fr, int fq) const {
        const int pn = u.pn, row0 = u.pm * 256 + wr * 64 + fr;
        const int cl = 32 * wc + 8 * fq;
#pragma unroll
        for (int ai = 0; ai < 2; ++ai)
#pragma unroll
            for (int m = 0; m < 4; ++m) {
                const int row = row0 + ai * 128 + m * 16;
                const float rs = rsqrtf(pre.v[ai * 4 + m] * (1.0f / DM) + EPS);
                bf16_t* prow = p1 + (size_t)row * P1W;
                if (pn < 4) {
                    f32x4 c0, c1, s0, s1; const int pos = row_pos(row);
                    if ((wc & 1) == 0) { rope_cs(pos, 0, c0, s0); rope_cs(pos, 1, c1, s1); }
                    float* orow = (pn >= 2) ? (row < MP ? out + O_KP + (size_t)row * 512 : out + O_KS + (size_t)(row - MP) * 512) : nullptr;
#pragma unroll
                    for (int bj = 0; bj < 2; ++bj) {
                        f32x4 v0 = acc[ai][bj][m][0] * rs, v1 = acc[ai][bj][m][1] * rs;
                        if ((wc & 1) == 0) {
                            const f32x4 o0 = oth4(v0, fq & 1), o1 = oth4(v1, fq & 1);
                            if (fq == 0) { v0 = v0 * c0 - o0 * s0; v1 = v1 * c1 - o1 * s1; }
                            else if (fq == 1) { v0 = v0 * c0 + o0 * s0; v1 = v1 * c1 + o1 * s1; }
                        }
                        const int c = (pn & 1) * 256 + bj * 128 + cl;
                        if (pn >= 2) store8_f32(orow + c - 8 * fq, v0, v1, fq);
                        *(u32x4*)(prow + (pn >> 1) * 512 + c) = pack8(v0, v1);
                    }
                } else if (pn < 6) {
                    float* orow = row < MP ? out + O_VP + (size_t)row * 512 : out + O_VS + (size_t)(row - MP) * 512;
#pragma unroll
                    for (int bj = 0; bj < 2; ++bj) {
                        const f32x4 v0 = acc[ai][bj][m][0] * rs, v1 = acc[ai][bj][m][1] * rs;
                        const int c = (pn & 1) * 256 + bj * 128 + cl;
                        store8_f32(orow + c - 8 * fq, v0, v1, fq);
                        *(u32x4*)(prow + 1024 + c) = pack8(v0, v1);
                    }
                } else if (pn < 8) {
#pragma unroll
                    for (int bj = 0; bj < 2; ++bj) {
                        const f32x4 v0 = acc[ai][bj][m][0] * rs, v1 = acc[ai][bj][m][1] * rs;
                        const int c = (pn & 1) * 256 + bj * 128 + cl;
                        *(u32x4*)(prow + 1536 + c) = pack8(v0, v1);
                    }
                } else {
                    const float rs2 = rs * rs;
                    const f32x4 v0 = acc[ai][0][m][0] * acc[ai][1][m][0] * rs2, v1 = acc[ai][0][m][1] * acc[ai][1][m][1] * rs2;
                    const int c = (pn - 8) * 128 + cl;
                    *(u32x4*)(prow + 2048 + c) = pack8(v0, v1);
                    if (row < MP) { const int t = row & (SEQ - 1); if (t >= SEQ - 2) { float* o = out + O_SCP + ((size_t)(row >> 11) * 2 + (t - (SEQ - 2))) * CW + c; *(f32x4*)o = v0; *(f32x4*)(o + 4) = v1; } }
                    else { const int t = (row - MP) & (DECT - 1); if (t >= DECT - 2) { float* o = out + O_SCS + ((size_t)((row - MP) >> 4) * 2 + (t - (DECT - 2))) * CW + c; *(f32x4*)o = v0; *(f32x4*)(o + 4) = v1; } }
                }
            }
    }
};

struct EpiMemKV {
    static constexpr bool PERM = true, EARLY = true;
    typedef Pre8 Pre;
    const float* ssq; bf16_t* mk; bf16_t* mv; float* out;
    __device__ __forceinline__ Pre prefetch(const Unit& u, int wr, int wc, int fr, int fq) const { return load8rows(ssq, u.pm * 256 + wr * 64 + fr); }
    __device__ __forceinline__ void operator()(Acc& acc, const Unit& u, const Pre& pre, int wr, int wc, int fr, int fq) const {
        const int pn = u.pn, row0 = u.pm * 256 + wr * 64 + fr, cl = 32 * wc + 8 * fq;
        float* ob = out + (pn < 4 ? O_MK : O_MV); bf16_t* bb = pn < 4 ? mk : mv;
#pragma unroll
        for (int ai = 0; ai < 2; ++ai)
#pragma unroll
            for (int m = 0; m < 4; ++m) {
                const int row = row0 + ai * 128 + m * 16;
                const float rs = rsqrtf(pre.v[ai * 4 + m] * (1.0f / DM) + EPS);
#pragma unroll
                for (int bj = 0; bj < 2; ++bj) {
                    const f32x4 v0 = acc[ai][bj][m][0] * rs, v1 = acc[ai][bj][m][1] * rs;
                    const int c = (pn & 3) * 256 + bj * 128 + cl;
                    store8_f32(ob + (size_t)row * DM + c - 8 * fq, v0, v1, fq);
                    *(u32x4*)(bb + (size_t)row * DM + c) = pack8(v0, v1);
                }
            }
    }
};

struct EpiResidual {
    static constexpr bool PERM = true, EARLY = false;
    typedef PreNone Pre;
    bf16_t* XB; float* ssp;
    __device__ __forceinline__ Pre prefetch(const Unit&, int, int, int, int) const { return Pre{}; }
    __device__ __forceinline__ void operator()(Acc& acc, const Unit& u, const Pre&, int wr, int wc, int fr, int fq) const {
        const int row0 = u.pm * 256 + wr * 64 + fr, col0 = u.pn * 256 + wc * 32 + 8 * fq;
        bf16_t* xb = XB + (size_t)row0 * DM + col0;
        u32x4 old[8][2];
#pragma unroll
        for (int g = 0; g < 8; ++g)
#pragma unroll
            for (int bj = 0; bj < 2; ++bj) old[g][bj] = *(const u32x4*)(xb + (size_t)((g >> 2) * 128 + (g & 3) * 16) * DM + bj * 128);
#pragma unroll
        for (int g = 0; g < 8; ++g) {
            const int ai = g >> 2, m = g & 3, row = row0 + ai * 128 + m * 16; float ss = 0.f;
#pragma unroll
            for (int bj = 0; bj < 2; ++bj) {
                const u32x4 o = old[g][bj]; f32x4 v0, v1;
                v0[0] = __uint_as_float(o.x << 16) + acc[ai][bj][m][0][0]; v0[1] = __uint_as_float(o.x & 0xffff0000u) + acc[ai][bj][m][0][1]; v0[2] = __uint_as_float(o.y << 16) + acc[ai][bj][m][0][2]; v0[3] = __uint_as_float(o.y & 0xffff0000u) + acc[ai][bj][m][0][3];
                v1[0] = __uint_as_float(o.z << 16) + acc[ai][bj][m][1][0]; v1[1] = __uint_as_float(o.z & 0xffff0000u) + acc[ai][bj][m][1][1]; v1[2] = __uint_as_float(o.w << 16) + acc[ai][bj][m][1][2]; v1[3] = __uint_as_float(o.w & 0xffff0000u) + acc[ai][bj][m][1][3];
                ss += ((v0[0] * v0[0] + v0[1] * v0[1]) + (v0[2] * v0[2] + v0[3] * v0[3])) + ((v1[0] * v1[0] + v1[1] * v1[1]) + (v1[2] * v1[2] + v1[3] * v1[3]));
                *(u32x4*)(xb + (size_t)(ai * 128 + m * 16) * DM + bj * 128) = pack8(v0, v1);
            }
            ss = xor32_sum(xor16_sum(ss));
            if (fq == 0) ssp[(size_t)row * 16 + u.pn * 4 + wc] = ss;
        }
    }
};
struct EpiResidualOut {
    static constexpr bool PERM = false, EARLY = false;
    typedef PreNone Pre;
    const bf16_t* XB; float* X; float* ssp;
    __device__ __forceinline__ Pre prefetch(const Unit&, int, int, int, int) const { return Pre{}; }
    __device__ __forceinline__ void operator()(Acc& acc, const Unit& u, const Pre&, int wr, int wc, int fr, int fq) const {
        const int row0 = u.pm * 256 + wr * 64 + fr, col0 = u.pn * 256 + wc * 32 + 4 * fq;
        const bf16_t* xb = XB + (size_t)row0 * DM + col0;
        u32x2 old[8][2][2];
#pragma unroll
        for (int g = 0; g < 8; ++g)
#pragma unroll
            for (int bj = 0; bj < 2; ++bj)
#pragma unroll
                for (int n = 0; n < 2; ++n) old[g][bj][n] = *(const u32x2*)(xb + (size_t)((g >> 2) * 128 + (g & 3) * 16) * DM + bj * 128 + n * 16);
#pragma unroll
        for (int g = 0; g < 8; ++g) {
            const int ai = g >> 2, m = g & 3, row = row0 + ai * 128 + m * 16; float* xrow = X + (size_t)row * DM + col0; float ss = 0.f;
#pragma unroll
            for (int bj = 0; bj < 2; ++bj)
#pragma unroll
                for (int n = 0; n < 2; ++n) {
                    const u32x2 o = old[g][bj][n]; f32x4 v;
                    v[0] = __uint_as_float(o.x << 16) + acc[ai][bj][m][n][0]; v[1] = __uint_as_float(o.x & 0xffff0000u) + acc[ai][bj][m][n][1]; v[2] = __uint_as_float(o.y << 16) + acc[ai][bj][m][n][2]; v[3] = __uint_as_float(o.y & 0xffff0000u) + acc[ai][bj][m][n][3];
                    ss += (v[0] * v[0] + v[1] * v[1]) + (v[2] * v[2] + v[3] * v[3]);
                    *(f32x4*)(xrow + bj * 128 + n * 16) = v;
                }
            ss = xor32_sum(xor16_sum(ss));
            if (fq == 0) ssp[(size_t)row * 16 + u.pn * 4 + wc] = ss;
        }
    }
};
__device__ __forceinline__ float rstd16(const float* ssp, int row) {
    const f32x4* p = (const f32x4*)(ssp + (size_t)row * 16); const f32x4 a = p[0], b = p[1], c = p[2], d = p[3];
    const float s = ((a[0] + a[1]) + (a[2] + a[3])) + ((b[0] + b[1]) + (b[2] + b[3])) + ((c[0] + c[1]) + (c[2] + c[3])) + ((d[0] + d[1]) + (d[2] + d[3]));
    return rsqrtf(s * (1.0f / DM) + EPS);
}
struct EpiScaleBf16 {
    static constexpr bool PERM = true, EARLY = true;
    typedef Pre8 Pre;
    const float* rs; bf16_t* O; int ldo;
    __device__ __forceinline__ Pre prefetch(const Unit& u, int wr, int wc, int fr, int fq) const { return load8rows(rs, u.pm * 256 + wr * 64 + fr); }
    __device__ __forceinline__ void operator()(Acc& acc, const Unit& u, const Pre& pre, int wr, int wc, int fr, int fq) const {
        const int row0 = u.pm * 256 + wr * 64 + fr, col0 = u.pn * 256 + 32 * wc + 8 * fq;
#pragma unroll
        for (int ai = 0; ai < 2; ++ai)
#pragma unroll
            for (int m = 0; m < 4; ++m) {
                const int row = row0 + ai * 128 + m * 16; const float r = pre.v[ai * 4 + m];
#pragma unroll
                for (int bj = 0; bj < 2; ++bj) *(u32x4*)(O + (size_t)row * ldo + col0 + bj * 128) = pack8(acc[ai][bj][m][0] * r, acc[ai][bj][m][1] * r);
            }
    }
};
struct EpiXScores {
    static constexpr bool PERM = true, EARLY = false;
    typedef PreNone Pre;
    __device__ __forceinline__ Pre prefetch(const Unit&, int, int, int, int) const { return Pre{}; }
    bf16_t* P; float* lp; LAS float* red;
    __device__ __forceinline__ void operator()(Acc& acc, const Unit& u, const Pre&, int wr, int wc, int fr, int fq) const {
        constexpr float C = 0.0625f * 1.4426950408889634f;
        float mx[2][4];
#pragma unroll
        for (int ai = 0; ai < 2; ++ai)
#pragma unroll
            for (int m = 0; m < 4; ++m) {
                float a = -3.0e38f;
#pragma unroll
                for (int bj = 0; bj < 2; ++bj)
#pragma unroll
                    for (int n = 0; n < 2; ++n) { const f32x4 v = acc[ai][bj][m][n]; a = fmaxf(a, fmaxf(fmaxf(v[0], v[1]), fmaxf(v[2], v[3]))); }
                a = xor32_max(xor16_max(a));
                if (fq == 0) red[(ai * 128 + wr * 64 + m * 16 + fr) * 4 + wc] = a;
            }
        EPI_BAR();
#pragma unroll
        for (int ai = 0; ai < 2; ++ai)
#pragma unroll
            for (int m = 0; m < 4; ++m) { const f32x4 r = *(const LAS f32x4*)(red + (ai * 128 + wr * 64 + m * 16 + fr) * 4); mx[ai][m] = fmaxf(fmaxf(r[0], r[1]), fmaxf(r[2], r[3])); }
        const int row0 = u.pm * 256 + wr * 64 + fr, col0 = u.pn * 256 + 32 * wc + 8 * fq;
#pragma unroll
        for (int ai = 0; ai < 2; ++ai)
#pragma unroll
            for (int m = 0; m < 4; ++m) {
                const int row = row0 + ai * 128 + m * 16; const float mc = mx[ai][m] * C; float s = 0.f;
#pragma unroll
                for (int bj = 0; bj < 2; ++bj) {
#pragma unroll
                    for (int j = 0; j < 4; ++j) { acc[ai][bj][m][0][j] = __builtin_amdgcn_exp2f(acc[ai][bj][m][0][j] * C - mc); acc[ai][bj][m][1][j] = __builtin_amdgcn_exp2f(acc[ai][bj][m][1][j] * C - mc); }
                    const u32x4 w = pack8(acc[ai][bj][m][0], acc[ai][bj][m][1]);
                    s += (__uint_as_float(w.x << 16) + __uint_as_float(w.x & 0xffff0000u)) + (__uint_as_float(w.y << 16) + __uint_as_float(w.y & 0xffff0000u))
                       + (__uint_as_float(w.z << 16) + __uint_as_float(w.z & 0xffff0000u)) + (__uint_as_float(w.w << 16) + __uint_as_float(w.w & 0xffff0000u));
                    *(u32x4*)(P + (size_t)row * DM + col0 + bj * 128) = w;
                }
                s = xor32_sum(xor16_sum(s));
                if (fq == 0) lp[(size_t)row * 16 + u.pn * 4 + wc] = s;
                asm volatile("" ::: "memory");
            }
        EPI_BAR();
    }
};
struct EpiXPV {
    static constexpr bool PERM = true, EARLY = false;
    typedef PreNone Pre;
    __device__ __forceinline__ Pre prefetch(const Unit&, int, int, int, int) const { return Pre{}; }
    const float* lp; bf16_t* O;
    __device__ __forceinline__ void operator()(Acc& acc, const Unit& u, const Pre&, int wr, int wc, int fr, int fq) const {
        const int row0 = u.pm * 256 + wr * 64 + fr, col0 = u.pn * 256 + 32 * wc + 8 * fq;
#pragma unroll
        for (int ai = 0; ai < 2; ++ai)
#pragma unroll
            for (int m = 0; m < 4; ++m) {
                const int row = row0 + ai * 128 + m * 16; const f32x4 l4 = *(const f32x4*)(lp + (size_t)row * 16 + u.pn * 4);
                const float rl = 1.0f / ((l4[0] + l4[1]) + (l4[2] + l4[3]));
#pragma unroll
                for (int bj = 0; bj < 2; ++bj) *(u32x4*)(O + (size_t)row * DM + col0 + bj * 128) = pack8(acc[ai][bj][m][0] * rl, acc[ai][bj][m][1] * rl);
            }
    }
};
struct EpiUpGate {
    static constexpr bool PERM = true, EARLY = false;
    typedef Pre8 Pre;
    const float* rs; const float* wconv;
    const float* state;
    bf16_t* H; float* out;
    float* uh; float* u01; float* g01;
    LAS float* tail;
    __device__ __forceinline__ Pre prefetch(const Unit& u, int wr, int wc, int fr, int fq) const { return load8rows(rs, u.pm * 256 + wr * 64 + fr); }
    __device__ __forceinline__ void operator()(Acc& acc, const Unit& u, const Pre& pre, int wr, int wc, int fr, int fq) const {
        const int pm = u.pm, pn = u.pn, row0 = pm * 256 + wr * 64 + fr, cl = 32 * wc + 8 * fq, gc = pn * 128 + cl;
        const bool sample = pm >= NTILE_P;
        const f32x4 w00 = *(const f32x4*)(wconv + gc), w01 = *(const f32x4*)(wconv + gc + 4), w10 = *(const f32x4*)(wconv + DFF + gc), w11 = *(const f32x4*)(wconv + DFF + gc + 4),
                    w20 = *(const f32x4*)(wconv + 2 * DFF + gc), w21 = *(const f32x4*)(wconv + 2 * DFF + gc + 4);
#pragma unroll
        for (int ai = 0; ai < 2; ++ai)
#pragma unroll
            for (int m = 0; m < 4; ++m) {
                const int g = ai * 8 + wr * 4 + m; const float r = pre.v[ai * 4 + m];
#pragma unroll
                for (int bj = 0; bj < 2; ++bj)
#pragma unroll
                    for (int n = 0; n < 2; ++n) acc[ai][bj][m][n] *= r;
                if (fr >= 14) {
                    LAS float* t = tail + (g * 2 + (fr - 14)) * 128 + cl; *(LAS f32x4*)t = acc[ai][0][m][0]; *(LAS f32x4*)(t + 4) = acc[ai][0][m][1];
                    if (sample) { float* o = out + O_FFS + ((size_t)((pm - NTILE_P) * 16 + g) * 2 + (fr - 14)) * DFF + gc; *(f32x4*)o = acc[ai][0][m][0]; *(f32x4*)(o + 4) = acc[ai][0][m][1]; }
                    else if (g == 15) {
                        float* o = uh + ((size_t)pm * 2 + (fr - 14)) * DFF + gc; *(f32x4*)o = acc[ai][0][m][0]; *(f32x4*)(o + 4) = acc[ai][0][m][1];
                        if ((pm & 7) == 7) { float* q = out + O_FFP + ((size_t)(pm >> 3) * 2 + (fr - 14)) * DFF + gc; *(f32x4*)q = acc[ai][0][m][0]; *(f32x4*)(q + 4) = acc[ai][0][m][1]; }
                    }
                }
                if (!sample && g == 0 && fr < 2) {
                    float* o = u01 + ((size_t)pm * 2 + fr) * DFF + gc; *(f32x4*)o = acc[ai][0][m][0]; *(f32x4*)(o + 4) = acc[ai][0][m][1];
                    float* q = g01 + ((size_t)pm * 2 + fr) * DFF + gc; *(f32x4*)q = acc[ai][1][m][0]; *(f32x4*)(q + 4) = acc[ai][1][m][1];
                }
            }
        EPI_BAR();
#pragma unroll
        for (int ai = 0; ai < 2; ++ai)
#pragma unroll
            for (int m = 0; m < 4; ++m) {
                const int row = row0 + ai * 128 + m * 16, g = ai * 8 + wr * 4 + m;
                f32x4 h1[2] = {(f32x4){0.f, 0.f, 0.f, 0.f}, (f32x4){0.f, 0.f, 0.f, 0.f}}, h2[2] = {(f32x4){0.f, 0.f, 0.f, 0.f}, (f32x4){0.f, 0.f, 0.f, 0.f}};
                if (fr < 2) {
                    if (sample) { const float* s = state + (size_t)((pm - NTILE_P) * 16 + g) * 2 * DFF + gc; h2[0] = *(const f32x4*)(s + fr * DFF); h2[1] = *(const f32x4*)(s + fr * DFF + 4); if (fr == 0) { h1[0] = *(const f32x4*)(s + DFF); h1[1] = *(const f32x4*)(s + DFF + 4); } }
                    else if (g > 0) { const LAS float* t = tail + ((g - 1) * 2) * 128 + cl; h2[0] = *(const LAS f32x4*)(t + fr * 128); h2[1] = *(const LAS f32x4*)(t + fr * 128 + 4); if (fr == 0) { h1[0] = *(const LAS f32x4*)(t + 128); h1[1] = *(const LAS f32x4*)(t + 132); } }
                }
                f32x4 hv[2];
#pragma unroll
                for (int n = 0; n < 2; ++n) {
                    const f32x4 uc = acc[ai][0][m][n];
                    const f32x4 wa = (n == 0 ? w00 : w01), wb = (n == 0 ? w10 : w11), wc2 = (n == 0 ? w20 : w21);
                    f32x4 y = wa * h2[n] + wb * h1[n];
                    y = wc2 * uc + y;
#pragma unroll
                    for (int j = 0; j < 4; ++j) {
                        float yj = y[j];
                        asm volatile("v_fmac_f32_dpp %0, %1, %2 row_shr:1 row_mask:0xf bank_mask:0xf bound_ctrl:0\n\tv_fmac_f32_dpp %0, %1, %3 row_shr:2 row_mask:0xf bank_mask:0xf bound_ctrl:0"
                                     : "+v"(yj) : "v"(uc[j]), "v"(wb[j]), "v"(wa[j]));
                        y[j] = yj; }
                    const f32x4 t = y * (-1.4426950408889634f); f32x4 d;
#pragma unroll
                    for (int j = 0; j < 4; ++j) d[j] = __builtin_amdgcn_exp2f(t[j]);
                    d = d + 1.0f;
#pragma unroll
                    for (int j = 0; j < 4; ++j) d[j] = __builtin_amdgcn_rcpf(d[j]);
                    hv[n] = (y * d) * acc[ai][1][m][n];
                }
                *(u32x4*)(H + (size_t)row * DFF + gc) = pack8(hv[0], hv[1]);
            }
        EPI_BAR();
    }
};
struct EpiPartialF32 {
    static constexpr bool PERM = false, EARLY = false;
    typedef PreNone Pre;
    float* S;
    __device__ __forceinline__ Pre prefetch(const Unit&, int, int, int, int) const { return Pre{}; }
    __device__ __forceinline__ void operator()(Acc& acc, const Unit& u, const Pre&, int wr, int wc, int fr, int fq) const {
        const int kh = u.pn >> 4, pn = u.pn & 15, row0 = (u.pm - NTILE_P) * 256 + wr * 64 + fr, col0 = pn * 256 + wc * 32 + 4 * fq;
        float* b = S + (size_t)kh * MS * DM + (size_t)row0 * DM + col0;
#pragma unroll
        for (int ai = 0; ai < 2; ++ai)
#pragma unroll
            for (int m = 0; m < 4; ++m)
#pragma unroll
                for (int bj = 0; bj < 2; ++bj)
#pragma unroll
                    for (int n = 0; n < 2; ++n) *(f32x4*)(b + (size_t)(ai * 128 + m * 16) * DM + bj * 128 + n * 16) = acc[ai][bj][m][n];
    }
};
}
namespace dattn {
constexpr int NW = 8, QBLK = 32, KVBLK = 64;
constexpr float SCALE = 0.125f, THR = 8.f;
constexpr int SHM_V = KVBLK * 128 * 2, SHM_K = KVBLK * 128 * 2, SHM_ATTN = 2 * SHM_V + 2 * SHM_K + NW * 64 * 4;
#define KSWZ(row, colB) ((row) * 256 + ((colB) ^ (((row) & 7) << 4)))
#define SBAR() __builtin_amdgcn_sched_barrier(0)
__device__ __forceinline__ int crow(int r, int hi) { return (r & 3) + 8 * (r >> 2) + 4 * hi; }
__device__ __forceinline__ void partialSM(f32x16& p0, f32x16& p1, float& m_reg, float& mn, float& alpha) {
  constexpr float C = SCALE * 1.4426950408889634f;
  float pmax = p0[0];
#pragma unroll
  for (int r = 1; r < 16; ++r) pmax = fmaxf(pmax, p0[r]);
#pragma unroll
  for (int r = 0; r < 16; ++r) pmax = fmaxf(pmax, p1[r]);
  { auto rr = __builtin_amdgcn_permlane32_swap(__float_as_uint(pmax), __float_as_uint(pmax), false, false);
    pmax = fmaxf(__uint_as_float(rr[0]), __uint_as_float(rr[1])); }
  if (__builtin_expect(__all(pmax - m_reg <= THR / SCALE), 1)) { mn = m_reg; alpha = 1.f; }
  else { mn = fmaxf(m_reg, pmax); alpha = __builtin_amdgcn_exp2f((m_reg - mn) * C); m_reg = mn; }
  const float mnC = -mn * C;
#pragma unroll
  for (int r = 0; r < 16; ++r) p0[r] = fmaf(p0[r], C, mnC);
#pragma unroll
  for (int r = 0; r < 16; ++r) p1[r] = fmaf(p1[r], C, mnC);
#pragma unroll
  for (int r = 0; r < 16; ++r) p0[r] = __builtin_amdgcn_exp2f(p0[r]);
}
__device__ __forceinline__ void finishSM(f32x16& p0, f32x16& p1, float alpha, float& l_reg, bf16x8& pa0, bf16x8& pa1, bf16x8& pa2, bf16x8& pa3) {
#pragma unroll
  for (int r = 0; r < 16; ++r) p1[r] = __builtin_amdgcn_exp2f(p1[r]);
  float ps = 0;
#pragma unroll
  for (int r = 0; r < 16; ++r) ps += p0[r];
#pragma unroll
  for (int r = 0; r < 16; ++r) ps += p1[r];
  { auto rr = __builtin_amdgcn_permlane32_swap(__float_as_uint(ps), __float_as_uint(ps), false, false);
    ps = __uint_as_float(rr[0]) + __uint_as_float(rr[1]); }
  l_reg = l_reg * alpha + ps;
#define PK4(P, BASE, OUT) do { unsigned a0 = cvt_pk_bf16(P[BASE + 0], P[BASE + 1]), a1 = cvt_pk_bf16(P[BASE + 2], P[BASE + 3]);   \
    unsigned b0 = cvt_pk_bf16(P[BASE + 4], P[BASE + 5]), b1 = cvt_pk_bf16(P[BASE + 6], P[BASE + 7]);                              \
    auto r0 = __builtin_amdgcn_permlane32_swap(a0, b0, false, false); auto r1 = __builtin_amdgcn_permlane32_swap(a1, b1, false, false); \
    u32x4 w = {r0[0], r1[0], r0[1], r1[1]}; OUT = *reinterpret_cast<bf16x8*>(&w); } while (0)
  PK4(p0, 0, pa0); PK4(p0, 8, pa1); PK4(p1, 0, pa2); PK4(p1, 8, pa3);
#undef PK4
}
__device__ __forceinline__ void qkt(f32x16& p0, f32x16& p1, const char* Ks, const bf16x8* qr, int r32, int hi, int mp) {
  p0 = f32x16{}; p1 = f32x16{};
#pragma unroll
  for (int d0 = 0; d0 < 4; ++d0) { const int cb = (mp * 64 + d0 * 16 + hi * 8) * 2;
    const bf16x8 b0 = *reinterpret_cast<const bf16x8*>(Ks + KSWZ(r32, cb));
    const bf16x8 b1 = *reinterpret_cast<const bf16x8*>(Ks + KSWZ(32 + r32, cb));
    p0 = __builtin_amdgcn_mfma_f32_32x32x16_bf16(b0, qr[d0], p0, 0, 0, 0);
    p1 = __builtin_amdgcn_mfma_f32_32x32x16_bf16(b1, qr[d0], p1, 0, 0, 0); }
}
__device__ __forceinline__ int v_st(int k, int c) { const int kk = (k & ~0xC) | ((k & 4) << 1) | ((k & 8) >> 1); return ((kk >> 3) * 4 + (c >> 5)) * 512 + ((kk & 7) * 32 + (c & 31)) * 2; }
__device__ __forceinline__ int v_rd_base(int lane) { return ((lane & 3) << 3) | (((lane >> 2) & 3) << 6) | (((lane >> 4) & 1) << 5) | (((lane >> 5) & 1) << 8); }
constexpr int v_rd_off(int d0, int ks, int half) { return d0 * 512 + ks * 4096 + half * 2048; }
template <int OFF> __device__ __forceinline__ s16x4 tr_read(int vb) {
  s16x4 r; asm volatile("ds_read_b64_tr_b16 %0, %1 offset:%2" : "=&v"(r) : "v"(vb), "i"(OFF) : "memory"); return r;
}
template <int D0> __device__ __forceinline__ void pv_one(f32x16& od, int vb, bf16x8 pa0, bf16x8 pa1, bf16x8 pa2, bf16x8 pa3) {
  const s16x4 l0 = tr_read<v_rd_off(D0, 0, 0)>(vb), h0 = tr_read<v_rd_off(D0, 0, 1)>(vb), l1 = tr_read<v_rd_off(D0, 1, 0)>(vb), h1 = tr_read<v_rd_off(D0, 1, 1)>(vb);
  const s16x4 l2 = tr_read<v_rd_off(D0, 2, 0)>(vb), h2 = tr_read<v_rd_off(D0, 2, 1)>(vb), l3 = tr_read<v_rd_off(D0, 3, 0)>(vb), h3 = tr_read<v_rd_off(D0, 3, 1)>(vb);
  asm volatile("s_waitcnt lgkmcnt(0)" ::: "memory"); SBAR();
#define PK(L, H) (bf16x8){L[0], L[1], L[2], L[3], H[0], H[1], H[2], H[3]}
  od = __builtin_amdgcn_mfma_f32_32x32x16_bf16(pa0, PK(l0, h0), od, 0, 0, 0);
  od = __builtin_amdgcn_mfma_f32_32x32x16_bf16(pa1, PK(l1, h1), od, 0, 0, 0);
  od = __builtin_amdgcn_mfma_f32_32x32x16_bf16(pa2, PK(l2, h2), od, 0, 0, 0);
  od = __builtin_amdgcn_mfma_f32_32x32x16_bf16(pa3, PK(l3, h3), od, 0, 0, 0);
#undef PK
}
__device__ __forceinline__ void pv_d0(f32x16* o, int vb, bf16x8 pa0, bf16x8 pa1, bf16x8 pa2, bf16x8 pa3) {
  pv_one<0>(o[0], vb, pa0, pa1, pa2, pa3); pv_one<1>(o[1], vb, pa0, pa1, pa2, pa3); pv_one<2>(o[2], vb, pa0, pa1, pa2, pa3); pv_one<3>(o[3], vb, pa0, pa1, pa2, pa3);
}

__device__ __forceinline__ void qkt3(f32x16& p0, f32x16& p1, const LAS char* Ks, const bf16x8* qr, int r32, int hi, int mp) {
  p0 = f32x16{}; p1 = f32x16{};
#pragma unroll
  for (int d0 = 0; d0 < 4; ++d0) { const int cb = (mp * 64 + d0 * 16 + hi * 8) * 2;
    const bf16x8 b0 = *reinterpret_cast<const LAS bf16x8*>(Ks + KSWZ(r32, cb));
    const bf16x8 b1 = *reinterpret_cast<const LAS bf16x8*>(Ks + KSWZ(32 + r32, cb));
    p0 = __builtin_amdgcn_mfma_f32_32x32x16_bf16(b0, qr[d0], p0, 0, 0, 0);
    p1 = __builtin_amdgcn_mfma_f32_32x32x16_bf16(b1, qr[d0], p1, 0, 0, 0); }
}
__device__ __forceinline__ void unit(int b, int h, int qb, const bf16_t* __restrict__ p1, bf16_t* __restrict__ A2, float lam, const float* __restrict__ gsub, LAS char* lds3) {
  int tid = threadIdx.x; asm volatile("" : "+v"(tid));
  const int wid = __builtin_amdgcn_readfirstlane(tid >> 6), lane = tid & 63, r32 = lane & 31, hi = lane >> 5, wq = wid & 3, mp = wid >> 2;
  LAS float* ws = (LAS float*)(lds3 + 131072) + wid * 64; LAS float* li_l = ws; LAS float* al_l = ws + 32;
  float m_reg = -1e30f, l_reg = 0; f32x16 o[4] = {}; bf16x8 qr[4];
  const size_t rowb = (size_t)b * SEQ;
  const char* Kh = (const char*)(p1 + rowb * P1W + 512 + h * 128); const char* Vh = (const char*)(p1 + rowb * P1W + 1024 + h * 128);
  unsigned koff[2], voff[2];
#pragma unroll
  for (int i = 0; i < 2; ++i) {
    const int krow = wid * 8 + i * 4 + (lane >> 4), kch = (lane & 15) ^ (krow & 7); koff[i] = (unsigned)(krow * P1W * 2 + kch * 16);
    const int sub = wid * 4 + i * 2 + (lane >> 5), kk = (sub >> 2) * 8 + ((lane & 31) >> 2), key = (kk & ~0xC) | ((kk & 4) << 1) | ((kk & 8) >> 1), c = (sub & 3) * 32 + (lane & 3) * 8;
    voff[i] = (unsigned)(key * P1W * 2 + c * 2);
  }
  const unsigned dmaw = (unsigned)wid * 2048u;
#define DMA(t, slot) do { const char* kb_ = Kh + (size_t)(t) * (KVBLK * P1W * 2); const char* vb_ = Vh + (size_t)(t) * (KVBLK * P1W * 2); _Pragma("unroll") for (int i_ = 0; i_ < 2; ++i_) { \
    __builtin_amdgcn_global_load_lds((const unsigned*)(kb_ + koff[i_]), (LAS unsigned*)(lds3 + (slot) * 32768 + dmaw + i_ * 1024), 16, 0, 0); \
    __builtin_amdgcn_global_load_lds((const unsigned*)(vb_ + voff[i_]), (LAS unsigned*)(lds3 + (slot) * 32768 + 16384 + dmaw + i_ * 1024), 16, 0, 0); } } while (0)
#define WAITV(n) asm volatile("s_waitcnt vmcnt(" #n ")" ::: "memory")
#define LBAR() do { asm volatile("s_waitcnt lgkmcnt(0)" ::: "memory"); __builtin_amdgcn_s_barrier(); asm volatile("" ::: "memory"); } while (0)
#define KS(t) (lds3 + ((t) & 3) * 32768)
#define VB(t) (vrd + ((t) & 3) * 32768)
  const int NT = 2 * qb + 2;
  const bool vis_last = (wq >= 2);
  DMA(0, 0); DMA(1, 1);
  const bf16_t* Qw = p1 + (rowb + qb * 128 + wq * QBLK + r32) * P1W + h * 128 + mp * 64 + hi * 8;
#pragma unroll
  for (int d0 = 0; d0 < 4; ++d0) qr[d0] = *reinterpret_cast<const bf16x8*>(Qw + d0 * 16);
  const int vrd = (int)(uintptr_t)lds3 + 16384 + v_rd_base(lane);
#define RESC(a) do { if (__any((a) < 1.f)) { if (hi == 0) al_l[r32] = (a); asm volatile("s_waitcnt lgkmcnt(0)" ::: "memory"); \
    _Pragma("unroll") for (int d = 0; d < 4; ++d) _Pragma("unroll") for (int r = 0; r < 16; ++r) o[d][r] *= al_l[crow(r, hi)]; } } while (0)
  f32x16 pA0, pA1, pB0, pB1; float mnA, mnB, alA, alB; bf16x8 pa0, pa1, pa2, pa3;
  WAITV(4); LBAR();
  if (2 < NT) DMA(2, 2);
  qkt3(pA0, pA1, KS(0), qr, r32, hi, mp); partialSM(pA0, pA1, m_reg, mnA, alA);
  for (int j = 1; j + 1 < NT; j += 2) {
    WAITV(4); LBAR(); DMA(j + 2, (j + 2) & 3);
    SBAR(); qkt3(pB0, pB1, KS(j), qr, r32, hi, mp);
    finishSM(pA0, pA1, alA, l_reg, pa0, pa1, pa2, pa3); SBAR();
    pv_d0(o, VB(j - 1), pa0, pa1, pa2, pa3); partialSM(pB0, pB1, m_reg, mnB, alB);
    RESC(alB);
    WAITV(4); LBAR(); if (j + 3 < NT) DMA(j + 3, (j + 3) & 3);
    SBAR(); qkt3(pA0, pA1, KS(j + 1), qr, r32, hi, mp);
    finishSM(pB0, pB1, alB, l_reg, pa0, pa1, pa2, pa3); SBAR();
    pv_d0(o, VB(j), pa0, pa1, pa2, pa3); partialSM(pA0, pA1, m_reg, mnA, alA);
    RESC(alA);
  }
  WAITV(0); LBAR();
  SBAR();
  if (vis_last) qkt3(pB0, pB1, KS(NT - 1), qr, r32, hi, mp);
  finishSM(pA0, pA1, alA, l_reg, pa0, pa1, pa2, pa3); SBAR();
  pv_d0(o, VB(NT - 2), pa0, pa1, pa2, pa3);
  if (vis_last) {
    partialSM(pB0, pB1, m_reg, mnB, alB);
    RESC(alB);
    finishSM(pB0, pB1, alB, l_reg, pa0, pa1, pa2, pa3); SBAR();
    pv_d0(o, VB(NT - 1), pa0, pa1, pa2, pa3);
  }
  if (hi == 0) li_l[r32] = l_reg; asm volatile("s_waitcnt lgkmcnt(0)" ::: "memory");
  float rli[16];
#pragma unroll
  for (int r = 0; r < 16; ++r) rli[r] = __builtin_amdgcn_rcpf(li_l[crow(r, hi)]);
  LBAR();
  LAS float* X = (LAS float*)lds3 + wq * (32 * 132);
  if (mp == 1) {
#pragma unroll
    for (int r = 0; r < 16; ++r) { const int orow = crow(r, hi);
#pragma unroll
      for (int d0 = 0; d0 < 4; ++d0) X[orow * 132 + d0 * 32 + r32] = o[d0][r] * rli[r]; }
  }
  LBAR();
  if (mp == 0) {
#pragma unroll
    for (int r = 0; r < 16; ++r) { const int orow = crow(r, hi);
#pragma unroll
      for (int d0 = 0; d0 < 4; ++d0) { LAS float* p = &X[orow * 132 + d0 * 32 + r32]; *p = o[d0][r] * rli[r] - lam * (*p); } }
    asm volatile("s_waitcnt lgkmcnt(0)" ::: "memory");
    const int row = lane >> 1, half = lane & 1; const LAS float* xr = X + row * 132 + half * 64;
    f32x4 v[16]; float ss = 0.f;
#pragma unroll
    for (int i = 0; i < 16; ++i) { v[i] = *(const LAS f32x4*)(xr + 4 * i); ss += (v[i][0] * v[i][0] + v[i][1] * v[i][1]) + (v[i][2] * v[i][2] + v[i][3] * v[i][3]); }
    ss += DPPF(ss, 0xB1);
    const float rs = rsqrtf(ss * (1.0f / 128.0f) + EPS) * (1.0f - LAM_INIT);
    bf16_t* orow = A2 + (rowb + qb * 128 + wq * QBLK + row) * DM + h * 128 + half * 64; const float* g = gsub + half * 64;
#pragma unroll
    for (int i = 0; i < 16; i += 2) { const f32x4 g0 = *(const f32x4*)(g + 4 * i), g1 = *(const f32x4*)(g + 4 * i + 4);
      *(u32x4*)(orow + 4 * i) = epi::pack8(v[i] * g0 * rs, v[i + 1] * g1 * rs); }
  }
  asm volatile("s_waitcnt vmcnt(0)" ::: "memory");
  LBAR();
#undef DMA
#undef WAITV
#undef LBAR
#undef KS
#undef VB
#undef RESC
}
#undef KSWZ
#undef SBAR
}
namespace misc {
constexpr int SK = PAST + DECT;
__device__ __forceinline__ void sample_attn_unit(int b, int h, int qh, const bf16_t* __restrict__ p1, const float* __restrict__ ck, const float* __restrict__ cv,
                                                 const float* __restrict__ nk, const float* __restrict__ nv, bf16_t* __restrict__ A2, float lam, const float* __restrict__ gsub, char* lds) {
  int tid = threadIdx.x; asm volatile("" : "+v"(tid)); const int lane = tid & 63, wid = tid >> 6;
  float* S = (float*)lds; float* red = (float*)(lds + 66560); float* q = (float*)(lds + 132096); float* st = (float*)(lds + 136192);
  for (int i = tid; i < 1024; i += 512) { const int mp = i >> 9, r = (i >> 6) & 7, d = i & 63;
    q[i] = bf2f(p1[(size_t)(MP + b * DECT + qh * 8 + r) * P1W + h * 128 + mp * 64 + d]); }
  __syncthreads();
  for (int it = tid; it < 2 * SK; it += 512) {
    const int mp = it / SK, key = it - mp * SK;
    const float* kp = key < PAST ? ck + (((size_t)b * PAST + key) * NH + h) * 128 + mp * 64 : nk + ((size_t)(b * DECT + key - PAST)) * 512 + h * 128 + mp * 64;
    float a[8] = {0.f, 0.f, 0.f, 0.f, 0.f, 0.f, 0.f, 0.f};
#pragma unroll 4
    for (int d = 0; d < 64; d += 4) { const f32x4 kv = *(const f32x4*)(kp + d);
#pragma unroll
      for (int r = 0; r < 8; ++r) { const f32x4 qv = *(const f32x4*)(q + (mp * 8 + r) * 64 + d); a[r] += (kv[0] * qv[0] + kv[1] * qv[1]) + (kv[2] * qv[2] + kv[3] * qv[3]); } }
#pragma unroll
    for (int r = 0; r < 8; ++r) S[(mp * 8 + r) * SK + key] = a[r] * 0.125f;
  }
  __syncthreads();
  for (int rr = 0; rr < 2; ++rr) { const int row = wid * 2 + rr; float* s = S + row * SK;
    float mx = -3.0e38f; for (int k = lane; k < SK; k += 64) mx = fmaxf(mx, s[k]); mx = wave_max(mx);
    float sum = 0.f; for (int k = lane; k < SK; k += 64) { const float e = __expf(s[k] - mx); s[k] = e; sum += e; } sum = wave_sum(sum);
    if (lane == 0) st[row] = 1.0f / sum; }
  __syncthreads();
  for (int i = tid; i < 8 * SK; i += 512) { const int r = i / SK, k = i - r * SK; S[r * SK + k] = S[r * SK + k] * st[r] - lam * S[(8 + r) * SK + k] * st[8 + r]; }
  __syncthreads();
  { const int eg = tid & 31, ks = tid >> 5; f32x4 o[8];
#pragma unroll
    for (int r = 0; r < 8; ++r) o[r] = (f32x4){0.f, 0.f, 0.f, 0.f};
    for (int key = ks; key < SK; key += 16) {
      const float* vp = key < PAST ? cv + (((size_t)b * PAST + key) * NH + h) * 128 + eg * 4 : nv + ((size_t)(b * DECT + key - PAST)) * 512 + h * 128 + eg * 4;
      const f32x4 vv = *(const f32x4*)vp;
#pragma unroll
      for (int r = 0; r < 8; ++r) o[r] += vv * S[r * SK + key]; }
#pragma unroll
    for (int r = 0; r < 8; ++r) *(f32x4*)(red + (ks * 8 + r) * 128 + eg * 4) = o[r]; }
  __syncthreads();
  { const int r = wid; float x0 = 0.f, x1 = 0.f;
#pragma unroll
    for (int ks = 0; ks < 16; ++ks) { const f32x2 t = *(const f32x2*)(red + (ks * 8 + r) * 128 + 2 * lane); x0 += t[0]; x1 += t[1]; }
    const float ss = wave_sum(x0 * x0 + x1 * x1); const float rs = rsqrtf(ss * (1.0f / 128.0f) + EPS) * (1.0f - LAM_INIT);
    const unsigned w = cvt_pk_bf16(x0 * rs * gsub[2 * lane], x1 * rs * gsub[2 * lane + 1]);
    *(unsigned*)(A2 + (size_t)(MP + b * DECT + qh * 8 + r) * DM + h * 128 + 2 * lane) = w; }
  __syncthreads();
}

__device__ __forceinline__ void sample_xattn_unit(int b, int h, const bf16_t* __restrict__ HQ, const float* __restrict__ mk, const float* __restrict__ mv, bf16_t* __restrict__ XO, char* lds) {
  int tid = threadIdx.x; asm volatile("" : "+v"(tid)); const int lane = tid & 63, wid = tid >> 6;
  float* q = (float*)lds; float* S = (float*)(lds + 16384);
  for (int i = tid; i < 16 * 256; i += 512) { const int r = i >> 8, d = i & 255; q[i] = bf2f(HQ[(size_t)(MP + b * DECT + r) * DM + h * 256 + d]); }
  __syncthreads();
  { const int key = tid >> 1, qh = tid & 1; const float* kp = mk + (((size_t)b * NMEM + key) * NH + h) * 256;
    float a[8] = {0.f, 0.f, 0.f, 0.f, 0.f, 0.f, 0.f, 0.f};
#pragma unroll 4
    for (int d = 0; d < 256; d += 4) { const f32x4 kv = *(const f32x4*)(kp + d);
#pragma unroll
      for (int r = 0; r < 8; ++r) { const f32x4 qv = *(const f32x4*)(q + (qh * 8 + r) * 256 + d); a[r] += (kv[0] * qv[0] + kv[1] * qv[1]) + (kv[2] * qv[2] + kv[3] * qv[3]); } }
#pragma unroll
    for (int r = 0; r < 8; ++r) S[(qh * 8 + r) * 256 + key] = a[r] * 0.0625f; }
  __syncthreads();
  for (int rr = 0; rr < 2; ++rr) { const int row = wid * 2 + rr; float* s = S + row * 256;
    float v[4]; float mx = -3.0e38f;
#pragma unroll
    for (int i = 0; i < 4; ++i) { v[i] = s[lane + 64 * i]; mx = fmaxf(mx, v[i]); } mx = wave_max(mx);
    float sum = 0.f;
#pragma unroll
    for (int i = 0; i < 4; ++i) { v[i] = __expf(v[i] - mx); sum += v[i]; } sum = wave_sum(sum); const float rl = 1.0f / sum;
#pragma unroll
    for (int i = 0; i < 4; ++i) s[lane + 64 * i] = v[i] * rl; }
  __syncthreads();
  { const int r = tid >> 5, dg = tid & 31; const float* vp = mv + ((size_t)b * NMEM * NH + h) * 256 + dg * 8; f32x4 o0 = {0.f, 0.f, 0.f, 0.f}, o1 = {0.f, 0.f, 0.f, 0.f};
    for (int key = 0; key < NMEM; ++key) { const float p = S[r * 256 + key]; const f32x4 a = *(const f32x4*)(vp + (size_t)key * NH * 256), c = *(const f32x4*)(vp + (size_t)key * NH * 256 + 4); o0 += a * p; o1 += c * p; }
    *(u32x4*)(XO + (size_t)(MP + b * DECT + r) * DM + h * 256 + dg * 8) = epi::pack8(o0, o1); }
  __syncthreads();
}

__device__ __forceinline__ void shortconv_item(int item, const bf16_t* __restrict__ p1, const float* __restrict__ wsc, const float* __restrict__ state, bf16_t* __restrict__ A2) {
  const int cgp = item & 63, chunk = item >> 6, c = cgp * 8, r0 = chunk * 64;
  float w0[8], w1[8], w2[8], um2[8], um1[8];
#pragma unroll
  for (int j = 0; j < 8; ++j) { w0[j] = wsc[c + j]; w1[j] = wsc[CW + c + j]; w2[j] = wsc[2 * CW + c + j]; um2[j] = 0.f; um1[j] = 0.f; }
  const bool sample = r0 >= MP;
  if (!sample && (r0 & (SEQ - 1)) != 0) {
    const u32x4 a = *(const u32x4*)(p1 + (size_t)(r0 - 2) * P1W + 2048 + c), bq = *(const u32x4*)(p1 + (size_t)(r0 - 1) * P1W + 2048 + c);
#pragma unroll
    for (int j = 0; j < 4; ++j) { um2[2 * j] = __uint_as_float(a[j] << 16); um2[2 * j + 1] = __uint_as_float(a[j] & 0xffff0000u); um1[2 * j] = __uint_as_float(bq[j] << 16); um1[2 * j + 1] = __uint_as_float(bq[j] & 0xffff0000u); }
  }
  for (int r = 0; r < 64; ++r) {
    const int row = r0 + r;
    if (sample && ((row - MP) & (DECT - 1)) == 0) { const float* s = state + (size_t)((row - MP) >> 4) * 2 * CW + c;
#pragma unroll
      for (int j = 0; j < 8; ++j) { um2[j] = s[j]; um1[j] = s[CW + j]; } }
    const u32x4 uu = *(const u32x4*)(p1 + (size_t)row * P1W + 2048 + c), gg = *(const u32x4*)(p1 + (size_t)row * P1W + 1536 + c);
    float y[8];
#pragma unroll
    for (int j = 0; j < 4; ++j) {
      const float u0 = __uint_as_float(uu[j] << 16), u1 = __uint_as_float(uu[j] & 0xffff0000u), g0 = __uint_as_float(gg[j] << 16), g1 = __uint_as_float(gg[j] & 0xffff0000u);
      y[2 * j] = g0 * (w0[2 * j] * um2[2 * j] + w1[2 * j] * um1[2 * j] + w2[2 * j] * u0); y[2 * j + 1] = g1 * (w0[2 * j + 1] * um2[2 * j + 1] + w1[2 * j + 1] * um1[2 * j + 1] + w2[2 * j + 1] * u1);
      um2[2 * j] = um1[2 * j]; um2[2 * j + 1] = um1[2 * j + 1]; um1[2 * j] = u0; um1[2 * j + 1] = u1; }
    u32x4 w; w.x = cvt_pk_bf16(y[0], y[1]); w.y = cvt_pk_bf16(y[2], y[3]); w.z = cvt_pk_bf16(y[4], y[5]); w.w = cvt_pk_bf16(y[6], y[7]);
    *(u32x4*)(A2 + (size_t)row * DM + 512 + c) = w;
  }
}
__device__ __forceinline__ void transpose_item(int item, const bf16_t* __restrict__ src, bf16_t* __restrict__ dst, LAS bf16_t* scr, int lane) {
  const int bi = item >> 4, bj = item & 15, r0 = bi * 64, c0 = bj * 64;
  for (int i = 0; i < 64; ++i) scr[i * 66 + lane] = src[(size_t)(r0 + i) * DM + c0 + lane];
  asm volatile("s_waitcnt lgkmcnt(0)" ::: "memory");
  for (int i = 0; i < 64; ++i) dst[(size_t)(c0 + i) * MMEM + r0 + lane] = scr[lane * 66 + i];
  asm volatile("s_waitcnt lgkmcnt(0)" ::: "memory");
}
}
constexpr size_t MiB = 1u << 20;
constexpr size_t WS_SSQ0 = 1 * MiB, WS_SSQM = WS_SSQ0 + 288 * 1024, WS_RS1 = WS_SSQ0 + 320 * 1024, WS_RS2 = WS_SSQ0 + 640 * 1024;
constexpr size_t WS_SSP1 = 2 * MiB, WS_SSP2 = 7 * MiB, WS_SSP3 = 12 * MiB, WS_L4 = 17 * MiB;
constexpr size_t WS_UH = 22 * MiB, WS_U01 = 28 * MiB, WS_G01 = 34 * MiB;
constexpr size_t WS_WIN = 40 * MiB, WS_WOUT = 46 * MiB, WS_WXQ = 48 * MiB, WS_WXKV = 50 * MiB, WS_WXO = 54 * MiB, WS_WUG = 56 * MiB, WS_WDN = 67 * MiB;
constexpr size_t WS_MN = 74 * MiB, WS_MK = 90 * MiB, WS_MV = 106 * MiB, WS_MVT = 122 * MiB;
constexpr size_t WS_XA = 138 * MiB;
constexpr size_t WS_P1 = 268 * MiB;
constexpr size_t WS_A2 = 591 * MiB;
constexpr size_t WS_SPART = WS_MN;
constexpr size_t WS_HQ = WS_P1, WS_P = WS_P1 + 129 * MiB, WS_H = WS_P1;
constexpr size_t WS_END = 720 * MiB;
static_assert(WS_XA + (size_t)RT * DM * 2 <= WS_P1 && WS_P1 + (size_t)RT * P1W * 2 <= WS_A2 && WS_A2 + (size_t)RT * DM * 2 <= WS_END && WS_H + (size_t)RT * DFF * 2 <= WS_END, "ws map");
static_assert(WS_WDN + (size_t)DM * DFF * 2 <= WS_MN && WS_WUG + (size_t)2 * DFF * DM * 2 <= WS_WDN && WS_G01 + (size_t)NTILE_P * 2 * DFF * 4 <= WS_WIN && WS_L4 + (size_t)RT * 16 <= WS_UH && WS_RS2 + (size_t)RT * 4 <= WS_SSP1, "ws map 2");

constexpr int RING_BYTES = 131072, XTRA_OFF = RING_BYTES, BARST_OFF = XTRA_OFF + 20480, LDS_BYTES = 155648;

struct SchedGrid {
    const char* A; const char* B; size_t a_tile, b_tile; int nM, nN, nwg, G, c;
    __device__ __forceinline__ void init(const void* A_, size_t a_tile_, const void* B_, size_t b_tile_, int nM_, int nN_, int G_, int c_) { A = (const char*)A_; B = (const char*)B_; a_tile = a_tile_; b_tile = b_tile_; nM = nM_; nN = nN_; nwg = nM * nN; G = G_; c = c_; }
    __device__ __forceinline__ bool next(int i, pg8::Unit& u) const {
        const long L = (long)i * G + c; if (L >= nwg) return false;
        int wgid = (int)L; { const int q = nwg / 8, r = nwg % 8, xcd = wgid % 8, off = wgid / 8; wgid = (xcd < r ? xcd * (q + 1) : r * (q + 1) + (xcd - r) * q) + off; }
        const int nig = 8 * nN, gid = wgid / nig, fm = gid * 8, gsz = (nM - fm) < 8 ? (nM - fm) : 8;
        u.pm = fm + ((wgid % nig) % gsz); u.pn = (wgid % nig) / gsz; u.A = A + (size_t)u.pm * a_tile; u.B = B + (size_t)u.pn * b_tile; return true;
    }
};
struct SchedX {
    const char* A; const char* B; int G, c; bool pv;
    __device__ __forceinline__ bool next(int i, pg8::Unit& u) const {
        const long L = (long)i * G + c; if (L >= 4 * NTILE_P) return false;
        const int h = (int)(L >> 8), idx = (int)(L & 255), pm = (idx & 7) * 32 + (idx >> 3), b = pm >> 3;
        u.pm = pm; u.pn = h; u.A = A + ((size_t)pm * 256 * DM + h * 256) * 2;
        u.B = pv ? B + ((size_t)h * 256 * MMEM + b * 256) * 2 : B + ((size_t)b * 256 * DM + h * 256) * 2; return true;
    }
};

struct SchedSplitK {
    const char* A; const char* B; int G, c;
    __device__ __forceinline__ bool next(int i, pg8::Unit& u) const {
        const long L = (long)i * G + c; if (L >= 16) return false;
        const int t = (int)(L >> 3), pn = (int)(L >> 1) & 3, kh = (int)L & 1;
        u.pm = NTILE_P + t; u.pn = pn | (kh << 4);
        u.A = A + ((size_t)(NTILE_P + t) * 256 * DFF + kh * (DFF / 2)) * 2; u.B = B + ((size_t)pn * 256 * DFF + kh * (DFF / 2)) * 2; return true;
    }
};

__device__ __forceinline__ void p0_transpose_item(const float* __restrict__ W, int ldw, int K, int kb, int ns, bf16_t* __restrict__ WT, int nd, const float* __restrict__ gain, LAS float* scr, int lane) {
    const int k0 = 64 * kb;
    float wv[32];
#pragma unroll
    for (int i = 0; i < 32; ++i) wv[i] = W[(size_t)(k0 + 2 * i + (lane >> 5)) * ldw + ns + (lane & 31)];
    if (gain) {
#pragma unroll
        for (int i = 0; i < 32; ++i) wv[i] *= gain[k0 + 2 * i + (lane >> 5)]; }
#pragma unroll
    for (int i = 0; i < 32; ++i) scr[(2 * i + (lane >> 5)) * 33 + (lane & 31)] = wv[i];
    asm volatile("s_waitcnt lgkmcnt(0)" ::: "memory");
    const int cc = lane & 7;
#pragma unroll
    for (int j = 0; j < 4; ++j) { const int n = (lane >> 3) + 8 * j; const LAS float* s = scr + (8 * cc) * 33 + n;
        u32x4 o; o.x = cvt_pk_bf16(s[0 * 33], s[1 * 33]); o.y = cvt_pk_bf16(s[2 * 33], s[3 * 33]); o.z = cvt_pk_bf16(s[4 * 33], s[5 * 33]); o.w = cvt_pk_bf16(s[6 * 33], s[7 * 33]);
        *(u32x4*)(WT + (size_t)(nd + n) * K + k0 + 8 * cc) = o; }
    asm volatile("s_waitcnt lgkmcnt(0)" ::: "memory");
}
__device__ __forceinline__ void rows2_to_bf16(const float* __restrict__ x0, const float* __restrict__ x1, bf16_t* __restrict__ o0, bf16_t* __restrict__ o1, float* q0, float* q1, int lane) {
    const f32x4* r0 = (const f32x4*)x0 + lane; const f32x4* r1 = (const f32x4*)x1 + lane; f32x4 v[4], w[4]; float s = 0.f, t = 0.f;
#pragma unroll
    for (int j = 0; j < 4; ++j) { v[j] = __builtin_nontemporal_load(r0 + 64 * j); w[j] = __builtin_nontemporal_load(r1 + 64 * j); }
#pragma unroll
    for (int j = 0; j < 4; ++j) { s += (v[j][0] * v[j][0] + v[j][1] * v[j][1]) + (v[j][2] * v[j][2] + v[j][3] * v[j][3]); t += (w[j][0] * w[j][0] + w[j][1] * w[j][1]) + (w[j][2] * w[j][2] + w[j][3] * w[j][3]); }
    s = wave_sum(s); t = wave_sum(t);
    u32x2* p0 = (u32x2*)o0 + lane; u32x2* p1 = (u32x2*)o1 + lane;
#pragma unroll
    for (int j = 0; j < 4; ++j) { p0[64 * j] = epi::pack4(v[j]); p1[64 * j] = epi::pack4(w[j]); }
    if (lane == 0) { *q0 = s; *q1 = t; }
}

#define XB_TMO      128
#define XB_XCNT(j)  (256  + 64 * (j))
#define XB_XSUB(j)  (1280 + 64 * (j))
#define XB_XGEN(j)  (2304 + 64 * (j))
#define XB_TOP      3328
#define XB_TOPGEN   3392
#define XCD_BAR_WORDS 3456
#define XB_SPIN_CAP (1u << 22)
__device__ __forceinline__ unsigned xb_ld(unsigned* p)              { return __hip_atomic_load(p, __ATOMIC_RELAXED, __HIP_MEMORY_SCOPE_AGENT); }
__device__ __forceinline__ unsigned xb_add(unsigned* p, unsigned v) { return __hip_atomic_fetch_add(p, v, __ATOMIC_RELAXED, __HIP_MEMORY_SCOPE_AGENT); }
__device__ __forceinline__ unsigned xb_xcc_id() { return (unsigned)__builtin_amdgcn_s_getreg((3 << 11) | 20) & 0xFu; }
#define XB_SPIN(cond, bar) do { unsigned _sp = 0; while (cond) { __builtin_amdgcn_s_sleep(1); \
    if ((++_sp & 255u) == 0u) { if (xb_ld(&(bar)[XB_TMO])) break; if (_sp > XB_SPIN_CAP) { atomicAdd(&(bar)[XB_TMO], 1u); break; } } } } while (0)
__device__ __forceinline__ void xcd_barrier_complete(unsigned* bar, unsigned x, unsigned& nloc, unsigned& nx) {
    const unsigned G = gridDim.x * gridDim.y * gridDim.z;
    unsigned sum, cnt, mine, sp = 0u;
    for (;;) {
        sum = 0u; cnt = 0u; mine = 0u;
#pragma unroll
        for (unsigned j = 0; j < 16; ++j) { const unsigned c = xb_ld(&bar[XB_XCNT(j)]); sum += c; cnt += (c > 0u) ? 1u : 0u; mine = (j == x) ? c : mine; }
        if (sum == G) break;
        __builtin_amdgcn_s_sleep(1);
        if ((++sp & 255u) == 0u) { if (xb_ld(&bar[XB_TMO])) break; if (sp > XB_SPIN_CAP) { atomicAdd(&bar[XB_TMO], 1u); break; } }
    }
    nloc = mine > 0u ? mine : 1u; nx = cnt > 0u ? cnt : 1u;
}
__device__ __forceinline__ void xcd_barrier(unsigned* bar, volatile LAS unsigned* st) {
    asm volatile("s_waitcnt vmcnt(0)" ::: "memory");
    __syncthreads();
    if (threadIdx.x == 0) {
        const unsigned x = xb_xcc_id();
        __builtin_amdgcn_s_waitcnt(0);
        unsigned nloc = st[0], nx = st[1];
        if (nloc == 0u) { xcd_barrier_complete(bar, x, nloc, nx); st[0] = nloc; st[1] = nx; }
        const unsigned old = xb_add(&bar[XB_XSUB(x)], 1u);
        const unsigned gen = old / nloc;
        if (old + 1u == (gen + 1u) * nloc) {
            __builtin_amdgcn_fence(__ATOMIC_RELEASE, "agent");
            asm volatile("s_waitcnt vmcnt(0)" ::: "memory");
            const unsigned og = xb_add(&bar[XB_TOP], 1u);
            const unsigned tg = og / nx;
            if (og + 1u == (tg + 1u) * nx) xb_add(&bar[XB_TOPGEN], 1u);
            else XB_SPIN(xb_ld(&bar[XB_TOPGEN]) == tg, bar);
            __builtin_amdgcn_fence(__ATOMIC_ACQUIRE, "agent");
            xb_add(&bar[XB_XGEN(x)], 1u);
            asm volatile("s_waitcnt vmcnt(0)" ::: "memory");
        } else {
            XB_SPIN(xb_ld(&bar[XB_XGEN(x)]) == gen, bar);
            __builtin_amdgcn_fence(__ATOMIC_ACQUIRE, "agent");
            asm volatile("s_waitcnt vmcnt(0)" ::: "memory");
        }
    }
    __syncthreads();
}

struct Args { const float* in[30]; float* out; unsigned char* ws; };
#define PHASE_ARGS() \
    const __attribute__((address_space(4))) Args* ap_ = (const __attribute__((address_space(4))) Args*)__builtin_amdgcn_kernarg_segment_ptr(); asm volatile("" : "+s"(ap_)); \
    unsigned char* const ws = ap_->ws; float* const out = ap_->out; (void)ws; (void)out; \
    int tid = threadIdx.x; asm volatile("" : "+v"(tid)); const int lane = tid & 63, wave = __builtin_amdgcn_readfirstlane(tid >> 6); (void)lane; (void)wave; \
    const int G = gridDim.x, bx = blockIdx.x, vcu = (G % 8 == 0) ? (bx % 8) * (G / 8) + bx / 8 : bx; (void)vcu; \
    const int gw = vcu * 8 + wave, NGW = G * 8; (void)gw; (void)NGW
#define IN(k) (ap_->in[k])
#define WSF(off) ((float*)(ws + (off)))
#define WSB(off) ((bf16_t*)(ws + (off)))

__global__ void __launch_bounds__(512, 2) fwd_kernel(Args a) {
    extern __shared__ __attribute__((aligned(16))) unsigned char lds_raw[];
    LAS unsigned char* const lds = (LAS unsigned char*)lds_raw;
    volatile LAS unsigned* const bst = (volatile LAS unsigned*)(lds + BARST_OFF);
    if (threadIdx.x < 2) bst[threadIdx.x] = 0u;
    __syncthreads();
    { PHASE_ARGS(); if (threadIdx.x == 0) (void)xb_add(&((unsigned*)ws)[XB_XCNT(xb_xcc_id())], 1u); }
#define GRID_BAR() do { PHASE_ARGS(); xcd_barrier((unsigned*)ws, bst); } while (0)

    {
        PHASE_ARGS();
        LAS float* scr = (LAS float*)(lds + wave * 16384);
        constexpr int I_IN = 16 * 96, I_SQ = 16 * 32, I_FF = 16 * 88, I_DN = 44 * 32;
        constexpr int NITEMS = I_IN + 5 * I_SQ + 2 * I_FF + I_DN;
        for (int it = gw; it < NITEMS; it += NGW) {
            int r = it;
            if (r < I_IN) { const int kb = r / 96, nb = r % 96, nd = nb * 32; int ns = nd;
                if (nd >= 2048) { const int T = (nd - 2048) >> 8, w = (nd - 2048) & 255; ns = (w < 128) ? 2048 + 128 * T + w : 2560 + 128 * T + (w - 128); }
                p0_transpose_item(IN(10), INP, DM, kb, ns, WSB(WS_WIN), nd, IN(9), scr, lane); continue; } r -= I_IN;
            if (r < I_SQ) { p0_transpose_item(IN(17), DM, DM, r / 32, (r % 32) * 32, WSB(WS_WOUT), (r % 32) * 32, nullptr, scr, lane); continue; } r -= I_SQ;
            if (r < I_SQ) { p0_transpose_item(IN(20), DM, DM, r / 32, (r % 32) * 32, WSB(WS_WXQ), (r % 32) * 32, IN(19), scr, lane); continue; } r -= I_SQ;
            if (r < I_SQ) { p0_transpose_item(IN(21), DM, DM, r / 32, (r % 32) * 32, WSB(WS_WXKV), (r % 32) * 32, IN(18), scr, lane); continue; } r -= I_SQ;
            if (r < I_SQ) { p0_transpose_item(IN(22), DM, DM, r / 32, (r % 32) * 32, WSB(WS_WXKV), 1024 + (r % 32) * 32, IN(18), scr, lane); continue; } r -= I_SQ;
            if (r < I_SQ) { p0_transpose_item(IN(23), DM, DM, r / 32, (r % 32) * 32, WSB(WS_WXO), (r % 32) * 32, nullptr, scr, lane); continue; } r -= I_SQ;
            if (r < I_FF) { const int kb = r / 88, nb = r % 88; p0_transpose_item(IN(25), DFF, DM, kb, nb * 32, WSB(WS_WUG), 256 * (nb >> 2) + (nb & 3) * 32, IN(24), scr, lane); continue; } r -= I_FF;
            if (r < I_FF) { const int kb = r / 88, nb = r % 88; p0_transpose_item(IN(26), DFF, DM, kb, nb * 32, WSB(WS_WUG), 256 * (nb >> 2) + 128 + (nb & 3) * 32, IN(24), scr, lane); continue; } r -= I_FF;
            p0_transpose_item(IN(28), DM, DFF, r / 32, (r % 32) * 32, WSB(WS_WDN), (r % 32) * 32, nullptr, scr, lane);
        }
        for (int m = 2 * gw; m < RT + MMEM; m += 2 * NGW) {
            const float* src; bf16_t* dst; float* sq;
            if (m < MP) { src = IN(0) + (size_t)m * DM; dst = WSB(WS_XA) + (size_t)m * DM; sq = WSF(WS_SSQ0) + m; }
            else if (m < RT) { src = IN(1) + (size_t)(m - MP) * DM; dst = WSB(WS_XA) + (size_t)m * DM; sq = WSF(WS_SSQ0) + m; }
            else { src = IN(8) + (size_t)(m - RT) * DM; dst = WSB(WS_MN) + (size_t)(m - RT) * DM; sq = WSF(WS_SSQM) + (m - RT); }
            rows2_to_bf16(src, src + DM, dst, dst + DM, sq, sq + 1, lane);
        }
    }
    GRID_BAR();

    {
        PHASE_ARGS();
        pg8::Gemm g{DM, DM, DM};
        { SchedGrid S; S.init(WSB(WS_XA), (size_t)256 * DM * 2, WSB(WS_WIN), (size_t)256 * DM * 2, NTILE, INP / 256, G, bx);
          epi::EpiInProj E{WSF(WS_SSQ0), WSB(WS_P1), out};
          pg8::gemm_phase(lds, g, S, E); }
        { SchedGrid S; S.init(WSB(WS_MN), (size_t)256 * DM * 2, WSB(WS_WXKV), (size_t)256 * DM * 2, MMEM / 256, 8, G, bx);
          epi::EpiMemKV E{WSF(WS_SSQM), WSB(WS_MK), WSB(WS_MV), out};
          pg8::gemm_phase(lds, g, S, E); }
    }
    GRID_BAR();

    {
        PHASE_ARGS();
        float lam;
        { const float a1 = wave_sum(IN(11)[lane] * IN(12)[lane]), a2 = wave_sum(IN(13)[lane] * IN(14)[lane]); lam = __expf(a1) - __expf(a2) + LAM_INIT; }
        for (long L = bx; L < 2048; L += G) {
            const int s = (int)(L >> 8), cc = (int)(L & 255), cv = (cc & 7) * 32 + (cc >> 3), bh = cv >> 1, par = cv & 1, p = 2 * (s >> 1) + par, qb = (s & 1) ? 15 - p : p;
            dattn::unit(bh >> 2, bh & 3, qb, WSB(WS_P1), WSB(WS_A2), lam, IN(15), (LAS char*)lds);
        }
        for (int L = bx; L < 256; L += G) misc::sample_attn_unit(L >> 3, (L >> 1) & 3, L & 1, WSB(WS_P1), IN(2), IN(3), out + O_KS, out + O_VS, WSB(WS_A2), lam, IN(15), (char*)lds_raw);
        for (int it = (vcu * 512 + tid); it < 64 * (RT / 64); it += G * 512) misc::shortconv_item(it, WSB(WS_P1), IN(16), IN(4), WSB(WS_A2));
        __syncthreads();
        { LAS bf16_t* scr = (LAS bf16_t*)(lds + wave * 16384); for (int it = gw; it < 2048; it += NGW) misc::transpose_item(it, WSB(WS_MV), WSB(WS_MVT), scr, lane); }
    }
    GRID_BAR();

    {
        PHASE_ARGS();
        pg8::Gemm g{DM, DM, DM}; SchedGrid S; S.init(WSB(WS_A2), (size_t)256 * DM * 2, WSB(WS_WOUT), (size_t)256 * DM * 2, NTILE, 4, G, bx);
        epi::EpiResidual E{WSB(WS_XA), WSF(WS_SSP1)};
        pg8::gemm_phase(lds, g, S, E);
    }
    GRID_BAR();
    {
        PHASE_ARGS();
        for (int r = bx * 512 + tid; r < RT; r += G * 512) WSF(WS_RS1)[r] = epi::rstd16(WSF(WS_SSP1), r);
    }
    GRID_BAR();
    {
        PHASE_ARGS();
        pg8::Gemm g{DM, DM, DM}; SchedGrid S; S.init(WSB(WS_XA), (size_t)256 * DM * 2, WSB(WS_WXQ), (size_t)256 * DM * 2, NTILE, 4, G, bx);
        epi::EpiScaleBf16 E{WSF(WS_RS1), WSB(WS_HQ), DM};
        pg8::gemm_phase(lds, g, S, E);
    }
    GRID_BAR();
    {
        PHASE_ARGS();
        pg8::Gemm g{DM, DM, 256}; SchedX S{(const char*)WSB(WS_HQ), (const char*)WSB(WS_MK), G, bx, false};
        epi::EpiXScores E{WSB(WS_P), WSF(WS_L4), (LAS float*)(lds + XTRA_OFF)};
        pg8::gemm_phase(lds, g, S, E);
    }
    GRID_BAR();
    {
        PHASE_ARGS();
        pg8::Gemm g{DM, MMEM, 256}; SchedX S{(const char*)WSB(WS_P), (const char*)WSB(WS_MVT), G, bx, true};
        epi::EpiXPV E{WSF(WS_L4), WSB(WS_HQ)};
        pg8::gemm_phase(lds, g, S, E);
        __syncthreads();
        for (int L = G - 1 - bx; L < NB * NH; L += G) misc::sample_xattn_unit(L >> 2, L & 3, WSB(WS_HQ), IN(6), IN(7), WSB(WS_HQ), (char*)lds_raw);
    }
    GRID_BAR();
    {
        PHASE_ARGS();
        pg8::Gemm g{DM, DM, DM}; SchedGrid S; S.init(WSB(WS_HQ), (size_t)256 * DM * 2, WSB(WS_WXO), (size_t)256 * DM * 2, NTILE, 4, G, bx);
        epi::EpiResidual E{WSB(WS_XA), WSF(WS_SSP2)};
        pg8::gemm_phase(lds, g, S, E);
    }
    GRID_BAR();
    {
        PHASE_ARGS();
        for (int r = bx * 512 + tid; r < RT; r += G * 512) WSF(WS_RS2)[r] = epi::rstd16(WSF(WS_SSP2), r);
    }
    GRID_BAR();
    {
        PHASE_ARGS();
        pg8::Gemm g{DM, DM, DM}; SchedGrid S; S.init(WSB(WS_XA), (size_t)256 * DM * 2, WSB(WS_WUG), (size_t)256 * DM * 2, NTILE, 22, G, bx);
        epi::EpiUpGate E{WSF(WS_RS2), IN(27), IN(5), WSB(WS_H), out, WSF(WS_UH), WSF(WS_U01), WSF(WS_G01), (LAS float*)(lds + XTRA_OFF)};
        pg8::gemm_phase(lds, g, S, E);
    }
    GRID_BAR();
    {
        PHASE_ARGS();
        pg8::Gemm g{DFF, DFF, DFF}; SchedGrid S; S.init(WSB(WS_H), (size_t)256 * DFF * 2, WSB(WS_WDN), (size_t)256 * DFF * 2, NTILE_P, 4, G, bx);
        { const float* UH = WSF(WS_UH); const float* U01 = WSF(WS_U01); const float* G01 = WSF(WS_G01); const float* w_ffc = IN(27); bf16_t* HB = WSB(WS_H); pg8::Unit uu;
          for (int i = 0; S.next(i, uu); ++i) { const int pm = uu.pm; if (pm >= NTILE_P || (pm & 7) == 0) continue;
            for (int it = tid; it < 2 * DFF; it += 512) {
                const int r = it / DFF, c = it - r * DFF;
                const float um2 = UH[((size_t)(pm - 1) * 2 + r) * DFF + c];
                const float um1 = (r == 0) ? UH[((size_t)(pm - 1) * 2 + 1) * DFF + c] : U01[((size_t)pm * 2) * DFF + c];
                const float u0 = U01[((size_t)pm * 2 + r) * DFF + c];
                const float y = w_ffc[c] * um2 + w_ffc[DFF + c] * um1 + w_ffc[2 * DFF + c] * u0;
                const float hv = y * __builtin_amdgcn_rcpf(1.0f + __builtin_amdgcn_exp2f(-1.4426950408889634f * y)) * G01[((size_t)pm * 2 + r) * DFF + c];
                HB[(size_t)(pm * 256 + r) * DFF + c] = (bf16_t)(cvt_pk_bf16(hv, 0.f) & 0xffffu);
            } }
          asm volatile("s_waitcnt vmcnt(0)" ::: "memory"); __syncthreads(); }
        epi::EpiResidual E{WSB(WS_XA), WSF(WS_SSP3)};
        pg8::gemm_phase(lds, g, S, E);
        { pg8::Gemm g2{DFF, DFF, DFF / 2}; SchedSplitK S2{(const char*)WSB(WS_H), (const char*)WSB(WS_WDN), G, bx};
          epi::EpiPartialF32 E2{WSF(WS_SPART)};
          pg8::gemm_phase(lds, g2, S2, E2); }
    }
    GRID_BAR();
    {
        PHASE_ARGS();
        const float* g_fin = IN(29); const bf16_t* XB = WSB(WS_XA);
        f32x4 gg[4];
#pragma unroll
        for (int j = 0; j < 4; ++j) gg[j] = *((const f32x4*)g_fin + lane + 64 * j);
        for (int m = 2 * gw; m < MP; m += 2 * NGW) {
            const float rs0 = epi::rstd16(WSF(WS_SSP3), m), rs1 = epi::rstd16(WSF(WS_SSP3), m + 1);
            const u32x2* x0 = (const u32x2*)(XB + (size_t)m * DM) + lane; const u32x2* x1 = x0 + DM / 4;
            u32x2 a[4], b[4];
#pragma unroll
            for (int j = 0; j < 4; ++j) { a[j] = __builtin_nontemporal_load(x0 + 64 * j); b[j] = __builtin_nontemporal_load(x1 + 64 * j); }
            f32x4* y0 = (f32x4*)(out + O_Y + (size_t)m * DM) + lane; f32x4* y1 = y0 + DM / 4;
#pragma unroll
            for (int j = 0; j < 4; ++j) {
                f32x4 v = {__uint_as_float(a[j].x << 16), __uint_as_float(a[j].x & 0xffff0000u), __uint_as_float(a[j].y << 16), __uint_as_float(a[j].y & 0xffff0000u)};
                f32x4 w = {__uint_as_float(b[j].x << 16), __uint_as_float(b[j].x & 0xffff0000u), __uint_as_float(b[j].y << 16), __uint_as_float(b[j].y & 0xffff0000u)};
                __builtin_nontemporal_store(v * gg[j] * rs0, y0 + 64 * j); __builtin_nontemporal_store(w * gg[j] * rs1, y1 + 64 * j);
            }
        }
        for (int r = gw; r < MS; r += NGW) {
            const u32x2* x0 = (const u32x2*)(XB + (size_t)(MP + r) * DM) + lane; const f32x4* sa = (const f32x4*)(WSF(WS_SPART) + (size_t)r * DM) + lane; const f32x4* sb = sa + (size_t)MS * DM / 4;
            f32x4 v[4]; float ss = 0.f;
#pragma unroll
            for (int j = 0; j < 4; ++j) { const u32x2 a = x0[64 * j];
                v[j] = (f32x4){__uint_as_float(a.x << 16), __uint_as_float(a.x & 0xffff0000u), __uint_as_float(a.y << 16), __uint_as_float(a.y & 0xffff0000u)} + sa[64 * j] + sb[64 * j];
                ss += (v[j][0] * v[j][0] + v[j][1] * v[j][1]) + (v[j][2] * v[j][2] + v[j][3] * v[j][3]); }
            const float rs = rsqrtf(wave_sum(ss) * (1.0f / DM) + EPS);
            f32x4* y0 = (f32x4*)(out + O_Y + (size_t)(MP + r) * DM) + lane;
#pragma unroll
            for (int j = 0; j < 4; ++j) y0[64 * j] = v[j] * gg[j] * rs;
        }
    }
}

extern "C" void kernel_launch(void* const* d_in, const int* in_sizes, int n_in, void* d_out, int out_size, void* d_ws, size_t ws_size, hipStream_t stream) {
    static int grid = 0;
    if (grid == 0) {
        if (n_in != 30 || (size_t)out_size != O_END || ws_size < WS_END) { fprintf(stderr, "kernel_launch: unexpected shapes: n_in %d out %d ws %zu (need %zu, %zu)\n", n_in, out_size, ws_size, (size_t)O_END, (size_t)WS_END); grid = -1; return; }
        int dev = 0, cus = 0, per_cu = 0;
        if (hipGetDevice(&dev) != hipSuccess || hipDeviceGetAttribute(&cus, hipDeviceAttributeMultiprocessorCount, dev) != hipSuccess) { grid = -1; return; }
        if (hipFuncSetAttribute((const void*)fwd_kernel, hipFuncAttributeMaxDynamicSharedMemorySize, LDS_BYTES) != hipSuccess) { fprintf(stderr, "kernel_launch: hipFuncSetAttribute failed\n"); grid = -1; return; }
        if (hipOccupancyMaxActiveBlocksPerMultiprocessor(&per_cu, (const void*)fwd_kernel, 512, LDS_BYTES) != hipSuccess || per_cu < 1) { fprintf(stderr, "kernel_launch: occupancy query says %d\n", per_cu); grid = -1; return; }
        grid = cus;
        fprintf(stderr, "kernel_launch: %d CUs, %d blocks/CU by the occupancy query, grid %d\n", cus, per_cu, grid);
    }
    if (grid < 0) return;
    if (hipMemsetAsync(d_ws, 0, 16384, stream) != hipSuccess) { fprintf(stderr, "kernel_launch: memset failed\n"); return; }
    Args a{};
    for (int i = 0; i < 30; ++i) a.in[i] = (const float*)d_in[i];
    a.out = (float*)d_out; a.ws = (unsigned char*)d_ws;
    void* args[] = {&a};
    const hipError_t e = hipLaunchCooperativeKernel((const void*)fwd_kernel, dim3(grid), dim3(512), args, LDS_BYTES, stream);
    if (e != hipSuccess) fprintf(stderr, "kernel_launch: cooperative launch failed: %s (grid %d)\n", hipGetErrorString(e), grid);
}
```

```cpp
#include <hip/hip_runtime.h>
#include <hip/hip_cooperative_groups.h>
#include <cstdio>
#include <cstdint>
namespace cg = cooperative_groups;

#define LAS __attribute__((address_space(3)))
typedef unsigned short bf16_t;
typedef short bf16x8 __attribute__((ext_vector_type(8)));
typedef short s16x4 __attribute__((ext_vector_type(4)));
typedef float f32x4 __attribute__((ext_vector_type(4)));
typedef float f32x2 __attribute__((ext_vector_type(2)));
typedef float f32x16 __attribute__((ext_vector_type(16)));
typedef unsigned u32x4 __attribute__((ext_vector_type(4)));
typedef unsigned u32x2 __attribute__((ext_vector_type(2)));

constexpr int DM = 1024, NB = 32, SEQ = 2048, DECT = 16, PAST = 1024;
constexpr int MP = NB * SEQ, MS = NB * DECT, RT = MP + MS;
constexpr int NTILE_P = MP / 256, NTILE = RT / 256;
constexpr int NH = 4, QKD = 64, VD = 128, NMEM = 256, XD = 256, DFF = 2816, INP = 3072, CW = 512;
constexpr int MMEM = NB * NMEM;
constexpr float EPS = 1e-6f;
constexpr float LAM_INIT = 0.2f;
constexpr int P1W = 2560;

constexpr size_t O_Y = 0;
constexpr size_t O_KP = (size_t)RT * DM;
constexpr size_t O_VP = O_KP + (size_t)MP * 512;
constexpr size_t O_SCP = O_VP + (size_t)MP * 512;
constexpr size_t O_FFP = O_SCP + (size_t)NB * 2 * CW;
constexpr size_t O_MK = O_FFP + (size_t)NB * 2 * DFF;
constexpr size_t O_MV = O_MK + (size_t)MMEM * DM;
constexpr size_t O_KS = O_MV + (size_t)MMEM * DM;
constexpr size_t O_VS = O_KS + (size_t)MS * 512;
constexpr size_t O_SCS = O_VS + (size_t)MS * 512;
constexpr size_t O_FFS = O_SCS + (size_t)NB * 2 * CW;
constexpr size_t O_END = O_FFS + (size_t)NB * 2 * DFF;

__device__ __forceinline__ unsigned cvt_pk_bf16(float lo, float hi) { unsigned r; asm volatile("v_cvt_pk_bf16_f32 %0, %1, %2" : "=v"(r) : "v"(lo), "v"(hi)); return r; }
__device__ __forceinline__ float bf2f(unsigned short h) { return __uint_as_float((unsigned)h << 16); }
#define DPPF(v, ctrl) __int_as_float(__builtin_amdgcn_update_dpp(0, __float_as_int(v), (ctrl), 0xf, 0xf, true))
__device__ __forceinline__ float xor16_sum(float v) { auto r = __builtin_amdgcn_permlane16_swap(__float_as_uint(v), __float_as_uint(v), false, false); return __uint_as_float(r[0]) + __uint_as_float(r[1]); }
__device__ __forceinline__ float xor32_sum(float v) { auto r = __builtin_amdgcn_permlane32_swap(__float_as_uint(v), __float_as_uint(v), false, false); return __uint_as_float(r[0]) + __uint_as_float(r[1]); }
__device__ __forceinline__ float xor16_max(float v) { auto r = __builtin_amdgcn_permlane16_swap(__float_as_uint(v), __float_as_uint(v), false, false); return fmaxf(__uint_as_float(r[0]), __uint_as_float(r[1])); }
__device__ __forceinline__ float xor32_max(float v) { auto r = __builtin_amdgcn_permlane32_swap(__float_as_uint(v), __float_as_uint(v), false, false); return fmaxf(__uint_as_float(r[0]), __uint_as_float(r[1])); }
__device__ __forceinline__ float other16(float v, int odd) { auto r = __builtin_amdgcn_permlane16_swap(__float_as_uint(v), __float_as_uint(v), false, false); return __uint_as_float(odd ? r[0] : r[1]); }
__device__ __forceinline__ float wave_sum(float v) {
    v += DPPF(v, 0xB1); v += DPPF(v, 0x4E); v += DPPF(v, 0x141); v += DPPF(v, 0x140);
    return xor32_sum(xor16_sum(v));
}
__device__ __forceinline__ float wave_max(float v) {
    v = fmaxf(v, DPPF(v, 0xB1)); v = fmaxf(v, DPPF(v, 0x4E)); v = fmaxf(v, DPPF(v, 0x141)); v = fmaxf(v, DPPF(v, 0x140));
    return xor32_max(xor16_max(v));
}
__device__ __forceinline__ float row_shr1(float v) { return __int_as_float(__builtin_amdgcn_update_dpp(__float_as_int(v), __float_as_int(v), 0x111, 0xf, 0xf, false)); }
__device__ __forceinline__ float row_shr2(float v) { return __int_as_float(__builtin_amdgcn_update_dpp(__float_as_int(v), __float_as_int(v), 0x112, 0xf, 0xf, false)); }

namespace pg8 {
constexpr int BM = 256, BK = 64, HALF = 128, HTB = HALF * BK * 2, STAGE_BYTES = 8 * HTB;
__host__ __device__ __forceinline__ int lds_byte(int r, int c) { const int st = (r >> 4) * 2 + (c >> 5), rr = r & 15, cc = c & 31, ob = rr * 64 + cc * 2; return st * 1024 + (ob ^ (((ob >> 9) & 1) << 5)); }
__host__ __device__ __forceinline__ void stage_rc(int b, int& R, int& C) { const int st = b / 1024, sb = b % 1024, swz = sb ^ (((sb >> 9) & 1) << 5); R = (st >> 1) * 16 + swz / 64; C = (st & 1) * 32 + (swz % 64) / 2; }
__host__ __device__ __forceinline__ int perm32(int rho) { const int n = rho >> 4, i = rho & 15; return 8 * (i >> 2) + 4 * n + (i & 3); }

struct Unit { const char* A; const char* B; int pm, pn; };
struct Gemm { int lda, ldb, K; };

template <class Epi, class Sched>
__device__ __forceinline__ void gemm_phase(LAS unsigned char* lds, const Gemm g, const Sched& S, const Epi& E) {
    int tid = threadIdx.x; asm volatile("" : "+v"(tid));
    const int wid = __builtin_amdgcn_readfirstlane(tid >> 6), lane = tid & 63, wr = wid >> 2, wc = wid & 3, fr = lane & 15, fq = lane >> 4;
    const int K = g.K, nt = K / BK;
    unsigned voffA[2], voffB[2];
#pragma unroll
    for (int i = 0; i < 2; ++i) { int R, C; stage_rc(tid * 16 + i * 8192, R, C); const int Rb = Epi::PERM ? ((R & ~31) + perm32(R & 31)) : R;
        voffA[i] = (unsigned)(R * g.lda + C) * 2u; voffB[i] = (unsigned)(Rb * g.ldb + C) * 2u; }
    const size_t kstep = (size_t)(BK * 2);
    const size_t hstepA = (size_t)HALF * g.lda * 2, hstepB = (size_t)HALF * g.ldb * 2;
    const unsigned ldsw = (unsigned)wid * 1024u;
    const int aoff = lds_byte(wr * 64 + fr, fq * 8), boff = lds_byte(wc * 32 + fr, fq * 8);
#define PG8_SA(b, h) (((b) * 2 + (h)) * HTB)
#define PG8_SB(b, h) ((4 + (b) * 2 + (h)) * HTB)
#define PG8_STAGE(bufoff, gbase, voff) do { _Pragma("unroll") for (int _i = 0; _i < 2; ++_i) \
        __builtin_amdgcn_global_load_lds((const unsigned*)((const char*)(gbase) + (voff)[_i]), (LAS unsigned*)(lds + (bufoff) + ldsw + _i * 8192), 16, 0, 0); } while (0)
#define PG8_LDA(dst, b, h) do { _Pragma("unroll") for (int m = 0; m < 4; ++m) _Pragma("unroll") for (int k = 0; k < 2; ++k) dst[m][k] = *(const LAS bf16x8*)(lds + PG8_SA(b, h) + aoff + m * 2048 + k * 1024); } while (0)
#define PG8_LDB(dst, b, h) do { _Pragma("unroll") for (int n = 0; n < 2; ++n) _Pragma("unroll") for (int k = 0; k < 2; ++k) dst[n][k] = *(const LAS bf16x8*)(lds + PG8_SB(b, h) + boff + n * 2048 + k * 1024); } while (0)
#define PG8_MMA(ai, bj, At, Bt) do { __builtin_amdgcn_s_setprio(1); _Pragma("unroll") for (int m = 0; m < 4; ++m) _Pragma("unroll") for (int n = 0; n < 2; ++n) _Pragma("unroll") for (int k = 0; k < 2; ++k) \
        acc[ai][bj][m][n] = __builtin_amdgcn_mfma_f32_16x16x32_bf16(Bt[n][k], At[m][k], acc[ai][bj][m][n], 0, 0, 0); __builtin_amdgcn_s_setprio(0); } while (0)
#define PG8_WAIT_V(n) asm volatile("s_waitcnt vmcnt(" #n ")" ::: "memory")
#define PG8_WAIT_L(n) asm volatile("s_waitcnt lgkmcnt(" #n ")" ::: "memory")
#define PG8_BAR __builtin_amdgcn_s_barrier()
#define PG8_SCHED __builtin_amdgcn_sched_barrier(0)
    Unit cur, nxt; int ui = 0;
    if (!S.next(0, cur)) return;
    f32x4 acc[2][2][4][2];
#pragma unroll
    for (int a = 0; a < 2; ++a)
#pragma unroll
        for (int b = 0; b < 2; ++b)
#pragma unroll
            for (int m = 0; m < 4; ++m)
#pragma unroll
                for (int n = 0; n < 2; ++n) acc[a][b][m][n] = (f32x4){0.f, 0.f, 0.f, 0.f};
    bf16x8 At[4][2], B0[2][2], B1[2][2];
    typename Epi::Pre pre{};
    const char* cA = cur.A; const char* cB = cur.B;
    PG8_STAGE(PG8_SB(0, 0), cB, voffB); PG8_STAGE(PG8_SB(0, 1), cB + hstepB, voffB); PG8_STAGE(PG8_SA(0, 0), cA, voffA); PG8_STAGE(PG8_SA(0, 1), cA + hstepA, voffA);
    if (wr == 1) PG8_BAR;
    PG8_WAIT_V(2); PG8_BAR;
    PG8_STAGE(PG8_SB(1, 0), cB + kstep, voffB); PG8_STAGE(PG8_SA(1, 0), cA + kstep, voffA); PG8_STAGE(PG8_SB(1, 1), cB + hstepB + kstep, voffB);
    PG8_WAIT_V(6); PG8_BAR;
    for (;;) {
        const bool has_next = S.next(ui + 1, nxt);
        const char* nA = has_next ? nxt.A : cA; const char* nB = has_next ? nxt.B : cB;
        for (int t = 0; t < nt; t += 2) {
            const bool last = (t == nt - 2);
            if (Epi::EARLY && last) pre = E.prefetch(cur, wr, wc, fr, fq);
            const char* a1 = cA + (size_t)(t + 1) * kstep;
            const char* a2 = last ? nA : cA + (size_t)(t + 2) * kstep; const char* b2 = last ? nB : cB + (size_t)(t + 2) * kstep;
            const char* a3 = a2 + kstep; const char* b3 = b2 + kstep;
            PG8_LDB(B0, 0, 0); PG8_LDB(B1, 0, 1); PG8_SCHED; PG8_LDA(At, 0, 0); PG8_STAGE(PG8_SA(1, 1), a1 + hstepA, voffA);
            PG8_WAIT_V(8); PG8_WAIT_L(0); PG8_BAR; PG8_MMA(0, 0, At, B0); PG8_MMA(0, 1, At, B1); PG8_BAR; PG8_SCHED;
            PG8_LDA(At, 0, 1); PG8_STAGE(PG8_SB(0, 0), b2, voffB); PG8_STAGE(PG8_SB(0, 1), b2 + hstepB, voffB); PG8_STAGE(PG8_SA(0, 0), a2, voffA);
            PG8_WAIT_V(8); PG8_WAIT_L(0); PG8_BAR; PG8_MMA(1, 0, At, B0); PG8_MMA(1, 1, At, B1); PG8_BAR; PG8_SCHED;
            PG8_LDB(B0, 1, 0); PG8_LDB(B1, 1, 1); PG8_SCHED; PG8_LDA(At, 1, 0); PG8_STAGE(PG8_SA(0, 1), a2 + hstepA, voffA);
            PG8_WAIT_V(8); PG8_WAIT_L(0); PG8_BAR; PG8_MMA(0, 0, At, B0); PG8_MMA(0, 1, At, B1); PG8_BAR; PG8_SCHED;
            PG8_LDA(At, 1, 1); PG8_STAGE(PG8_SB(1, 0), b3, voffB); PG8_STAGE(PG8_SB(1, 1), b3 + hstepB, voffB); PG8_STAGE(PG8_SA(1, 0), a3, voffA);
            PG8_WAIT_V(8); PG8_WAIT_L(0); PG8_BAR; PG8_MMA(1, 0, At, B0); PG8_MMA(1, 1, At, B1); PG8_BAR; PG8_SCHED;
        }
        if (wr == 0) PG8_BAR;
        if (!Epi::EARLY) pre = E.prefetch(cur, wr, wc, fr, fq);
        E(acc, cur, pre, wr, wc, fr, fq);
        if (!has_next) break;
#pragma unroll
        for (int a = 0; a < 2; ++a)
#pragma unroll
            for (int b = 0; b < 2; ++b)
#pragma unroll
                for (int m = 0; m < 4; ++m)
#pragma unroll
                    for (int n = 0; n < 2; ++n) acc[a][b][m][n] = (f32x4){0.f, 0.f, 0.f, 0.f};
        cur = nxt; cA = nA; cB = nB; ++ui;
        if (wr == 1) PG8_BAR;
    }
    PG8_WAIT_V(0);
    PG8_BAR;
#undef PG8_SA
#undef PG8_SB
#undef PG8_STAGE
#undef PG8_LDA
#undef PG8_LDB
#undef PG8_MMA
}
}
namespace epi {
using pg8::Unit;
typedef f32x4 Acc[2][2][4][2];
#define EPI_BAR() do { asm volatile("s_waitcnt lgkmcnt(0)" ::: "memory"); __builtin_amdgcn_s_barrier(); asm volatile("" ::: "memory"); } while (0)

__device__ __forceinline__ u32x4 pack8(const f32x4 a, const f32x4 b) { u32x4 w; w.x = cvt_pk_bf16(a[0], a[1]); w.y = cvt_pk_bf16(a[2], a[3]); w.z = cvt_pk_bf16(b[0], b[1]); w.w = cvt_pk_bf16(b[2], b[3]); return w; }
__device__ __forceinline__ u32x2 pack4(const f32x4 a) { u32x2 w; w.x = cvt_pk_bf16(a[0], a[1]); w.y = cvt_pk_bf16(a[2], a[3]); return w; }
__device__ __forceinline__ int row_pos(int row) { return row < MP ? (row & (SEQ - 1)) : PAST + ((row - MP) & (DECT - 1)); }
__device__ __forceinline__ f32x4 oth4(const f32x4 v, int odd) { f32x4 r; r[0] = other16(v[0], odd); r[1] = other16(v[1], odd); r[2] = other16(v[2], odd); r[3] = other16(v[3], odd); return r; }
__device__ __forceinline__ void store8_f32(float* p  , const f32x4 v0, const f32x4 v1, int fq) {
    f32x4 x, y;
#pragma unroll
    for (int j = 0; j < 4; ++j) { auto r = __builtin_amdgcn_permlane16_swap(__float_as_uint(v0[j]), __float_as_uint(v1[j]), false, false); x[j] = __uint_as_float(r[0]); y[j] = __uint_as_float(r[1]); }
    float* q = p + 16 * (fq >> 1) + 4 * (fq & 1);
    __builtin_nontemporal_store(x, (f32x4*)q); __builtin_nontemporal_store(y, (f32x4*)(q + 8));
}
struct PreNone {};
struct Pre8 { float v[8]; };
__device__ __forceinline__ Pre8 load8rows(const float* __restrict__ p, int row0) {
    Pre8 r;
#pragma unroll
    for (int i = 0; i < 8; ++i) r.v[i] = p[row0 + (i >> 2) * 128 + (i & 3) * 16];
    return r;
}
__device__ __forceinline__ void rope_cs(int pos, int n, f32x4& c, f32x4& s) {
    const float fp = (float)pos;
    const f32x4 k = n == 0 ? (f32x4){1.5915494309e-01f, 3.0863763405e-02f, 5.9851857127e-03f, 1.1606636412e-03f} : (f32x4){2.2507907904e-04f, 4.3647952793e-05f, 8.4643308082e-06f, 1.6414262628e-06f};
#pragma unroll
    for (int j = 0; j < 4; ++j) { const float r = __builtin_amdgcn_fractf(fp * k[j]); c[j] = __builtin_amdgcn_cosf(r); s[j] = __builtin_amdgcn_sinf(r); }
}

struct EpiInProj {
    static constexpr bool PERM = true, EARLY = true;
    typedef Pre8 Pre;
    const float* ssq;
    bf16_t* p1;
    float* out;
    __device__ __forceinline__ Pre prefetch(const Unit& u, int wr, int wc, int fr, int fq) const { return load8rows(ssq, u.pm * 256 + wr * 64 + fr); }
    __device__ __forceinline__ void operator()(Acc& acc, const Unit& u, const Pre& pre, int wr, int wc, int fr, int fq) const {
        const int pn = u.pn, row0 = u.pm * 256 + wr * 64 + fr;
        const int cl = 32 * wc + 8 * fq;
#pragma unroll
        for (int ai = 0; ai < 2; ++ai)
#pragma unroll
            for (int m = 0; m < 4; ++m) {
                const int row = row0 + ai * 128 + m * 16;
                const float rs = rsqrtf(pre.v[ai * 4 + m] * (1.0f / DM) + EPS);
                bf16_t* prow = p1 + (size_t)row * P1W;
                if (pn < 4) {
                    f32x4 c0, c1, s0, s1; const int pos = row_pos(row);
                    if ((wc & 1) == 0) { rope_cs(pos, 0, c0, s0); rope_cs(pos, 1, c1, s1); }
                    float* orow = (pn >= 2) ? (row < MP ? out + O_KP + (size_t)row * 512 : out + O_KS + (size_t)(row - MP) * 512) : nullptr;
#pragma unroll
                    for (int bj = 0; bj < 2; ++bj) {
                        f32x4 v0 = acc[ai][bj][m][0] * rs, v1 = acc[ai][bj][m][1] * rs;
                        if ((wc & 1) == 0) {
                            const f32x4 o0 = oth4(v0, fq & 1), o1 = oth4(v1, fq & 1);
                            if (fq == 0) { v0 = v0 * c0 - o0 * s0; v1 = v1 * c1 - o1 * s1; }
                            else if (fq == 1) { v0 = v0 * c0 + o0 * s0; v1 = v1 * c1 + o1 * s1; }
                        }
                        const int c = (pn & 1) * 256 + bj * 128 + cl;
                        if (pn >= 2) store8_f32(orow + c - 8 * fq, v0, v1, fq);
                        *(u32x4*)(prow + (pn >> 1) * 512 + c) = pack8(v0, v1);
                    }
                } else if (pn < 6) {
                    float* orow = row < MP ? out + O_VP + (size_t)row * 512 : out + O_VS + (size_t)(row - MP) * 512;
#pragma unroll
                    for (int bj = 0; bj < 2; ++bj) {
                        const f32x4 v0 = acc[ai][bj][m][0] * rs, v1 = acc[ai][bj][m][1] * rs;
                        const int c = (pn & 1) * 256 + bj * 128 + cl;
                        store8_f32(orow + c - 8 * fq, v0, v1, fq);
                        *(u32x4*)(prow + 1024 + c) = pack8(v0, v1);
                    }
                } else if (pn < 8) {
#pragma unroll
                    for (int bj = 0; bj < 2; ++bj) {
                        const f32x4 v0 = acc[ai][bj][m][0] * rs, v1 = acc[ai][bj][m][1] * rs;
                        const int c = (pn & 1) * 256 + bj * 128 + cl;
                        *(u32x4*)(prow + 1536 + c) = pack8(v0, v1);
                    }
                } else {
                    const float rs2 = rs * rs;
                    const f32x4 v0 = acc[ai][0][m][0] * acc[ai][1][m][0] * rs2, v1 = acc[ai][0][m][1] * acc[ai][1][m][1] * rs2;
                    const int c = (pn - 8) * 128 + cl;
                    *(u32x4*)(prow + 2048 + c) = pack8(v0, v1);
                    if (row < MP) { const int t = row & (SEQ - 1); if (t >= SEQ - 2) { float* o = out + O_SCP + ((size_t)(row >> 11) * 2 + (t - (SEQ - 2))) * CW + c; *(f32x4*)o = v0; *(f32x4*)(o + 4) = v1; } }
                    else { const int t = (row - MP) & (DECT - 1); if (t >= DECT - 2) { float* o = out + O_SCS + ((size_t)((row - MP) >> 4) * 2 + (t - (DECT - 2))) * CW + c; *(f32x4*)o = v0; *(f32x4*)(o + 4) = v1; } }
                }
            }
    }
};

struct EpiMemKV {
    static constexpr bool PERM = true, EARLY = true;
    typedef Pre8 Pre;
    const float* ssq; bf16_t* mk; bf16_t* mv; float* out;
    __device__ __forceinline__ Pre prefetch(const Unit& u, int wr, int wc, int fr, int fq) const { return load8rows(ssq, u.pm * 256 + wr * 64 + fr); }
    __device__ __forceinline__ void operator()(Acc& acc, const Unit& u, const Pre& pre, int wr, int wc, int fr, int fq) const {
        const int pn = u.pn, row0 = u.pm * 256 + wr * 64 + fr, cl = 32 * wc + 8 * fq;
        float* ob = out + (pn < 4 ? O_MK : O_MV); bf16_t* bb = pn < 4 ? mk : mv;
#pragma unroll
        for (int ai = 0; ai < 2; ++ai)
#pragma unroll
            for (int m = 0; m < 4; ++m) {
                const int row = row0 + ai * 128 + m * 16;
                const float rs = rsqrtf(pre.v[ai * 4 + m] * (1.0f / DM) + EPS);
#pragma unroll
                for (int bj = 0; bj < 2; ++bj) {
                    const f32x4 v0 = acc[ai][bj][m][0] * rs, v1 = acc[ai][bj][m][1] * rs;
                    const int c = (pn & 3) * 256 + bj * 128 + cl;
                    store8_f32(ob + (size_t)row * DM + c - 8 * fq, v0, v1, fq);
                    *(u32x4*)(bb + (size_t)row * DM + c) = pack8(v0, v1);
                }
            }
    }
};

struct EpiResidual {
    static constexpr bool PERM = true, EARLY = false;
    typedef PreNone Pre;
    bf16_t* XB; float* ssp;
    __device__ __forceinline__ Pre prefetch(const Unit&, int, int, int, int) const { return Pre{}; }
    __device__ __forceinline__ void operator()(Acc& acc, const Unit& u, const Pre&, int wr, int wc, int fr, int fq) const {
        const int row0 = u.pm * 256 + wr * 64 + fr, col0 = u.pn * 256 + wc * 32 + 8 * fq;
        bf16_t* xb = XB + (size_t)row0 * DM + col0;
        u32x4 old[8][2];
#pragma unroll
        for (int g = 0; g < 8; ++g)
#pragma unroll
            for (int bj = 0; bj < 2; ++bj) old[g][bj] = *(const u32x4*)(xb + (size_t)((g >> 2) * 128 + (g & 3) * 16) * DM + bj * 128);
#pragma unroll
        for (int g = 0; g < 8; ++g) {
            const int ai = g >> 2, m = g & 3, row = row0 + ai * 128 + m * 16; float ss = 0.f;
#pragma unroll
            for (int bj = 0; bj < 2; ++bj) {
                const u32x4 o = old[g][bj]; f32x4 v0, v1;
                v0[0] = __uint_as_float(o.x << 16) + acc[ai][bj][m][0][0]; v0[1] = __uint_as_float(o.x & 0xffff0000u) + acc[ai][bj][m][0][1]; v0[2] = __uint_as_float(o.y << 16) + acc[ai][bj][m][0][2]; v0[3] = __uint_as_float(o.y & 0xffff0000u) + acc[ai][bj][m][0][3];
                v1[0] = __uint_as_float(o.z << 16) + acc[ai][bj][m][1][0]; v1[1] = __uint_as_float(o.z & 0xffff0000u) + acc[ai][bj][m][1][1]; v1[2] = __uint_as_float(o.w << 16) + acc[ai][bj][m][1][2]; v1[3] = __uint_as_float(o.w & 0xffff0000u) + acc[ai][bj][m][1][3];
                ss += ((v0[0] * v0[0] + v0[1] * v0[1]) + (v0[2] * v0[2] + v0[3] * v0[3])) + ((v1[0] * v1[0] + v1[1] * v1[1]) + (v1[2] * v1[2] + v1[3] * v1[3]));
                *(u32x4*)(xb + (size_t)(ai * 128 + m * 16) * DM + bj * 128) = pack8(v0, v1);
            }
            ss = xor32_sum(xor16_sum(ss));
            if (fq == 0) ssp[(size_t)row * 16 + u.pn * 4 + wc] = ss;
        }
    }
};
struct EpiResidualOut {
    static constexpr bool PERM = false, EARLY = false;
    typedef PreNone Pre;
    const bf16_t* XB; float* X; float* ssp;
    __device__ __forceinline__ Pre prefetch(const Unit&, int, int, int, int) const { return Pre{}; }
    __device__ __forceinline__ void operator()(Acc& acc, const Unit& u, const Pre&, int wr, int wc, int fr, int fq) const {
        const int row0 = u.pm * 256 + wr * 64 + fr, col0 = u.pn * 256 + wc * 32 + 4 * fq;
        const bf16_t* xb = XB + (size_t)row0 * DM + col0;
        u32x2 old[8][2][2];
#pragma unroll
        for (int g = 0; g < 8; ++g)
#pragma unroll
            for (int bj = 0; bj < 2; ++bj)
#pragma unroll
                for (int n = 0; n < 2; ++n) old[g][bj][n] = *(const u32x2*)(xb + (size_t)((g >> 2) * 128 + (g & 3) * 16) * DM + bj * 128 + n * 16);
#pragma unroll
        for (int g = 0; g < 8; ++g) {
            const int ai = g >> 2, m = g & 3, row = row0 + ai * 128 + m * 16; float* xrow = X + (size_t)row * DM + col0; float ss = 0.f;
#pragma unroll
            for (int bj = 0; bj < 2; ++bj)
#pragma unroll
                for (int n = 0; n < 2; ++n) {
                    const u32x2 o = old[g][bj][n]; f32x4 v;
                    v[0] = __uint_as_float(o.x << 16) + acc[ai][bj][m][n][0]; v[1] = __uint_as_float(o.x & 0xffff0000u) + acc[ai][bj][m][n][1]; v[2] = __uint_as_float(o.y << 16) + acc[ai][bj][m][n][2]; v[3] = __uint_as_float(o.y & 0xffff0000u) + acc[ai][bj][m][n][3];
                    ss += (v[0] * v[0] + v[1] * v[1]) + (v[2] * v[2] + v[3] * v[3]);
                    *(f32x4*)(xrow + bj * 128 + n * 16) = v;
                }
            ss = xor32_sum(xor16_sum(ss));
            if (fq == 0) ssp[(size_t)row * 16 + u.pn * 4 + wc] = ss;
        }
    }
};
__device__ __forceinline__ float rstd16(const float* ssp, int row) {
    const f32x4* p = (const f32x4*)(ssp + (size_t)row * 16); const f32x4 a = p[0], b = p[1], c = p[2], d = p[3];
    const float s = ((a[0] + a[1]) + (a[2] + a[3])) + ((b[0] + b[1]) + (b[2] + b[3])) + ((c[0] + c[1]) + (c[2] + c[3])) + ((d[0] + d[1]) + (d[2] + d[3]));
    return rsqrtf(s * (1.0f / DM) + EPS);
}
struct EpiScaleBf16 {
    static constexpr bool PERM = true, EARLY = true;
    typedef Pre8 Pre;
    const float* rs; bf16_t* O; int ldo;
    __device__ __forceinline__ Pre prefetch(const Unit& u, int wr, int wc, int fr, int fq) const { return load8rows(rs, u.pm * 256 + wr * 64 + fr); }
    __device__ __forceinline__ void operator()(Acc& acc, const Unit& u, const Pre& pre, int wr, int wc, int fr, int fq) const {
        const int row0 = u.pm * 256 + wr * 64 + fr, col0 = u.pn * 256 + 32 * wc + 8 * fq;
#pragma unroll
        for (int ai = 0; ai < 2; ++ai)
#pragma unroll
            for (int m = 0; m < 4; ++m) {
                const int row = row0 + ai * 128 + m * 16; const float r = pre.v[ai * 4 + m];
#pragma unroll
                for (int bj = 0; bj < 2; ++bj) *(u32x4*)(O + (size_t)row * ldo + col0 + bj * 128) = pack8(acc[ai][bj][m][0] * r, acc[ai][bj][m][1] * r);
            }
    }
};
struct EpiXScores {
    static constexpr bool PERM = true, EARLY = false;
    typedef PreNone Pre;
    __device__ __forceinline__ Pre prefetch(const Unit&, int, int, int, int) const { return Pre{}; }
    bf16_t* P; float* lp; LAS float* red;
    __device__ __forceinline__ void operator()(Acc& acc, const Unit& u, const Pre&, int wr, int wc, int fr, int fq) const {
        constexpr float C = 0.0625f * 1.4426950408889634f;
        float mx[2][4];
#pragma unroll
        for (int ai = 0; ai < 2; ++ai)
#pragma unroll
            for (int m = 0; m < 4; ++m) {
                float a = -3.0e38f;
#pragma unroll
                for (int bj = 0; bj < 2; ++bj)
#pragma unroll
                    for (int n = 0; n < 2; ++n) { const f32x4 v = acc[ai][bj][m][n]; a = fmaxf(a, fmaxf(fmaxf(v[0], v[1]), fmaxf(v[2], v[3]))); }
                a = xor32_max(xor16_max(a));
                if (fq == 0) red[(ai * 128 + wr * 64 + m * 16 + fr) * 4 + wc] = a;
            }
        EPI_BAR();
#pragma unroll
        for (int ai = 0; ai < 2; ++ai)
#pragma unroll
            for (int m = 0; m < 4; ++m) { const f32x4 r = *(const LAS f32x4*)(red + (ai * 128 + wr * 64 + m * 16 + fr) * 4); mx[ai][m] = fmaxf(fmaxf(r[0], r[1]), fmaxf(r[2], r[3])); }
        const int row0 = u.pm * 256 + wr * 64 + fr, col0 = u.pn * 256 + 32 * wc + 8 * fq;
#pragma unroll
        for (int ai = 0; ai < 2; ++ai)
#pragma unroll
            for (int m = 0; m < 4; ++m) {
                const int row = row0 + ai * 128 + m * 16; const float mc = mx[ai][m] * C; float s = 0.f;
#pragma unroll
                for (int bj = 0; bj < 2; ++bj) {
#pragma unroll
                    for (int j = 0; j < 4; ++j) { acc[ai][bj][m][0][j] = __builtin_amdgcn_exp2f(acc[ai][bj][m][0][j] * C - mc); acc[ai][bj][m][1][j] = __builtin_amdgcn_exp2f(acc[ai][bj][m][1][j] * C - mc); }
                    const u32x4 w = pack8(acc[ai][bj][m][0], acc[ai][bj][m][1]);
                    s += (__uint_as_float(w.x << 16) + __uint_as_float(w.x & 0xffff0000u)) + (__uint_as_float(w.y << 16) + __uint_as_float(w.y & 0xffff0000u))
                       + (__uint_as_float(w.z << 16) + __uint_as_float(w.z & 0xffff0000u)) + (__uint_as_float(w.w << 16) + __uint_as_float(w.w & 0xffff0000u));
                    *(u32x4*)(P + (size_t)row * DM + col0 + bj * 128) = w;
                }
                s = xor32_sum(xor16_sum(s));
                if (fq == 0) lp[(size_t)row * 16 + u.pn * 4 + wc] = s;
                asm volatile("" ::: "memory");
            }
        EPI_BAR();
    }
};
struct EpiXPV {
    static constexpr bool PERM = true, EARLY = false;
    typedef PreNone Pre;
    __device__ __forceinline__ Pre prefetch(const Unit&, int, int, int, int) const { return Pre{}; }
    const float* lp; bf16_t* O;
    __device__ __forceinline__ void operator()(Acc& acc, const Unit& u, const Pre&, int wr, int wc, int fr, int fq) const {
        const int row0 = u.pm * 256 + wr * 64 + fr, col0 = u.pn * 256 + 32 * wc + 8 * fq;
#pragma unroll
        for (int ai = 0; ai < 2; ++ai)
#pragma unroll
            for (int m = 0; m < 4; ++m) {
                const int row = row0 + ai * 128 + m * 16; const f32x4 l4 = *(const f32x4*)(lp + (size_t)row * 16 + u.pn * 4);
                const float rl = 1.0f / ((l4[0] + l4[1]) + (l4[2] + l4[3]));
#pragma unroll
                for (int bj = 0; bj < 2; ++bj) *(u32x4*)(O + (size_t)row * DM + col0 + bj * 128) = pack8(acc[ai][bj][m][0] * rl, acc[ai][bj][m][1] * rl);
            }
    }
};
struct EpiUpGate {
    static constexpr bool PERM = true, EARLY = false;
    typedef Pre8 Pre;
    const float* rs; const float* wconv;
    const float* state;
    bf16_t* H; float* out;
    float* uh; float* u01; float* g01;
    LAS float* tail;
    __device__ __forceinline__ Pre prefetch(const Unit& u, int wr, int wc, int fr, int fq) const { return load8rows(rs, u.pm * 256 + wr * 64 + fr); }
    __device__ __forceinline__ void operator()(Acc& acc, const Unit& u, const Pre& pre, int wr, int wc, int fr, int fq) const {
        const int pm = u.pm, pn = u.pn, row0 = pm * 256 + wr * 64 + fr, cl = 32 * wc + 8 * fq, gc = pn * 128 + cl;
        const bool sample = pm >= NTILE_P;
        const f32x4 w00 = *(const f32x4*)(wconv + gc), w01 = *(const f32x4*)(wconv + gc + 4), w10 = *(const f32x4*)(wconv + DFF + gc), w11 = *(const f32x4*)(wconv + DFF + gc + 4),
                    w20 = *(const f32x4*)(wconv + 2 * DFF + gc), w21 = *(const f32x4*)(wconv + 2 * DFF + gc + 4);
#pragma unroll
        for (int ai = 0; ai < 2; ++ai)
#pragma unroll
            for (int m = 0; m < 4; ++m) {
                const int g = ai * 8 + wr * 4 + m; const float r = pre.v[ai * 4 + m];
#pragma unroll
                for (int bj = 0; bj < 2; ++bj)
#pragma unroll
                    for (int n = 0; n < 2; ++n) acc[ai][bj][m][n] *= r;
                if (fr >= 14) {
                    LAS float* t = tail + (g * 2 + (fr - 14)) * 128 + cl; *(LAS f32x4*)t = acc[ai][0][m][0]; *(LAS f32x4*)(t + 4) = acc[ai][0][m][1];
                    if (sample) { float* o = out + O_FFS + ((size_t)((pm - NTILE_P) * 16 + g) * 2 + (fr - 14)) * DFF + gc; *(f32x4*)o = acc[ai][0][m][0]; *(f32x4*)(o + 4) = acc[ai][0][m][1]; }
                    else if (g == 15) {
                        float* o = uh + ((size_t)pm * 2 + (fr - 14)) * DFF + gc; *(f32x4*)o = acc[ai][0][m][0]; *(f32x4*)(o + 4) = acc[ai][0][m][1];
                        if ((pm & 7) == 7) { float* q = out + O_FFP + ((size_t)(pm >> 3) * 2 + (fr - 14)) * DFF + gc; *(f32x4*)q = acc[ai][0][m][0]; *(f32x4*)(q + 4) = acc[ai][0][m][1]; }
                    }
                }
                if (!sample && g == 0 && fr < 2) {
                    float* o = u01 + ((size_t)pm * 2 + fr) * DFF + gc; *(f32x4*)o = acc[ai][0][m][0]; *(f32x4*)(o + 4) = acc[ai][0][m][1];
                    float* q = g01 + ((size_t)pm * 2 + fr) * DFF + gc; *(f32x4*)q = acc[ai][1][m][0]; *(f32x4*)(q + 4) = acc[ai][1][m][1];
                }
            }
        EPI_BAR();
#pragma unroll
        for (int ai = 0; ai < 2; ++ai)
#pragma unroll
            for (int m = 0; m < 4; ++m) {
                const int row = row0 + ai * 128 + m * 16, g = ai * 8 + wr * 4 + m;
                f32x4 h1[2] = {(f32x4){0.f, 0.f, 0.f, 0.f}, (f32x4){0.f, 0.f, 0.f, 0.f}}, h2[2] = {(f32x4){0.f, 0.f, 0.f, 0.f}, (f32x4){0.f, 0.f, 0.f, 0.f}};
                if (fr < 2) {
                    if (sample) { const float* s = state + (size_t)((pm - NTILE_P) * 16 + g) * 2 * DFF + gc; h2[0] = *(const f32x4*)(s + fr * DFF); h2[1] = *(const f32x4*)(s + fr * DFF + 4); if (fr == 0) { h1[0] = *(const f32x4*)(s + DFF); h1[1] = *(const f32x4*)(s + DFF + 4); } }
                    else if (g > 0) { const LAS float* t = tail + ((g - 1) * 2) * 128 + cl; h2[0] = *(const LAS f32x4*)(t + fr * 128); h2[1] = *(const LAS f32x4*)(t + fr * 128 + 4); if (fr == 0) { h1[0] = *(const LAS f32x4*)(t + 128); h1[1] = *(const LAS f32x4*)(t + 132); } }
                }
                f32x4 hv[2];
#pragma unroll
                for (int n = 0; n < 2; ++n) {
                    const f32x4 uc = acc[ai][0][m][n];
                    const f32x4 wa = (n == 0 ? w00 : w01), wb = (n == 0 ? w10 : w11), wc2 = (n == 0 ? w20 : w21);
                    f32x4 y = wa * h2[n] + wb * h1[n];
                    y = wc2 * uc + y;
#pragma unroll
                    for (int j = 0; j < 4; ++j) {
                        float yj = y[j];
                        asm("v_fmac_f32_dpp %0, %1, %2 row_shr:1 row_mask:0xf bank_mask:0xf bound_ctrl:0\n\tv_fmac_f32_dpp %0, %1, %3 row_shr:2 row_mask:0xf bank_mask:0xf bound_ctrl:0"
                                     : "+v"(yj) : "v"(uc[j]), "v"(wb[j]), "v"(wa[j]));
                        y[j] = yj; }
                    const f32x4 t = y * (-1.4426950408889634f); f32x4 d;
#pragma unroll
                    for (int j = 0; j < 4; ++j) d[j] = __builtin_amdgcn_exp2f(t[j]);
                    d = d + 1.0f;
#pragma unroll
                    for (int j = 0; j < 4; ++j) d[j] = __builtin_amdgcn_rcpf(d[j]);
                    hv[n] = (y * d) * acc[ai][1][m][n];
                }
                *(u32x4*)(H + (size_t)row * DFF + gc) = pack8(hv[0], hv[1]);
            }
        EPI_BAR();
    }
};
struct EpiPartialF32 {
    static constexpr bool PERM = false, EARLY = false;
    typedef PreNone Pre;
    float* S;
    __device__ __forceinline__ Pre prefetch(const Unit&, int, int, int, int) const { return Pre{}; }
    __device__ __forceinline__ void operator()(Acc& acc, const Unit& u, const Pre&, int wr, int wc, int fr, int fq) const {
        const int kh = u.pn >> 4, pn = u.pn & 15, row0 = (u.pm - NTILE_P) * 256 + wr * 64 + fr, col0 = pn * 256 + wc * 32 + 4 * fq;
        float* b = S + (size_t)kh * MS * DM + (size_t)row0 * DM + col0;
#pragma unroll
        for (int ai = 0; ai < 2; ++ai)
#pragma unroll
            for (int m = 0; m < 4; ++m)
#pragma unroll
                for (int bj = 0; bj < 2; ++bj)
#pragma unroll
                    for (int n = 0; n < 2; ++n) *(f32x4*)(b + (size_t)(ai * 128 + m * 16) * DM + bj * 128 + n * 16) = acc[ai][bj][m][n];
    }
};
}
namespace dattn {
constexpr int NW = 8, QBLK = 32, KVBLK = 64;
constexpr float SCALE = 0.125f, THR = 8.f;
constexpr int SHM_V = KVBLK * 128 * 2, SHM_K = KVBLK * 128 * 2, SHM_ATTN = 2 * SHM_V + 2 * SHM_K + NW * 64 * 4;
#define KSWZ(row, colB) ((row) * 256 + ((colB) ^ (((row) & 7) << 4)))
#define SBAR() __builtin_amdgcn_sched_barrier(0)
__device__ __forceinline__ int crow(int r, int hi) { return (r & 3) + 8 * (r >> 2) + 4 * hi; }
__device__ __forceinline__ void partialSM(f32x16& p0, f32x16& p1, float& m_reg, float& mn, float& alpha) {
  constexpr float C = SCALE * 1.4426950408889634f;
  float pmax = p0[0];
#pragma unroll
  for (int r = 1; r < 16; ++r) pmax = fmaxf(pmax, p0[r]);
#pragma unroll
  for (int r = 0; r < 16; ++r) pmax = fmaxf(pmax, p1[r]);
  { auto rr = __builtin_amdgcn_permlane32_swap(__float_as_uint(pmax), __float_as_uint(pmax), false, false);
    pmax = fmaxf(__uint_as_float(rr[0]), __uint_as_float(rr[1])); }
  if (__builtin_expect(__all(pmax - m_reg <= THR / SCALE), 1)) { mn = m_reg; alpha = 1.f; }
  else { mn = fmaxf(m_reg, pmax); alpha = __builtin_amdgcn_exp2f((m_reg - mn) * C); m_reg = mn; }
  const float mnC = -mn * C;
#pragma unroll
  for (int r = 0; r < 16; ++r) p0[r] = fmaf(p0[r], C, mnC);
#pragma unroll
  for (int r = 0; r < 16; ++r) p1[r] = fmaf(p1[r], C, mnC);
#pragma unroll
  for (int r = 0; r < 16; ++r) p0[r] = __builtin_amdgcn_exp2f(p0[r]);
}
__device__ __forceinline__ void finishSM(f32x16& p0, f32x16& p1, float alpha, float& l_reg, bf16x8& pa0, bf16x8& pa1, bf16x8& pa2, bf16x8& pa3) {
#pragma unroll
  for (int r = 0; r < 16; ++r) p1[r] = __builtin_amdgcn_exp2f(p1[r]);
  float ps = 0;
#pragma unroll
  for (int r = 0; r < 16; ++r) ps += p0[r];
#pragma unroll
  for (int r = 0; r < 16; ++r) ps += p1[r];
  { auto rr = __builtin_amdgcn_permlane32_swap(__float_as_uint(ps), __float_as_uint(ps), false, false);
    ps = __uint_as_float(rr[0]) + __uint_as_float(rr[1]); }
  l_reg = l_reg * alpha + ps;
#define PK4(P, BASE, OUT) do { unsigned a0 = cvt_pk_bf16(P[BASE + 0], P[BASE + 1]), a1 = cvt_pk_bf16(P[BASE + 2], P[BASE + 3]);   \
    unsigned b0 = cvt_pk_bf16(P[BASE + 4], P[BASE + 5]), b1 = cvt_pk_bf16(P[BASE + 6], P[BASE + 7]);                              \
    auto r0 = __builtin_amdgcn_permlane32_swap(a0, b0, false, false); auto r1 = __builtin_amdgcn_permlane32_swap(a1, b1, false, false); \
    u32x4 w = {r0[0], r1[0], r0[1], r1[1]}; OUT = *reinterpret_cast<bf16x8*>(&w); } while (0)
  PK4(p0, 0, pa0); PK4(p0, 8, pa1); PK4(p1, 0, pa2); PK4(p1, 8, pa3);
#undef PK4
}
__device__ __forceinline__ void qkt(f32x16& p0, f32x16& p1, const char* Ks, const bf16x8* qr, int r32, int hi, int mp) {
  p0 = f32x16{}; p1 = f32x16{};
#pragma unroll
  for (int d0 = 0; d0 < 4; ++d0) { const int cb = (mp * 64 + d0 * 16 + hi * 8) * 2;
    const bf16x8 b0 = *reinterpret_cast<const bf16x8*>(Ks + KSWZ(r32, cb));
    const bf16x8 b1 = *reinterpret_cast<const bf16x8*>(Ks + KSWZ(32 + r32, cb));
    p0 = __builtin_amdgcn_mfma_f32_32x32x16_bf16(b0, qr[d0], p0, 0, 0, 0);
    p1 = __builtin_amdgcn_mfma_f32_32x32x16_bf16(b1, qr[d0], p1, 0, 0, 0); }
}
__device__ __forceinline__ int v_st(int k, int c) { const int kk = (k & ~0xC) | ((k & 4) << 1) | ((k & 8) >> 1); return ((kk >> 3) * 4 + (c >> 5)) * 512 + ((kk & 7) * 32 + (c & 31)) * 2; }
__device__ __forceinline__ int v_rd_base(int lane) { return ((lane & 3) << 3) | (((lane >> 2) & 3) << 6) | (((lane >> 4) & 1) << 5) | (((lane >> 5) & 1) << 8); }
constexpr int v_rd_off(int d0, int ks, int half) { return d0 * 512 + ks * 4096 + half * 2048; }
template <int OFF> __device__ __forceinline__ s16x4 tr_read(int vb) {
  s16x4 r; asm volatile("ds_read_b64_tr_b16 %0, %1 offset:%2" : "=&v"(r) : "v"(vb), "i"(OFF) : "memory"); return r;
}
template <int D0> __device__ __forceinline__ void pv_one(f32x16& od, int vb, bf16x8 pa0, bf16x8 pa1, bf16x8 pa2, bf16x8 pa3) {
  const s16x4 l0 = tr_read<v_rd_off(D0, 0, 0)>(vb), h0 = tr_read<v_rd_off(D0, 0, 1)>(vb), l1 = tr_read<v_rd_off(D0, 1, 0)>(vb), h1 = tr_read<v_rd_off(D0, 1, 1)>(vb);
  const s16x4 l2 = tr_read<v_rd_off(D0, 2, 0)>(vb), h2 = tr_read<v_rd_off(D0, 2, 1)>(vb), l3 = tr_read<v_rd_off(D0, 3, 0)>(vb), h3 = tr_read<v_rd_off(D0, 3, 1)>(vb);
  asm volatile("s_waitcnt lgkmcnt(0)" ::: "memory"); SBAR();
#define PK(L, H) (bf16x8){L[0], L[1], L[2], L[3], H[0], H[1], H[2], H[3]}
  od = __builtin_amdgcn_mfma_f32_32x32x16_bf16(pa0, PK(l0, h0), od, 0, 0, 0);
  od = __builtin_amdgcn_mfma_f32_32x32x16_bf16(pa1, PK(l1, h1), od, 0, 0, 0);
  od = __builtin_amdgcn_mfma_f32_32x32x16_bf16(pa2, PK(l2, h2), od, 0, 0, 0);
  od = __builtin_amdgcn_mfma_f32_32x32x16_bf16(pa3, PK(l3, h3), od, 0, 0, 0);
#undef PK
}
__device__ __forceinline__ void pv_d0(f32x16* o, int vb, bf16x8 pa0, bf16x8 pa1, bf16x8 pa2, bf16x8 pa3) {
  pv_one<0>(o[0], vb, pa0, pa1, pa2, pa3); pv_one<1>(o[1], vb, pa0, pa1, pa2, pa3); pv_one<2>(o[2], vb, pa0, pa1, pa2, pa3); pv_one<3>(o[3], vb, pa0, pa1, pa2, pa3);
}

__device__ __forceinline__ void qkt3(f32x16& p0, f32x16& p1, const LAS char* Ks, const bf16x8* qr, int r32, int hi, int mp) {
  p0 = f32x16{}; p1 = f32x16{};
#pragma unroll
  for (int d0 = 0; d0 < 4; ++d0) { const int cb = (mp * 64 + d0 * 16 + hi * 8) * 2;
    const bf16x8 b0 = *reinterpret_cast<const LAS bf16x8*>(Ks + KSWZ(r32, cb));
    const bf16x8 b1 = *reinterpret_cast<const LAS bf16x8*>(Ks + KSWZ(32 + r32, cb));
    p0 = __builtin_amdgcn_mfma_f32_32x32x16_bf16(b0, qr[d0], p0, 0, 0, 0);
    p1 = __builtin_amdgcn_mfma_f32_32x32x16_bf16(b1, qr[d0], p1, 0, 0, 0); }
}
__device__ __forceinline__ void unit(int b, int h, int qb, const bf16_t* __restrict__ p1, bf16_t* __restrict__ A2, float lam, const float* __restrict__ gsub, LAS char* lds3) {
  int tid = threadIdx.x; asm volatile("" : "+v"(tid));
  const int wid = __builtin_amdgcn_readfirstlane(tid >> 6), lane = tid & 63, r32 = lane & 31, hi = lane >> 5, wq = wid & 3, mp = wid >> 2;
  LAS float* ws = (LAS float*)(lds3 + 131072) + wid * 64; LAS float* li_l = ws; LAS float* al_l = ws + 32;
  float m_reg = -1e30f, l_reg = 0; f32x16 o[4] = {}; bf16x8 qr[4];
  const size_t rowb = (size_t)b * SEQ;
  const char* Kh = (const char*)(p1 + rowb * P1W + 512 + h * 128); const char* Vh = (const char*)(p1 + rowb * P1W + 1024 + h * 128);
  unsigned koff[2], voff[2];
#pragma unroll
  for (int i = 0; i < 2; ++i) {
    const int krow = wid * 8 + i * 4 + (lane >> 4), kch = (lane & 15) ^ (krow & 7); koff[i] = (unsigned)(krow * P1W * 2 + kch * 16);
    const int sub = wid * 4 + i * 2 + (lane >> 5), kk = (sub >> 2) * 8 + ((lane & 31) >> 2), key = (kk & ~0xC) | ((kk & 4) << 1) | ((kk & 8) >> 1), c = (sub & 3) * 32 + (lane & 3) * 8;
    voff[i] = (unsigned)(key * P1W * 2 + c * 2);
  }
  const unsigned dmaw = (unsigned)wid * 2048u;
#define DMA(t, slot) do { const char* kb_ = Kh + (size_t)(t) * (KVBLK * P1W * 2); const char* vb_ = Vh + (size_t)(t) * (KVBLK * P1W * 2); _Pragma("unroll") for (int i_ = 0; i_ < 2; ++i_) { \
    __builtin_amdgcn_global_load_lds((const unsigned*)(kb_ + koff[i_]), (LAS unsigned*)(lds3 + (slot) * 32768 + dmaw + i_ * 1024), 16, 0, 0); \
    __builtin_amdgcn_global_load_lds((const unsigned*)(vb_ + voff[i_]), (LAS unsigned*)(lds3 + (slot) * 32768 + 16384 + dmaw + i_ * 1024), 16, 0, 0); } } while (0)
#define WAITV(n) asm volatile("s_waitcnt vmcnt(" #n ")" ::: "memory")
#define LBAR() do { asm volatile("s_waitcnt lgkmcnt(0)" ::: "memory"); __builtin_amdgcn_s_barrier(); asm volatile("" ::: "memory"); } while (0)
#define KS(t) (lds3 + ((t) & 3) * 32768)
#define VB(t) (vrd + ((t) & 3) * 32768)
  const int NT = 2 * qb + 2;
  const bool vis_last = (wq >= 2);
  DMA(0, 0); DMA(1, 1);
  const bf16_t* Qw = p1 + (rowb + qb * 128 + wq * QBLK + r32) * P1W + h * 128 + mp * 64 + hi * 8;
#pragma unroll
  for (int d0 = 0; d0 < 4; ++d0) qr[d0] = *reinterpret_cast<const bf16x8*>(Qw + d0 * 16);
  const int vrd = (int)(uintptr_t)lds3 + 16384 + v_rd_base(lane);
#define RESC(a) do { if (__any((a) < 1.f)) { if (hi == 0) al_l[r32] = (a); asm volatile("s_waitcnt lgkmcnt(0)" ::: "memory"); \
    _Pragma("unroll") for (int d = 0; d < 4; ++d) _Pragma("unroll") for (int r = 0; r < 16; ++r) o[d][r] *= al_l[crow(r, hi)]; } } while (0)
  f32x16 pA0, pA1, pB0, pB1; float mnA, mnB, alA, alB; bf16x8 pa0, pa1, pa2, pa3;
  WAITV(4); LBAR();
  if (2 < NT) DMA(2, 2);
  qkt3(pA0, pA1, KS(0), qr, r32, hi, mp); partialSM(pA0, pA1, m_reg, mnA, alA);
  for (int j = 1; j + 1 < NT; j += 2) {
    WAITV(4); LBAR(); DMA(j + 2, (j + 2) & 3);
    SBAR(); qkt3(pB0, pB1, KS(j), qr, r32, hi, mp);
    finishSM(pA0, pA1, alA, l_reg, pa0, pa1, pa2, pa3); SBAR();
    pv_d0(o, VB(j - 1), pa0, pa1, pa2, pa3); partialSM(pB0, pB1, m_reg, mnB, alB);
    RESC(alB);
    WAITV(4); LBAR(); if (j + 3 < NT) DMA(j + 3, (j + 3) & 3);
    SBAR(); qkt3(pA0, pA1, KS(j + 1), qr, r32, hi, mp);
    finishSM(pB0, pB1, alB, l_reg, pa0, pa1, pa2, pa3); SBAR();
    pv_d0(o, VB(j), pa0, pa1, pa2, pa3); partialSM(pA0, pA1, m_reg, mnA, alA);
    RESC(alA);
  }
  WAITV(0); LBAR();
  SBAR();
  if (vis_last) qkt3(pB0, pB1, KS(NT - 1), qr, r32, hi, mp);
  finishSM(pA0, pA1, alA, l_reg, pa0, pa1, pa2, pa3); SBAR();
  pv_d0(o, VB(NT - 2), pa0, pa1, pa2, pa3);
  if (vis_last) {
    partialSM(pB0, pB1, m_reg, mnB, alB);
    RESC(alB);
    finishSM(pB0, pB1, alB, l_reg, pa0, pa1, pa2, pa3); SBAR();
    pv_d0(o, VB(NT - 1), pa0, pa1, pa2, pa3);
  }
  if (hi == 0) li_l[r32] = l_reg; asm volatile("s_waitcnt lgkmcnt(0)" ::: "memory");
  float rli[16];
#pragma unroll
  for (int r = 0; r < 16; ++r) rli[r] = __builtin_amdgcn_rcpf(li_l[crow(r, hi)]);
  LBAR();
  LAS float* X = (LAS float*)lds3 + wq * (32 * 132);
  if (mp == 1) {
#pragma unroll
    for (int r = 0; r < 16; ++r) { const int orow = crow(r, hi);
#pragma unroll
      for (int d0 = 0; d0 < 4; ++d0) X[orow * 132 + d0 * 32 + r32] = o[d0][r] * rli[r]; }
  }
  LBAR();
  if (mp == 0) {
#pragma unroll
    for (int r = 0; r < 16; ++r) { const int orow = crow(r, hi);
#pragma unroll
      for (int d0 = 0; d0 < 4; ++d0) { LAS float* p = &X[orow * 132 + d0 * 32 + r32]; *p = o[d0][r] * rli[r] - lam * (*p); } }
    asm volatile("s_waitcnt lgkmcnt(0)" ::: "memory");
    const int row = lane >> 1, half = lane & 1; const LAS float* xr = X + row * 132 + half * 64;
    f32x4 v[16]; float ss = 0.f;
#pragma unroll
    for (int i = 0; i < 16; ++i) { v[i] = *(const LAS f32x4*)(xr + 4 * i); ss += (v[i][0] * v[i][0] + v[i][1] * v[i][1]) + (v[i][2] * v[i][2] + v[i][3] * v[i][3]); }
    ss += DPPF(ss, 0xB1);
    const float rs = rsqrtf(ss * (1.0f / 128.0f) + EPS) * (1.0f - LAM_INIT);
    bf16_t* orow = A2 + (rowb + qb * 128 + wq * QBLK + row) * DM + h * 128 + half * 64; const float* g = gsub + half * 64;
#pragma unroll
    for (int i = 0; i < 16; i += 2) { const f32x4 g0 = *(const f32x4*)(g + 4 * i), g1 = *(const f32x4*)(g + 4 * i + 4);
      *(u32x4*)(orow + 4 * i) = epi::pack8(v[i] * g0 * rs, v[i + 1] * g1 * rs); }
  }
  asm volatile("s_waitcnt vmcnt(0)" ::: "memory");
  LBAR();
#undef DMA
#undef WAITV
#undef LBAR
#undef KS
#undef VB
#undef RESC
}
#undef KSWZ
#undef SBAR
}
namespace misc {
constexpr int SK = PAST + DECT;
__device__ __forceinline__ void sample_attn_unit(int b, int h, int qh, const bf16_t* __restrict__ p1, const float* __restrict__ ck, const float* __restrict__ cv,
                                                 const float* __restrict__ nk, const float* __restrict__ nv, bf16_t* __restrict__ A2, float lam, const float* __restrict__ gsub, char* lds) {
  int tid = threadIdx.x; asm volatile("" : "+v"(tid)); const int lane = tid & 63, wid = tid >> 6;
  float* S = (float*)lds; float* red = (float*)(lds + 66560); float* q = (float*)(lds + 132096); float* st = (float*)(lds + 136192);
  for (int i = tid; i < 1024; i += 512) { const int mp = i >> 9, r = (i >> 6) & 7, d = i & 63;
    q[i] = bf2f(p1[(size_t)(MP + b * DECT + qh * 8 + r) * P1W + h * 128 + mp * 64 + d]); }
  __syncthreads();
  for (int it = tid; it < 2 * SK; it += 512) {
    const int mp = it / SK, key = it - mp * SK;
    const float* kp = key < PAST ? ck + (((size_t)b * PAST + key) * NH + h) * 128 + mp * 64 : nk + ((size_t)(b * DECT + key - PAST)) * 512 + h * 128 + mp * 64;
    float a[8] = {0.f, 0.f, 0.f, 0.f, 0.f, 0.f, 0.f, 0.f};
#pragma unroll 4
    for (int d = 0; d < 64; d += 4) { const f32x4 kv = *(const f32x4*)(kp + d);
#pragma unroll
      for (int r = 0; r < 8; ++r) { const f32x4 qv = *(const f32x4*)(q + (mp * 8 + r) * 64 + d); a[r] += (kv[0] * qv[0] + kv[1] * qv[1]) + (kv[2] * qv[2] + kv[3] * qv[3]); } }
#pragma unroll
    for (int r = 0; r < 8; ++r) S[(mp * 8 + r) * SK + key] = a[r] * 0.125f;
  }
  __syncthreads();
  for (int rr = 0; rr < 2; ++rr) { const int row = wid * 2 + rr; float* s = S + row * SK;
    float mx = -3.0e38f; for (int k = lane; k < SK; k += 64) mx = fmaxf(mx, s[k]); mx = wave_max(mx);
    float sum = 0.f; for (int k = lane; k < SK; k += 64) { const float e = __expf(s[k] - mx); s[k] = e; sum += e; } sum = wave_sum(sum);
    if (lane == 0) st[row] = 1.0f / sum; }
  __syncthreads();
  for (int i = tid; i < 8 * SK; i += 512) { const int r = i / SK, k = i - r * SK; S[r * SK + k] = S[r * SK + k] * st[r] - lam * S[(8 + r) * SK + k] * st[8 + r]; }
  __syncthreads();
  { const int eg = tid & 31, ks = tid >> 5; f32x4 o[8];
#pragma unroll
    for (int r = 0; r < 8; ++r) o[r] = (f32x4){0.f, 0.f, 0.f, 0.f};
    for (int key = ks; key < SK; key += 16) {
      const float* vp = key < PAST ? cv + (((size_t)b * PAST + key) * NH + h) * 128 + eg * 4 : nv + ((size_t)(b * DECT + key - PAST)) * 512 + h * 128 + eg * 4;
      const f32x4 vv = *(const f32x4*)vp;
#pragma unroll
      for (int r = 0; r < 8; ++r) o[r] += vv * S[r * SK + key]; }
#pragma unroll
    for (int r = 0; r < 8; ++r) *(f32x4*)(red + (ks * 8 + r) * 128 + eg * 4) = o[r]; }
  __syncthreads();
  { const int r = wid; float x0 = 0.f, x1 = 0.f;
#pragma unroll
    for (int ks = 0; ks < 16; ++ks) { const f32x2 t = *(const f32x2*)(red + (ks * 8 + r) * 128 + 2 * lane); x0 += t[0]; x1 += t[1]; }
    const float ss = wave_sum(x0 * x0 + x1 * x1); const float rs = rsqrtf(ss * (1.0f / 128.0f) + EPS) * (1.0f - LAM_INIT);
    const unsigned w = cvt_pk_bf16(x0 * rs * gsub[2 * lane], x1 * rs * gsub[2 * lane + 1]);
    *(unsigned*)(A2 + (size_t)(MP + b * DECT + qh * 8 + r) * DM + h * 128 + 2 * lane) = w; }
  __syncthreads();
}

__device__ __forceinline__ void sample_xattn_unit(int b, int h, const bf16_t* __restrict__ HQ, const float* __restrict__ mk, const float* __restrict__ mv, bf16_t* __restrict__ XO, char* lds) {
  int tid = threadIdx.x; asm volatile("" : "+v"(tid)); const int lane = tid & 63, wid = tid >> 6;
  float* q = (float*)lds; float* S = (float*)(lds + 16384);
  for (int i = tid; i < 16 * 256; i += 512) { const int r = i >> 8, d = i & 255; q[i] = bf2f(HQ[(size_t)(MP + b * DECT + r) * DM + h * 256 + d]); }
  __syncthreads();
  { const int key = tid >> 1, qh = tid & 1; const float* kp = mk + (((size_t)b * NMEM + key) * NH + h) * 256;
    float a[8] = {0.f, 0.f, 0.f, 0.f, 0.f, 0.f, 0.f, 0.f};
#pragma unroll 4
    for (int d = 0; d < 256; d += 4) { const f32x4 kv = *(const f32x4*)(kp + d);
#pragma unroll
      for (int r = 0; r < 8; ++r) { const f32x4 qv = *(const f32x4*)(q + (qh * 8 + r) * 256 + d); a[r] += (kv[0] * qv[0] + kv[1] * qv[1]) + (kv[2] * qv[2] + kv[3] * qv[3]); } }
#pragma unroll
    for (int r = 0; r < 8; ++r) S[(qh * 8 + r) * 256 + key] = a[r] * 0.0625f; }
  __syncthreads();
  for (int rr = 0; rr < 2; ++rr) { const int row = wid * 2 + rr; float* s = S + row * 256;
    float v[4]; float mx = -3.0e38f;
#pragma unroll
    for (int i = 0; i < 4; ++i) { v[i] = s[lane + 64 * i]; mx = fmaxf(mx, v[i]); } mx = wave_max(mx);
    float sum = 0.f;
#pragma unroll
    for (int i = 0; i < 4; ++i) { v[i] = __expf(v[i] - mx); sum += v[i]; } sum = wave_sum(sum); const float rl = 1.0f / sum;
#pragma unroll
    for (int i = 0; i < 4; ++i) s[lane + 64 * i] = v[i] * rl; }
  __syncthreads();
  { const int r = tid >> 5, dg = tid & 31; const float* vp = mv + ((size_t)b * NMEM * NH + h) * 256 + dg * 8; f32x4 o0 = {0.f, 0.f, 0.f, 0.f}, o1 = {0.f, 0.f, 0.f, 0.f};
    for (int key = 0; key < NMEM; ++key) { const float p = S[r * 256 + key]; const f32x4 a = *(const f32x4*)(vp + (size_t)key * NH * 256), c = *(const f32x4*)(vp + (size_t)key * NH * 256 + 4); o0 += a * p; o1 += c * p; }
    *(u32x4*)(XO + (size_t)(MP + b * DECT + r) * DM + h * 256 + dg * 8) = epi::pack8(o0, o1); }
  __syncthreads();
}

__device__ __forceinline__ void shortconv_item(int item, const bf16_t* __restrict__ p1, const float* __restrict__ wsc, const float* __restrict__ state, bf16_t* __restrict__ A2) {
  const int cgp = item & 63, chunk = item >> 6, c = cgp * 8, r0 = chunk * 64;
  float w0[8], w1[8], w2[8], um2[8], um1[8];
#pragma unroll
  for (int j = 0; j < 8; ++j) { w0[j] = wsc[c + j]; w1[j] = wsc[CW + c + j]; w2[j] = wsc[2 * CW + c + j]; um2[j] = 0.f; um1[j] = 0.f; }
  const bool sample = r0 >= MP;
  if (!sample && (r0 & (SEQ - 1)) != 0) {
    const u32x4 a = *(const u32x4*)(p1 + (size_t)(r0 - 2) * P1W + 2048 + c), bq = *(const u32x4*)(p1 + (size_t)(r0 - 1) * P1W + 2048 + c);
#pragma unroll
    for (int j = 0; j < 4; ++j) { um2[2 * j] = __uint_as_float(a[j] << 16); um2[2 * j + 1] = __uint_as_float(a[j] & 0xffff0000u); um1[2 * j] = __uint_as_float(bq[j] << 16); um1[2 * j + 1] = __uint_as_float(bq[j] & 0xffff0000u); }
  }
  for (int r = 0; r < 64; ++r) {
    const int row = r0 + r;
    if (sample && ((row - MP) & (DECT - 1)) == 0) { const float* s = state + (size_t)((row - MP) >> 4) * 2 * CW + c;
#pragma unroll
      for (int j = 0; j < 8; ++j) { um2[j] = s[j]; um1[j] = s[CW + j]; } }
    const u32x4 uu = *(const u32x4*)(p1 + (size_t)row * P1W + 2048 + c), gg = *(const u32x4*)(p1 + (size_t)row * P1W + 1536 + c);
    float y[8];
#pragma unroll
    for (int j = 0; j < 4; ++j) {
      const float u0 = __uint_as_float(uu[j] << 16), u1 = __uint_as_float(uu[j] & 0xffff0000u), g0 = __uint_as_float(gg[j] << 16), g1 = __uint_as_float(gg[j] & 0xffff0000u);
      y[2 * j] = g0 * (w0[2 * j] * um2[2 * j] + w1[2 * j] * um1[2 * j] + w2[2 * j] * u0); y[2 * j + 1] = g1 * (w0[2 * j + 1] * um2[2 * j + 1] + w1[2 * j + 1] * um1[2 * j + 1] + w2[2 * j + 1] * u1);
      um2[2 * j] = um1[2 * j]; um2[2 * j + 1] = um1[2 * j + 1]; um1[2 * j] = u0; um1[2 * j + 1] = u1; }
    u32x4 w; w.x = cvt_pk_bf16(y[0], y[1]); w.y = cvt_pk_bf16(y[2], y[3]); w.z = cvt_pk_bf16(y[4], y[5]); w.w = cvt_pk_bf16(y[6], y[7]);
    *(u32x4*)(A2 + (size_t)row * DM + 512 + c) = w;
  }
}
__device__ __forceinline__ void transpose_item(int item, const bf16_t* __restrict__ src, bf16_t* __restrict__ dst, LAS bf16_t* scr, int lane) {
  const int bi = item >> 4, bj = item & 15, r0 = bi * 64, c0 = bj * 64;
  for (int i = 0; i < 64; ++i) scr[i * 66 + lane] = src[(size_t)(r0 + i) * DM + c0 + lane];
  asm volatile("s_waitcnt lgkmcnt(0)" ::: "memory");
  for (int i = 0; i < 64; ++i) dst[(size_t)(c0 + i) * MMEM + r0 + lane] = scr[lane * 66 + i];
  asm volatile("s_waitcnt lgkmcnt(0)" ::: "memory");
}
}
constexpr size_t MiB = 1u << 20;
constexpr size_t WS_SSQ0 = 1 * MiB, WS_SSQM = WS_SSQ0 + 288 * 1024, WS_RS1 = WS_SSQ0 + 320 * 1024, WS_RS2 = WS_SSQ0 + 640 * 1024;
constexpr size_t WS_SSP1 = 2 * MiB, WS_SSP2 = 7 * MiB, WS_SSP3 = 12 * MiB, WS_L4 = 17 * MiB;
constexpr size_t WS_UH = 22 * MiB, WS_U01 = 28 * MiB, WS_G01 = 34 * MiB;
constexpr size_t WS_WIN = 40 * MiB, WS_WOUT = 46 * MiB, WS_WXQ = 48 * MiB, WS_WXKV = 50 * MiB, WS_WXO = 54 * MiB, WS_WUG = 56 * MiB, WS_WDN = 67 * MiB;
constexpr size_t WS_MN = 74 * MiB, WS_MK = 90 * MiB, WS_MV = 106 * MiB, WS_MVT = 122 * MiB;
constexpr size_t WS_XA = 138 * MiB;
constexpr size_t WS_P1 = 268 * MiB;
constexpr size_t WS_A2 = 591 * MiB;
constexpr size_t WS_SPART = WS_MN;
constexpr size_t WS_HQ = WS_P1, WS_P = WS_P1 + 129 * MiB, WS_H = WS_P1;
constexpr size_t WS_END = 720 * MiB;
static_assert(WS_XA + (size_t)RT * DM * 2 <= WS_P1 && WS_P1 + (size_t)RT * P1W * 2 <= WS_A2 && WS_A2 + (size_t)RT * DM * 2 <= WS_END && WS_H + (size_t)RT * DFF * 2 <= WS_END, "ws map");
static_assert(WS_WDN + (size_t)DM * DFF * 2 <= WS_MN && WS_WUG + (size_t)2 * DFF * DM * 2 <= WS_WDN && WS_G01 + (size_t)NTILE_P * 2 * DFF * 4 <= WS_WIN && WS_L4 + (size_t)RT * 16 <= WS_UH && WS_RS2 + (size_t)RT * 4 <= WS_SSP1, "ws map 2");

constexpr int RING_BYTES = 131072, XTRA_OFF = RING_BYTES, BARST_OFF = XTRA_OFF + 20480, LDS_BYTES = 155648;

struct SchedGrid {
    const char* A; const char* B; size_t a_tile, b_tile; int nM, nN, nwg, G, c;
    __device__ __forceinline__ void init(const void* A_, size_t a_tile_, const void* B_, size_t b_tile_, int nM_, int nN_, int G_, int c_) { A = (const char*)A_; B = (const char*)B_; a_tile = a_tile_; b_tile = b_tile_; nM = nM_; nN = nN_; nwg = nM * nN; G = G_; c = c_; }
    __device__ __forceinline__ bool next(int i, pg8::Unit& u) const {
        const long L = (long)i * G + c; if (L >= nwg) return false;
        int wgid = (int)L; { const int q = nwg / 8, r = nwg % 8, xcd = wgid % 8, off = wgid / 8; wgid = (xcd < r ? xcd * (q + 1) : r * (q + 1) + (xcd - r) * q) + off; }
        const int nig = 8 * nN, gid = wgid / nig, fm = gid * 8, gsz = (nM - fm) < 8 ? (nM - fm) : 8;
        u.pm = fm + ((wgid % nig) % gsz); u.pn = (wgid % nig) / gsz; u.A = A + (size_t)u.pm * a_tile; u.B = B + (size_t)u.pn * b_tile; return true;
    }
};
struct SchedX {
    const char* A; const char* B; int G, c; bool pv;
    __device__ __forceinline__ bool next(int i, pg8::Unit& u) const {
        const long L = (long)i * G + c; if (L >= 4 * NTILE_P) return false;
        const int h = (int)(L >> 8), idx = (int)(L & 255), pm = (idx & 7) * 32 + (idx >> 3), b = pm >> 3;
        u.pm = pm; u.pn = h; u.A = A + ((size_t)pm * 256 * DM + h * 256) * 2;
        u.B = pv ? B + ((size_t)h * 256 * MMEM + b * 256) * 2 : B + ((size_t)b * 256 * DM + h * 256) * 2; return true;
    }
};

struct SchedSplitK {
    const char* A; const char* B; int G, c;
    __device__ __forceinline__ bool next(int i, pg8::Unit& u) const {
        const long L = (long)i * G + c; if (L >= 16) return false;
        const int t = (int)(L >> 3), pn = (int)(L >> 1) & 3, kh = (int)L & 1;
        u.pm = NTILE_P + t; u.pn = pn | (kh << 4);
        u.A = A + ((size_t)(NTILE_P + t) * 256 * DFF + kh * (DFF / 2)) * 2; u.B = B + ((size_t)pn * 256 * DFF + kh * (DFF / 2)) * 2; return true;
    }
};

__device__ __forceinline__ void p0_transpose_item(const float* __restrict__ W, int ldw, int K, int kb, int ns, bf16_t* __restrict__ WT, int nd, const float* __restrict__ gain, LAS float* scr, int lane) {
    const int k0 = 64 * kb;
    float wv[32];
#pragma unroll
    for (int i = 0; i < 32; ++i) wv[i] = W[(size_t)(k0 + 2 * i + (lane >> 5)) * ldw + ns + (lane & 31)];
    if (gain) {
#pragma unroll
        for (int i = 0; i < 32; ++i) wv[i] *= gain[k0 + 2 * i + (lane >> 5)]; }
#pragma unroll
    for (int i = 0; i < 32; ++i) scr[(2 * i + (lane >> 5)) * 33 + (lane & 31)] = wv[i];
    asm volatile("s_waitcnt lgkmcnt(0)" ::: "memory");
    const int cc = lane & 7;
#pragma unroll
    for (int j = 0; j < 4; ++j) { const int n = (lane >> 3) + 8 * j; const LAS float* s = scr + (8 * cc) * 33 + n;
        u32x4 o; o.x = cvt_pk_bf16(s[0 * 33], s[1 * 33]); o.y = cvt_pk_bf16(s[2 * 33], s[3 * 33]); o.z = cvt_pk_bf16(s[4 * 33], s[5 * 33]); o.w = cvt_pk_bf16(s[6 * 33], s[7 * 33]);
        *(u32x4*)(WT + (size_t)(nd + n) * K + k0 + 8 * cc) = o; }
    asm volatile("s_waitcnt lgkmcnt(0)" ::: "memory");
}
__device__ __forceinline__ void rows2_to_bf16(const float* __restrict__ x0, const float* __restrict__ x1, bf16_t* __restrict__ o0, bf16_t* __restrict__ o1, float* q0, float* q1, int lane) {
    const f32x4* r0 = (const f32x4*)x0 + lane; const f32x4* r1 = (const f32x4*)x1 + lane; f32x4 v[4], w[4]; float s = 0.f, t = 0.f;
#pragma unroll
    for (int j = 0; j < 4; ++j) { v[j] = __builtin_nontemporal_load(r0 + 64 * j); w[j] = __builtin_nontemporal_load(r1 + 64 * j); }
#pragma unroll
    for (int j = 0; j < 4; ++j) { s += (v[j][0] * v[j][0] + v[j][1] * v[j][1]) + (v[j][2] * v[j][2] + v[j][3] * v[j][3]); t += (w[j][0] * w[j][0] + w[j][1] * w[j][1]) + (w[j][2] * w[j][2] + w[j][3] * w[j][3]); }
    s = wave_sum(s); t = wave_sum(t);
    u32x2* p0 = (u32x2*)o0 + lane; u32x2* p1 = (u32x2*)o1 + lane;
#pragma unroll
    for (int j = 0; j < 4; ++j) { p0[64 * j] = epi::pack4(v[j]); p1[64 * j] = epi::pack4(w[j]); }
    if (lane == 0) { *q0 = s; *q1 = t; }
}

#define XB_TMO      128
#define XB_XCNT(j)  (256  + 64 * (j))
#define XB_XSUB(j)  (1280 + 64 * (j))
#define XB_XGEN(j)  (2304 + 64 * (j))
#define XB_TOP      3328
#define XB_TOPGEN   3392
#define XCD_BAR_WORDS 3456
#define XB_SPIN_CAP (1u << 22)
__device__ __forceinline__ unsigned xb_ld(unsigned* p)              { return __hip_atomic_load(p, __ATOMIC_RELAXED, __HIP_MEMORY_SCOPE_AGENT); }
__device__ __forceinline__ unsigned xb_add(unsigned* p, unsigned v) { return __hip_atomic_fetch_add(p, v, __ATOMIC_RELAXED, __HIP_MEMORY_SCOPE_AGENT); }
__device__ __forceinline__ unsigned xb_xcc_id() { return (unsigned)__builtin_amdgcn_s_getreg((3 << 11) | 20) & 0xFu; }
#define XB_SPIN(cond, bar) do { unsigned _sp = 0; while (cond) { __builtin_amdgcn_s_sleep(1); \
    if ((++_sp & 255u) == 0u) { if (xb_ld(&(bar)[XB_TMO])) break; if (_sp > XB_SPIN_CAP) { atomicAdd(&(bar)[XB_TMO], 1u); break; } } } } while (0)
__device__ __forceinline__ void xcd_barrier_complete(unsigned* bar, unsigned x, unsigned& nloc, unsigned& nx) {
    const unsigned G = gridDim.x * gridDim.y * gridDim.z;
    unsigned sum, cnt, mine, sp = 0u;
    for (;;) {
        sum = 0u; cnt = 0u; mine = 0u;
#pragma unroll
        for (unsigned j = 0; j < 16; ++j) { const unsigned c = xb_ld(&bar[XB_XCNT(j)]); sum += c; cnt += (c > 0u) ? 1u : 0u; mine = (j == x) ? c : mine; }
        if (sum == G) break;
        __builtin_amdgcn_s_sleep(1);
        if ((++sp & 255u) == 0u) { if (xb_ld(&bar[XB_TMO])) break; if (sp > XB_SPIN_CAP) { atomicAdd(&bar[XB_TMO], 1u); break; } }
    }
    nloc = mine > 0u ? mine : 1u; nx = cnt > 0u ? cnt : 1u;
}
__device__ __forceinline__ void xcd_barrier(unsigned* bar, volatile LAS unsigned* st) {
    asm volatile("s_waitcnt vmcnt(0)" ::: "memory");
    __syncthreads();
    if (threadIdx.x == 0) {
        const unsigned x = xb_xcc_id();
        __builtin_amdgcn_s_waitcnt(0);
        unsigned nloc = st[0], nx = st[1];
        if (nloc == 0u) { xcd_barrier_complete(bar, x, nloc, nx); st[0] = nloc; st[1] = nx; }
        const unsigned old = xb_add(&bar[XB_XSUB(x)], 1u);
        const unsigned gen = old / nloc;
        if (old + 1u == (gen + 1u) * nloc) {
            __builtin_amdgcn_fence(__ATOMIC_RELEASE, "agent");
            asm volatile("s_waitcnt vmcnt(0)" ::: "memory");
            const unsigned og = xb_add(&bar[XB_TOP], 1u);
            const unsigned tg = og / nx;
            if (og + 1u == (tg + 1u) * nx) xb_add(&bar[XB_TOPGEN], 1u);
            else XB_SPIN(xb_ld(&bar[XB_TOPGEN]) == tg, bar);
            __builtin_amdgcn_fence(__ATOMIC_ACQUIRE, "agent");
            xb_add(&bar[XB_XGEN(x)], 1u);
            asm volatile("s_waitcnt vmcnt(0)" ::: "memory");
        } else {
            XB_SPIN(xb_ld(&bar[XB_XGEN(x)]) == gen, bar);
            __builtin_amdgcn_fence(__ATOMIC_ACQUIRE, "agent");
            asm volatile("s_waitcnt vmcnt(0)" ::: "memory");
        }
    }
    __syncthreads();
}

struct Args { const float* in[30]; float* out; unsigned char* ws; };
#define PHASE_ARGS() \
    const __attribute__((address_space(4))) Args* ap_ = (const __attribute__((address_space(4))) Args*)__builtin_amdgcn_kernarg_segment_ptr(); asm volatile("" : "+s"(ap_)); \
    unsigned char* const ws = ap_->ws; float* const out = ap_->out; (void)ws; (void)out; \
    int tid = threadIdx.x; asm volatile("" : "+v"(tid)); const int lane = tid & 63, wave = __builtin_amdgcn_readfirstlane(tid >> 6); (void)lane; (void)wave; \
    const int G = gridDim.x, bx = blockIdx.x, vcu = (G % 8 == 0) ? (bx % 8) * (G / 8) + bx / 8 : bx; (void)vcu; \
    const int gw = vcu * 8 + wave, NGW = G * 8; (void)gw; (void)NGW
#define IN(k) (ap_->in[k])
#define WSF(off) ((float*)(ws + (off)))
#define WSB(off) ((bf16_t*)(ws + (off)))

__global__ void __launch_bounds__(512, 2) fwd_kernel(Args a) {
    extern __shared__ __attribute__((aligned(16))) unsigned char lds_raw[];
    LAS unsigned char* const lds = (LAS unsigned char*)lds_raw;
    volatile LAS unsigned* const bst = (volatile LAS unsigned*)(lds + BARST_OFF);
    if (threadIdx.x < 2) bst[threadIdx.x] = 0u;
    __syncthreads();
    { PHASE_ARGS(); if (threadIdx.x == 0) (void)xb_add(&((unsigned*)ws)[XB_XCNT(xb_xcc_id())], 1u); }
#define GRID_BAR() do { PHASE_ARGS(); xcd_barrier((unsigned*)ws, bst); } while (0)

    {
        PHASE_ARGS();
        LAS float* scr = (LAS float*)(lds + wave * 16384);
        constexpr int I_IN = 16 * 96, I_SQ = 16 * 32, I_FF = 16 * 88, I_DN = 44 * 32;
        constexpr int NITEMS = I_IN + 5 * I_SQ + 2 * I_FF + I_DN;
        for (int it = gw; it < NITEMS; it += NGW) {
            int r = it;
            if (r < I_IN) { const int kb = r / 96, nb = r % 96, nd = nb * 32; int ns = nd;
                if (nd >= 2048) { const int T = (nd - 2048) >> 8, w = (nd - 2048) & 255; ns = (w < 128) ? 2048 + 128 * T + w : 2560 + 128 * T + (w - 128); }
                p0_transpose_item(IN(10), INP, DM, kb, ns, WSB(WS_WIN), nd, IN(9), scr, lane); continue; } r -= I_IN;
            if (r < I_SQ) { p0_transpose_item(IN(17), DM, DM, r / 32, (r % 32) * 32, WSB(WS_WOUT), (r % 32) * 32, nullptr, scr, lane); continue; } r -= I_SQ;
            if (r < I_SQ) { p0_transpose_item(IN(20), DM, DM, r / 32, (r % 32) * 32, WSB(WS_WXQ), (r % 32) * 32, IN(19), scr, lane); continue; } r -= I_SQ;
            if (r < I_SQ) { p0_transpose_item(IN(21), DM, DM, r / 32, (r % 32) * 32, WSB(WS_WXKV), (r % 32) * 32, IN(18), scr, lane); continue; } r -= I_SQ;
            if (r < I_SQ) { p0_transpose_item(IN(22), DM, DM, r / 32, (r % 32) * 32, WSB(WS_WXKV), 1024 + (r % 32) * 32, IN(18), scr, lane); continue; } r -= I_SQ;
            if (r < I_SQ) { p0_transpose_item(IN(23), DM, DM, r / 32, (r % 32) * 32, WSB(WS_WXO), (r % 32) * 32, nullptr, scr, lane); continue; } r -= I_SQ;
            if (r < I_FF) { const int kb = r / 88, nb = r % 88; p0_transpose_item(IN(25), DFF, DM, kb, nb * 32, WSB(WS_WUG), 256 * (nb >> 2) + (nb & 3) * 32, IN(24), scr, lane); continue; } r -= I_FF;
            if (r < I_FF) { const int kb = r / 88, nb = r % 88; p0_transpose_item(IN(26), DFF, DM, kb, nb * 32, WSB(WS_WUG), 256 * (nb >> 2) + 128 + (nb & 3) * 32, IN(24), scr, lane); continue; } r -= I_FF;
            p0_transpose_item(IN(28), DM, DFF, r / 32, (r % 32) * 32, WSB(WS_WDN), (r % 32) * 32, nullptr, scr, lane);
        }
        for (int m = 2 * gw; m < RT + MMEM; m += 2 * NGW) {
            const float* src; bf16_t* dst; float* sq;
            if (m < MP) { src = IN(0) + (size_t)m * DM; dst = WSB(WS_XA) + (size_t)m * DM; sq = WSF(WS_SSQ0) + m; }
            else if (m < RT) { src = IN(1) + (size_t)(m - MP) * DM; dst = WSB(WS_XA) + (size_t)m * DM; sq = WSF(WS_SSQ0) + m; }
            else { src = IN(8) + (size_t)(m - RT) * DM; dst = WSB(WS_MN) + (size_t)(m - RT) * DM; sq = WSF(WS_SSQM) + (m - RT); }
            rows2_to_bf16(src, src + DM, dst, dst + DM, sq, sq + 1, lane);
        }
    }
    GRID_BAR();

    {
        PHASE_ARGS();
        pg8::Gemm g{DM, DM, DM};
        { SchedGrid S; S.init(WSB(WS_XA), (size_t)256 * DM * 2, WSB(WS_WIN), (size_t)256 * DM * 2, NTILE, INP / 256, G, bx);
          epi::EpiInProj E{WSF(WS_SSQ0), WSB(WS_P1), out};
          pg8::gemm_phase(lds, g, S, E); }
        { SchedGrid S; S.init(WSB(WS_MN), (size_t)256 * DM * 2, WSB(WS_WXKV), (size_t)256 * DM * 2, MMEM / 256, 8, G, bx);
          epi::EpiMemKV E{WSF(WS_SSQM), WSB(WS_MK), WSB(WS_MV), out};
          pg8::gemm_phase(lds, g, S, E); }
    }
    GRID_BAR();

    {
        PHASE_ARGS();
        float lam;
        { const float a1 = wave_sum(IN(11)[lane] * IN(12)[lane]), a2 = wave_sum(IN(13)[lane] * IN(14)[lane]); lam = __expf(a1) - __expf(a2) + LAM_INIT; }
        for (long L = bx; L < 2048; L += G) {
            const int s = (int)(L >> 8), cc = (int)(L & 255), cv = (cc & 7) * 32 + (cc >> 3), bh = cv >> 1, par = cv & 1, p = 2 * (s >> 1) + par, qb = (s & 1) ? 15 - p : p;
            dattn::unit(bh >> 2, bh & 3, qb, WSB(WS_P1), WSB(WS_A2), lam, IN(15), (LAS char*)lds);
        }
        for (int L = bx; L < 256; L += G) misc::sample_attn_unit(L >> 3, (L >> 1) & 3, L & 1, WSB(WS_P1), IN(2), IN(3), out + O_KS, out + O_VS, WSB(WS_A2), lam, IN(15), (char*)lds_raw);
        for (int it = (vcu * 512 + tid); it < 64 * (RT / 64); it += G * 512) misc::shortconv_item(it, WSB(WS_P1), IN(16), IN(4), WSB(WS_A2));
        __syncthreads();
        { LAS bf16_t* scr = (LAS bf16_t*)(lds + wave * 16384); for (int it = gw; it < 2048; it += NGW) misc::transpose_item(it, WSB(WS_MV), WSB(WS_MVT), scr, lane); }
    }
    GRID_BAR();

    {
        PHASE_ARGS();
        pg8::Gemm g{DM, DM, DM}; SchedGrid S; S.init(WSB(WS_A2), (size_t)256 * DM * 2, WSB(WS_WOUT), (size_t)256 * DM * 2, NTILE, 4, G, bx);
        epi::EpiResidual E{WSB(WS_XA), WSF(WS_SSP1)};
        pg8::gemm_phase(lds, g, S, E);
    }
    GRID_BAR();
    {
        PHASE_ARGS();
        for (int r = bx * 512 + tid; r < RT; r += G * 512) WSF(WS_RS1)[r] = epi::rstd16(WSF(WS_SSP1), r);
    }
    GRID_BAR();
    {
        PHASE_ARGS();
        pg8::Gemm g{DM, DM, DM}; SchedGrid S; S.init(WSB(WS_XA), (size_t)256 * DM * 2, WSB(WS_WXQ), (size_t)256 * DM * 2, NTILE, 4, G, bx);
        epi::EpiScaleBf16 E{WSF(WS_RS1), WSB(WS_HQ), DM};
        pg8::gemm_phase(lds, g, S, E);
    }
    GRID_BAR();
    {
        PHASE_ARGS();
        pg8::Gemm g{DM, DM, 256}; SchedX S{(const char*)WSB(WS_HQ), (const char*)WSB(WS_MK), G, bx, false};
        epi::EpiXScores E{WSB(WS_P), WSF(WS_L4), (LAS float*)(lds + XTRA_OFF)};
        pg8::gemm_phase(lds, g, S, E);
    }
    GRID_BAR();
    {
        PHASE_ARGS();
        pg8::Gemm g{DM, MMEM, 256}; SchedX S{(const char*)WSB(WS_P), (const char*)WSB(WS_MVT), G, bx, true};
        epi::EpiXPV E{WSF(WS_L4), WSB(WS_HQ)};
        pg8::gemm_phase(lds, g, S, E);
        __syncthreads();
        for (int L = G - 1 - bx; L < NB * NH; L += G) misc::sample_xattn_unit(L >> 2, L & 3, WSB(WS_HQ), IN(6), IN(7), WSB(WS_HQ), (char*)lds_raw);
    }
    GRID_BAR();
    {
        PHASE_ARGS();
        pg8::Gemm g{DM, DM, DM}; SchedGrid S; S.init(WSB(WS_HQ), (size_t)256 * DM * 2, WSB(WS_WXO), (size_t)256 * DM * 2, NTILE, 4, G, bx);
        epi::EpiResidual E{WSB(WS_XA), WSF(WS_SSP2)};
        pg8::gemm_phase(lds, g, S, E);
    }
    GRID_BAR();
    {
        PHASE_ARGS();
        for (int r = bx * 512 + tid; r < RT; r += G * 512) WSF(WS_RS2)[r] = epi::rstd16(WSF(WS_SSP2), r);
    }
    GRID_BAR();
    {
        PHASE_ARGS();
        pg8::Gemm g{DM, DM, DM}; SchedGrid S; S.init(WSB(WS_XA), (size_t)256 * DM * 2, WSB(WS_WUG), (size_t)256 * DM * 2, NTILE, 22, G, bx);
        epi::EpiUpGate E{WSF(WS_RS2), IN(27), IN(5), WSB(WS_H), out, WSF(WS_UH), WSF(WS_U01), WSF(WS_G01), (LAS float*)(lds + XTRA_OFF)};
        pg8::gemm_phase(lds, g, S, E);
    }
    GRID_BAR();
    {
        PHASE_ARGS();
        pg8::Gemm g{DFF, DFF, DFF}; SchedGrid S; S.init(WSB(WS_H), (size_t)256 * DFF * 2, WSB(WS_WDN), (size_t)256 * DFF * 2, NTILE_P, 4, G, bx);
        { const float* UH = WSF(WS_UH); const float* U01 = WSF(WS_U01); const float* G01 = WSF(WS_G01); const float* w_ffc = IN(27); bf16_t* HB = WSB(WS_H); pg8::Unit uu;
          for (int i = 0; S.next(i, uu); ++i) { const int pm = uu.pm; if (pm >= NTILE_P || (pm & 7) == 0) continue;
            for (int it = tid; it < 2 * DFF; it += 512) {
                const int r = it / DFF, c = it - r * DFF;
                const float um2 = UH[((size_t)(pm - 1) * 2 + r) * DFF + c];
                const float um1 = (r == 0) ? UH[((size_t)(pm - 1) * 2 + 1) * DFF + c] : U01[((size_t)pm * 2) * DFF + c];
                const float u0 = U01[((size_t)pm * 2 + r) * DFF + c];
                const float y = w_ffc[c] * um2 + w_ffc[DFF + c] * um1 + w_ffc[2 * DFF + c] * u0;
                const float hv = y * __builtin_amdgcn_rcpf(1.0f + __builtin_amdgcn_exp2f(-1.4426950408889634f * y)) * G01[((size_t)pm * 2 + r) * DFF + c];
                HB[(size_t)(pm * 256 + r) * DFF + c] = (bf16_t)(cvt_pk_bf16(hv, 0.f) & 0xffffu);
            } }
          asm volatile("s_waitcnt vmcnt(0)" ::: "memory"); __syncthreads(); }
        epi::EpiResidual E{WSB(WS_XA), WSF(WS_SSP3)};
        pg8::gemm_phase(lds, g, S, E);
        { pg8::Gemm g2{DFF, DFF, DFF / 2}; SchedSplitK S2{(const char*)WSB(WS_H), (const char*)WSB(WS_WDN), G, bx};
          epi::EpiPartialF32 E2{WSF(WS_SPART)};
          pg8::gemm_phase(lds, g2, S2, E2); }
    }
    GRID_BAR();
    {
        PHASE_ARGS();
        const float* g_fin = IN(29); const bf16_t* XB = WSB(WS_XA);
        f32x4 gg[4];
#pragma unroll
        for (int j = 0; j < 4; ++j) gg[j] = *((const f32x4*)g_fin + lane + 64 * j);
        for (int m = 2 * gw; m < MP; m += 2 * NGW) {
            const float rs0 = epi::rstd16(WSF(WS_SSP3), m), rs1 = epi::rstd16(WSF(WS_SSP3), m + 1);
            const u32x2* x0 = (const u32x2*)(XB + (size_t)m * DM) + lane; const u32x2* x1 = x0 + DM / 4;
            u32x2 a[4], b[4];
#pragma unroll
            for (int j = 0; j < 4; ++j) { a[j] = __builtin_nontemporal_load(x0 + 64 * j); b[j] = __builtin_nontemporal_load(x1 + 64 * j); }
            f32x4* y0 = (f32x4*)(out + O_Y + (size_t)m * DM) + lane; f32x4* y1 = y0 + DM / 4;
#pragma unroll
            for (int j = 0; j < 4; ++j) {
                f32x4 v = {__uint_as_float(a[j].x << 16), __uint_as_float(a[j].x & 0xffff0000u), __uint_as_float(a[j].y << 16), __uint_as_float(a[j].y & 0xffff0000u)};
                f32x4 w = {__uint_as_float(b[j].x << 16), __uint_as_float(b[j].x & 0xffff0000u), __uint_as_float(b[j].y << 16), __uint_as_float(b[j].y & 0xffff0000u)};
                __builtin_nontemporal_store(v * gg[j] * rs0, y0 + 64 * j); __builtin_nontemporal_store(w * gg[j] * rs1, y1 + 64 * j);
            }
        }
        for (int r = gw; r < MS; r += NGW) {
            const u32x2* x0 = (const u32x2*)(XB + (size_t)(MP + r) * DM) + lane; const f32x4* sa = (const f32x4*)(WSF(WS_SPART) + (size_t)r * DM) + lane; const f32x4* sb = sa + (size_t)MS * DM / 4;
            f32x4 v[4]; float ss = 0.f;
#pragma unroll
            for (int j = 0; j < 4; ++j) { const u32x2 a = x0[64 * j];
                v[j] = (f32x4){__uint_as_float(a.x << 16), __uint_as_float(a.x & 0xffff0000u), __uint_as_float(a.y << 16), __uint_as_float(a.y & 0xffff0000u)} + sa[64 * j] + sb[64 * j];
                ss += (v[j][0] * v[j][0] + v[j][1] * v[j][1]) + (v[j][2] * v[j][2] + v[j][3] * v[j][3]); }
            const float rs = rsqrtf(wave_sum(ss) * (1.0f / DM) + EPS);
            f32x4* y0 = (f32x4*)(out + O_Y + (size_t)(MP + r) * DM) + lane;
#pragma unroll
            for (int j = 0; j < 4; ++j) y0[64 * j] = v[j] * gg[j] * rs;
        }
    }
}

extern "C" void kernel_launch(void* const* d_in, const int* in_sizes, int n_in, void* d_out, int out_size, void* d_ws, size_t ws_size, hipStream_t stream) {
    static int grid = 0;
    if (grid == 0) {
        if (n_in != 30 || (size_t)out_size != O_END || ws_size < WS_END) { fprintf(stderr, "kernel_launch: unexpected shapes: n_in %d out %d ws %zu (need %zu, %zu)\n", n_in, out_size, ws_size, (size_t)O_END, (size_t)WS_END); grid = -1; return; }
        int dev = 0, cus = 0, per_cu = 0;
        if (hipGetDevice(&dev) != hipSuccess || hipDeviceGetAttribute(&cus, hipDeviceAttributeMultiprocessorCount, dev) != hipSuccess) { grid = -1; return; }
        if (hipFuncSetAttribute((const void*)fwd_kernel, hipFuncAttributeMaxDynamicSharedMemorySize, LDS_BYTES) != hipSuccess) { fprintf(stderr, "kernel_launch: hipFuncSetAttribute failed\n"); grid = -1; return; }
        if (hipOccupancyMaxActiveBlocksPerMultiprocessor(&per_cu, (const void*)fwd_kernel, 512, LDS_BYTES) != hipSuccess || per_cu < 1) { fprintf(stderr, "kernel_launch: occupancy query says %d\n", per_cu); grid = -1; return; }
        grid = cus;
        fprintf(stderr, "kernel_launch: %d CUs, %d blocks/CU by the occupancy query, grid %d\n", cus, per_cu, grid);
    }
    if (grid < 0) return;
    if (hipMemsetAsync(d_ws, 0, 16384, stream) != hipSuccess) { fprintf(stderr, "kernel_launch: memset failed\n"); return; }
    Args a{};
    for (int i = 0; i < 30; ++i) a.in[i] = (const float*)d_in[i];
    a.out = (float*)d_out; a.ws = (unsigned char*)d_ws;
    void* args[] = {&a};
    const hipError_t e = hipLaunchCooperativeKernel((const void*)fwd_kernel, dim3(grid), dim3(512), args, LDS_BYTES, stream);
    if (e != hipSuccess) fprintf(stderr, "kernel_launch: cooperative launch failed: %s (grid %d)\n", hipGetErrorString(e), grid);
}
```

```cpp
#include <hip/hip_runtime.h>
#include <hip/hip_cooperative_groups.h>
#include <cstdio>
#include <cstdint>
namespace cg = cooperative_groups;

#define LAS __attribute__((address_space(3)))
typedef unsigned short bf16_t;
typedef short bf16x8 __attribute__((ext_vector_type(8)));
typedef short s16x4 __attribute__((ext_vector_type(4)));
typedef float f32x4 __attribute__((ext_vector_type(4)));
typedef float f32x2 __attribute__((ext_vector_type(2)));
typedef float f32x16 __attribute__((ext_vector_type(16)));
typedef unsigned u32x4 __attribute__((ext_vector_type(4)));
typedef unsigned u32x2 __attribute__((ext_vector_type(2)));

constexpr int DM = 1024, NB = 32, SEQ = 2048, DECT = 16, PAST = 1024;
constexpr int MP = NB * SEQ, MS = NB * DECT, RT = MP + MS;
constexpr int NTILE_P = MP / 256, NTILE = RT / 256;
constexpr int NH = 4, QKD = 64, VD = 128, NMEM = 256, XD = 256, DFF = 2816, INP = 3072, CW = 512;
constexpr int MMEM = NB * NMEM;
constexpr float EPS = 1e-6f;
constexpr float LAM_INIT = 0.2f;
constexpr int P1W = 2560;

constexpr size_t O_Y = 0;
constexpr size_t O_KP = (size_t)RT * DM;
constexpr size_t O_VP = O_KP + (size_t)MP * 512;
constexpr size_t O_SCP = O_VP + (size_t)MP * 512;
constexpr size_t O_FFP = O_SCP + (size_t)NB * 2 * CW;
constexpr size_t O_MK = O_FFP + (size_t)NB * 2 * DFF;
constexpr size_t O_MV = O_MK + (size_t)MMEM * DM;
constexpr size_t O_KS = O_MV + (size_t)MMEM * DM;
constexpr size_t O_VS = O_KS + (size_t)MS * 512;
constexpr size_t O_SCS = O_VS + (size_t)MS * 512;
constexpr size_t O_FFS = O_SCS + (size_t)NB * 2 * CW;
constexpr size_t O_END = O_FFS + (size_t)NB * 2 * DFF;

__device__ __forceinline__ unsigned cvt_pk_bf16(float lo, float hi) { unsigned r; asm volatile("v_cvt_pk_bf16_f32 %0, %1, %2" : "=v"(r) : "v"(lo), "v"(hi)); return r; }
__device__ __forceinline__ float bf2f(unsigned short h) { return __uint_as_float((unsigned)h << 16); }
#define DPPF(v, ctrl) __int_as_float(__builtin_amdgcn_update_dpp(0, __float_as_int(v), (ctrl), 0xf, 0xf, true))
__device__ __forceinline__ float xor16_sum(float v) { auto r = __builtin_amdgcn_permlane16_swap(__float_as_uint(v), __float_as_uint(v), false, false); return __uint_as_float(r[0]) + __uint_as_float(r[1]); }
__device__ __forceinline__ float xor32_sum(float v) { auto r = __builtin_amdgcn_permlane32_swap(__float_as_uint(v), __float_as_uint(v), false, false); return __uint_as_float(r[0]) + __uint_as_float(r[1]); }
__device__ __forceinline__ float xor16_max(float v) { auto r = __builtin_amdgcn_permlane16_swap(__float_as_uint(v), __float_as_uint(v), false, false); return fmaxf(__uint_as_float(r[0]), __uint_as_float(r[1])); }
__device__ __forceinline__ float xor32_max(float v) { auto r = __builtin_amdgcn_permlane32_swap(__float_as_uint(v), __float_as_uint(v), false, false); return fmaxf(__uint_as_float(r[0]), __uint_as_float(r[1])); }
__device__ __forceinline__ float other16(float v, int odd) { auto r = __builtin_amdgcn_permlane16_swap(__float_as_uint(v), __float_as_uint(v), false, false); return __uint_as_float(odd ? r[0] : r[1]); }
__device__ __forceinline__ float wave_sum(float v) {
    v += DPPF(v, 0xB1); v += DPPF(v, 0x4E); v += DPPF(v, 0x141); v += DPPF(v, 0x140);
    return xor32_sum(xor16_sum(v));
}
__device__ __forceinline__ float wave_max(float v) {
    v = fmaxf(v, DPPF(v, 0xB1)); v = fmaxf(v, DPPF(v, 0x4E)); v = fmaxf(v, DPPF(v, 0x141)); v = fmaxf(v, DPPF(v, 0x140));
    return xor32_max(xor16_max(v));
}
__device__ __forceinline__ float row_shr1(float v) { return __int_as_float(__builtin_amdgcn_update_dpp(__float_as_int(v), __float_as_int(v), 0x111, 0xf, 0xf, false)); }
__device__ __forceinline__ float row_shr2(float v) { return __int_as_float(__builtin_amdgcn_update_dpp(__float_as_int(v), __float_as_int(v), 0x112, 0xf, 0xf, false)); }

namespace pg8 {
constexpr int BM = 256, BK = 64, HALF = 128, HTB = HALF * BK * 2, STAGE_BYTES = 8 * HTB;
__host__ __device__ __forceinline__ int lds_byte(int r, int c) { const int st = (r >> 4) * 2 + (c >> 5), rr = r & 15, cc = c & 31, ob = rr * 64 + cc * 2; return st * 1024 + (ob ^ (((ob >> 9) & 1) << 5)); }
__host__ __device__ __forceinline__ void stage_rc(int b, int& R, int& C) { const int st = b / 1024, sb = b % 1024, swz = sb ^ (((sb >> 9) & 1) << 5); R = (st >> 1) * 16 + swz / 64; C = (st & 1) * 32 + (swz % 64) / 2; }
__host__ __device__ __forceinline__ int perm32(int rho) { const int n = rho >> 4, i = rho & 15; return 8 * (i >> 2) + 4 * n + (i & 3); }

struct Unit { const char* A; const char* B; int pm, pn; };
struct Gemm { int lda, ldb, K; };

template <class Epi, class Sched>
__device__ __forceinline__ void gemm_phase(LAS unsigned char* lds, const Gemm g, const Sched& S, const Epi& E) {
    int tid = threadIdx.x; asm volatile("" : "+v"(tid));
    const int wid = __builtin_amdgcn_readfirstlane(tid >> 6), lane = tid & 63, wr = wid >> 2, wc = wid & 3, fr = lane & 15, fq = lane >> 4;
    const int K = g.K, nt = K / BK;
    unsigned voffA[2], voffB[2];
#pragma unroll
    for (int i = 0; i < 2; ++i) { int R, C; stage_rc(tid * 16 + i * 8192, R, C); const int Rb = Epi::PERM ? ((R & ~31) + perm32(R & 31)) : R;
        voffA[i] = (unsigned)(R * g.lda + C) * 2u; voffB[i] = (unsigned)(Rb * g.ldb + C) * 2u; }
    const size_t kstep = (size_t)(BK * 2);
    const size_t hstepA = (size_t)HALF * g.lda * 2, hstepB = (size_t)HALF * g.ldb * 2;
    const unsigned ldsw = (unsigned)wid * 1024u;
    const int aoff = lds_byte(wr * 64 + fr, fq * 8), boff = lds_byte(wc * 32 + fr, fq * 8);
#define PG8_SA(b, h) (((b) * 2 + (h)) * HTB)
#define PG8_SB(b, h) ((4 + (b) * 2 + (h)) * HTB)
#define PG8_STAGE(bufoff, gbase, voff) do { _Pragma("unroll") for (int _i = 0; _i < 2; ++_i) \
        __builtin_amdgcn_global_load_lds((const unsigned*)((const char*)(gbase) + (voff)[_i]), (LAS unsigned*)(lds + (bufoff) + ldsw + _i * 8192), 16, 0, 0); } while (0)
#define PG8_LDA(dst, b, h) do { _Pragma("unroll") for (int m = 0; m < 4; ++m) _Pragma("unroll") for (int k = 0; k < 2; ++k) dst[m][k] = *(const LAS bf16x8*)(lds + PG8_SA(b, h) + aoff + m * 2048 + k * 1024); } while (0)
#define PG8_LDB(dst, b, h) do { _Pragma("unroll") for (int n = 0; n < 2; ++n) _Pragma("unroll") for (int k = 0; k < 2; ++k) dst[n][k] = *(const LAS bf16x8*)(lds + PG8_SB(b, h) + boff + n * 2048 + k * 1024); } while (0)
#define PG8_MMA(ai, bj, At, Bt) do { __builtin_amdgcn_s_setprio(1); _Pragma("unroll") for (int m = 0; m < 4; ++m) _Pragma("unroll") for (int n = 0; n < 2; ++n) _Pragma("unroll") for (int k = 0; k < 2; ++k) \
        acc[ai][bj][m][n] = __builtin_amdgcn_mfma_f32_16x16x32_bf16(Bt[n][k], At[m][k], acc[ai][bj][m][n], 0, 0, 0); __builtin_amdgcn_s_setprio(0); } while (0)
#define PG8_WAIT_V(n) asm volatile("s_waitcnt vmcnt(" #n ")" ::: "memory")
#define PG8_WAIT_L(n) asm volatile("s_waitcnt lgkmcnt(" #n ")" ::: "memory")
#define PG8_BAR __builtin_amdgcn_s_barrier()
#define PG8_SCHED __builtin_amdgcn_sched_barrier(0)
    Unit cur, nxt; int ui = 0;
    if (!S.next(0, cur)) return;
    f32x4 acc[2][2][4][2];
#pragma unroll
    for (int a = 0; a < 2; ++a)
#pragma unroll
        for (int b = 0; b < 2; ++b)
#pragma unroll
            for (int m = 0; m < 4; ++m)
#pragma unroll
                for (int n = 0; n < 2; ++n) acc[a][b][m][n] = (f32x4){0.f, 0.f, 0.f, 0.f};
    bf16x8 At[4][2], B0[2][2], B1[2][2];
    typename Epi::Pre pre{};
    const char* cA = cur.A; const char* cB = cur.B;
    PG8_STAGE(PG8_SB(0, 0), cB, voffB); PG8_STAGE(PG8_SB(0, 1), cB + hstepB, voffB); PG8_STAGE(PG8_SA(0, 0), cA, voffA); PG8_STAGE(PG8_SA(0, 1), cA + hstepA, voffA);
    if (wr == 1) PG8_BAR;
    PG8_WAIT_V(2); PG8_BAR;
    PG8_STAGE(PG8_SB(1, 0), cB + kstep, voffB); PG8_STAGE(PG8_SA(1, 0), cA + kstep, voffA); PG8_STAGE(PG8_SB(1, 1), cB + hstepB + kstep, voffB);
    PG8_WAIT_V(6); PG8_BAR;
    for (;;) {
        const bool has_next = S.next(ui + 1, nxt);
        const char* nA = has_next ? nxt.A : cA; const char* nB = has_next ? nxt.B : cB;
        for (int t = 0; t < nt; t += 2) {
            const bool last = (t == nt - 2);
            if (Epi::EARLY && last) pre = E.prefetch(cur, wr, wc, fr, fq);
            const char* a1 = cA + (size_t)(t + 1) * kstep;
            const char* a2 = last ? nA : cA + (size_t)(t + 2) * kstep; const char* b2 = last ? nB : cB + (size_t)(t + 2) * kstep;
            const char* a3 = a2 + kstep; const char* b3 = b2 + kstep;
            PG8_LDB(B0, 0, 0); PG8_LDB(B1, 0, 1); PG8_SCHED; PG8_LDA(At, 0, 0); PG8_STAGE(PG8_SA(1, 1), a1 + hstepA, voffA);
            PG8_WAIT_V(8); PG8_WAIT_L(0); PG8_BAR; PG8_MMA(0, 0, At, B0); PG8_MMA(0, 1, At, B1); PG8_BAR; PG8_SCHED;
            PG8_LDA(At, 0, 1); PG8_STAGE(PG8_SB(0, 0), b2, voffB); PG8_STAGE(PG8_SB(0, 1), b2 + hstepB, voffB); PG8_STAGE(PG8_SA(0, 0), a2, voffA);
            PG8_WAIT_V(8); PG8_WAIT_L(0); PG8_BAR; PG8_MMA(1, 0, At, B0); PG8_MMA(1, 1, At, B1); PG8_BAR; PG8_SCHED;
            PG8_LDB(B0, 1, 0); PG8_LDB(B1, 1, 1); PG8_SCHED; PG8_LDA(At, 1, 0); PG8_STAGE(PG8_SA(0, 1), a2 + hstepA, voffA);
            PG8_WAIT_V(8); PG8_WAIT_L(0); PG8_BAR; PG8_MMA(0, 0, At, B0); PG8_MMA(0, 1, At, B1); PG8_BAR; PG8_SCHED;
            PG8_LDA(At, 1, 1); PG8_STAGE(PG8_SB(1, 0), b3, voffB); PG8_STAGE(PG8_SB(1, 1), b3 + hstepB, voffB); PG8_STAGE(PG8_SA(1, 0), a3, voffA);
            PG8_WAIT_V(8); PG8_WAIT_L(0); PG8_BAR; PG8_MMA(1, 0, At, B0); PG8_MMA(1, 1, At, B1); PG8_BAR; PG8_SCHED;
        }
        if (wr == 0) PG8_BAR;
        if (!Epi::EARLY) pre = E.prefetch(cur, wr, wc, fr, fq);
        E(acc, cur, pre, wr, wc, fr, fq);
        if (!has_next) break;
#pragma unroll
        for (int a = 0; a < 2; ++a)
#pragma unroll
            for (int b = 0; b < 2; ++b)
#pragma unroll
                for (int m = 0; m < 4; ++m)
#pragma unroll
                    for (int n = 0; n < 2; ++n) acc[a][b][m][n] = (f32x4){0.f, 0.f, 0.f, 0.f};
        cur = nxt; cA = nA; cB = nB; ++ui;
        if (wr == 1) PG8_BAR;
    }
    PG8_WAIT_V(0);
    PG8_BAR;
#undef PG8_SA
#undef PG8_SB
#undef PG8_STAGE
#undef PG8_LDA
#undef PG8_LDB
#undef PG8_MMA
}
}
namespace epi {
using pg8::Unit;
typedef f32x4 Acc[2][2][4][2];
#define EPI_BAR() do { asm volatile("s_waitcnt lgkmcnt(0)" ::: "memory"); __builtin_amdgcn_s_barrier(); asm volatile("" ::: "memory"); } while (0)

__device__ __forceinline__ u32x4 pack8(const f32x4 a, const f32x4 b) { u32x4 w; w.x = cvt_pk_bf16(a[0], a[1]); w.y = cvt_pk_bf16(a[2], a[3]); w.z = cvt_pk_bf16(b[0], b[1]); w.w = cvt_pk_bf16(b[2], b[3]); return w; }
__device__ __forceinline__ u32x2 pack4(const f32x4 a) { u32x2 w; w.x = cvt_pk_bf16(a[0], a[1]); w.y = cvt_pk_bf16(a[2], a[3]); return w; }
__device__ __forceinline__ int row_pos(int row) { return row < MP ? (row & (SEQ - 1)) : PAST + ((row - MP) & (DECT - 1)); }
__device__ __forceinline__ f32x4 oth4(const f32x4 v, int odd) { f32x4 r; r[0] = other16(v[0], odd); r[1] = other16(v[1], odd); r[2] = other16(v[2], odd); r[3] = other16(v[3], odd); return r; }
__device__ __forceinline__ void store8_f32(float* p  , const f32x4 v0, const f32x4 v1, int fq) {
    f32x4 x, y;
#pragma unroll
    for (int j = 0; j < 4; ++j) { auto r = __builtin_amdgcn_permlane16_swap(__float_as_uint(v0[j]), __float_as_uint(v1[j]), false, false); x[j] = __uint_as_float(r[0]); y[j] = __uint_as_float(r[1]); }
    float* q = p + 16 * (fq >> 1) + 4 * (fq & 1);
    __builtin_nontemporal_store(x, (f32x4*)q); __builtin_nontemporal_store(y, (f32x4*)(q + 8));
}
struct PreNone {};
struct Pre8 { float v[8]; };
__device__ __forceinline__ Pre8 load8rows(const float* __restrict__ p, int row0) {
    Pre8 r;
#pragma unroll
    for (int i = 0; i < 8; ++i) r.v[i] = p[row0 + (i >> 2) * 128 + (i & 3) * 16];
    return r;
}
__device__ __forceinline__ void rope_cs(int pos, int n, f32x4& c, f32x4& s) {
    const float fp = (float)pos;
    const f32x4 k = n == 0 ? (f32x4){1.5915494309e-01f, 3.0863763405e-02f, 5.9851857127e-03f, 1.1606636412e-03f} : (f32x4){2.2507907904e-04f, 4.3647952793e-05f, 8.4643308082e-06f, 1.6414262628e-06f};
#pragma unroll
    for (int j = 0; j < 4; ++j) { const float r = __builtin_amdgcn_fractf(fp * k[j]); c[j] = __builtin_amdgcn_cosf(r); s[j] = __builtin_amdgcn_sinf(r); }
}

struct EpiInProj {
    static constexpr bool PERM = true, EARLY = true;
    typedef Pre8 Pre;
    const float* ssq;
    bf16_t* p1;
    float* out;
    __device__ __forceinline__ Pre prefetch(const Unit& u, int wr, int wc, int fr, int fq) const { return load8rows(ssq, u.pm * 256 + wr * 64 + fr); }
    __device__ __forceinline__ void operator()(Acc& acc, const Unit& u, const Pre& pre, int wr, int wc, int fr, int fq) const {
        const int pn = u.pn, row0 = u.pm * 256 + wr * 64 + fr;
        const int cl = 32 * wc + 8 * fq;
#pragma unroll
        for (int ai = 0; ai < 2; ++ai)
#pragma unroll
            for (int m = 0; m < 4; ++m) {
                const int row = row0 + ai * 128 + m * 16;
                const float rs = rsqrtf(pre.v[ai * 4 + m] * (1.0f / DM) + EPS);
                bf16_t* prow = p1 + (size_t)row * P1W;
                if (pn < 4) {
                    f32x4 c0, c1, s0, s1; const int pos = row_pos(row);
                    if ((wc & 1) == 0) { rope_cs(pos, 0, c0, s0); rope_cs(pos, 1, c1, s1); }
                    float* orow = (pn >= 2) ? (row < MP ? out + O_KP + (size_t)row * 512 : out + O_KS + (size_t)(row - MP) * 512) : nullptr;
#pragma unroll
                    for (int bj = 0; bj < 2; ++bj) {
                        f32x4 v0 = acc[ai][bj][m][0] * rs, v1 = acc[ai][bj][m][1] * rs;
                        if ((wc & 1) == 0) {
                            const f32x4 o0 = oth4(v0, fq & 1), o1 = oth4(v1, fq & 1);
                            if (fq == 0) { v0 = v0 * c0 - o0 * s0; v1 = v1 * c1 - o1 * s1; }
                            else if (fq == 1) { v0 = v0 * c0 + o0 * s0; v1 = v1 * c1 + o1 * s1; }
                        }
                        const int c = (pn & 1) * 256 + bj * 128 + cl;
                        if (pn >= 2) store8_f32(orow + c - 8 * fq, v0, v1, fq);
                        *(u32x4*)(prow + (pn >> 1) * 512 + c) = pack8(v0, v1);
                    }
                } else if (pn < 6) {
                    float* orow = row < MP ? out + O_VP + (size_t)row * 512 : out + O_VS + (size_t)(row - MP) * 512;
#pragma unroll
                    for (int bj = 0; bj < 2; ++bj) {
                        const f32x4 v0 = acc[ai][bj][m][0] * rs, v1 = acc[ai][bj][m][1] * rs;
                        const int c = (pn & 1) * 256 + bj * 128 + cl;
                        store8_f32(orow + c - 8 * fq, v0, v1, fq);
                        *(u32x4*)(prow + 1024 + c) = pack8(v0, v1);
                    }
                } else if (pn < 8) {
#pragma unroll
                    for (int bj = 0; bj < 2; ++bj) {
                        const f32x4 v0 = acc[ai][bj][m][0] * rs, v1 = acc[ai][bj][m][1] * rs;
                        const int c = (pn & 1) * 256 + bj * 128 + cl;
                        *(u32x4*)(prow + 1536 + c) = pack8(v0, v1);
                    }
                } else {
                    const float rs2 = rs * rs;
                    const f32x4 v0 = acc[ai][0][m][0] * acc[ai][1][m][0] * rs2, v1 = acc[ai][0][m][1] * acc[ai][1][m][1] * rs2;
                    const int c = (pn - 8) * 128 + cl;
                    *(u32x4*)(prow + 2048 + c) = pack8(v0, v1);
                    if (row < MP) { const int t = row & (SEQ - 1); if (t >= SEQ - 2) { float* o = out + O_SCP + ((size_t)(row >> 11) * 2 + (t - (SEQ - 2))) * CW + c; *(f32x4*)o = v0; *(f32x4*)(o + 4) = v1; } }
                    else { const int t = (row - MP) & (DECT - 1); if (t >= DECT - 2) { float* o = out + O_SCS + ((size_t)((row - MP) >> 4) * 2 + (t - (DECT - 2))) * CW + c; *(f32x4*)o = v0; *(f32x4*)(o + 4) = v1; } }
                }
            }
    }
};

struct EpiMemKV {
    static constexpr bool PERM = true, EARLY = true;
    typedef Pre8 Pre;
    const float* ssq; bf16_t* mk; bf16_t* mv; float* out;
    __device__ __forceinline__ Pre prefetch(const Unit& u, int wr, int wc, int fr, int fq) const { return load8rows(ssq, u.pm * 256 + wr * 64 + fr); }
    __device__ __forceinline__ void operator()(Acc& acc, const Unit& u, const Pre& pre, int wr, int wc, int fr, int fq) const {
        const int pn = u.pn, row0 = u.pm * 256 + wr * 64 + fr, cl = 32 * wc + 8 * fq;
        float* ob = out + (pn < 4 ? O_MK : O_MV); bf16_t* bb = pn < 4 ? mk : mv;
#pragma unroll
        for (int ai = 0; ai < 2; ++ai)
#pragma unroll
            for (int m = 0; m < 4; ++m) {
                const int row = row0 + ai * 128 + m * 16;
                const float rs = rsqrtf(pre.v[ai * 4 + m] * (1.0f / DM) + EPS);
#pragma unroll
                for (int bj = 0; bj < 2; ++bj) {
                    const f32x4 v0 = acc[ai][bj][m][0] * rs, v1 = acc[ai][bj][m][1] * rs;
                    const int c = (pn & 3) * 256 + bj * 128 + cl;
                    store8_f32(ob + (size_t)row * DM + c - 8 * fq, v0, v1, fq);
                    *(u32x4*)(bb + (size_t)row * DM + c) = pack8(v0, v1);
                }
            }
    }
};

struct EpiResidual {
    static constexpr bool PERM = true, EARLY = false;
    typedef PreNone Pre;
    bf16_t* XB; float* ssp;
    __device__ __forceinline__ Pre prefetch(const Unit&, int, int, int, int) const { return Pre{}; }
    __device__ __forceinline__ void operator()(Acc& acc, const Unit& u, const Pre&, int wr, int wc, int fr, int fq) const {
        const int row0 = u.pm * 256 + wr * 64 + fr, col0 = u.pn * 256 + wc * 32 + 8 * fq;
        bf16_t* xb = XB + (size_t)row0 * DM + col0;
        u32x4 old[8][2];
#pragma unroll
        for (int g = 0; g < 8; ++g)
#pragma unroll
            for (int bj = 0; bj < 2; ++bj) old[g][bj] = *(const u32x4*)(xb + (size_t)((g >> 2) * 128 + (g & 3) * 16) * DM + bj * 128);
#pragma unroll
        for (int g = 0; g < 8; ++g) {
            const int ai = g >> 2, m = g & 3, row = row0 + ai * 128 + m * 16; float ss = 0.f;
#pragma unroll
            for (int bj = 0; bj < 2; ++bj) {
                const u32x4 o = old[g][bj]; f32x4 v0, v1;
                v0[0] = __uint_as_float(o.x << 16) + acc[ai][bj][m][0][0]; v0[1] = __uint_as_float(o.x & 0xffff0000u) + acc[ai][bj][m][0][1]; v0[2] = __uint_as_float(o.y << 16) + acc[ai][bj][m][0][2]; v0[3] = __uint_as_float(o.y & 0xffff0000u) + acc[ai][bj][m][0][3];
                v1[0] = __uint_as_float(o.z << 16) + acc[ai][bj][m][1][0]; v1[1] = __uint_as_float(o.z & 0xffff0000u) + acc[ai][bj][m][1][1]; v1[2] = __uint_as_float(o.w << 16) + acc[ai][bj][m][1][2]; v1[3] = __uint_as_float(o.w & 0xffff0000u) + acc[ai][bj][m][1][3];
                ss += ((v0[0] * v0[0] + v0[1] * v0[1]) + (v0[2] * v0[2] + v0[3] * v0[3])) + ((v1[0] * v1[0] + v1[1] * v1[1]) + (v1[2] * v1[2] + v1[3] * v1[3]));
                *(u32x4*)(xb + (size_t)(ai * 128 + m * 16) * DM + bj * 128) = pack8(v0, v1);
            }
            ss = xor32_sum(xor16_sum(ss));
            if (fq == 0) ssp[(size_t)row * 16 + u.pn * 4 + wc] = ss;
        }
    }
};
struct EpiResidualOut {
    static constexpr bool PERM = false, EARLY = false;
    typedef PreNone Pre;
    const bf16_t* XB; float* X; float* ssp;
    __device__ __forceinline__ Pre prefetch(const Unit&, int, int, int, int) const { return Pre{}; }
    __device__ __forceinline__ void operator()(Acc& acc, const Unit& u, const Pre&, int wr, int wc, int fr, int fq) const {
        const int row0 = u.pm * 256 + wr * 64 + fr, col0 = u.pn * 256 + wc * 32 + 4 * fq;
        const bf16_t* xb = XB + (size_t)row0 * DM + col0;
        u32x2 old[8][2][2];
#pragma unroll
        for (int g = 0; g < 8; ++g)
#pragma unroll
            for (int bj = 0; bj < 2; ++bj)
#pragma unroll
                for (int n = 0; n < 2; ++n) old[g][bj][n] = *(const u32x2*)(xb + (size_t)((g >> 2) * 128 + (g & 3) * 16) * DM + bj * 128 + n * 16);
#pragma unroll
        for (int g = 0; g < 8; ++g) {
            const int ai = g >> 2, m = g & 3, row = row0 + ai * 128 + m * 16; float* xrow = X + (size_t)row * DM + col0; float ss = 0.f;
#pragma unroll
            for (int bj = 0; bj < 2; ++bj)
#pragma unroll
                for (int n = 0; n < 2; ++n) {
                    const u32x2 o = old[g][bj][n]; f32x4 v;
                    v[0] = __uint_as_float(o.x << 16) + acc[ai][bj][m][n][0]; v[1] = __uint_as_float(o.x & 0xffff0000u) + acc[ai][bj][m][n][1]; v[2] = __uint_as_float(o.y << 16) + acc[ai][bj][m][n][2]; v[3] = __uint_as_float(o.y & 0xffff0000u) + acc[ai][bj][m][n][3];
                    ss += (v[0] * v[0] + v[1] * v[1]) + (v[2] * v[2] + v[3] * v[3]);
                    *(f32x4*)(xrow + bj * 128 + n * 16) = v;
                }
            ss = xor32_sum(xor16_sum(ss));
            if (fq == 0) ssp[(size_t)row * 16 + u.pn * 4 + wc] = ss;
        }
    }
};
__device__ __forceinline__ float rstd16(const float* ssp, int row) {
    const f32x4* p = (const f32x4*)(ssp + (size_t)row * 16); const f32x4 a = p[0], b = p[1], c = p[2], d = p[3];
    const float s = ((a[0] + a[1]) + (a[2] + a[3])) + ((b[0] + b[1]) + (b[2] + b[3])) + ((c[0] + c[1]) + (c[2] + c[3])) + ((d[0] + d[1]) + (d[2] + d[3]));
    return rsqrtf(s * (1.0f / DM) + EPS);
}
struct EpiScaleBf16 {
    static constexpr bool PERM = true, EARLY = true;
    typedef Pre8 Pre;
    const float* rs; bf16_t* O; int ldo;
    __device__ __forceinline__ Pre prefetch(const Unit& u, int wr, int wc, int fr, int fq) const { return load8rows(rs, u.pm * 256 + wr * 64 + fr); }
    __device__ __forceinline__ void operator()(Acc& acc, const Unit& u, const Pre& pre, int wr, int wc, int fr, int fq) const {
        const int row0 = u.pm * 256 + wr * 64 + fr, col0 = u.pn * 256 + 32 * wc + 8 * fq;
#pragma unroll
        for (int ai = 0; ai < 2; ++ai)
#pragma unroll
            for (int m = 0; m < 4; ++m) {
                const int row = row0 + ai * 128 + m * 16; const float r = pre.v[ai * 4 + m];
#pragma unroll
                for (int bj = 0; bj < 2; ++bj) *(u32x4*)(O + (size_t)row * ldo + col0 + bj * 128) = pack8(acc[ai][bj][m][0] * r, acc[ai][bj][m][1] * r);
            }
    }
};
struct EpiXScores {
    static constexpr bool PERM = true, EARLY = false;
    typedef PreNone Pre;
    __device__ __forceinline__ Pre prefetch(const Unit&, int, int, int, int) const { return Pre{}; }
    bf16_t* P; float* lp; LAS float* red;
    __device__ __forceinline__ void operator()(Acc& acc, const Unit& u, const Pre&, int wr, int wc, int fr, int fq) const {
        constexpr float C = 0.0625f * 1.4426950408889634f;
        float mx[2][4];
#pragma unroll
        for (int ai = 0; ai < 2; ++ai)
#pragma unroll
            for (int m = 0; m < 4; ++m) {
                float a = -3.0e38f;
#pragma unroll
                for (int bj = 0; bj < 2; ++bj)
#pragma unroll
                    for (int n = 0; n < 2; ++n) { const f32x4 v = acc[ai][bj][m][n]; a = fmaxf(a, fmaxf(fmaxf(v[0], v[1]), fmaxf(v[2], v[3]))); }
                a = xor32_max(xor16_max(a));
                if (fq == 0) red[(ai * 128 + wr * 64 + m * 16 + fr) * 4 + wc] = a;
            }
        EPI_BAR();
#pragma unroll
        for (int ai = 0; ai < 2; ++ai)
#pragma unroll
            for (int m = 0; m < 4; ++m) { const f32x4 r = *(const LAS f32x4*)(red + (ai * 128 + wr * 64 + m * 16 + fr) * 4); mx[ai][m] = fmaxf(fmaxf(r[0], r[1]), fmaxf(r[2], r[3])); }
        const int row0 = u.pm * 256 + wr * 64 + fr, col0 = u.pn * 256 + 32 * wc + 8 * fq;
#pragma unroll
        for (int ai = 0; ai < 2; ++ai)
#pragma unroll
            for (int m = 0; m < 4; ++m) {
                const int row = row0 + ai * 128 + m * 16; const float mc = mx[ai][m] * C; float s = 0.f;
#pragma unroll
                for (int bj = 0; bj < 2; ++bj) {
#pragma unroll
                    for (int j = 0; j < 4; ++j) { acc[ai][bj][m][0][j] = __builtin_amdgcn_exp2f(acc[ai][bj][m][0][j] * C - mc); acc[ai][bj][m][1][j] = __builtin_amdgcn_exp2f(acc[ai][bj][m][1][j] * C - mc); }
                    const u32x4 w = pack8(acc[ai][bj][m][0], acc[ai][bj][m][1]);
                    s += (__uint_as_float(w.x << 16) + __uint_as_float(w.x & 0xffff0000u)) + (__uint_as_float(w.y << 16) + __uint_as_float(w.y & 0xffff0000u))
                       + (__uint_as_float(w.z << 16) + __uint_as_float(w.z & 0xffff0000u)) + (__uint_as_float(w.w << 16) + __uint_as_float(w.w & 0xffff0000u));
                    *(u32x4*)(P + (size_t)row * DM + col0 + bj * 128) = w;
                }
                s = xor32_sum(xor16_sum(s));
                if (fq == 0) lp[(size_t)row * 16 + u.pn * 4 + wc] = s;
                asm volatile("" ::: "memory");
            }
        EPI_BAR();
    }
};
struct EpiXPV {
    static constexpr bool PERM = true, EARLY = false;
    typedef PreNone Pre;
    __device__ __forceinline__ Pre prefetch(const Unit&, int, int, int, int) const { return Pre{}; }
    const float* lp; bf16_t* O;
    __device__ __forceinline__ void operator()(Acc& acc, const Unit& u, const Pre&, int wr, int wc, int fr, int fq) const {
        const int row0 = u.pm * 256 + wr * 64 + fr, col0 = u.pn * 256 + 32 * wc + 8 * fq;
#pragma unroll
        for (int ai = 0; ai < 2; ++ai)
#pragma unroll
            for (int m = 0; m < 4; ++m) {
                const int row = row0 + ai * 128 + m * 16; const f32x4 l4 = *(const f32x4*)(lp + (size_t)row * 16 + u.pn * 4);
                const float rl = 1.0f / ((l4[0] + l4[1]) + (l4[2] + l4[3]));
#pragma unroll
                for (int bj = 0; bj < 2; ++bj) *(u32x4*)(O + (size_t)row * DM + col0 + bj * 128) = pack8(acc[ai][bj][m][0] * rl, acc[ai][bj][m][1] * rl);
            }
    }
};
struct EpiUpGate {
    static constexpr bool PERM = true, EARLY = true;
    struct Pre { float v; };
    const float* rs; const float* wconv;
    const float* state;
    bf16_t* H; float* out;
    float* uh; float* u01; float* g01;
    LAS float* tail;
    __device__ __forceinline__ Pre prefetch(const Unit& u, int wr, int wc, int fr, int fq) const { const int t = ((wr * 4 + wc) << 6) + (fq << 4) + fr; Pre p; p.v = rs[u.pm * 256 + (t & 255)]; return p; }
    __device__ __forceinline__ void operator()(Acc& acc, const Unit& u, const Pre& pre, int wr, int wc, int fr, int fq) const {
        asm volatile("" : "+v"(fr), "+v"(fq));
        const int pm = u.pm, pn = u.pn, row0 = pm * 256 + wr * 64 + fr, cl = 32 * wc + 8 * fq, gc = pn * 128 + cl;
        const bool sample = pm >= NTILE_P;
        LAS float* rsl = tail + 4096;
        { const int t = ((wr * 4 + wc) << 6) + (fq << 4) + fr; if (t < 256) rsl[t] = pre.v; }
        EPI_BAR();
        const f32x4 w00 = *(const f32x4*)(wconv + gc), w01 = *(const f32x4*)(wconv + gc + 4), w10 = *(const f32x4*)(wconv + DFF + gc), w11 = *(const f32x4*)(wconv + DFF + gc + 4),
                    w20 = *(const f32x4*)(wconv + 2 * DFF + gc), w21 = *(const f32x4*)(wconv + 2 * DFF + gc + 4);
#pragma unroll
        for (int ai = 0; ai < 2; ++ai)
#pragma unroll
            for (int m = 0; m < 4; ++m) {
                const int g = ai * 8 + wr * 4 + m; const float r = rsl[ai * 128 + wr * 64 + m * 16 + fr];
#pragma unroll
                for (int bj = 0; bj < 2; ++bj)
#pragma unroll
                    for (int n = 0; n < 2; ++n) acc[ai][bj][m][n] *= r;
                if (fr >= 14) {
                    LAS float* t = tail + (g * 2 + (fr - 14)) * 128 + cl; *(LAS f32x4*)t = acc[ai][0][m][0]; *(LAS f32x4*)(t + 4) = acc[ai][0][m][1];
                    if (sample) { float* o = out + O_FFS + ((size_t)((pm - NTILE_P) * 16 + g) * 2 + (fr - 14)) * DFF + gc; *(f32x4*)o = acc[ai][0][m][0]; *(f32x4*)(o + 4) = acc[ai][0][m][1]; }
                    else if (g == 15) {
                        float* o = uh + ((size_t)pm * 2 + (fr - 14)) * DFF + gc; *(f32x4*)o = acc[ai][0][m][0]; *(f32x4*)(o + 4) = acc[ai][0][m][1];
                        if ((pm & 7) == 7) { float* q = out + O_FFP + ((size_t)(pm >> 3) * 2 + (fr - 14)) * DFF + gc; *(f32x4*)q = acc[ai][0][m][0]; *(f32x4*)(q + 4) = acc[ai][0][m][1]; }
                    }
                }
                if (!sample && g == 0 && fr < 2) {
                    float* o = u01 + ((size_t)pm * 2 + fr) * DFF + gc; *(f32x4*)o = acc[ai][0][m][0]; *(f32x4*)(o + 4) = acc[ai][0][m][1];
                    float* q = g01 + ((size_t)pm * 2 + fr) * DFF + gc; *(f32x4*)q = acc[ai][1][m][0]; *(f32x4*)(q + 4) = acc[ai][1][m][1];
                }
            }
        EPI_BAR();
#pragma unroll
        for (int ai = 0; ai < 2; ++ai)
#pragma unroll
            for (int m = 0; m < 4; ++m) {
                const int row = row0 + ai * 128 + m * 16, g = ai * 8 + wr * 4 + m;
                f32x4 h1[2] = {(f32x4){0.f, 0.f, 0.f, 0.f}, (f32x4){0.f, 0.f, 0.f, 0.f}}, h2[2] = {(f32x4){0.f, 0.f, 0.f, 0.f}, (f32x4){0.f, 0.f, 0.f, 0.f}};
                if (fr < 2) {
                    if (sample) { const float* s = state + (size_t)((pm - NTILE_P) * 16 + g) * 2 * DFF + gc; h2[0] = *(const f32x4*)(s + fr * DFF); h2[1] = *(const f32x4*)(s + fr * DFF + 4); h1[0] = *(const f32x4*)(s + DFF); h1[1] = *(const f32x4*)(s + DFF + 4); }
                    else if (g > 0) { const LAS float* t = tail + ((g - 1) * 2) * 128 + cl; h2[0] = *(const LAS f32x4*)(t + fr * 128); h2[1] = *(const LAS f32x4*)(t + fr * 128 + 4); h1[0] = *(const LAS f32x4*)(t + 128); h1[1] = *(const LAS f32x4*)(t + 132); }
                }
                f32x4 hv[2];
#pragma unroll
                for (int n = 0; n < 2; ++n) {
                    const f32x4 uc = acc[ai][0][m][n]; f32x4 p1, p2;
#pragma unroll
                    for (int j = 0; j < 4; ++j) {
                        p1[j] = __int_as_float(__builtin_amdgcn_update_dpp(__float_as_int(h1[n][j]), __float_as_int(uc[j]), 0x111, 0xf, 0xf, false));
                        p2[j] = __int_as_float(__builtin_amdgcn_update_dpp(__float_as_int(h2[n][j]), __float_as_int(uc[j]), 0x112, 0xf, 0xf, false)); }
                    const f32x4 y = (n == 0 ? w00 : w01) * p2 + (n == 0 ? w10 : w11) * p1 + (n == 0 ? w20 : w21) * uc;
                    const f32x4 t = y * (-1.4426950408889634f); f32x4 d;
#pragma unroll
                    for (int j = 0; j < 4; ++j) d[j] = __builtin_amdgcn_exp2f(t[j]);
                    d = d + 1.0f;
#pragma unroll
                    for (int j = 0; j < 4; ++j) d[j] = __builtin_amdgcn_rcpf(d[j]);
                    hv[n] = (y * d) * acc[ai][1][m][n];
                }
                *(u32x4*)(H + (size_t)row * DFF + gc) = pack8(hv[0], hv[1]);
            }
        EPI_BAR();
    }
};
struct EpiPartialF32 {
    static constexpr bool PERM = false, EARLY = false;
    typedef PreNone Pre;
    float* S;
    __device__ __forceinline__ Pre prefetch(const Unit&, int, int, int, int) const { return Pre{}; }
    __device__ __forceinline__ void operator()(Acc& acc, const Unit& u, const Pre&, int wr, int wc, int fr, int fq) const {
        const int kh = u.pn >> 4, pn = u.pn & 15, row0 = (u.pm - NTILE_P) * 256 + wr * 64 + fr, col0 = pn * 256 + wc * 32 + 4 * fq;
        float* b = S + (size_t)kh * MS * DM + (size_t)row0 * DM + col0;
#pragma unroll
        for (int ai = 0; ai < 2; ++ai)
#pragma unroll
            for (int m = 0; m < 4; ++m)
#pragma unroll
                for (int bj = 0; bj < 2; ++bj)
#pragma unroll
                    for (int n = 0; n < 2; ++n) *(f32x4*)(b + (size_t)(ai * 128 + m * 16) * DM + bj * 128 + n * 16) = acc[ai][bj][m][n];
    }
};
}
namespace dattn {
constexpr int NW = 8, QBLK = 32, KVBLK = 64;
constexpr float SCALE = 0.125f, THR = 8.f;
constexpr int SHM_V = KVBLK * 128 * 2, SHM_K = KVBLK * 128 * 2, SHM_ATTN = 2 * SHM_V + 2 * SHM_K + NW * 64 * 4;
#define KSWZ(row, colB) ((row) * 256 + ((colB) ^ (((row) & 7) << 4)))
#define SBAR() __builtin_amdgcn_sched_barrier(0)
__device__ __forceinline__ int crow(int r, int hi) { return (r & 3) + 8 * (r >> 2) + 4 * hi; }
__device__ __forceinline__ void partialSM(f32x16& p0, f32x16& p1, float& m_reg, float& mn, float& alpha) {
  constexpr float C = SCALE * 1.4426950408889634f;
  float pmax = p0[0];
#pragma unroll
  for (int r = 1; r < 16; ++r) pmax = fmaxf(pmax, p0[r]);
#pragma unroll
  for (int r = 0; r < 16; ++r) pmax = fmaxf(pmax, p1[r]);
  { auto rr = __builtin_amdgcn_permlane32_swap(__float_as_uint(pmax), __float_as_uint(pmax), false, false);
    pmax = fmaxf(__uint_as_float(rr[0]), __uint_as_float(rr[1])); }
  if (__builtin_expect(__all(pmax - m_reg <= THR / SCALE), 1)) { mn = m_reg; alpha = 1.f; }
  else { mn = fmaxf(m_reg, pmax); alpha = __builtin_amdgcn_exp2f((m_reg - mn) * C); m_reg = mn; }
  const float mnC = -mn * C;
#pragma unroll
  for (int r = 0; r < 16; ++r) p0[r] = fmaf(p0[r], C, mnC);
#pragma unroll
  for (int r = 0; r < 16; ++r) p1[r] = fmaf(p1[r], C, mnC);
#pragma unroll
  for (int r = 0; r < 16; ++r) p0[r] = __builtin_amdgcn_exp2f(p0[r]);
}
__device__ __forceinline__ void finishSM(f32x16& p0, f32x16& p1, float alpha, float& l_reg, bf16x8& pa0, bf16x8& pa1, bf16x8& pa2, bf16x8& pa3) {
#pragma unroll
  for (int r = 0; r < 16; ++r) p1[r] = __builtin_amdgcn_exp2f(p1[r]);
  float ps = 0;
#pragma unroll
  for (int r = 0; r < 16; ++r) ps += p0[r];
#pragma unroll
  for (int r = 0; r < 16; ++r) ps += p1[r];
  { auto rr = __builtin_amdgcn_permlane32_swap(__float_as_uint(ps), __float_as_uint(ps), false, false);
    ps = __uint_as_float(rr[0]) + __uint_as_float(rr[1]); }
  l_reg = l_reg * alpha + ps;
#define PK4(P, BASE, OUT) do { unsigned a0 = cvt_pk_bf16(P[BASE + 0], P[BASE + 1]), a1 = cvt_pk_bf16(P[BASE + 2], P[BASE + 3]);   \
    unsigned b0 = cvt_pk_bf16(P[BASE + 4], P[BASE + 5]), b1 = cvt_pk_bf16(P[BASE + 6], P[BASE + 7]);                              \
    auto r0 = __builtin_amdgcn_permlane32_swap(a0, b0, false, false); auto r1 = __builtin_amdgcn_permlane32_swap(a1, b1, false, false); \
    u32x4 w = {r0[0], r1[0], r0[1], r1[1]}; OUT = *reinterpret_cast<bf16x8*>(&w); } while (0)
  PK4(p0, 0, pa0); PK4(p0, 8, pa1); PK4(p1, 0, pa2); PK4(p1, 8, pa3);
#undef PK4
}
__device__ __forceinline__ void qkt(f32x16& p0, f32x16& p1, const char* Ks, const bf16x8* qr, int r32, int hi, int mp) {
  p0 = f32x16{}; p1 = f32x16{};
#pragma unroll
  for (int d0 = 0; d0 < 4; ++d0) { const int cb = (mp * 64 + d0 * 16 + hi * 8) * 2;
    const bf16x8 b0 = *reinterpret_cast<const bf16x8*>(Ks + KSWZ(r32, cb));
    const bf16x8 b1 = *reinterpret_cast<const bf16x8*>(Ks + KSWZ(32 + r32, cb));
    p0 = __builtin_amdgcn_mfma_f32_32x32x16_bf16(b0, qr[d0], p0, 0, 0, 0);
    p1 = __builtin_amdgcn_mfma_f32_32x32x16_bf16(b1, qr[d0], p1, 0, 0, 0); }
}
__device__ __forceinline__ int v_st(int k, int c) { const int kk = (k & ~0xC) | ((k & 4) << 1) | ((k & 8) >> 1); return ((kk >> 3) * 4 + (c >> 5)) * 512 + ((kk & 7) * 32 + (c & 31)) * 2; }
__device__ __forceinline__ int v_rd_base(int lane) { return ((lane & 3) << 3) | (((lane >> 2) & 3) << 6) | (((lane >> 4) & 1) << 5) | (((lane >> 5) & 1) << 8); }
constexpr int v_rd_off(int d0, int ks, int half) { return d0 * 512 + ks * 4096 + half * 2048; }
template <int OFF> __device__ __forceinline__ s16x4 tr_read(int vb) {
  s16x4 r; asm volatile("ds_read_b64_tr_b16 %0, %1 offset:%2" : "=&v"(r) : "v"(vb), "i"(OFF) : "memory"); return r;
}
template <int D0> __device__ __forceinline__ void pv_one(f32x16& od, int vb, bf16x8 pa0, bf16x8 pa1, bf16x8 pa2, bf16x8 pa3) {
  const s16x4 l0 = tr_read<v_rd_off(D0, 0, 0)>(vb), h0 = tr_read<v_rd_off(D0, 0, 1)>(vb), l1 = tr_read<v_rd_off(D0, 1, 0)>(vb), h1 = tr_read<v_rd_off(D0, 1, 1)>(vb);
  const s16x4 l2 = tr_read<v_rd_off(D0, 2, 0)>(vb), h2 = tr_read<v_rd_off(D0, 2, 1)>(vb), l3 = tr_read<v_rd_off(D0, 3, 0)>(vb), h3 = tr_read<v_rd_off(D0, 3, 1)>(vb);
  asm volatile("s_waitcnt lgkmcnt(0)" ::: "memory"); SBAR();
#define PK(L, H) (bf16x8){L[0], L[1], L[2], L[3], H[0], H[1], H[2], H[3]}
  od = __builtin_amdgcn_mfma_f32_32x32x16_bf16(pa0, PK(l0, h0), od, 0, 0, 0);
  od = __builtin_amdgcn_mfma_f32_32x32x16_bf16(pa1, PK(l1, h1), od, 0, 0, 0);
  od = __builtin_amdgcn_mfma_f32_32x32x16_bf16(pa2, PK(l2, h2), od, 0, 0, 0);
  od = __builtin_amdgcn_mfma_f32_32x32x16_bf16(pa3, PK(l3, h3), od, 0, 0, 0);
#undef PK
}
__device__ __forceinline__ void pv_d0(f32x16* o, int vb, bf16x8 pa0, bf16x8 pa1, bf16x8 pa2, bf16x8 pa3) {
  pv_one<0>(o[0], vb, pa0, pa1, pa2, pa3); pv_one<1>(o[1], vb, pa0, pa1, pa2, pa3); pv_one<2>(o[2], vb, pa0, pa1, pa2, pa3); pv_one<3>(o[3], vb, pa0, pa1, pa2, pa3);
}

__device__ __forceinline__ void qkt3(f32x16& p0, f32x16& p1, const LAS char* Ks, const bf16x8* qr, int r32, int hi, int mp) {
  p0 = f32x16{}; p1 = f32x16{};
#pragma unroll
  for (int d0 = 0; d0 < 4; ++d0) { const int cb = (mp * 64 + d0 * 16 + hi * 8) * 2;
    const bf16x8 b0 = *reinterpret_cast<const LAS bf16x8*>(Ks + KSWZ(r32, cb));
    const bf16x8 b1 = *reinterpret_cast<const LAS bf16x8*>(Ks + KSWZ(32 + r32, cb));
    p0 = __builtin_amdgcn_mfma_f32_32x32x16_bf16(b0, qr[d0], p0, 0, 0, 0);
    p1 = __builtin_amdgcn_mfma_f32_32x32x16_bf16(b1, qr[d0], p1, 0, 0, 0); }
}
__device__ __forceinline__ void unit(int b, int h, int qb, const bf16_t* __restrict__ p1, bf16_t* __restrict__ A2, float lam, const float* __restrict__ gsub, LAS char* lds3) {
  int tid = threadIdx.x; asm volatile("" : "+v"(tid));
  const int wid = __builtin_amdgcn_readfirstlane(tid >> 6), lane = tid & 63, r32 = lane & 31, hi = lane >> 5, wq = wid & 3, mp = wid >> 2;
  LAS float* ws = (LAS float*)(lds3 + 131072) + wid * 64; LAS float* li_l = ws; LAS float* al_l = ws + 32;
  float m_reg = -1e30f, l_reg = 0; f32x16 o[4] = {}; bf16x8 qr[4];
  const size_t rowb = (size_t)b * SEQ;
  const char* Kh = (const char*)(p1 + rowb * P1W + 512 + h * 128); const char* Vh = (const char*)(p1 + rowb * P1W + 1024 + h * 128);
  unsigned koff[2], voff[2];
#pragma unroll
  for (int i = 0; i < 2; ++i) {
    const int krow = wid * 8 + i * 4 + (lane >> 4), kch = (lane & 15) ^ (krow & 7); koff[i] = (unsigned)(krow * P1W * 2 + kch * 16);
    const int sub = wid * 4 + i * 2 + (lane >> 5), kk = (sub >> 2) * 8 + ((lane & 31) >> 2), key = (kk & ~0xC) | ((kk & 4) << 1) | ((kk & 8) >> 1), c = (sub & 3) * 32 + (lane & 3) * 8;
    voff[i] = (unsigned)(key * P1W * 2 + c * 2);
  }
  const unsigned dmaw = (unsigned)wid * 2048u;
#define DMA(t, slot) do { const char* kb_ = Kh + (size_t)(t) * (KVBLK * P1W * 2); const char* vb_ = Vh + (size_t)(t) * (KVBLK * P1W * 2); _Pragma("unroll") for (int i_ = 0; i_ < 2; ++i_) { \
    __builtin_amdgcn_global_load_lds((const unsigned*)(kb_ + koff[i_]), (LAS unsigned*)(lds3 + (slot) * 32768 + dmaw + i_ * 1024), 16, 0, 0); \
    __builtin_amdgcn_global_load_lds((const unsigned*)(vb_ + voff[i_]), (LAS unsigned*)(lds3 + (slot) * 32768 + 16384 + dmaw + i_ * 1024), 16, 0, 0); } } while (0)
#define WAITV(n) asm volatile("s_waitcnt vmcnt(" #n ")" ::: "memory")
#define LBAR() do { asm volatile("s_waitcnt lgkmcnt(0)" ::: "memory"); __builtin_amdgcn_s_barrier(); asm volatile("" ::: "memory"); } while (0)
#define KS(t) (lds3 + ((t) & 3) * 32768)
#define VB(t) (vrd + ((t) & 3) * 32768)
  const int NT = 2 * qb + 2;
  const bool vis_last = (wq >= 2);
  DMA(0, 0); DMA(1, 1);
  const bf16_t* Qw = p1 + (rowb + qb * 128 + wq * QBLK + r32) * P1W + h * 128 + mp * 64 + hi * 8;
#pragma unroll
  for (int d0 = 0; d0 < 4; ++d0) qr[d0] = *reinterpret_cast<const bf16x8*>(Qw + d0 * 16);
  const int vrd = (int)(uintptr_t)lds3 + 16384 + v_rd_base(lane);
#define RESC(a) do { if (__any((a) < 1.f)) { if (hi == 0) al_l[r32] = (a); asm volatile("s_waitcnt lgkmcnt(0)" ::: "memory"); \
    _Pragma("unroll") for (int d = 0; d < 4; ++d) _Pragma("unroll") for (int r = 0; r < 16; ++r) o[d][r] *= al_l[crow(r, hi)]; } } while (0)
  f32x16 pA0, pA1, pB0, pB1; float mnA, mnB, alA, alB; bf16x8 pa0, pa1, pa2, pa3;
  WAITV(4); LBAR();
  if (2 < NT) DMA(2, 2);
  qkt3(pA0, pA1, KS(0), qr, r32, hi, mp); partialSM(pA0, pA1, m_reg, mnA, alA);
  for (int j = 1; j + 1 < NT; j += 2) {
    WAITV(4); LBAR(); DMA(j + 2, (j + 2) & 3);
    SBAR(); qkt3(pB0, pB1, KS(j), qr, r32, hi, mp);
    finishSM(pA0, pA1, alA, l_reg, pa0, pa1, pa2, pa3); SBAR();
    pv_d0(o, VB(j - 1), pa0, pa1, pa2, pa3); partialSM(pB0, pB1, m_reg, mnB, alB);
    RESC(alB);
    WAITV(4); LBAR(); if (j + 3 < NT) DMA(j + 3, (j + 3) & 3);
    SBAR(); qkt3(pA0, pA1, KS(j + 1), qr, r32, hi, mp);
    finishSM(pB0, pB1, alB, l_reg, pa0, pa1, pa2, pa3); SBAR();
    pv_d0(o, VB(j), pa0, pa1, pa2, pa3); partialSM(pA0, pA1, m_reg, mnA, alA);
    RESC(alA);
  }
  WAITV(0); LBAR();
  SBAR();
  if (vis_last) qkt3(pB0, pB1, KS(NT - 1), qr, r32, hi, mp);
  finishSM(pA0, pA1, alA, l_reg, pa0, pa1, pa2, pa3); SBAR();
  pv_d0(o, VB(NT - 2), pa0, pa1, pa2, pa3);
  if (vis_last) {
    partialSM(pB0, pB1, m_reg, mnB, alB);
    RESC(alB);
    finishSM(pB0, pB1, alB, l_reg, pa0, pa1, pa2, pa3); SBAR();
    pv_d0(o, VB(NT - 1), pa0, pa1, pa2, pa3);
  }
  if (hi == 0) li_l[r32] = l_reg; asm volatile("s_waitcnt lgkmcnt(0)" ::: "memory");
  float rli[16];
#pragma unroll
  for (int r = 0; r < 16; ++r) rli[r] = __builtin_amdgcn_rcpf(li_l[crow(r, hi)]);
  LBAR();
  LAS float* X = (LAS float*)lds3 + wq * (32 * 132);
  if (mp == 1) {
#pragma unroll
    for (int r = 0; r < 16; ++r) { const int orow = crow(r, hi);
#pragma unroll
      for (int d0 = 0; d0 < 4; ++d0) X[orow * 132 + d0 * 32 + r32] = o[d0][r] * rli[r]; }
  }
  LBAR();
  if (mp == 0) {
#pragma unroll
    for (int r = 0; r < 16; ++r) { const int orow = crow(r, hi);
#pragma unroll
      for (int d0 = 0; d0 < 4; ++d0) { LAS float* p = &X[orow * 132 + d0 * 32 + r32]; *p = o[d0][r] * rli[r] - lam * (*p); } }
    asm volatile("s_waitcnt lgkmcnt(0)" ::: "memory");
    const int row = lane >> 1, half = lane & 1; const LAS float* xr = X + row * 132 + half * 64;
    f32x4 v[16]; float ss = 0.f;
#pragma unroll
    for (int i = 0; i < 16; ++i) { v[i] = *(const LAS f32x4*)(xr + 4 * i); ss += (v[i][0] * v[i][0] + v[i][1] * v[i][1]) + (v[i][2] * v[i][2] + v[i][3] * v[i][3]); }
    ss += DPPF(ss, 0xB1);
    const float rs = rsqrtf(ss * (1.0f / 128.0f) + EPS) * (1.0f - LAM_INIT);
    bf16_t* orow = A2 + (rowb + qb * 128 + wq * QBLK + row) * DM + h * 128 + half * 64; const float* g = gsub + half * 64;
#pragma unroll
    for (int i = 0; i < 16; i += 2) { const f32x4 g0 = *(const f32x4*)(g + 4 * i), g1 = *(const f32x4*)(g + 4 * i + 4);
      *(u32x4*)(orow + 4 * i) = epi::pack8(v[i] * g0 * rs, v[i + 1] * g1 * rs); }
  }
  asm volatile("s_waitcnt vmcnt(0)" ::: "memory");
  LBAR();
#undef DMA
#undef WAITV
#undef LBAR
#undef KS
#undef VB
#undef RESC
}
#undef KSWZ
#undef SBAR
}
namespace misc {
constexpr int SK = PAST + DECT;
__device__ __forceinline__ void sample_attn_unit(int b, int h, int qh, const bf16_t* __restrict__ p1, const float* __restrict__ ck, const float* __restrict__ cv,
                                                 const float* __restrict__ nk, const float* __restrict__ nv, bf16_t* __restrict__ A2, float lam, const float* __restrict__ gsub, char* lds) {
  int tid = threadIdx.x; asm volatile("" : "+v"(tid)); const int lane = tid & 63, wid = tid >> 6;
  float* S = (float*)lds; float* red = (float*)(lds + 66560); float* q = (float*)(lds + 132096); float* st = (float*)(lds + 136192);
  for (int i = tid; i < 1024; i += 512) { const int mp = i >> 9, r = (i >> 6) & 7, d = i & 63;
    q[i] = bf2f(p1[(size_t)(MP + b * DECT + qh * 8 + r) * P1W + h * 128 + mp * 64 + d]); }
  __syncthreads();
  for (int it = tid; it < 2 * SK; it += 512) {
    const int mp = it / SK, key = it - mp * SK;
    const float* kp = key < PAST ? ck + (((size_t)b * PAST + key) * NH + h) * 128 + mp * 64 : nk + ((size_t)(b * DECT + key - PAST)) * 512 + h * 128 + mp * 64;
    float a[8] = {0.f, 0.f, 0.f, 0.f, 0.f, 0.f, 0.f, 0.f};
#pragma unroll 4
    for (int d = 0; d < 64; d += 4) { const f32x4 kv = *(const f32x4*)(kp + d);
#pragma unroll
      for (int r = 0; r < 8; ++r) { const f32x4 qv = *(const f32x4*)(q + (mp * 8 + r) * 64 + d); a[r] += (kv[0] * qv[0] + kv[1] * qv[1]) + (kv[2] * qv[2] + kv[3] * qv[3]); } }
#pragma unroll
    for (int r = 0; r < 8; ++r) S[(mp * 8 + r) * SK + key] = a[r] * 0.125f;
  }
  __syncthreads();
  for (int rr = 0; rr < 2; ++rr) { const int row = wid * 2 + rr; float* s = S + row * SK;
    float mx = -3.0e38f; for (int k = lane; k < SK; k += 64) mx = fmaxf(mx, s[k]); mx = wave_max(mx);
    float sum = 0.f; for (int k = lane; k < SK; k += 64) { const float e = __expf(s[k] - mx); s[k] = e; sum += e; } sum = wave_sum(sum);
    if (lane == 0) st[row] = 1.0f / sum; }
  __syncthreads();
  for (int i = tid; i < 8 * SK; i += 512) { const int r = i / SK, k = i - r * SK; S[r * SK + k] = S[r * SK + k] * st[r] - lam * S[(8 + r) * SK + k] * st[8 + r]; }
  __syncthreads();
  { const int eg = tid & 31, ks = tid >> 5; f32x4 o[8];
#pragma unroll
    for (int r = 0; r < 8; ++r) o[r] = (f32x4){0.f, 0.f, 0.f, 0.f};
    for (int key = ks; key < SK; key += 16) {
      const float* vp = key < PAST ? cv + (((size_t)b * PAST + key) * NH + h) * 128 + eg * 4 : nv + ((size_t)(b * DECT + key - PAST)) * 512 + h * 128 + eg * 4;
      const f32x4 vv = *(const f32x4*)vp;
#pragma unroll
      for (int r = 0; r < 8; ++r) o[r] += vv * S[r * SK + key]; }
#pragma unroll
    for (int r = 0; r < 8; ++r) *(f32x4*)(red + (ks * 8 + r) * 128 + eg * 4) = o[r]; }
  __syncthreads();
  { const int r = wid; float x0 = 0.f, x1 = 0.f;
#pragma unroll
    for (int ks = 0; ks < 16; ++ks) { const f32x2 t = *(const f32x2*)(red + (ks * 8 + r) * 128 + 2 * lane); x0 += t[0]; x1 += t[1]; }
    const float ss = wave_sum(x0 * x0 + x1 * x1); const float rs = rsqrtf(ss * (1.0f / 128.0f) + EPS) * (1.0f - LAM_INIT);
    const unsigned w = cvt_pk_bf16(x0 * rs * gsub[2 * lane], x1 * rs * gsub[2 * lane + 1]);
    *(unsigned*)(A2 + (size_t)(MP + b * DECT + qh * 8 + r) * DM + h * 128 + 2 * lane) = w; }
  __syncthreads();
}

__device__ __forceinline__ void sample_xattn_unit(int b, int h, const bf16_t* __restrict__ HQ, const float* __restrict__ mk, const float* __restrict__ mv, bf16_t* __restrict__ XO, char* lds) {
  int tid = threadIdx.x; asm volatile("" : "+v"(tid)); const int lane = tid & 63, wid = tid >> 6;
  float* q = (float*)lds; float* S = (float*)(lds + 16384);
  for (int i = tid; i < 16 * 256; i += 512) { const int r = i >> 8, d = i & 255; q[i] = bf2f(HQ[(size_t)(MP + b * DECT + r) * DM + h * 256 + d]); }
  __syncthreads();
  { const int key = tid >> 1, qh = tid & 1; const float* kp = mk + (((size_t)b * NMEM + key) * NH + h) * 256;
    float a[8] = {0.f, 0.f, 0.f, 0.f, 0.f, 0.f, 0.f, 0.f};
#pragma unroll 4
    for (int d = 0; d < 256; d += 4) { const f32x4 kv = *(const f32x4*)(kp + d);
#pragma unroll
      for (int r = 0; r < 8; ++r) { const f32x4 qv = *(const f32x4*)(q + (qh * 8 + r) * 256 + d); a[r] += (kv[0] * qv[0] + kv[1] * qv[1]) + (kv[2] * qv[2] + kv[3] * qv[3]); } }
#pragma unroll
    for (int r = 0; r < 8; ++r) S[(qh * 8 + r) * 256 + key] = a[r] * 0.0625f; }
  __syncthreads();
  for (int rr = 0; rr < 2; ++rr) { const int row = wid * 2 + rr; float* s = S + row * 256;
    float v[4]; float mx = -3.0e38f;
#pragma unroll
    for (int i = 0; i < 4; ++i) { v[i] = s[lane + 64 * i]; mx = fmaxf(mx, v[i]); } mx = wave_max(mx);
    float sum = 0.f;
#pragma unroll
    for (int i = 0; i < 4; ++i) { v[i] = __expf(v[i] - mx); sum += v[i]; } sum = wave_sum(sum); const float rl = 1.0f / sum;
#pragma unroll
    for (int i = 0; i < 4; ++i) s[lane + 64 * i] = v[i] * rl; }
  __syncthreads();
  { const int r = tid >> 5, dg = tid & 31; const float* vp = mv + ((size_t)b * NMEM * NH + h) * 256 + dg * 8; f32x4 o0 = {0.f, 0.f, 0.f, 0.f}, o1 = {0.f, 0.f, 0.f, 0.f};
    for (int key = 0; key < NMEM; ++key) { const float p = S[r * 256 + key]; const f32x4 a = *(const f32x4*)(vp + (size_t)key * NH * 256), c = *(const f32x4*)(vp + (size_t)key * NH * 256 + 4); o0 += a * p; o1 += c * p; }
    *(u32x4*)(XO + (size_t)(MP + b * DECT + r) * DM + h * 256 + dg * 8) = epi::pack8(o0, o1); }
  __syncthreads();
}

__device__ __forceinline__ void shortconv_item(int item, const bf16_t* __restrict__ p1, const float* __restrict__ wsc, const float* __restrict__ state, bf16_t* __restrict__ A2) {
  const int cgp = item & 63, chunk = item >> 6, c = cgp * 8, r0 = chunk * 64;
  float w0[8], w1[8], w2[8], um2[8], um1[8];
#pragma unroll
  for (int j = 0; j < 8; ++j) { w0[j] = wsc[c + j]; w1[j] = wsc[CW + c + j]; w2[j] = wsc[2 * CW + c + j]; um2[j] = 0.f; um1[j] = 0.f; }
  const bool sample = r0 >= MP;
  if (!sample && (r0 & (SEQ - 1)) != 0) {
    const u32x4 a = *(const u32x4*)(p1 + (size_t)(r0 - 2) * P1W + 2048 + c), bq = *(const u32x4*)(p1 + (size_t)(r0 - 1) * P1W + 2048 + c);
#pragma unroll
    for (int j = 0; j < 4; ++j) { um2[2 * j] = __uint_as_float(a[j] << 16); um2[2 * j + 1] = __uint_as_float(a[j] & 0xffff0000u); um1[2 * j] = __uint_as_float(bq[j] << 16); um1[2 * j + 1] = __uint_as_float(bq[j] & 0xffff0000u); }
  }
  for (int r = 0; r < 64; ++r) {
    const int row = r0 + r;
    if (sample && ((row - MP) & (DECT - 1)) == 0) { const float* s = state + (size_t)((row - MP) >> 4) * 2 * CW + c;
#pragma unroll
      for (int j = 0; j < 8; ++j) { um2[j] = s[j]; um1[j] = s[CW + j]; } }
    const u32x4 uu = *(const u32x4*)(p1 + (size_t)row * P1W + 2048 + c), gg = *(const u32x4*)(p1 + (size_t)row * P1W + 1536 + c);
    float y[8];
#pragma unroll
    for (int j = 0; j < 4; ++j) {
      const float u0 = __uint_as_float(uu[j] << 16), u1 = __uint_as_float(uu[j] & 0xffff0000u), g0 = __uint_as_float(gg[j] << 16), g1 = __uint_as_float(gg[j] & 0xffff0000u);
      y[2 * j] = g0 * (w0[2 * j] * um2[2 * j] + w1[2 * j] * um1[2 * j] + w2[2 * j] * u0); y[2 * j + 1] = g1 * (w0[2 * j + 1] * um2[2 * j + 1] + w1[2 * j + 1] * um1[2 * j + 1] + w2[2 * j + 1] * u1);
      um2[2 * j] = um1[2 * j]; um2[2 * j + 1] = um1[2 * j + 1]; um1[2 * j] = u0; um1[2 * j + 1] = u1; }
    u32x4 w; w.x = cvt_pk_bf16(y[0], y[1]); w.y = cvt_pk_bf16(y[2], y[3]); w.z = cvt_pk_bf16(y[4], y[5]); w.w = cvt_pk_bf16(y[6], y[7]);
    *(u32x4*)(A2 + (size_t)row * DM + 512 + c) = w;
  }
}
__device__ __forceinline__ void transpose_item(int item, const bf16_t* __restrict__ src, bf16_t* __restrict__ dst, LAS bf16_t* scr, int lane) {
  const int bi = item >> 4, bj = item & 15, r0 = bi * 64, c0 = bj * 64;
  for (int i = 0; i < 64; ++i) scr[i * 66 + lane] = src[(size_t)(r0 + i) * DM + c0 + lane];
  asm volatile("s_waitcnt lgkmcnt(0)" ::: "memory");
  for (int i = 0; i < 64; ++i) dst[(size_t)(c0 + i) * MMEM + r0 + lane] = scr[lane * 66 + i];
  asm volatile("s_waitcnt lgkmcnt(0)" ::: "memory");
}
}
constexpr size_t MiB = 1u << 20;
constexpr size_t WS_SSQ0 = 1 * MiB, WS_SSQM = WS_SSQ0 + 288 * 1024, WS_RS1 = WS_SSQ0 + 320 * 1024, WS_RS2 = WS_SSQ0 + 640 * 1024;
constexpr size_t WS_SSP1 = 2 * MiB, WS_SSP2 = 7 * MiB, WS_SSP3 = 12 * MiB, WS_L4 = 17 * MiB;
constexpr size_t WS_UH = 22 * MiB, WS_U01 = 28 * MiB, WS_G01 = 34 * MiB;
constexpr size_t WS_WIN = 40 * MiB, WS_WOUT = 46 * MiB, WS_WXQ = 48 * MiB, WS_WXKV = 50 * MiB, WS_WXO = 54 * MiB, WS_WUG = 56 * MiB, WS_WDN = 67 * MiB;
constexpr size_t WS_MN = 74 * MiB, WS_MK = 90 * MiB, WS_MV = 106 * MiB, WS_MVT = 122 * MiB;
constexpr size_t WS_XA = 138 * MiB;
constexpr size_t WS_P1 = 268 * MiB;
constexpr size_t WS_A2 = 591 * MiB;
constexpr size_t WS_SPART = WS_MN;
constexpr size_t WS_HQ = WS_P1, WS_P = WS_P1 + 129 * MiB, WS_H = WS_P1;
constexpr size_t WS_END = 720 * MiB;
static_assert(WS_XA + (size_t)RT * DM * 2 <= WS_P1 && WS_P1 + (size_t)RT * P1W * 2 <= WS_A2 && WS_A2 + (size_t)RT * DM * 2 <= WS_END && WS_H + (size_t)RT * DFF * 2 <= WS_END, "ws map");
static_assert(WS_WDN + (size_t)DM * DFF * 2 <= WS_MN && WS_WUG + (size_t)2 * DFF * DM * 2 <= WS_WDN && WS_G01 + (size_t)NTILE_P * 2 * DFF * 4 <= WS_WIN && WS_L4 + (size_t)RT * 16 <= WS_UH && WS_RS2 + (size_t)RT * 4 <= WS_SSP1, "ws map 2");

constexpr int RING_BYTES = 131072, XTRA_OFF = RING_BYTES, BARST_OFF = XTRA_OFF + 20480, LDS_BYTES = 155648;

struct SchedGrid {
    const char* A; const char* B; size_t a_tile, b_tile; int nM, nN, nwg, G, c;
    __device__ __forceinline__ void init(const void* A_, size_t a_tile_, const void* B_, size_t b_tile_, int nM_, int nN_, int G_, int c_) { A = (const char*)A_; B = (const char*)B_; a_tile = a_tile_; b_tile = b_tile_; nM = nM_; nN = nN_; nwg = nM * nN; G = G_; c = c_; }
    __device__ __forceinline__ bool next(int i, pg8::Unit& u) const {
        const long L = (long)i * G + c; if (L >= nwg) return false;
        int wgid = (int)L; { const int q = nwg / 8, r = nwg % 8, xcd = wgid % 8, off = wgid / 8; wgid = (xcd < r ? xcd * (q + 1) : r * (q + 1) + (xcd - r) * q) + off; }
        const int nig = 8 * nN, gid = wgid / nig, fm = gid * 8, gsz = (nM - fm) < 8 ? (nM - fm) : 8;
        u.pm = fm + ((wgid % nig) % gsz); u.pn = (wgid % nig) / gsz; u.A = A + (size_t)u.pm * a_tile; u.B = B + (size_t)u.pn * b_tile; return true;
    }
};
struct SchedX {
    const char* A; const char* B; int G, c; bool pv;
    __device__ __forceinline__ bool next(int i, pg8::Unit& u) const {
        const long L = (long)i * G + c; if (L >= 4 * NTILE_P) return false;
        const int h = (int)(L >> 8), idx = (int)(L & 255), pm = (idx & 7) * 32 + (idx >> 3), b = pm >> 3;
        u.pm = pm; u.pn = h; u.A = A + ((size_t)pm * 256 * DM + h * 256) * 2;
        u.B = pv ? B + ((size_t)h * 256 * MMEM + b * 256) * 2 : B + ((size_t)b * 256 * DM + h * 256) * 2; return true;
    }
};

struct SchedSplitK {
    const char* A; const char* B; int G, c;
    __device__ __forceinline__ bool next(int i, pg8::Unit& u) const {
        const long L = (long)i * G + c; if (L >= 16) return false;
        const int t = (int)(L >> 3), pn = (int)(L >> 1) & 3, kh = (int)L & 1;
        u.pm = NTILE_P + t; u.pn = pn | (kh << 4);
        u.A = A + ((size_t)(NTILE_P + t) * 256 * DFF + kh * (DFF / 2)) * 2; u.B = B + ((size_t)pn * 256 * DFF + kh * (DFF / 2)) * 2; return true;
    }
};

__device__ __forceinline__ void p0_transpose_item(const float* __restrict__ W, int ldw, int K, int kb, int ns, bf16_t* __restrict__ WT, int nd, const float* __restrict__ gain, LAS float* scr, int lane) {
    const int k0 = 64 * kb;
    float wv[32];
#pragma unroll
    for (int i = 0; i < 32; ++i) wv[i] = W[(size_t)(k0 + 2 * i + (lane >> 5)) * ldw + ns + (lane & 31)];
    if (gain) {
#pragma unroll
        for (int i = 0; i < 32; ++i) wv[i] *= gain[k0 + 2 * i + (lane >> 5)]; }
#pragma unroll
    for (int i = 0; i < 32; ++i) scr[(2 * i + (lane >> 5)) * 33 + (lane & 31)] = wv[i];
    asm volatile("s_waitcnt lgkmcnt(0)" ::: "memory");
    const int cc = lane & 7;
#pragma unroll
    for (int j = 0; j < 4; ++j) { const int n = (lane >> 3) + 8 * j; const LAS float* s = scr + (8 * cc) * 33 + n;
        u32x4 o; o.x = cvt_pk_bf16(s[0 * 33], s[1 * 33]); o.y = cvt_pk_bf16(s[2 * 33], s[3 * 33]); o.z = cvt_pk_bf16(s[4 * 33], s[5 * 33]); o.w = cvt_pk_bf16(s[6 * 33], s[7 * 33]);
        *(u32x4*)(WT + (size_t)(nd + n) * K + k0 + 8 * cc) = o; }
    asm volatile("s_waitcnt lgkmcnt(0)" ::: "memory");
}
__device__ __forceinline__ void rows2_to_bf16(const float* __restrict__ x0, const float* __restrict__ x1, bf16_t* __restrict__ o0, bf16_t* __restrict__ o1, float* q0, float* q1, int lane) {
    const f32x4* r0 = (const f32x4*)x0 + lane; const f32x4* r1 = (const f32x4*)x1 + lane; f32x4 v[4], w[4]; float s = 0.f, t = 0.f;
#pragma unroll
    for (int j = 0; j < 4; ++j) { v[j] = __builtin_nontemporal_load(r0 + 64 * j); w[j] = __builtin_nontemporal_load(r1 + 64 * j); }
#pragma unroll
    for (int j = 0; j < 4; ++j) { s += (v[j][0] * v[j][0] + v[j][1] * v[j][1]) + (v[j][2] * v[j][2] + v[j][3] * v[j][3]); t += (w[j][0] * w[j][0] + w[j][1] * w[j][1]) + (w[j][2] * w[j][2] + w[j][3] * w[j][3]); }
    s = wave_sum(s); t = wave_sum(t);
    u32x2* p0 = (u32x2*)o0 + lane; u32x2* p1 = (u32x2*)o1 + lane;
#pragma unroll
    for (int j = 0; j < 4; ++j) { p0[64 * j] = epi::pack4(v[j]); p1[64 * j] = epi::pack4(w[j]); }
    if (lane == 0) { *q0 = s; *q1 = t; }
}

#define XB_TMO      128
#define XB_XCNT(j)  (256  + 64 * (j))
#define XB_XSUB(j)  (1280 + 64 * (j))
#define XB_XGEN(j)  (2304 + 64 * (j))
#define XB_TOP      3328
#define XB_TOPGEN   3392
#define XCD_BAR_WORDS 3456
#define XB_SPIN_CAP (1u << 22)
__device__ __forceinline__ unsigned xb_ld(unsigned* p)              { return __hip_atomic_load(p, __ATOMIC_RELAXED, __HIP_MEMORY_SCOPE_AGENT); }
__device__ __forceinline__ unsigned xb_add(unsigned* p, unsigned v) { return __hip_atomic_fetch_add(p, v, __ATOMIC_RELAXED, __HIP_MEMORY_SCOPE_AGENT); }
__device__ __forceinline__ unsigned xb_xcc_id() { return (unsigned)__builtin_amdgcn_s_getreg((3 << 11) | 20) & 0xFu; }
#define XB_SPIN(cond, bar) do { unsigned _sp = 0; while (cond) { __builtin_amdgcn_s_sleep(1); \
    if ((++_sp & 255u) == 0u) { if (xb_ld(&(bar)[XB_TMO])) break; if (_sp > XB_SPIN_CAP) { atomicAdd(&(bar)[XB_TMO], 1u); break; } } } } while (0)
__device__ __forceinline__ void xcd_barrier_complete(unsigned* bar, unsigned x, unsigned& nloc, unsigned& nx) {
    const unsigned G = gridDim.x * gridDim.y * gridDim.z;
    unsigned sum, cnt, mine, sp = 0u;
    for (;;) {
        sum = 0u; cnt = 0u; mine = 0u;
#pragma unroll
        for (unsigned j = 0; j < 16; ++j) { const unsigned c = xb_ld(&bar[XB_XCNT(j)]); sum += c; cnt += (c > 0u) ? 1u : 0u; mine = (j == x) ? c : mine; }
        if (sum == G) break;
        __builtin_amdgcn_s_sleep(1);
        if ((++sp & 255u) == 0u) { if (xb_ld(&bar[XB_TMO])) break; if (sp > XB_SPIN_CAP) { atomicAdd(&bar[XB_TMO], 1u); break; } }
    }
    nloc = mine > 0u ? mine : 1u; nx = cnt > 0u ? cnt : 1u;
}
__device__ __forceinline__ void xcd_barrier(unsigned* bar, volatile LAS unsigned* st) {
    asm volatile("s_waitcnt vmcnt(0)" ::: "memory");
    __syncthreads();
    if (threadIdx.x == 0) {
        const unsigned x = xb_xcc_id();
        __builtin_amdgcn_s_waitcnt(0);
        unsigned nloc = st[0], nx = st[1];
        if (nloc == 0u) { xcd_barrier_complete(bar, x, nloc, nx); st[0] = nloc; st[1] = nx; }
        const unsigned old = xb_add(&bar[XB_XSUB(x)], 1u);
        const unsigned gen = old / nloc;
        if (old + 1u == (gen + 1u) * nloc) {
            __builtin_amdgcn_fence(__ATOMIC_RELEASE, "agent");
            asm volatile("s_waitcnt vmcnt(0)" ::: "memory");
            const unsigned og = xb_add(&bar[XB_TOP], 1u);
            const unsigned tg = og / nx;
            if (og + 1u == (tg + 1u) * nx) xb_add(&bar[XB_TOPGEN], 1u);
            else XB_SPIN(xb_ld(&bar[XB_TOPGEN]) == tg, bar);
            __builtin_amdgcn_fence(__ATOMIC_ACQUIRE, "agent");
            xb_add(&bar[XB_XGEN(x)], 1u);
            asm volatile("s_waitcnt vmcnt(0)" ::: "memory");
        } else {
            XB_SPIN(xb_ld(&bar[XB_XGEN(x)]) == gen, bar);
            __builtin_amdgcn_fence(__ATOMIC_ACQUIRE, "agent");
            asm volatile("s_waitcnt vmcnt(0)" ::: "memory");
        }
    }
    __syncthreads();
}

struct Args { const float* in[30]; float* out; unsigned char* ws; };
#define PHASE_ARGS() \
    const __attribute__((address_space(4))) Args* ap_ = (const __attribute__((address_space(4))) Args*)__builtin_amdgcn_kernarg_segment_ptr(); asm volatile("" : "+s"(ap_)); \
    unsigned char* const ws = ap_->ws; float* const out = ap_->out; (void)ws; (void)out; \
    int tid = threadIdx.x; asm volatile("" : "+v"(tid)); const int lane = tid & 63, wave = __builtin_amdgcn_readfirstlane(tid >> 6); (void)lane; (void)wave; \
    const int G = gridDim.x, bx = blockIdx.x, vcu = (G % 8 == 0) ? (bx % 8) * (G / 8) + bx / 8 : bx; (void)vcu; \
    const int gw = vcu * 8 + wave, NGW = G * 8; (void)gw; (void)NGW
#define IN(k) (ap_->in[k])
#define WSF(off) ((float*)(ws + (off)))
#define WSB(off) ((bf16_t*)(ws + (off)))

__global__ void __launch_bounds__(512, 2) fwd_kernel(Args a) {
    extern __shared__ __attribute__((aligned(16))) unsigned char lds_raw[];
    LAS unsigned char* const lds = (LAS unsigned char*)lds_raw;
    volatile LAS unsigned* const bst = (volatile LAS unsigned*)(lds + BARST_OFF);
    if (threadIdx.x < 2) bst[threadIdx.x] = 0u;
    __syncthreads();
    { PHASE_ARGS(); if (threadIdx.x == 0) (void)xb_add(&((unsigned*)ws)[XB_XCNT(xb_xcc_id())], 1u); }
#define GRID_BAR() do { PHASE_ARGS(); xcd_barrier((unsigned*)ws, bst); } while (0)

    {
        PHASE_ARGS();
        LAS float* scr = (LAS float*)(lds + wave * 16384);
        constexpr int I_IN = 16 * 96, I_SQ = 16 * 32, I_FF = 16 * 88, I_DN = 44 * 32;
        constexpr int NITEMS = I_IN + 5 * I_SQ + 2 * I_FF + I_DN;
        for (int it = gw; it < NITEMS; it += NGW) {
            int r = it;
            if (r < I_IN) { const int kb = r / 96, nb = r % 96, nd = nb * 32; int ns = nd;
                if (nd >= 2048) { const int T = (nd - 2048) >> 8, w = (nd - 2048) & 255; ns = (w < 128) ? 2048 + 128 * T + w : 2560 + 128 * T + (w - 128); }
                p0_transpose_item(IN(10), INP, DM, kb, ns, WSB(WS_WIN), nd, IN(9), scr, lane); continue; } r -= I_IN;
            if (r < I_SQ) { p0_transpose_item(IN(17), DM, DM, r / 32, (r % 32) * 32, WSB(WS_WOUT), (r % 32) * 32, nullptr, scr, lane); continue; } r -= I_SQ;
            if (r < I_SQ) { p0_transpose_item(IN(20), DM, DM, r / 32, (r % 32) * 32, WSB(WS_WXQ), (r % 32) * 32, IN(19), scr, lane); continue; } r -= I_SQ;
            if (r < I_SQ) { p0_transpose_item(IN(21), DM, DM, r / 32, (r % 32) * 32, WSB(WS_WXKV), (r % 32) * 32, IN(18), scr, lane); continue; } r -= I_SQ;
            if (r < I_SQ) { p0_transpose_item(IN(22), DM, DM, r / 32, (r % 32) * 32, WSB(WS_WXKV), 1024 + (r % 32) * 32, IN(18), scr, lane); continue; } r -= I_SQ;
            if (r < I_SQ) { p0_transpose_item(IN(23), DM, DM, r / 32, (r % 32) * 32, WSB(WS_WXO), (r % 32) * 32, nullptr, scr, lane); continue; } r -= I_SQ;
            if (r < I_FF) { const int kb = r / 88, nb = r % 88; p0_transpose_item(IN(25), DFF, DM, kb, nb * 32, WSB(WS_WUG), 256 * (nb >> 2) + (nb & 3) * 32, IN(24), scr, lane); continue; } r -= I_FF;
            if (r < I_FF) { const int kb = r / 88, nb = r % 88; p0_transpose_item(IN(26), DFF, DM, kb, nb * 32, WSB(WS_WUG), 256 * (nb >> 2) + 128 + (nb & 3) * 32, IN(24), scr, lane); continue; } r -= I_FF;
            p0_transpose_item(IN(28), DM, DFF, r / 32, (r % 32) * 32, WSB(WS_WDN), (r % 32) * 32, nullptr, scr, lane);
        }
        for (int m = 2 * gw; m < RT + MMEM; m += 2 * NGW) {
            const float* src; bf16_t* dst; float* sq;
            if (m < MP) { src = IN(0) + (size_t)m * DM; dst = WSB(WS_XA) + (size_t)m * DM; sq = WSF(WS_SSQ0) + m; }
            else if (m < RT) { src = IN(1) + (size_t)(m - MP) * DM; dst = WSB(WS_XA) + (size_t)m * DM; sq = WSF(WS_SSQ0) + m; }
            else { src = IN(8) + (size_t)(m - RT) * DM; dst = WSB(WS_MN) + (size_t)(m - RT) * DM; sq = WSF(WS_SSQM) + (m - RT); }
            rows2_to_bf16(src, src + DM, dst, dst + DM, sq, sq + 1, lane);
        }
    }
    GRID_BAR();

    {
        PHASE_ARGS();
        pg8::Gemm g{DM, DM, DM};
        { SchedGrid S; S.init(WSB(WS_XA), (size_t)256 * DM * 2, WSB(WS_WIN), (size_t)256 * DM * 2, NTILE, INP / 256, G, bx);
          epi::EpiInProj E{WSF(WS_SSQ0), WSB(WS_P1), out};
          pg8::gemm_phase(lds, g, S, E); }
        { SchedGrid S; S.init(WSB(WS_MN), (size_t)256 * DM * 2, WSB(WS_WXKV), (size_t)256 * DM * 2, MMEM / 256, 8, G, bx);
          epi::EpiMemKV E{WSF(WS_SSQM), WSB(WS_MK), WSB(WS_MV), out};
          pg8::gemm_phase(lds, g, S, E); }
    }
    GRID_BAR();

    {
        PHASE_ARGS();
        float lam;
        { const float a1 = wave_sum(IN(11)[lane] * IN(12)[lane]), a2 = wave_sum(IN(13)[lane] * IN(14)[lane]); lam = __expf(a1) - __expf(a2) + LAM_INIT; }
        for (long L = bx; L < 2048; L += G) {
            const int s = (int)(L >> 8), cc = (int)(L & 255), cv = (cc & 7) * 32 + (cc >> 3), bh = cv >> 1, par = cv & 1, p = 2 * (s >> 1) + par, qb = (s & 1) ? 15 - p : p;
            dattn::unit(bh >> 2, bh & 3, qb, WSB(WS_P1), WSB(WS_A2), lam, IN(15), (LAS char*)lds);
        }
        for (int L = bx; L < 256; L += G) misc::sample_attn_unit(L >> 3, (L >> 1) & 3, L & 1, WSB(WS_P1), IN(2), IN(3), out + O_KS, out + O_VS, WSB(WS_A2), lam, IN(15), (char*)lds_raw);
        for (int it = (vcu * 512 + tid); it < 64 * (RT / 64); it += G * 512) misc::shortconv_item(it, WSB(WS_P1), IN(16), IN(4), WSB(WS_A2));
        __syncthreads();
        { LAS bf16_t* scr = (LAS bf16_t*)(lds + wave * 16384); for (int it = gw; it < 2048; it += NGW) misc::transpose_item(it, WSB(WS_MV), WSB(WS_MVT), scr, lane); }
    }
    GRID_BAR();

    {
        PHASE_ARGS();
        pg8::Gemm g{DM, DM, DM}; SchedGrid S; S.init(WSB(WS_A2), (size_t)256 * DM * 2, WSB(WS_WOUT), (size_t)256 * DM * 2, NTILE, 4, G, bx);
        epi::EpiResidual E{WSB(WS_XA), WSF(WS_SSP1)};
        pg8::gemm_phase(lds, g, S, E);
    }
    GRID_BAR();
    {
        PHASE_ARGS();
        for (int r = bx * 512 + tid; r < RT; r += G * 512) WSF(WS_RS1)[r] = epi::rstd16(WSF(WS_SSP1), r);
    }
    GRID_BAR();
    {
        PHASE_ARGS();
        pg8::Gemm g{DM, DM, DM}; SchedGrid S; S.init(WSB(WS_XA), (size_t)256 * DM * 2, WSB(WS_WXQ), (size_t)256 * DM * 2, NTILE, 4, G, bx);
        epi::EpiScaleBf16 E{WSF(WS_RS1), WSB(WS_HQ), DM};
        pg8::gemm_phase(lds, g, S, E);
    }
    GRID_BAR();
    {
        PHASE_ARGS();
        pg8::Gemm g{DM, DM, 256}; SchedX S{(const char*)WSB(WS_HQ), (const char*)WSB(WS_MK), G, bx, false};
        epi::EpiXScores E{WSB(WS_P), WSF(WS_L4), (LAS float*)(lds + XTRA_OFF)};
        pg8::gemm_phase(lds, g, S, E);
    }
    GRID_BAR();
    {
        PHASE_ARGS();
        pg8::Gemm g{DM, MMEM, 256}; SchedX S{(const char*)WSB(WS_P), (const char*)WSB(WS_MVT), G, bx, true};
        epi::EpiXPV E{WSF(WS_L4), WSB(WS_HQ)};
        pg8::gemm_phase(lds, g, S, E);
        __syncthreads();
        for (int L = G - 1 - bx; L < NB * NH; L += G) misc::sample_xattn_unit(L >> 2, L & 3, WSB(WS_HQ), IN(6), IN(7), WSB(WS_HQ), (char*)lds_raw);
    }
    GRID_BAR();
    {
        PHASE_ARGS();
        pg8::Gemm g{DM, DM, DM}; SchedGrid S; S.init(WSB(WS_HQ), (size_t)256 * DM * 2, WSB(WS_WXO), (size_t)256 * DM * 2, NTILE, 4, G, bx);
        epi::EpiResidual E{WSB(WS_XA), WSF(WS_SSP2)};
        pg8::gemm_phase(lds, g, S, E);
    }
    GRID_BAR();
    {
        PHASE_ARGS();
        for (int r = bx * 512 + tid; r < RT; r += G * 512) WSF(WS_RS2)[r] = epi::rstd16(WSF(WS_SSP2), r);
    }
    GRID_BAR();
    {
        PHASE_ARGS();
        pg8::Gemm g{DM, DM, DM}; SchedGrid S; S.init(WSB(WS_XA), (size_t)256 * DM * 2, WSB(WS_WUG), (size_t)256 * DM * 2, NTILE, 22, G, bx);
        epi::EpiUpGate E{WSF(WS_RS2), IN(27), IN(5), WSB(WS_H), out, WSF(WS_UH), WSF(WS_U01), WSF(WS_G01), (LAS float*)(lds + XTRA_OFF)};
        pg8::gemm_phase(lds, g, S, E);
    }
    GRID_BAR();
    {
        PHASE_ARGS();
        pg8::Gemm g{DFF, DFF, DFF}; SchedGrid S; S.init(WSB(WS_H), (size_t)256 * DFF * 2, WSB(WS_WDN), (size_t)256 * DFF * 2, NTILE_P, 4, G, bx);
        { const float* UH = WSF(WS_UH); const float* U01 = WSF(WS_U01); const float* G01 = WSF(WS_G01); const float* w_ffc = IN(27); bf16_t* HB = WSB(WS_H); pg8::Unit uu;
          for (int i = 0; S.next(i, uu); ++i) { const int pm = uu.pm; if (pm >= NTILE_P || (pm & 7) == 0) continue;
            for (int it = tid; it < 2 * DFF; it += 512) {
                const int r = it / DFF, c = it - r * DFF;
                const float um2 = UH[((size_t)(pm - 1) * 2 + r) * DFF + c];
                const float um1 = (r == 0) ? UH[((size_t)(pm - 1) * 2 + 1) * DFF + c] : U01[((size_t)pm * 2) * DFF + c];
                const float u0 = U01[((size_t)pm * 2 + r) * DFF + c];
                const float y = w_ffc[c] * um2 + w_ffc[DFF + c] * um1 + w_ffc[2 * DFF + c] * u0;
                const float hv = y * __builtin_amdgcn_rcpf(1.0f + __builtin_amdgcn_exp2f(-1.4426950408889634f * y)) * G01[((size_t)pm * 2 + r) * DFF + c];
                HB[(size_t)(pm * 256 + r) * DFF + c] = (bf16_t)(cvt_pk_bf16(hv, 0.f) & 0xffffu);
            } }
          asm volatile("s_waitcnt vmcnt(0)" ::: "memory"); __syncthreads(); }
        epi::EpiResidual E{WSB(WS_XA), WSF(WS_SSP3)};
        pg8::gemm_phase(lds, g, S, E);
        { pg8::Gemm g2{DFF, DFF, DFF / 2}; SchedSplitK S2{(const char*)WSB(WS_H), (const char*)WSB(WS_WDN), G, bx};
          epi::EpiPartialF32 E2{WSF(WS_SPART)};
          pg8::gemm_phase(lds, g2, S2, E2); }
    }
    GRID_BAR();
    {
        PHASE_ARGS();
        const float* g_fin = IN(29); const bf16_t* XB = WSB(WS_XA);
        f32x4 gg[4];
#pragma unroll
        for (int j = 0; j < 4; ++j) gg[j] = *((const f32x4*)g_fin + lane + 64 * j);
        for (int m = 2 * gw; m < MP; m += 2 * NGW) {
            const float rs0 = epi::rstd16(WSF(WS_SSP3), m), rs1 = epi::rstd16(WSF(WS_SSP3), m + 1);
            const u32x2* x0 = (const u32x2*)(XB + (size_t)m * DM) + lane; const u32x2* x1 = x0 + DM / 4;
            u32x2 a[4], b[4];
#pragma unroll
            for (int j = 0; j < 4; ++j) { a[j] = __builtin_nontemporal_load(x0 + 64 * j); b[j] = __builtin_nontemporal_load(x1 + 64 * j); }
            f32x4* y0 = (f32x4*)(out + O_Y + (size_t)m * DM) + lane; f32x4* y1 = y0 + DM / 4;
#pragma unroll
            for (int j = 0; j < 4; ++j) {
                f32x4 v = {__uint_as_float(a[j].x << 16), __uint_as_float(a[j].x & 0xffff0000u), __uint_as_float(a[j].y << 16), __uint_as_float(a[j].y & 0xffff0000u)};
                f32x4 w = {__uint_as_float(b[j].x << 16), __uint_as_float(b[j].x & 0xffff0000u), __uint_as_float(b[j].y << 16), __uint_as_float(b[j].y & 0xffff0000u)};
                __builtin_nontemporal_store(v * gg[j] * rs0, y0 + 64 * j); __builtin_nontemporal_store(w * gg[j] * rs1, y1 + 64 * j);
            }
        }
        for (int r = gw; r < MS; r += NGW) {
            const u32x2* x0 = (const u32x2*)(XB + (size_t)(MP + r) * DM) + lane; const f32x4* sa = (const f32x4*)(WSF(WS_SPART) + (size_t)r * DM) + lane; const f32x4* sb = sa + (size_t)MS * DM / 4;
            f32x4 v[4]; float ss = 0.f;
#pragma unroll
            for (int j = 0; j < 4; ++j) { const u32x2 a = x0[64 * j];
                v[j] = (f32x4){__uint_as_float(a.x << 16), __uint_as_float(a.x & 0xffff0000u), __uint_as_float(a.y << 16), __uint_as_float(a.y & 0xffff0000u)} + sa[64 * j] + sb[64 * j];
                ss += (v[j][0] * v[j][0] + v[j][1] * v[j][1]) + (v[j][2] * v[j][2] + v[j][3] * v[j][3]); }
            const float rs = rsqrtf(wave_sum(ss) * (1.0f / DM) + EPS);
            f32x4* y0 = (f32x4*)(out + O_Y + (size_t)(MP + r) * DM) + lane;
#pragma unroll
            for (int j = 0; j < 4; ++j) y0[64 * j] = v[j] * gg[j] * rs;
        }
    }
}

extern "C" void kernel_launch(void* const* d_in, const int* in_sizes, int n_in, void* d_out, int out_size, void* d_ws, size_t ws_size, hipStream_t stream) {
    static int grid = 0;
    if (grid == 0) {
        if (n_in != 30 || (size_t)out_size != O_END || ws_size < WS_END) { fprintf(stderr, "kernel_launch: unexpected shapes: n_in %d out %d ws %zu (need %zu, %zu)\n", n_in, out_size, ws_size, (size_t)O_END, (size_t)WS_END); grid = -1; return; }
        int dev = 0, cus = 0, per_cu = 0;
        if (hipGetDevice(&dev) != hipSuccess || hipDeviceGetAttribute(&cus, hipDeviceAttributeMultiprocessorCount, dev) != hipSuccess) { grid = -1; return; }
        if (hipFuncSetAttribute((const void*)fwd_kernel, hipFuncAttributeMaxDynamicSharedMemorySize, LDS_BYTES) != hipSuccess) { fprintf(stderr, "kernel_launch: hipFuncSetAttribute failed\n"); grid = -1; return; }
        if (hipOccupancyMaxActiveBlocksPerMultiprocessor(&per_cu, (const void*)fwd_kernel, 512, LDS_BYTES) != hipSuccess || per_cu < 1) { fprintf(stderr, "kernel_launch: occupancy query says %d\n", per_cu); grid = -1; return; }
        grid = cus;
        fprintf(stderr, "kernel_launch: %d CUs, %d blocks/CU by the occupancy query, grid %d\n", cus, per_cu, grid);
    }
    if (grid < 0) return;
    if (hipMemsetAsync(d_ws, 0, 16384, stream) != hipSuccess) { fprintf(stderr, "kernel_launch: memset failed\n"); return; }
    Args a{};
    for (int i = 0; i < 30; ++i) a.in[i] = (const float*)d_in[i];
    a.out = (float*)d_out; a.ws = (unsigned char*)d_ws;
    void* args[] = {&a};
    const hipError_t e = hipLaunchCooperativeKernel((const void*)fwd_kernel, dim3(grid), dim3(512), args, LDS_BYTES, stream);
    if (e != hipSuccess) fprintf(stderr, "kernel_launch: cooperative launch failed: %s (grid %d)\n", hipGetErrorString(e), grid);
}
```

```cpp
#include <hip/hip_runtime.h>
#include <hip/hip_cooperative_groups.h>
#include <cstdio>
#include <cstdint>
namespace cg = cooperative_groups;

#define LAS __attribute__((address_space(3)))
typedef unsigned short bf16_t;
typedef short bf16x8 __attribute__((ext_vector_type(8)));
typedef short s16x4 __attribute__((ext_vector_type(4)));
typedef float f32x4 __attribute__((ext_vector_type(4)));
typedef float f32x2 __attribute__((ext_vector_type(2)));
typedef float f32x16 __attribute__((ext_vector_type(16)));
typedef unsigned u32x4 __attribute__((ext_vector_type(4)));
typedef unsigned u32x2 __attribute__((ext_vector_type(2)));

constexpr int DM = 1024, NB = 32, SEQ = 2048, DECT = 16, PAST = 1024;
constexpr int MP = NB * SEQ, MS = NB * DECT, RT = MP + MS;
constexpr int NTILE_P = MP / 256, NTILE = RT / 256;
constexpr int NH = 4, QKD = 64, VD = 128, NMEM = 256, XD = 256, DFF = 2816, INP = 3072, CW = 512;
constexpr int MMEM = NB * NMEM;
constexpr float EPS = 1e-6f;
constexpr float LAM_INIT = 0.2f;
constexpr int P1W = 2560;

constexpr size_t O_Y = 0;
constexpr size_t O_KP = (size_t)RT * DM;
constexpr size_t O_VP = O_KP + (size_t)MP * 512;
constexpr size_t O_SCP = O_VP + (size_t)MP * 512;
constexpr size_t O_FFP = O_SCP + (size_t)NB * 2 * CW;
constexpr size_t O_MK = O_FFP + (size_t)NB * 2 * DFF;
constexpr size_t O_MV = O_MK + (size_t)MMEM * DM;
constexpr size_t O_KS = O_MV + (size_t)MMEM * DM;
constexpr size_t O_VS = O_KS + (size_t)MS * 512;
constexpr size_t O_SCS = O_VS + (size_t)MS * 512;
constexpr size_t O_FFS = O_SCS + (size_t)NB * 2 * CW;
constexpr size_t O_END = O_FFS + (size_t)NB * 2 * DFF;

__device__ __forceinline__ unsigned cvt_pk_bf16(float lo, float hi) { unsigned r; asm volatile("v_cvt_pk_bf16_f32 %0, %1, %2" : "=v"(r) : "v"(lo), "v"(hi)); return r; }
__device__ __forceinline__ float bf2f(unsigned short h) { return __uint_as_float((unsigned)h << 16); }
#define DPPF(v, ctrl) __int_as_float(__builtin_amdgcn_update_dpp(0, __float_as_int(v), (ctrl), 0xf, 0xf, true))
__device__ __forceinline__ float xor16_sum(float v) { auto r = __builtin_amdgcn_permlane16_swap(__float_as_uint(v), __float_as_uint(v), false, false); return __uint_as_float(r[0]) + __uint_as_float(r[1]); }
__device__ __forceinline__ float xor32_sum(float v) { auto r = __builtin_amdgcn_permlane32_swap(__float_as_uint(v), __float_as_uint(v), false, false); return __uint_as_float(r[0]) + __uint_as_float(r[1]); }
__device__ __forceinline__ float xor16_max(float v) { auto r = __builtin_amdgcn_permlane16_swap(__float_as_uint(v), __float_as_uint(v), false, false); return fmaxf(__uint_as_float(r[0]), __uint_as_float(r[1])); }
__device__ __forceinline__ float xor32_max(float v) { auto r = __builtin_amdgcn_permlane32_swap(__float_as_uint(v), __float_as_uint(v), false, false); return fmaxf(__uint_as_float(r[0]), __uint_as_float(r[1])); }
__device__ __forceinline__ float other16(float v, int odd) { auto r = __builtin_amdgcn_permlane16_swap(__float_as_uint(v), __float_as_uint(v), false, false); return __uint_as_float(odd ? r[0] : r[1]); }
__device__ __forceinline__ float wave_sum(float v) {
    v += DPPF(v, 0xB1); v += DPPF(v, 0x4E); v += DPPF(v, 0x141); v += DPPF(v, 0x140);
    return xor32_sum(xor16_sum(v));
}
__device__ __forceinline__ float wave_max(float v) {
    v = fmaxf(v, DPPF(v, 0xB1)); v = fmaxf(v, DPPF(v, 0x4E)); v = fmaxf(v, DPPF(v, 0x141)); v = fmaxf(v, DPPF(v, 0x140));
    return xor32_max(xor16_max(v));
}
__device__ __forceinline__ float row_shr1(float v) { return __int_as_float(__builtin_amdgcn_update_dpp(__float_as_int(v), __float_as_int(v), 0x111, 0xf, 0xf, false)); }
__device__ __forceinline__ float row_shr2(float v) { return __int_as_float(__builtin_amdgcn_update_dpp(__float_as_int(v), __float_as_int(v), 0x112, 0xf, 0xf, false)); }

namespace pg8 {
constexpr int BM = 256, BK = 64, HALF = 128, HTB = HALF * BK * 2, STAGE_BYTES = 8 * HTB;
__host__ __device__ __forceinline__ int lds_byte(int r, int c) { const int st = (r >> 4) * 2 + (c >> 5), rr = r & 15, cc = c & 31, ob = rr * 64 + cc * 2; return st * 1024 + (ob ^ (((ob >> 9) & 1) << 5)); }
__host__ __device__ __forceinline__ void stage_rc(int b, int& R, int& C) { const int st = b / 1024, sb = b % 1024, swz = sb ^ (((sb >> 9) & 1) << 5); R = (st >> 1) * 16 + swz / 64; C = (st & 1) * 32 + (swz % 64) / 2; }
__host__ __device__ __forceinline__ int perm32(int rho) { const int n = rho >> 4, i = rho & 15; return 8 * (i >> 2) + 4 * n + (i & 3); }

struct Unit { const char* A; const char* B; int pm, pn; };
struct Gemm { int lda, ldb, K; };

template <class Epi, class Sched>
__device__ __forceinline__ void gemm_phase(LAS unsigned char* lds, const Gemm g, const Sched& S, const Epi& E) {
    int tid = threadIdx.x; asm volatile("" : "+v"(tid));
    const int wid = __builtin_amdgcn_readfirstlane(tid >> 6), lane = tid & 63, wr = wid >> 2, wc = wid & 3, fr = lane & 15, fq = lane >> 4;
    const int K = g.K, nt = K / BK;
    unsigned voffA[2], voffB[2];
#pragma unroll
    for (int i = 0; i < 2; ++i) { int R, C; stage_rc(tid * 16 + i * 8192, R, C); const int Rb = Epi::PERM ? ((R & ~31) + perm32(R & 31)) : R;
        voffA[i] = (unsigned)(R * g.lda + C) * 2u; voffB[i] = (unsigned)(Rb * g.ldb + C) * 2u; }
    const size_t kstep = (size_t)(BK * 2);
    const size_t hstepA = (size_t)HALF * g.lda * 2, hstepB = (size_t)HALF * g.ldb * 2;
    const unsigned ldsw = (unsigned)wid * 1024u;
    const int aoff = lds_byte(wr * 64 + fr, fq * 8), boff = lds_byte(wc * 32 + fr, fq * 8);
#define PG8_SA(b, h) (((b) * 2 + (h)) * HTB)
#define PG8_SB(b, h) ((4 + (b) * 2 + (h)) * HTB)
#define PG8_STAGE(bufoff, gbase, voff) do { _Pragma("unroll") for (int _i = 0; _i < 2; ++_i) \
        __builtin_amdgcn_global_load_lds((const unsigned*)((const char*)(gbase) + (voff)[_i]), (LAS unsigned*)(lds + (bufoff) + ldsw + _i * 8192), 16, 0, 0); } while (0)
#define PG8_LDA(dst, b, h) do { _Pragma("unroll") for (int m = 0; m < 4; ++m) _Pragma("unroll") for (int k = 0; k < 2; ++k) dst[m][k] = *(const LAS bf16x8*)(lds + PG8_SA(b, h) + aoff + m * 2048 + k * 1024); } while (0)
#define PG8_LDB(dst, b, h) do { _Pragma("unroll") for (int n = 0; n < 2; ++n) _Pragma("unroll") for (int k = 0; k < 2; ++k) dst[n][k] = *(const LAS bf16x8*)(lds + PG8_SB(b, h) + boff + n * 2048 + k * 1024); } while (0)
#define PG8_MMA(ai, bj, At, Bt) do { __builtin_amdgcn_s_setprio(1); _Pragma("unroll") for (int m = 0; m < 4; ++m) _Pragma("unroll") for (int n = 0; n < 2; ++n) _Pragma("unroll") for (int k = 0; k < 2; ++k) \
        acc[ai][bj][m][n] = __builtin_amdgcn_mfma_f32_16x16x32_bf16(Bt[n][k], At[m][k], acc[ai][bj][m][n], 0, 0, 0); __builtin_amdgcn_s_setprio(0); } while (0)
#define PG8_WAIT_V(n) asm volatile("s_waitcnt vmcnt(" #n ")" ::: "memory")
#define PG8_WAIT_L(n) asm volatile("s_waitcnt lgkmcnt(" #n ")" ::: "memory")
#define PG8_BAR __builtin_amdgcn_s_barrier()
#define PG8_SCHED __builtin_amdgcn_sched_barrier(0)
    Unit cur, nxt; int ui = 0;
    if (!S.next(0, cur)) return;
    f32x4 acc[2][2][4][2];
#pragma unroll
    for (int a = 0; a < 2; ++a)
#pragma unroll
        for (int b = 0; b < 2; ++b)
#pragma unroll
            for (int m = 0; m < 4; ++m)
#pragma unroll
                for (int n = 0; n < 2; ++n) acc[a][b][m][n] = (f32x4){0.f, 0.f, 0.f, 0.f};
    bf16x8 At[4][2], B0[2][2], B1[2][2];
    typename Epi::Pre pre{};
    const char* cA = cur.A; const char* cB = cur.B;
    PG8_STAGE(PG8_SB(0, 0), cB, voffB); PG8_STAGE(PG8_SB(0, 1), cB + hstepB, voffB); PG8_STAGE(PG8_SA(0, 0), cA, voffA); PG8_STAGE(PG8_SA(0, 1), cA + hstepA, voffA);
    if (wr == 1) PG8_BAR;
    PG8_WAIT_V(2); PG8_BAR;
    PG8_STAGE(PG8_SB(1, 0), cB + kstep, voffB); PG8_STAGE(PG8_SA(1, 0), cA + kstep, voffA); PG8_STAGE(PG8_SB(1, 1), cB + hstepB + kstep, voffB);
    PG8_WAIT_V(6); PG8_BAR;
    for (;;) {
        const bool has_next = S.next(ui + 1, nxt);
        const char* nA = has_next ? nxt.A : cA; const char* nB = has_next ? nxt.B : cB;
        for (int t = 0; t < nt; t += 2) {
            const bool last = (t == nt - 2);
            if (Epi::EARLY && last) pre = E.prefetch(cur, wr, wc, fr, fq);
            const char* a1 = cA + (size_t)(t + 1) * kstep;
            const char* a2 = last ? nA : cA + (size_t)(t + 2) * kstep; const char* b2 = last ? nB : cB + (size_t)(t + 2) * kstep;
            const char* a3 = a2 + kstep; const char* b3 = b2 + kstep;
            PG8_LDB(B0, 0, 0); PG8_LDB(B1, 0, 1); PG8_SCHED; PG8_LDA(At, 0, 0); PG8_STAGE(PG8_SA(1, 1), a1 + hstepA, voffA);
            PG8_WAIT_V(8); PG8_WAIT_L(0); PG8_BAR; PG8_MMA(0, 0, At, B0); PG8_MMA(0, 1, At, B1); PG8_BAR; PG8_SCHED;
            PG8_LDA(At, 0, 1); PG8_STAGE(PG8_SB(0, 0), b2, voffB); PG8_STAGE(PG8_SB(0, 1), b2 + hstepB, voffB); PG8_STAGE(PG8_SA(0, 0), a2, voffA);
            PG8_WAIT_V(8); PG8_WAIT_L(0); PG8_BAR; PG8_MMA(1, 0, At, B0); PG8_MMA(1, 1, At, B1); PG8_BAR; PG8_SCHED;
            PG8_LDB(B0, 1, 0); PG8_LDB(B1, 1, 1); PG8_SCHED; PG8_LDA(At, 1, 0); PG8_STAGE(PG8_SA(0, 1), a2 + hstepA, voffA);
            PG8_WAIT_V(8); PG8_WAIT_L(0); PG8_BAR; PG8_MMA(0, 0, At, B0); PG8_MMA(0, 1, At, B1); PG8_BAR; PG8_SCHED;
            PG8_LDA(At, 1, 1); PG8_STAGE(PG8_SB(1, 0), b3, voffB); PG8_STAGE(PG8_SB(1, 1), b3 + hstepB, voffB); PG8_STAGE(PG8_SA(1, 0), a3, voffA);
            PG8_WAIT_V(8); PG8_WAIT_L(0); PG8_BAR; PG8_MMA(1, 0, At, B0); PG8_MMA(1, 1, At, B1); PG8_BAR; PG8_SCHED;
        }
        if (wr == 0) PG8_BAR;
        if (!Epi::EARLY) pre = E.prefetch(cur, wr, wc, fr, fq);
        E(acc, cur, pre, wr, wc, fr, fq);
        if (!has_next) break;
#pragma unroll
        for (int a = 0; a < 2; ++a)
#pragma unroll
            for (int b = 0; b < 2; ++b)
#pragma unroll
                for (int m = 0; m < 4; ++m)
#pragma unroll
                    for (int n = 0; n < 2; ++n) acc[a][b][m][n] = (f32x4){0.f, 0.f, 0.f, 0.f};
        cur = nxt; cA = nA; cB = nB; ++ui;
        if (wr == 1) PG8_BAR;
    }
    PG8_WAIT_V(0);
    PG8_BAR;
#undef PG8_SA
#undef PG8_SB
#undef PG8_STAGE
#undef PG8_LDA
#undef PG8_LDB
#undef PG8_MMA
}
}
namespace epi {
using pg8::Unit;
typedef f32x4 Acc[2][2][4][2];
#define EPI_BAR() do { asm volatile("s_waitcnt lgkmcnt(0)" ::: "memory"); __builtin_amdgcn_s_barrier(); asm volatile("" ::: "memory"); } while (0)

__device__ __forceinline__ u32x4 pack8(const f32x4 a, const f32x4 b) { u32x4 w; w.x = cvt_pk_bf16(a[0], a[1]); w.y = cvt_pk_bf16(a[2], a[3]); w.z = cvt_pk_bf16(b[0], b[1]); w.w = cvt_pk_bf16(b[2], b[3]); return w; }
__device__ __forceinline__ u32x2 pack4(const f32x4 a) { u32x2 w; w.x = cvt_pk_bf16(a[0], a[1]); w.y = cvt_pk_bf16(a[2], a[3]); return w; }
__device__ __forceinline__ int row_pos(int row) { return row < MP ? (row & (SEQ - 1)) : PAST + ((row - MP) & (DECT - 1)); }
__device__ __forceinline__ f32x4 oth4(const f32x4 v, int odd) { f32x4 r; r[0] = other16(v[0], odd); r[1] = other16(v[1], odd); r[2] = other16(v[2], odd); r[3] = other16(v[3], odd); return r; }
__device__ __forceinline__ void store8_f32(float* p  , const f32x4 v0, const f32x4 v1, int fq) {
    f32x4 x, y;
#pragma unroll
    for (int j = 0; j < 4; ++j) { auto r = __builtin_amdgcn_permlane16_swap(__float_as_uint(v0[j]), __float_as_uint(v1[j]), false, false); x[j] = __uint_as_float(r[0]); y[j] = __uint_as_float(r[1]); }
    float* q = p + 16 * (fq >> 1) + 4 * (fq & 1);
    __builtin_nontemporal_store(x, (f32x4*)q); __builtin_nontemporal_store(y, (f32x4*)(q + 8));
}
struct PreNone {};
struct Pre8 { float v[8]; };
__device__ __forceinline__ Pre8 load8rows(const float* __restrict__ p, int row0) {
    Pre8 r;
#pragma unroll
    for (int i = 0; i < 8; ++i) r.v[i] = p[row0 + (i >> 2) * 128 + (i & 3) * 16];
    return r;
}
__device__ __forceinline__ void rope_cs(int pos, int n, f32x4& c, f32x4& s) {
    const float fp = (float)pos;
    const f32x4 k = n == 0 ? (f32x4){1.5915494309e-01f, 3.0863763405e-02f, 5.9851857127e-03f, 1.1606636412e-03f} : (f32x4){2.2507907904e-04f, 4.3647952793e-05f, 8.4643308082e-06f, 1.6414262628e-06f};
#pragma unroll
    for (int j = 0; j < 4; ++j) { const float r = __builtin_amdgcn_fractf(fp * k[j]); c[j] = __builtin_amdgcn_cosf(r); s[j] = __builtin_amdgcn_sinf(r); }
}

struct EpiInProj {
    static constexpr bool PERM = true, EARLY = true;
    typedef Pre8 Pre;
    const float* ssq;
    bf16_t* p1;
    float* out;
    __device__ __forceinline__ Pre prefetch(const Unit& u, int wr, int wc, int fr, int fq) const { return load8rows(ssq, u.pm * 256 + wr * 64 + fr); }
    __device__ __forceinline__ void operator()(Acc& acc, const Unit& u, const Pre& pre, int wr, int wc, int fr, int fq) const {
        const int pn = u.pn, row0 = u.pm * 256 + wr * 64 + fr;
        const int cl = 32 * wc + 8 * fq;
#pragma unroll
        for (int ai = 0; ai < 2; ++ai)
#pragma unroll
            for (int m = 0; m < 4; ++m) {
                const int row = row0 + ai * 128 + m * 16;
                const float rs = rsqrtf(pre.v[ai * 4 + m] * (1.0f / DM) + EPS);
                bf16_t* prow = p1 + (size_t)row * P1W;
                if (pn < 4) {
                    f32x4 c0, c1, s0, s1; const int pos = row_pos(row);
                    if ((wc & 1) == 0) { rope_cs(pos, 0, c0, s0); rope_cs(pos, 1, c1, s1); }
                    float* orow = (pn >= 2) ? (row < MP ? out + O_KP + (size_t)row * 512 : out + O_KS + (size_t)(row - MP) * 512) : nullptr;
#pragma unroll
                    for (int bj = 0; bj < 2; ++bj) {
                        f32x4 v0 = acc[ai][bj][m][0] * rs, v1 = acc[ai][bj][m][1] * rs;
                        if ((wc & 1) == 0) {
                            const f32x4 o0 = oth4(v0, fq & 1), o1 = oth4(v1, fq & 1);
                            if (fq == 0) { v0 = v0 * c0 - o0 * s0; v1 = v1 * c1 - o1 * s1; }
                            else if (fq == 1) { v0 = v0 * c0 + o0 * s0; v1 = v1 * c1 + o1 * s1; }
                        }
                        const int c = (pn & 1) * 256 + bj * 128 + cl;
                        if (pn >= 2) store8_f32(orow + c - 8 * fq, v0, v1, fq);
                        *(u32x4*)(prow + (pn >> 1) * 512 + c) = pack8(v0, v1);
                    }
                } else if (pn < 6) {
                    float* orow = row < MP ? out + O_VP + (size_t)row * 512 : out + O_VS + (size_t)(row - MP) * 512;
#pragma unroll
                    for (int bj = 0; bj < 2; ++bj) {
                        const f32x4 v0 = acc[ai][bj][m][0] * rs, v1 = acc[ai][bj][m][1] * rs;
                        const int c = (pn & 1) * 256 + bj * 128 + cl;
                        store8_f32(orow + c - 8 * fq, v0, v1, fq);
                        *(u32x4*)(prow + 1024 + c) = pack8(v0, v1);
                    }
                } else if (pn < 8) {
#pragma unroll
                    for (int bj = 0; bj < 2; ++bj) {
                        const f32x4 v0 = acc[ai][bj][m][0] * rs, v1 = acc[ai][bj][m][1] * rs;
                        const int c = (pn & 1) * 256 + bj * 128 + cl;
                        *(u32x4*)(prow + 1536 + c) = pack8(v0, v1);
                    }
                } else {
                    const float rs2 = rs * rs;
                    const f32x4 v0 = acc[ai][0][m][0] * acc[ai][1][m][0] * rs2, v1 = acc[ai][0][m][1] * acc[ai][1][m][1] * rs2;
                    const int c = (pn - 8) * 128 + cl;
                    *(u32x4*)(prow + 2048 + c) = pack8(v0, v1);
                    if (row < MP) { const int t = row & (SEQ - 1); if (t >= SEQ - 2) { float* o = out + O_SCP + ((size_t)(row >> 11) * 2 + (t - (SEQ - 2))) * CW + c; *(f32x4*)o = v0; *(f32x4*)(o + 4) = v1; } }
                    else { const int t = (row - MP) & (DECT - 1); if (t >= DECT - 2) { float* o = out + O_SCS + ((size_t)((row - MP) >> 4) * 2 + (t - (DECT - 2))) * CW + c; *(f32x4*)o = v0; *(f32x4*)(o + 4) = v1; } }
                }
            }
    }
};

struct EpiMemKV {
    static constexpr bool PERM = true, EARLY = true;
    typedef Pre8 Pre;
    const float* ssq; bf16_t* mk; bf16_t* mv; float* out;
    __device__ __forceinline__ Pre prefetch(const Unit& u, int wr, int wc, int fr, int fq) const { return load8rows(ssq, u.pm * 256 + wr * 64 + fr); }
    __device__ __forceinline__ void operator()(Acc& acc, const Unit& u, const Pre& pre, int wr, int wc, int fr, int fq) const {
        const int pn = u.pn, row0 = u.pm * 256 + wr * 64 + fr, cl = 32 * wc + 8 * fq;
        float* ob = out + (pn < 4 ? O_MK : O_MV); bf16_t* bb = pn < 4 ? mk : mv;
#pragma unroll
        for (int ai = 0; ai < 2; ++ai)
#pragma unroll
            for (int m = 0; m < 4; ++m) {
                const int row = row0 + ai * 128 + m * 16;
                const float rs = rsqrtf(pre.v[ai * 4 + m] * (1.0f / DM) + EPS);
#pragma unroll
                for (int bj = 0; bj < 2; ++bj) {
                    const f32x4 v0 = acc[ai][bj][m][0] * rs, v1 = acc[ai][bj][m][1] * rs;
                    const int c = (pn & 3) * 256 + bj * 128 + cl;
                    store8_f32(ob + (size_t)row * DM + c - 8 * fq, v0, v1, fq);
                    *(u32x4*)(bb + (size_t)row * DM + c) = pack8(v0, v1);
                }
            }
    }
};

struct EpiResidual {
    static constexpr bool PERM = true, EARLY = false;
    typedef PreNone Pre;
    bf16_t* XB; float* ssp;
    __device__ __forceinline__ Pre prefetch(const Unit&, int, int, int, int) const { return Pre{}; }
    __device__ __forceinline__ void operator()(Acc& acc, const Unit& u, const Pre&, int wr, int wc, int fr, int fq) const {
        const int row0 = u.pm * 256 + wr * 64 + fr, col0 = u.pn * 256 + wc * 32 + 8 * fq;
        bf16_t* xb = XB + (size_t)row0 * DM + col0;
        u32x4 old[8][2];
#pragma unroll
        for (int g = 0; g < 8; ++g)
#pragma unroll
            for (int bj = 0; bj < 2; ++bj) old[g][bj] = *(const u32x4*)(xb + (size_t)((g >> 2) * 128 + (g & 3) * 16) * DM + bj * 128);
#pragma unroll
        for (int g = 0; g < 8; ++g) {
            const int ai = g >> 2, m = g & 3, row = row0 + ai * 128 + m * 16; float ss = 0.f;
#pragma unroll
            for (int bj = 0; bj < 2; ++bj) {
                const u32x4 o = old[g][bj]; f32x4 v0, v1;
                v0[0] = __uint_as_float(o.x << 16) + acc[ai][bj][m][0][0]; v0[1] = __uint_as_float(o.x & 0xffff0000u) + acc[ai][bj][m][0][1]; v0[2] = __uint_as_float(o.y << 16) + acc[ai][bj][m][0][2]; v0[3] = __uint_as_float(o.y & 0xffff0000u) + acc[ai][bj][m][0][3];
                v1[0] = __uint_as_float(o.z << 16) + acc[ai][bj][m][1][0]; v1[1] = __uint_as_float(o.z & 0xffff0000u) + acc[ai][bj][m][1][1]; v1[2] = __uint_as_float(o.w << 16) + acc[ai][bj][m][1][2]; v1[3] = __uint_as_float(o.w & 0xffff0000u) + acc[ai][bj][m][1][3];
                ss += ((v0[0] * v0[0] + v0[1] * v0[1]) + (v0[2] * v0[2] + v0[3] * v0[3])) + ((v1[0] * v1[0] + v1[1] * v1[1]) + (v1[2] * v1[2] + v1[3] * v1[3]));
                *(u32x4*)(xb + (size_t)(ai * 128 + m * 16) * DM + bj * 128) = pack8(v0, v1);
            }
            ss = xor32_sum(xor16_sum(ss));
            if (fq == 0) ssp[(size_t)row * 16 + u.pn * 4 + wc] = ss;
        }
    }
};
struct EpiResidualOut {
    static constexpr bool PERM = false, EARLY = false;
    typedef PreNone Pre;
    const bf16_t* XB; float* X; float* ssp;
    __device__ __forceinline__ Pre prefetch(const Unit&, int, int, int, int) const { return Pre{}; }
    __device__ __forceinline__ void operator()(Acc& acc, const Unit& u, const Pre&, int wr, int wc, int fr, int fq) const {
        const int row0 = u.pm * 256 + wr * 64 + fr, col0 = u.pn * 256 + wc * 32 + 4 * fq;
        const bf16_t* xb = XB + (size_t)row0 * DM + col0;
        u32x2 old[8][2][2];
#pragma unroll
        for (int g = 0; g < 8; ++g)
#pragma unroll
            for (int bj = 0; bj < 2; ++bj)
#pragma unroll
                for (int n = 0; n < 2; ++n) old[g][bj][n] = *(const u32x2*)(xb + (size_t)((g >> 2) * 128 + (g & 3) * 16) * DM + bj * 128 + n * 16);
#pragma unroll
        for (int g = 0; g < 8; ++g) {
            const int ai = g >> 2, m = g & 3, row = row0 + ai * 128 + m * 16; float* xrow = X + (size_t)row * DM + col0; float ss = 0.f;
#pragma unroll
            for (int bj = 0; bj < 2; ++bj)
#pragma unroll
                for (int n = 0; n < 2; ++n) {
                    const u32x2 o = old[g][bj][n]; f32x4 v;
                    v[0] = __uint_as_float(o.x << 16) + acc[ai][bj][m][n][0]; v[1] = __uint_as_float(o.x & 0xffff0000u) + acc[ai][bj][m][n][1]; v[2] = __uint_as_float(o.y << 16) + acc[ai][bj][m][n][2]; v[3] = __uint_as_float(o.y & 0xffff0000u) + acc[ai][bj][m][n][3];
                    ss += (v[0] * v[0] + v[1] * v[1]) + (v[2] * v[2] + v[3] * v[3]);
                    *(f32x4*)(xrow + bj * 128 + n * 16) = v;
                }
            ss = xor32_sum(xor16_sum(ss));
            if (fq == 0) ssp[(size_t)row * 16 + u.pn * 4 + wc] = ss;
        }
    }
};
__device__ __forceinline__ float rstd16(const float* ssp, int row) {
    const f32x4* p = (const f32x4*)(ssp + (size_t)row * 16); const f32x4 a = p[0], b = p[1], c = p[2], d = p[3];
    const float s = ((a[0] + a[1]) + (a[2] + a[3])) + ((b[0] + b[1]) + (b[2] + b[3])) + ((c[0] + c[1]) + (c[2] + c[3])) + ((d[0] + d[1]) + (d[2] + d[3]));
    return rsqrtf(s * (1.0f / DM) + EPS);
}
struct EpiScaleBf16 {
    static constexpr bool PERM = true, EARLY = true;
    typedef Pre8 Pre;
    const float* rs; bf16_t* O; int ldo;
    __device__ __forceinline__ Pre prefetch(const Unit& u, int wr, int wc, int fr, int fq) const { return load8rows(rs, u.pm * 256 + wr * 64 + fr); }
    __device__ __forceinline__ void operator()(Acc& acc, const Unit& u, const Pre& pre, int wr, int wc, int fr, int fq) const {
        const int row0 = u.pm * 256 + wr * 64 + fr, col0 = u.pn * 256 + 32 * wc + 8 * fq;
#pragma unroll
        for (int ai = 0; ai < 2; ++ai)
#pragma unroll
            for (int m = 0; m < 4; ++m) {
                const int row = row0 + ai * 128 + m * 16; const float r = pre.v[ai * 4 + m];
#pragma unroll
                for (int bj = 0; bj < 2; ++bj) *(u32x4*)(O + (size_t)row * ldo + col0 + bj * 128) = pack8(acc[ai][bj][m][0] * r, acc[ai][bj][m][1] * r);
            }
    }
};
struct EpiXScores {
    static constexpr bool PERM = true, EARLY = false;
    typedef PreNone Pre;
    __device__ __forceinline__ Pre prefetch(const Unit&, int, int, int, int) const { return Pre{}; }
    bf16_t* P; float* lp; LAS float* red;
    __device__ __forceinline__ void operator()(Acc& acc, const Unit& u, const Pre&, int wr, int wc, int fr, int fq) const {
        constexpr float C = 0.0625f * 1.4426950408889634f;
        float mx[2][4];
#pragma unroll
        for (int ai = 0; ai < 2; ++ai)
#pragma unroll
            for (int m = 0; m < 4; ++m) {
                float a = -3.0e38f;
#pragma unroll
                for (int bj = 0; bj < 2; ++bj)
#pragma unroll
                    for (int n = 0; n < 2; ++n) { const f32x4 v = acc[ai][bj][m][n]; a = fmaxf(a, fmaxf(fmaxf(v[0], v[1]), fmaxf(v[2], v[3]))); }
                a = xor32_max(xor16_max(a));
                if (fq == 0) red[(ai * 128 + wr * 64 + m * 16 + fr) * 4 + wc] = a;
            }
        EPI_BAR();
#pragma unroll
        for (int ai = 0; ai < 2; ++ai)
#pragma unroll
            for (int m = 0; m < 4; ++m) { const f32x4 r = *(const LAS f32x4*)(red + (ai * 128 + wr * 64 + m * 16 + fr) * 4); mx[ai][m] = fmaxf(fmaxf(r[0], r[1]), fmaxf(r[2], r[3])); }
        const int row0 = u.pm * 256 + wr * 64 + fr, col0 = u.pn * 256 + 32 * wc + 8 * fq;
#pragma unroll
        for (int ai = 0; ai < 2; ++ai)
#pragma unroll
            for (int m = 0; m < 4; ++m) {
                const int row = row0 + ai * 128 + m * 16; const float mc = mx[ai][m] * C; float s = 0.f;
#pragma unroll
                for (int bj = 0; bj < 2; ++bj) {
#pragma unroll
                    for (int j = 0; j < 4; ++j) { acc[ai][bj][m][0][j] = __builtin_amdgcn_exp2f(acc[ai][bj][m][0][j] * C - mc); acc[ai][bj][m][1][j] = __builtin_amdgcn_exp2f(acc[ai][bj][m][1][j] * C - mc); }
                    const u32x4 w = pack8(acc[ai][bj][m][0], acc[ai][bj][m][1]);
                    s += (__uint_as_float(w.x << 16) + __uint_as_float(w.x & 0xffff0000u)) + (__uint_as_float(w.y << 16) + __uint_as_float(w.y & 0xffff0000u))
                       + (__uint_as_float(w.z << 16) + __uint_as_float(w.z & 0xffff0000u)) + (__uint_as_float(w.w << 16) + __uint_as_float(w.w & 0xffff0000u));
                    *(u32x4*)(P + (size_t)row * DM + col0 + bj * 128) = w;
                }
                s = xor32_sum(xor16_sum(s));
                if (fq == 0) lp[(size_t)row * 16 + u.pn * 4 + wc] = s;
                asm volatile("" ::: "memory");
            }
        EPI_BAR();
    }
};
struct EpiXPV {
    static constexpr bool PERM = true, EARLY = false;
    typedef PreNone Pre;
    __device__ __forceinline__ Pre prefetch(const Unit&, int, int, int, int) const { return Pre{}; }
    const float* lp; bf16_t* O;
    __device__ __forceinline__ void operator()(Acc& acc, const Unit& u, const Pre&, int wr, int wc, int fr, int fq) const {
        const int row0 = u.pm * 256 + wr * 64 + fr, col0 = u.pn * 256 + 32 * wc + 8 * fq;
#pragma unroll
        for (int ai = 0; ai < 2; ++ai)
#pragma unroll
            for (int m = 0; m < 4; ++m) {
                const int row = row0 + ai * 128 + m * 16; const f32x4 l4 = *(const f32x4*)(lp + (size_t)row * 16 + u.pn * 4);
                const float rl = 1.0f / ((l4[0] + l4[1]) + (l4[2] + l4[3]));
#pragma unroll
                for (int bj = 0; bj < 2; ++bj) *(u32x4*)(O + (size_t)row * DM + col0 + bj * 128) = pack8(acc[ai][bj][m][0] * rl, acc[ai][bj][m][1] * rl);
            }
    }
};
struct EpiUpGate {
    static constexpr bool PERM = true, EARLY = false;
    typedef Pre8 Pre;
    const float* rs; const float* wconv;
    const float* state;
    bf16_t* H; float* out;
    float* uh; float* u01; float* g01;
    LAS float* tail;
    __device__ __forceinline__ Pre prefetch(const Unit& u, int wr, int wc, int fr, int fq) const { return load8rows(rs, u.pm * 256 + wr * 64 + fr); }
    __device__ __forceinline__ void operator()(Acc& acc, const Unit& u, const Pre& pre, int wr, int wc, int fr, int fq) const {
        const int pm = u.pm, pn = u.pn, row0 = pm * 256 + wr * 64 + fr, cl = 32 * wc + 8 * fq, gc = pn * 128 + cl;
        const bool sample = pm >= NTILE_P;
        const f32x4 w00 = *(const f32x4*)(wconv + gc), w01 = *(const f32x4*)(wconv + gc + 4), w10 = *(const f32x4*)(wconv + DFF + gc), w11 = *(const f32x4*)(wconv + DFF + gc + 4),
                    w20 = *(const f32x4*)(wconv + 2 * DFF + gc), w21 = *(const f32x4*)(wconv + 2 * DFF + gc + 4);
#pragma unroll
        for (int ai = 0; ai < 2; ++ai)
#pragma unroll
            for (int m = 0; m < 4; ++m) {
                const int g = ai * 8 + wr * 4 + m; const float r = pre.v[ai * 4 + m];
#pragma unroll
                for (int bj = 0; bj < 2; ++bj)
#pragma unroll
                    for (int n = 0; n < 2; ++n) acc[ai][bj][m][n] *= r;
                if (fr >= 14) {
                    LAS float* t = tail + (g * 2 + (fr - 14)) * 128 + cl; *(LAS f32x4*)t = acc[ai][0][m][0]; *(LAS f32x4*)(t + 4) = acc[ai][0][m][1];
                    if (sample) { float* o = out + O_FFS + ((size_t)((pm - NTILE_P) * 16 + g) * 2 + (fr - 14)) * DFF + gc; *(f32x4*)o = acc[ai][0][m][0]; *(f32x4*)(o + 4) = acc[ai][0][m][1]; }
                    else if (g == 15) {
                        float* o = uh + ((size_t)pm * 2 + (fr - 14)) * DFF + gc; *(f32x4*)o = acc[ai][0][m][0]; *(f32x4*)(o + 4) = acc[ai][0][m][1];
                        if ((pm & 7) == 7) { float* q = out + O_FFP + ((size_t)(pm >> 3) * 2 + (fr - 14)) * DFF + gc; *(f32x4*)q = acc[ai][0][m][0]; *(f32x4*)(q + 4) = acc[ai][0][m][1]; }
                    }
                }
                if (!sample && g == 0 && fr < 2) {
                    float* o = u01 + ((size_t)pm * 2 + fr) * DFF + gc; *(f32x4*)o = acc[ai][0][m][0]; *(f32x4*)(o + 4) = acc[ai][0][m][1];
                    float* q = g01 + ((size_t)pm * 2 + fr) * DFF + gc; *(f32x4*)q = acc[ai][1][m][0]; *(f32x4*)(q + 4) = acc[ai][1][m][1];
                }
            }
        EPI_BAR();
#pragma unroll
        for (int ai = 0; ai < 2; ++ai)
#pragma unroll
            for (int m = 0; m < 4; ++m) {
                const int row = row0 + ai * 128 + m * 16, g = ai * 8 + wr * 4 + m;
                f32x4 h1[2] = {(f32x4){0.f, 0.f, 0.f, 0.f}, (f32x4){0.f, 0.f, 0.f, 0.f}}, h2[2] = {(f32x4){0.f, 0.f, 0.f, 0.f}, (f32x4){0.f, 0.f, 0.f, 0.f}};
                if (fr < 2) {
                    if (sample) { const float* s = state + (size_t)((pm - NTILE_P) * 16 + g) * 2 * DFF + gc; h2[0] = *(const f32x4*)(s + fr * DFF); h2[1] = *(const f32x4*)(s + fr * DFF + 4); h1[0] = *(const f32x4*)(s + DFF); h1[1] = *(const f32x4*)(s + DFF + 4); }
                    else if (g > 0) { const LAS float* t = tail + ((g - 1) * 2) * 128 + cl; h2[0] = *(const LAS f32x4*)(t + fr * 128); h2[1] = *(const LAS f32x4*)(t + fr * 128 + 4); h1[0] = *(const LAS f32x4*)(t + 128); h1[1] = *(const LAS f32x4*)(t + 132); }
                }
                f32x4 hv[2];
#pragma unroll
                for (int n = 0; n < 2; ++n) {
                    const f32x4 uc = acc[ai][0][m][n]; f32x4 p1, p2;
#pragma unroll
                    for (int j = 0; j < 4; ++j) {
                        p1[j] = __int_as_float(__builtin_amdgcn_update_dpp(__float_as_int(h1[n][j]), __float_as_int(uc[j]), 0x111, 0xf, 0xf, false));
                        p2[j] = __int_as_float(__builtin_amdgcn_update_dpp(__float_as_int(h2[n][j]), __float_as_int(uc[j]), 0x112, 0xf, 0xf, false)); }
                    const f32x4 y = (n == 0 ? w00 : w01) * p2 + (n == 0 ? w10 : w11) * p1 + (n == 0 ? w20 : w21) * uc;
                    const f32x4 t = y * (-1.4426950408889634f); f32x4 d;
#pragma unroll
                    for (int j = 0; j < 4; ++j) d[j] = __builtin_amdgcn_exp2f(t[j]);
                    d = d + 1.0f;
#pragma unroll
                    for (int j = 0; j < 4; ++j) d[j] = __builtin_amdgcn_rcpf(d[j]);
                    hv[n] = (y * d) * acc[ai][1][m][n];
                }
                *(u32x4*)(H + (size_t)row * DFF + gc) = pack8(hv[0], hv[1]);
            }
        EPI_BAR();
    }
};
struct EpiPartialF32 {
    static constexpr bool PERM = false, EARLY = false;
    typedef PreNone Pre;
    float* S;
    __device__ __forceinline__ Pre prefetch(const Unit&, int, int, int, int) const { return Pre{}; }
    __device__ __forceinline__ void operator()(Acc& acc, const Unit& u, const Pre&, int wr, int wc, int fr, int fq) const {
        const int kh = u.pn >> 4, pn = u.pn & 15, row0 = (u.pm - NTILE_P) * 256 + wr * 64 + fr, col0 = pn * 256 + wc * 32 + 4 * fq;
        float* b = S + (size_t)kh * MS * DM + (size_t)row0 * DM + col0;
#pragma unroll
        for (int ai = 0; ai < 2; ++ai)
#pragma unroll
            for (int m = 0; m < 4; ++m)
#pragma unroll
                for (int bj = 0; bj < 2; ++bj)
#pragma unroll
                    for (int n = 0; n < 2; ++n) *(f32x4*)(b + (size_t)(ai * 128 + m * 16) * DM + bj * 128 + n * 16) = acc[ai][bj][m][n];
    }
};
}
namespace dattn {
constexpr int NW = 8, QBLK = 32, KVBLK = 64;
constexpr float SCALE = 0.125f, THR = 8.f;
constexpr int SHM_V = KVBLK * 128 * 2, SHM_K = KVBLK * 128 * 2, SHM_ATTN = 2 * SHM_V + 2 * SHM_K + NW * 64 * 4;
#define KSWZ(row, colB) ((row) * 256 + ((colB) ^ (((row) & 7) << 4)))
#define SBAR() __builtin_amdgcn_sched_barrier(0)
__device__ __forceinline__ int crow(int r, int hi) { return (r & 3) + 8 * (r >> 2) + 4 * hi; }
__device__ __forceinline__ void partialSM(f32x16& p0, f32x16& p1, float& m_reg, float& mn, float& alpha) {
  constexpr float C = SCALE * 1.4426950408889634f;
  float pmax = p0[0];
#pragma unroll
  for (int r = 1; r < 16; ++r) pmax = fmaxf(pmax, p0[r]);
#pragma unroll
  for (int r = 0; r < 16; ++r) pmax = fmaxf(pmax, p1[r]);
  { auto rr = __builtin_amdgcn_permlane32_swap(__float_as_uint(pmax), __float_as_uint(pmax), false, false);
    pmax = fmaxf(__uint_as_float(rr[0]), __uint_as_float(rr[1])); }
  if (__builtin_expect(__all(pmax - m_reg <= THR / SCALE), 1)) { mn = m_reg; alpha = 1.f; }
  else { mn = fmaxf(m_reg, pmax); alpha = __builtin_amdgcn_exp2f((m_reg - mn) * C); m_reg = mn; }
  const float mnC = -mn * C;
#pragma unroll
  for (int r = 0; r < 16; ++r) p0[r] = fmaf(p0[r], C, mnC);
#pragma unroll
  for (int r = 0; r < 16; ++r) p1[r] = fmaf(p1[r], C, mnC);
#pragma unroll
  for (int r = 0; r < 16; ++r) p0[r] = __builtin_amdgcn_exp2f(p0[r]);
}
__device__ __forceinline__ void finishSM(f32x16& p0, f32x16& p1, float alpha, float& l_reg, bf16x8& pa0, bf16x8& pa1, bf16x8& pa2, bf16x8& pa3) {
#pragma unroll
  for (int r = 0; r < 16; ++r) p1[r] = __builtin_amdgcn_exp2f(p1[r]);
  float ps = 0;
#pragma unroll
  for (int r = 0; r < 16; ++r) ps += p0[r];
#pragma unroll
  for (int r = 0; r < 16; ++r) ps += p1[r];
  { auto rr = __builtin_amdgcn_permlane32_swap(__float_as_uint(ps), __float_as_uint(ps), false, false);
    ps = __uint_as_float(rr[0]) + __uint_as_float(rr[1]); }
  l_reg = l_reg * alpha + ps;
#define PK4(P, BASE, OUT) do { unsigned a0 = cvt_pk_bf16(P[BASE + 0], P[BASE + 1]), a1 = cvt_pk_bf16(P[BASE + 2], P[BASE + 3]);   \
    unsigned b0 = cvt_pk_bf16(P[BASE + 4], P[BASE + 5]), b1 = cvt_pk_bf16(P[BASE + 6], P[BASE + 7]);                              \
    auto r0 = __builtin_amdgcn_permlane32_swap(a0, b0, false, false); auto r1 = __builtin_amdgcn_permlane32_swap(a1, b1, false, false); \
    u32x4 w = {r0[0], r1[0], r0[1], r1[1]}; OUT = *reinterpret_cast<bf16x8*>(&w); } while (0)
  PK4(p0, 0, pa0); PK4(p0, 8, pa1); PK4(p1, 0, pa2); PK4(p1, 8, pa3);
#undef PK4
}
__device__ __forceinline__ void qkt(f32x16& p0, f32x16& p1, const char* Ks, const bf16x8* qr, int r32, int hi, int mp) {
  p0 = f32x16{}; p1 = f32x16{};
#pragma unroll
  for (int d0 = 0; d0 < 4; ++d0) { const int cb = (mp * 64 + d0 * 16 + hi * 8) * 2;
    const bf16x8 b0 = *reinterpret_cast<const bf16x8*>(Ks + KSWZ(r32, cb));
    const bf16x8 b1 = *reinterpret_cast<const bf16x8*>(Ks + KSWZ(32 + r32, cb));
    p0 = __builtin_amdgcn_mfma_f32_32x32x16_bf16(b0, qr[d0], p0, 0, 0, 0);
    p1 = __builtin_amdgcn_mfma_f32_32x32x16_bf16(b1, qr[d0], p1, 0, 0, 0); }
}
__device__ __forceinline__ int v_st(int k, int c) { const int kk = (k & ~0xC) | ((k & 4) << 1) | ((k & 8) >> 1); return ((kk >> 3) * 4 + (c >> 5)) * 512 + ((kk & 7) * 32 + (c & 31)) * 2; }
__device__ __forceinline__ int v_rd_base(int lane) { return ((lane & 3) << 3) | (((lane >> 2) & 3) << 6) | (((lane >> 4) & 1) << 5) | (((lane >> 5) & 1) << 8); }
constexpr int v_rd_off(int d0, int ks, int half) { return d0 * 512 + ks * 4096 + half * 2048; }
template <int OFF> __device__ __forceinline__ s16x4 tr_read(int vb) {
  s16x4 r; asm volatile("ds_read_b64_tr_b16 %0, %1 offset:%2" : "=&v"(r) : "v"(vb), "i"(OFF) : "memory"); return r;
}
template <int D0> __device__ __forceinline__ void pv_one(f32x16& od, int vb, bf16x8 pa0, bf16x8 pa1, bf16x8 pa2, bf16x8 pa3) {
  const s16x4 l0 = tr_read<v_rd_off(D0, 0, 0)>(vb), h0 = tr_read<v_rd_off(D0, 0, 1)>(vb), l1 = tr_read<v_rd_off(D0, 1, 0)>(vb), h1 = tr_read<v_rd_off(D0, 1, 1)>(vb);
  const s16x4 l2 = tr_read<v_rd_off(D0, 2, 0)>(vb), h2 = tr_read<v_rd_off(D0, 2, 1)>(vb), l3 = tr_read<v_rd_off(D0, 3, 0)>(vb), h3 = tr_read<v_rd_off(D0, 3, 1)>(vb);
  asm volatile("s_waitcnt lgkmcnt(0)" ::: "memory"); SBAR();
#define PK(L, H) (bf16x8){L[0], L[1], L[2], L[3], H[0], H[1], H[2], H[3]}
  od = __builtin_amdgcn_mfma_f32_32x32x16_bf16(pa0, PK(l0, h0), od, 0, 0, 0);
  od = __builtin_amdgcn_mfma_f32_32x32x16_bf16(pa1, PK(l1, h1), od, 0, 0, 0);
  od = __builtin_amdgcn_mfma_f32_32x32x16_bf16(pa2, PK(l2, h2), od, 0, 0, 0);
  od = __builtin_amdgcn_mfma_f32_32x32x16_bf16(pa3, PK(l3, h3), od, 0, 0, 0);
#undef PK
}
__device__ __forceinline__ void pv_d0(f32x16* o, int vb, bf16x8 pa0, bf16x8 pa1, bf16x8 pa2, bf16x8 pa3) {
  pv_one<0>(o[0], vb, pa0, pa1, pa2, pa3); pv_one<1>(o[1], vb, pa0, pa1, pa2, pa3); pv_one<2>(o[2], vb, pa0, pa1, pa2, pa3); pv_one<3>(o[3], vb, pa0, pa1, pa2, pa3);
}

__device__ __forceinline__ void qkt3(f32x16& p0, f32x16& p1, const LAS char* Ks, const bf16x8* qr, int r32, int hi, int mp) {
  p0 = f32x16{}; p1 = f32x16{};
#pragma unroll
  for (int d0 = 0; d0 < 4; ++d0) { const int cb = (mp * 64 + d0 * 16 + hi * 8) * 2;
    const bf16x8 b0 = *reinterpret_cast<const LAS bf16x8*>(Ks + KSWZ(r32, cb));
    const bf16x8 b1 = *reinterpret_cast<const LAS bf16x8*>(Ks + KSWZ(32 + r32, cb));
    p0 = __builtin_amdgcn_mfma_f32_32x32x16_bf16(b0, qr[d0], p0, 0, 0, 0);
    p1 = __builtin_amdgcn_mfma_f32_32x32x16_bf16(b1, qr[d0], p1, 0, 0, 0); }
}
__device__ __forceinline__ void unit(int b, int h, int qb, const bf16_t* __restrict__ p1, bf16_t* __restrict__ A2, float lam, const float* __restrict__ gsub, LAS char* lds3) {
  int tid = threadIdx.x; asm volatile("" : "+v"(tid));
  const int wid = __builtin_amdgcn_readfirstlane(tid >> 6), lane = tid & 63, r32 = lane & 31, hi = lane >> 5, wq = wid & 3, mp = wid >> 2;
  LAS float* ws = (LAS float*)(lds3 + 131072) + wid * 64; LAS float* li_l = ws; LAS float* al_l = ws + 32;
  float m_reg = -1e30f, l_reg = 0; f32x16 o[4] = {}; bf16x8 qr[4];
  const size_t rowb = (size_t)b * SEQ;
  const char* Kh = (const char*)(p1 + rowb * P1W + 512 + h * 128); const char* Vh = (const char*)(p1 + rowb * P1W + 1024 + h * 128);
  unsigned koff[2], voff[2];
#pragma unroll
  for (int i = 0; i < 2; ++i) {
    const int krow = wid * 8 + i * 4 + (lane >> 4), kch = (lane & 15) ^ (krow & 7); koff[i] = (unsigned)(krow * P1W * 2 + kch * 16);
    const int sub = wid * 4 + i * 2 + (lane >> 5), kk = (sub >> 2) * 8 + ((lane & 31) >> 2), key = (kk & ~0xC) | ((kk & 4) << 1) | ((kk & 8) >> 1), c = (sub & 3) * 32 + (lane & 3) * 8;
    voff[i] = (unsigned)(key * P1W * 2 + c * 2);
  }
  const unsigned dmaw = (unsigned)wid * 2048u;
#define DMA(t, slot) do { const char* kb_ = Kh + (size_t)(t) * (KVBLK * P1W * 2); const char* vb_ = Vh + (size_t)(t) * (KVBLK * P1W * 2); _Pragma("unroll") for (int i_ = 0; i_ < 2; ++i_) { \
    __builtin_amdgcn_global_load_lds((const unsigned*)(kb_ + koff[i_]), (LAS unsigned*)(lds3 + (slot) * 32768 + dmaw + i_ * 1024), 16, 0, 0); \
    __builtin_amdgcn_global_load_lds((const unsigned*)(vb_ + voff[i_]), (LAS unsigned*)(lds3 + (slot) * 32768 + 16384 + dmaw + i_ * 1024), 16, 0, 0); } } while (0)
#define WAITV(n) asm volatile("s_waitcnt vmcnt(" #n ")" ::: "memory")
#define LBAR() do { asm volatile("s_waitcnt lgkmcnt(0)" ::: "memory"); __builtin_amdgcn_s_barrier(); asm volatile("" ::: "memory"); } while (0)
#define KS(t) (lds3 + ((t) & 3) * 32768)
#define VB(t) (vrd + ((t) & 3) * 32768)
  const int NT = 2 * qb + 2;
  const bool vis_last = (wq >= 2);
  DMA(0, 0); DMA(1, 1);
  const bf16_t* Qw = p1 + (rowb + qb * 128 + wq * QBLK + r32) * P1W + h * 128 + mp * 64 + hi * 8;
#pragma unroll
  for (int d0 = 0; d0 < 4; ++d0) qr[d0] = *reinterpret_cast<const bf16x8*>(Qw + d0 * 16);
  const int vrd = (int)(uintptr_t)lds3 + 16384 + v_rd_base(lane);
#define RESC(a) do { if (__any((a) < 1.f)) { if (hi == 0) al_l[r32] = (a); asm volatile("s_waitcnt lgkmcnt(0)" ::: "memory"); \
    _Pragma("unroll") for (int d = 0; d < 4; ++d) _Pragma("unroll") for (int r = 0; r < 16; ++r) o[d][r] *= al_l[crow(r, hi)]; } } while (0)
  f32x16 pA0, pA1, pB0, pB1; float mnA, mnB, alA, alB; bf16x8 pa0, pa1, pa2, pa3;
  WAITV(4); LBAR();
  if (2 < NT) DMA(2, 2);
  qkt3(pA0, pA1, KS(0), qr, r32, hi, mp); partialSM(pA0, pA1, m_reg, mnA, alA);
  for (int j = 1; j + 1 < NT; j += 2) {
    WAITV(4); LBAR(); DMA(j + 2, (j + 2) & 3);
    SBAR(); qkt3(pB0, pB1, KS(j), qr, r32, hi, mp);
    finishSM(pA0, pA1, alA, l_reg, pa0, pa1, pa2, pa3); SBAR();
    pv_d0(o, VB(j - 1), pa0, pa1, pa2, pa3); partialSM(pB0, pB1, m_reg, mnB, alB);
    RESC(alB);
    WAITV(4); LBAR(); if (j + 3 < NT) DMA(j + 3, (j + 3) & 3);
    SBAR(); qkt3(pA0, pA1, KS(j + 1), qr, r32, hi, mp);
    finishSM(pB0, pB1, alB, l_reg, pa0, pa1, pa2, pa3); SBAR();
    pv_d0(o, VB(j), pa0, pa1, pa2, pa3); partialSM(pA0, pA1, m_reg, mnA, alA);
    RESC(alA);
  }
  WAITV(0); LBAR();
  SBAR();
  if (vis_last) qkt3(pB0, pB1, KS(NT - 1), qr, r32, hi, mp);
  finishSM(pA0, pA1, alA, l_reg, pa0, pa1, pa2, pa3); SBAR();
  pv_d0(o, VB(NT - 2), pa0, pa1, pa2, pa3);
  if (vis_last) {
    partialSM(pB0, pB1, m_reg, mnB, alB);
    RESC(alB);
    finishSM(pB0, pB1, alB, l_reg, pa0, pa1, pa2, pa3); SBAR();
    pv_d0(o, VB(NT - 1), pa0, pa1, pa2, pa3);
  }
  if (hi == 0) li_l[r32] = l_reg; asm volatile("s_waitcnt lgkmcnt(0)" ::: "memory");
  float rli[16];
#pragma unroll
  for (int r = 0; r < 16; ++r) rli[r] = __builtin_amdgcn_rcpf(li_l[crow(r, hi)]);
  LBAR();
  LAS float* X = (LAS float*)lds3 + wq * (32 * 132);
  if (mp == 1) {
#pragma unroll
    for (int r = 0; r < 16; ++r) { const int orow = crow(r, hi);
#pragma unroll
      for (int d0 = 0; d0 < 4; ++d0) X[orow * 132 + d0 * 32 + r32] = o[d0][r] * rli[r]; }
  }
  LBAR();
  if (mp == 0) {
#pragma unroll
    for (int r = 0; r < 16; ++r) { const int orow = crow(r, hi);
#pragma unroll
      for (int d0 = 0; d0 < 4; ++d0) { LAS float* p = &X[orow * 132 + d0 * 32 + r32]; *p = o[d0][r] * rli[r] - lam * (*p); } }
    asm volatile("s_waitcnt lgkmcnt(0)" ::: "memory");
    const int row = lane >> 1, half = lane & 1; const LAS float* xr = X + row * 132 + half * 64;
    f32x4 v[16]; float ss = 0.f;
#pragma unroll
    for (int i = 0; i < 16; ++i) { v[i] = *(const LAS f32x4*)(xr + 4 * i); ss += (v[i][0] * v[i][0] + v[i][1] * v[i][1]) + (v[i][2] * v[i][2] + v[i][3] * v[i][3]); }
    ss += DPPF(ss, 0xB1);
    const float rs = rsqrtf(ss * (1.0f / 128.0f) + EPS) * (1.0f - LAM_INIT);
    bf16_t* orow = A2 + (rowb + qb * 128 + wq * QBLK + row) * DM + h * 128 + half * 64; const float* g = gsub + half * 64;
#pragma unroll
    for (int i = 0; i < 16; i += 2) { const f32x4 g0 = *(const f32x4*)(g + 4 * i), g1 = *(const f32x4*)(g + 4 * i + 4);
      *(u32x4*)(orow + 4 * i) = epi::pack8(v[i] * g0 * rs, v[i + 1] * g1 * rs); }
  }
  asm volatile("s_waitcnt vmcnt(0)" ::: "memory");
  LBAR();
#undef DMA
#undef WAITV
#undef LBAR
#undef KS
#undef VB
#undef RESC
}
#undef KSWZ
#undef SBAR
}
namespace misc {
constexpr int SK = PAST + DECT;
__device__ __forceinline__ void sample_attn_unit(int b, int h, int qh, const bf16_t* __restrict__ p1, const float* __restrict__ ck, const float* __restrict__ cv,
                                                 const float* __restrict__ nk, const float* __restrict__ nv, bf16_t* __restrict__ A2, float lam, const float* __restrict__ gsub, char* lds) {
  int tid = threadIdx.x; asm volatile("" : "+v"(tid)); const int lane = tid & 63, wid = tid >> 6;
  float* S = (float*)lds; float* red = (float*)(lds + 66560); float* q = (float*)(lds + 132096); float* st = (float*)(lds + 136192);
  for (int i = tid; i < 1024; i += 512) { const int mp = i >> 9, r = (i >> 6) & 7, d = i & 63;
    q[i] = bf2f(p1[(size_t)(MP + b * DECT + qh * 8 + r) * P1W + h * 128 + mp * 64 + d]); }
  __syncthreads();
  for (int it = tid; it < 2 * SK; it += 512) {
    const int mp = it / SK, key = it - mp * SK;
    const float* kp = key < PAST ? ck + (((size_t)b * PAST + key) * NH + h) * 128 + mp * 64 : nk + ((size_t)(b * DECT + key - PAST)) * 512 + h * 128 + mp * 64;
    float a[8] = {0.f, 0.f, 0.f, 0.f, 0.f, 0.f, 0.f, 0.f};
#pragma unroll 4
    for (int d = 0; d < 64; d += 4) { const f32x4 kv = *(const f32x4*)(kp + d);
#pragma unroll
      for (int r = 0; r < 8; ++r) { const f32x4 qv = *(const f32x4*)(q + (mp * 8 + r) * 64 + d); a[r] += (kv[0] * qv[0] + kv[1] * qv[1]) + (kv[2] * qv[2] + kv[3] * qv[3]); } }
#pragma unroll
    for (int r = 0; r < 8; ++r) S[(mp * 8 + r) * SK + key] = a[r] * 0.125f;
  }
  __syncthreads();
  for (int rr = 0; rr < 2; ++rr) { const int row = wid * 2 + rr; float* s = S + row * SK;
    float mx = -3.0e38f; for (int k = lane; k < SK; k += 64) mx = fmaxf(mx, s[k]); mx = wave_max(mx);
    float sum = 0.f; for (int k = lane; k < SK; k += 64) { const float e = __expf(s[k] - mx); s[k] = e; sum += e; } sum = wave_sum(sum);
    if (lane == 0) st[row] = 1.0f / sum; }
  __syncthreads();
  for (int i = tid; i < 8 * SK; i += 512) { const int r = i / SK, k = i - r * SK; S[r * SK + k] = S[r * SK + k] * st[r] - lam * S[(8 + r) * SK + k] * st[8 + r]; }
  __syncthreads();
  { const int eg = tid & 31, ks = tid >> 5; f32x4 o[8];
#pragma unroll
    for (int r = 0; r < 8; ++r) o[r] = (f32x4){0.f, 0.f, 0.f, 0.f};
    for (int key = ks; key < SK; key += 16) {
      const float* vp = key < PAST ? cv + (((size_t)b * PAST + key) * NH + h) * 128 + eg * 4 : nv + ((size_t)(b * DECT + key - PAST)) * 512 + h * 128 + eg * 4;
      const f32x4 vv = *(const f32x4*)vp;
#pragma unroll
      for (int r = 0; r < 8; ++r) o[r] += vv * S[r * SK + key]; }
#pragma unroll
    for (int r = 0; r < 8; ++r) *(f32x4*)(red + (ks * 8 + r) * 128 + eg * 4) = o[r]; }
  __syncthreads();
  { const int r = wid; float x0 = 0.f, x1 = 0.f;
#pragma unroll
    for (int ks = 0; ks < 16; ++ks) { const f32x2 t = *(const f32x2*)(red + (ks * 8 + r) * 128 + 2 * lane); x0 += t[0]; x1 += t[1]; }
    const float ss = wave_sum(x0 * x0 + x1 * x1); const float rs = rsqrtf(ss * (1.0f / 128.0f) + EPS) * (1.0f - LAM_INIT);
    const unsigned w = cvt_pk_bf16(x0 * rs * gsub[2 * lane], x1 * rs * gsub[2 * lane + 1]);
    *(unsigned*)(A2 + (size_t)(MP + b * DECT + qh * 8 + r) * DM + h * 128 + 2 * lane) = w; }
  __syncthreads();
}

__device__ __forceinline__ void sample_xattn_unit(int b, int h, const bf16_t* __restrict__ HQ, const float* __restrict__ mk, const float* __restrict__ mv, bf16_t* __restrict__ XO, char* lds) {
  int tid = threadIdx.x; asm volatile("" : "+v"(tid)); const int lane = tid & 63, wid = tid >> 6;
  float* q = (float*)lds; float* S = (float*)(lds + 16384);
  for (int i = tid; i < 16 * 256; i += 512) { const int r = i >> 8, d = i & 255; q[i] = bf2f(HQ[(size_t)(MP + b * DECT + r) * DM + h * 256 + d]); }
  __syncthreads();
  { const int key = tid >> 1, qh = tid & 1; const float* kp = mk + (((size_t)b * NMEM + key) * NH + h) * 256;
    float a[8] = {0.f, 0.f, 0.f, 0.f, 0.f, 0.f, 0.f, 0.f};
#pragma unroll 4
    for (int d = 0; d < 256; d += 4) { const f32x4 kv = *(const f32x4*)(kp + d);
#pragma unroll
      for (int r = 0; r < 8; ++r) { const f32x4 qv = *(const f32x4*)(q + (qh * 8 + r) * 256 + d); a[r] += (kv[0] * qv[0] + kv[1] * qv[1]) + (kv[2] * qv[2] + kv[3] * qv[3]); } }
#pragma unroll
    for (int r = 0; r < 8; ++r) S[(qh * 8 + r) * 256 + key] = a[r] * 0.0625f; }
  __syncthreads();
  for (int rr = 0; rr < 2; ++rr) { const int row = wid * 2 + rr; float* s = S + row * 256;
    float v[4]; float mx = -3.0e38f;
#pragma unroll
    for (int i = 0; i < 4; ++i) { v[i] = s[lane + 64 * i]; mx = fmaxf(mx, v[i]); } mx = wave_max(mx);
    float sum = 0.f;
#pragma unroll
    for (int i = 0; i < 4; ++i) { v[i] = __expf(v[i] - mx); sum += v[i]; } sum = wave_sum(sum); const float rl = 1.0f / sum;
#pragma unroll
    for (int i = 0; i < 4; ++i) s[lane + 64 * i] = v[i] * rl; }
  __syncthreads();
  { const int r = tid >> 5, dg = tid & 31; const float* vp = mv + ((size_t)b * NMEM * NH + h) * 256 + dg * 8; f32x4 o0 = {0.f, 0.f, 0.f, 0.f}, o1 = {0.f, 0.f, 0.f, 0.f};
    for (int key = 0; key < NMEM; ++key) { const float p = S[r * 256 + key]; const f32x4 a = *(const f32x4*)(vp + (size_t)key * NH * 256), c = *(const f32x4*)(vp + (size_t)key * NH * 256 + 4); o0 += a * p; o1 += c * p; }
    *(u32x4*)(XO + (size_t)(MP + b * DECT + r) * DM + h * 256 + dg * 8) = epi::pack8(o0, o1); }
  __syncthreads();
}

__device__ __forceinline__ void shortconv_item(int item, const bf16_t* __restrict__ p1, const float* __restrict__ wsc, const float* __restrict__ state, bf16_t* __restrict__ A2) {
  const int cgp = item & 63, chunk = item >> 6, c = cgp * 8, r0 = chunk * 8;
  const bool sample = r0 >= MP;
  const bool seq_start = sample ? (((r0 - MP) & (DECT - 1)) == 0) : ((r0 & (SEQ - 1)) == 0);
  u32x4 uu[10], gg[8];
#pragma unroll
  for (int r = 0; r < 10; ++r) { const int row = r0 - 2 + r; uu[r] = (r >= 2 || !seq_start) ? *(const u32x4*)(p1 + (size_t)row * P1W + 2048 + c) : (u32x4){0u, 0u, 0u, 0u}; }
#pragma unroll
  for (int r = 0; r < 8; ++r) gg[r] = *(const u32x4*)(p1 + (size_t)(r0 + r) * P1W + 1536 + c);
  float w0[8], w1[8], w2[8], um2[8], um1[8];
#pragma unroll
  for (int j = 0; j < 8; ++j) { w0[j] = wsc[c + j]; w1[j] = wsc[CW + c + j]; w2[j] = wsc[2 * CW + c + j]; }
  if (sample && seq_start) { const float* s = state + (size_t)((r0 - MP) >> 4) * 2 * CW + c;
#pragma unroll
    for (int j = 0; j < 8; ++j) { um2[j] = s[j]; um1[j] = s[CW + j]; } }
  else {
#pragma unroll
    for (int j = 0; j < 4; ++j) { um2[2 * j] = __uint_as_float(uu[0][j] << 16); um2[2 * j + 1] = __uint_as_float(uu[0][j] & 0xffff0000u); um1[2 * j] = __uint_as_float(uu[1][j] << 16); um1[2 * j + 1] = __uint_as_float(uu[1][j] & 0xffff0000u); } }
#pragma unroll
  for (int r = 0; r < 8; ++r) {
    float y[8];
#pragma unroll
    for (int j = 0; j < 4; ++j) {
      const float u0 = __uint_as_float(uu[r + 2][j] << 16), u1 = __uint_as_float(uu[r + 2][j] & 0xffff0000u), g0 = __uint_as_float(gg[r][j] << 16), g1 = __uint_as_float(gg[r][j] & 0xffff0000u);
      y[2 * j] = g0 * (w0[2 * j] * um2[2 * j] + w1[2 * j] * um1[2 * j] + w2[2 * j] * u0); y[2 * j + 1] = g1 * (w0[2 * j + 1] * um2[2 * j + 1] + w1[2 * j + 1] * um1[2 * j + 1] + w2[2 * j + 1] * u1);
      um2[2 * j] = um1[2 * j]; um2[2 * j + 1] = um1[2 * j + 1]; um1[2 * j] = u0; um1[2 * j + 1] = u1; }
    u32x4 w; w.x = cvt_pk_bf16(y[0], y[1]); w.y = cvt_pk_bf16(y[2], y[3]); w.z = cvt_pk_bf16(y[4], y[5]); w.w = cvt_pk_bf16(y[6], y[7]);
    *(u32x4*)(A2 + (size_t)(r0 + r) * DM + 512 + c) = w;
  }
}
__device__ __forceinline__ void transpose_item(int item, const bf16_t* __restrict__ src, bf16_t* __restrict__ dst, LAS bf16_t* scr, int lane) {
  const int bi = item >> 4, bj = item & 15, r0 = bi * 64, c0 = bj * 64;
  for (int i = 0; i < 64; ++i) scr[i * 66 + lane] = src[(size_t)(r0 + i) * DM + c0 + lane];
  asm volatile("s_waitcnt lgkmcnt(0)" ::: "memory");
  for (int i = 0; i < 64; ++i) dst[(size_t)(c0 + i) * MMEM + r0 + lane] = scr[lane * 66 + i];
  asm volatile("s_waitcnt lgkmcnt(0)" ::: "memory");
}
}
constexpr size_t MiB = 1u << 20;
constexpr size_t WS_SSQ0 = 1 * MiB, WS_SSQM = WS_SSQ0 + 288 * 1024, WS_RS1 = WS_SSQ0 + 320 * 1024, WS_RS2 = WS_SSQ0 + 640 * 1024;
constexpr size_t WS_SSP1 = 2 * MiB, WS_SSP2 = 7 * MiB, WS_SSP3 = 12 * MiB, WS_L4 = 17 * MiB;
constexpr size_t WS_UH = 22 * MiB, WS_U01 = 28 * MiB, WS_G01 = 34 * MiB;
constexpr size_t WS_WIN = 40 * MiB, WS_WOUT = 46 * MiB, WS_WXQ = 48 * MiB, WS_WXKV = 50 * MiB, WS_WXO = 54 * MiB, WS_WUG = 56 * MiB, WS_WDN = 67 * MiB;
constexpr size_t WS_MN = 74 * MiB, WS_MK = 90 * MiB, WS_MV = 106 * MiB, WS_MVT = 122 * MiB;
constexpr size_t WS_XA = 138 * MiB;
constexpr size_t WS_P1 = 268 * MiB;
constexpr size_t WS_A2 = 591 * MiB;
constexpr size_t WS_SPART = WS_MN;
constexpr size_t WS_HQ = WS_P1, WS_P = WS_P1 + 129 * MiB, WS_H = WS_P1;
constexpr size_t WS_END = 720 * MiB;
static_assert(WS_XA + (size_t)RT * DM * 2 <= WS_P1 && WS_P1 + (size_t)RT * P1W * 2 <= WS_A2 && WS_A2 + (size_t)RT * DM * 2 <= WS_END && WS_H + (size_t)RT * DFF * 2 <= WS_END, "ws map");
static_assert(WS_WDN + (size_t)DM * DFF * 2 <= WS_MN && WS_WUG + (size_t)2 * DFF * DM * 2 <= WS_WDN && WS_G01 + (size_t)NTILE_P * 2 * DFF * 4 <= WS_WIN && WS_L4 + (size_t)RT * 16 <= WS_UH && WS_RS2 + (size_t)RT * 4 <= WS_SSP1, "ws map 2");

constexpr int RING_BYTES = 131072, XTRA_OFF = RING_BYTES, BARST_OFF = XTRA_OFF + 20480, LDS_BYTES = 155648;

struct SchedGrid {
    const char* A; const char* B; size_t a_tile, b_tile; int nM, nN, nwg, G, c;
    __device__ __forceinline__ void init(const void* A_, size_t a_tile_, const void* B_, size_t b_tile_, int nM_, int nN_, int G_, int c_) { A = (const char*)A_; B = (const char*)B_; a_tile = a_tile_; b_tile = b_tile_; nM = nM_; nN = nN_; nwg = nM * nN; G = G_; c = c_; }
    __device__ __forceinline__ bool next(int i, pg8::Unit& u) const {
        const long L = (long)i * G + c; if (L >= nwg) return false;
        int wgid = (int)L; { const int q = nwg / 8, r = nwg % 8, xcd = wgid % 8, off = wgid / 8; wgid = (xcd < r ? xcd * (q + 1) : r * (q + 1) + (xcd - r) * q) + off; }
        const int nig = 8 * nN, gid = wgid / nig, fm = gid * 8, gsz = (nM - fm) < 8 ? (nM - fm) : 8;
        u.pm = fm + ((wgid % nig) % gsz); u.pn = (wgid % nig) / gsz; u.A = A + (size_t)u.pm * a_tile; u.B = B + (size_t)u.pn * b_tile; return true;
    }
};
struct SchedX {
    const char* A; const char* B; int G, c; bool pv;
    __device__ __forceinline__ bool next(int i, pg8::Unit& u) const {
        const long L = (long)i * G + c; if (L >= 4 * NTILE_P) return false;
        const int h = (int)(L >> 8), idx = (int)(L & 255), pm = (idx & 7) * 32 + (idx >> 3), b = pm >> 3;
        u.pm = pm; u.pn = h; u.A = A + ((size_t)pm * 256 * DM + h * 256) * 2;
        u.B = pv ? B + ((size_t)h * 256 * MMEM + b * 256) * 2 : B + ((size_t)b * 256 * DM + h * 256) * 2; return true;
    }
};

struct SchedSplitK {
    const char* A; const char* B; int G, c;
    __device__ __forceinline__ bool next(int i, pg8::Unit& u) const {
        const long L = (long)i * G + c; if (L >= 16) return false;
        const int t = (int)(L >> 3), pn = (int)(L >> 1) & 3, kh = (int)L & 1;
        u.pm = NTILE_P + t; u.pn = pn | (kh << 4);
        u.A = A + ((size_t)(NTILE_P + t) * 256 * DFF + kh * (DFF / 2)) * 2; u.B = B + ((size_t)pn * 256 * DFF + kh * (DFF / 2)) * 2; return true;
    }
};

__device__ __forceinline__ void p0_transpose_item(const float* __restrict__ W, int ldw, int K, int kb, int ns, bf16_t* __restrict__ WT, int nd, const float* __restrict__ gain, LAS float* scr, int lane) {
    const int k0 = 64 * kb;
    float wv[32];
#pragma unroll
    for (int i = 0; i < 32; ++i) wv[i] = W[(size_t)(k0 + 2 * i + (lane >> 5)) * ldw + ns + (lane & 31)];
    if (gain) {
#pragma unroll
        for (int i = 0; i < 32; ++i) wv[i] *= gain[k0 + 2 * i + (lane >> 5)]; }
#pragma unroll
    for (int i = 0; i < 32; ++i) scr[(2 * i + (lane >> 5)) * 33 + (lane & 31)] = wv[i];
    asm volatile("s_waitcnt lgkmcnt(0)" ::: "memory");
    const int cc = lane & 7;
#pragma unroll
    for (int j = 0; j < 4; ++j) { const int n = (lane >> 3) + 8 * j; const LAS float* s = scr + (8 * cc) * 33 + n;
        u32x4 o; o.x = cvt_pk_bf16(s[0 * 33], s[1 * 33]); o.y = cvt_pk_bf16(s[2 * 33], s[3 * 33]); o.z = cvt_pk_bf16(s[4 * 33], s[5 * 33]); o.w = cvt_pk_bf16(s[6 * 33], s[7 * 33]);
        *(u32x4*)(WT + (size_t)(nd + n) * K + k0 + 8 * cc) = o; }
    asm volatile("s_waitcnt lgkmcnt(0)" ::: "memory");
}
__device__ __forceinline__ void rows2_to_bf16(const float* __restrict__ x0, const float* __restrict__ x1, bf16_t* __restrict__ o0, bf16_t* __restrict__ o1, float* q0, float* q1, int lane) {
    const f32x4* r0 = (const f32x4*)x0 + lane; const f32x4* r1 = (const f32x4*)x1 + lane; f32x4 v[4], w[4]; float s = 0.f, t = 0.f;
#pragma unroll
    for (int j = 0; j < 4; ++j) { v[j] = __builtin_nontemporal_load(r0 + 64 * j); w[j] = __builtin_nontemporal_load(r1 + 64 * j); }
#pragma unroll
    for (int j = 0; j < 4; ++j) { s += (v[j][0] * v[j][0] + v[j][1] * v[j][1]) + (v[j][2] * v[j][2] + v[j][3] * v[j][3]); t += (w[j][0] * w[j][0] + w[j][1] * w[j][1]) + (w[j][2] * w[j][2] + w[j][3] * w[j][3]); }
    s = wave_sum(s); t = wave_sum(t);
    u32x2* p0 = (u32x2*)o0 + lane; u32x2* p1 = (u32x2*)o1 + lane;
#pragma unroll
    for (int j = 0; j < 4; ++j) { p0[64 * j] = epi::pack4(v[j]); p1[64 * j] = epi::pack4(w[j]); }
    if (lane == 0) { *q0 = s; *q1 = t; }
}

#define XB_TMO      128
#define XB_XCNT(j)  (256  + 64 * (j))
#define XB_XSUB(j)  (1280 + 64 * (j))
#define XB_XGEN(j)  (2304 + 64 * (j))
#define XB_TOP      3328
#define XB_TOPGEN   3392
#define XCD_BAR_WORDS 3456
#define XB_SPIN_CAP (1u << 22)
__device__ __forceinline__ unsigned xb_ld(unsigned* p)              { return __hip_atomic_load(p, __ATOMIC_RELAXED, __HIP_MEMORY_SCOPE_AGENT); }
__device__ __forceinline__ unsigned xb_add(unsigned* p, unsigned v) { return __hip_atomic_fetch_add(p, v, __ATOMIC_RELAXED, __HIP_MEMORY_SCOPE_AGENT); }
__device__ __forceinline__ unsigned xb_xcc_id() { return (unsigned)__builtin_amdgcn_s_getreg((3 << 11) | 20) & 0xFu; }
#define XB_SPIN(cond, bar) do { unsigned _sp = 0; while (cond) { __builtin_amdgcn_s_sleep(1); \
    if ((++_sp & 255u) == 0u) { if (xb_ld(&(bar)[XB_TMO])) break; if (_sp > XB_SPIN_CAP) { atomicAdd(&(bar)[XB_TMO], 1u); break; } } } } while (0)
__device__ __forceinline__ void xcd_barrier_complete(unsigned* bar, unsigned x, unsigned& nloc, unsigned& nx) {
    const unsigned G = gridDim.x * gridDim.y * gridDim.z;
    unsigned sum, cnt, mine, sp = 0u;
    for (;;) {
        sum = 0u; cnt = 0u; mine = 0u;
#pragma unroll
        for (unsigned j = 0; j < 16; ++j) { const unsigned c = xb_ld(&bar[XB_XCNT(j)]); sum += c; cnt += (c > 0u) ? 1u : 0u; mine = (j == x) ? c : mine; }
        if (sum == G) break;
        __builtin_amdgcn_s_sleep(1);
        if ((++sp & 255u) == 0u) { if (xb_ld(&bar[XB_TMO])) break; if (sp > XB_SPIN_CAP) { atomicAdd(&bar[XB_TMO], 1u); break; } }
    }
    nloc = mine > 0u ? mine : 1u; nx = cnt > 0u ? cnt : 1u;
}
__device__ __forceinline__ void xcd_barrier(unsigned* bar, volatile LAS unsigned* st) {
    asm volatile("s_waitcnt vmcnt(0)" ::: "memory");
    __syncthreads();
    if (threadIdx.x == 0) {
        const unsigned x = xb_xcc_id();
        __builtin_amdgcn_s_waitcnt(0);
        unsigned nloc = st[0], nx = st[1];
        if (nloc == 0u) { xcd_barrier_complete(bar, x, nloc, nx); st[0] = nloc; st[1] = nx; }
        const unsigned old = xb_add(&bar[XB_XSUB(x)], 1u);
        const unsigned gen = old / nloc;
        if (old + 1u == (gen + 1u) * nloc) {
            __builtin_amdgcn_fence(__ATOMIC_RELEASE, "agent");
            asm volatile("s_waitcnt vmcnt(0)" ::: "memory");
            const unsigned og = xb_add(&bar[XB_TOP], 1u);
            const unsigned tg = og / nx;
            if (og + 1u == (tg + 1u) * nx) xb_add(&bar[XB_TOPGEN], 1u);
            else XB_SPIN(xb_ld(&bar[XB_TOPGEN]) == tg, bar);
            __builtin_amdgcn_fence(__ATOMIC_ACQUIRE, "agent");
            xb_add(&bar[XB_XGEN(x)], 1u);
            asm volatile("s_waitcnt vmcnt(0)" ::: "memory");
        } else {
            XB_SPIN(xb_ld(&bar[XB_XGEN(x)]) == gen, bar);
            __builtin_amdgcn_fence(__ATOMIC_ACQUIRE, "agent");
            asm volatile("s_waitcnt vmcnt(0)" ::: "memory");
        }
    }
    __syncthreads();
}

struct Args { const float* in[30]; float* out; unsigned char* ws; };
#define PHASE_ARGS() \
    const __attribute__((address_space(4))) Args* ap_ = (const __attribute__((address_space(4))) Args*)__builtin_amdgcn_kernarg_segment_ptr(); asm volatile("" : "+s"(ap_)); \
    unsigned char* const ws = ap_->ws; float* const out = ap_->out; (void)ws; (void)out; \
    int tid = threadIdx.x; asm volatile("" : "+v"(tid)); const int lane = tid & 63, wave = __builtin_amdgcn_readfirstlane(tid >> 6); (void)lane; (void)wave; \
    const int G = gridDim.x, bx = blockIdx.x, vcu = (G % 8 == 0) ? (bx % 8) * (G / 8) + bx / 8 : bx; (void)vcu; \
    const int gw = vcu * 8 + wave, NGW = G * 8; (void)gw; (void)NGW
#define IN(k) (ap_->in[k])
#define WSF(off) ((float*)(ws + (off)))
#define WSB(off) ((bf16_t*)(ws + (off)))

__global__ void __launch_bounds__(512, 2) fwd_kernel(Args a) {
    extern __shared__ __attribute__((aligned(16))) unsigned char lds_raw[];
    LAS unsigned char* const lds = (LAS unsigned char*)lds_raw;
    volatile LAS unsigned* const bst = (volatile LAS unsigned*)(lds + BARST_OFF);
    if (threadIdx.x < 2) bst[threadIdx.x] = 0u;
    __syncthreads();
    { PHASE_ARGS(); if (threadIdx.x == 0) (void)xb_add(&((unsigned*)ws)[XB_XCNT(xb_xcc_id())], 1u); }
#define GRID_BAR() do { PHASE_ARGS(); xcd_barrier((unsigned*)ws, bst); } while (0)

    {
        PHASE_ARGS();
        LAS float* scr = (LAS float*)(lds + wave * 16384);
        constexpr int I_IN = 16 * 96, I_SQ = 16 * 32, I_FF = 16 * 88, I_DN = 44 * 32;
        constexpr int NITEMS = I_IN + 5 * I_SQ + 2 * I_FF + I_DN;
        for (int it = gw; it < NITEMS; it += NGW) {
            int r = it;
            if (r < I_IN) { const int kb = r / 96, nb = r % 96, nd = nb * 32; int ns = nd;
                if (nd >= 2048) { const int T = (nd - 2048) >> 8, w = (nd - 2048) & 255; ns = (w < 128) ? 2048 + 128 * T + w : 2560 + 128 * T + (w - 128); }
                p0_transpose_item(IN(10), INP, DM, kb, ns, WSB(WS_WIN), nd, IN(9), scr, lane); continue; } r -= I_IN;
            if (r < I_SQ) { p0_transpose_item(IN(17), DM, DM, r / 32, (r % 32) * 32, WSB(WS_WOUT), (r % 32) * 32, nullptr, scr, lane); continue; } r -= I_SQ;
            if (r < I_SQ) { p0_transpose_item(IN(20), DM, DM, r / 32, (r % 32) * 32, WSB(WS_WXQ), (r % 32) * 32, IN(19), scr, lane); continue; } r -= I_SQ;
            if (r < I_SQ) { p0_transpose_item(IN(21), DM, DM, r / 32, (r % 32) * 32, WSB(WS_WXKV), (r % 32) * 32, IN(18), scr, lane); continue; } r -= I_SQ;
            if (r < I_SQ) { p0_transpose_item(IN(22), DM, DM, r / 32, (r % 32) * 32, WSB(WS_WXKV), 1024 + (r % 32) * 32, IN(18), scr, lane); continue; } r -= I_SQ;
            if (r < I_SQ) { p0_transpose_item(IN(23), DM, DM, r / 32, (r % 32) * 32, WSB(WS_WXO), (r % 32) * 32, nullptr, scr, lane); continue; } r -= I_SQ;
            if (r < I_FF) { const int kb = r / 88, nb = r % 88; p0_transpose_item(IN(25), DFF, DM, kb, nb * 32, WSB(WS_WUG), 256 * (nb >> 2) + (nb & 3) * 32, IN(24), scr, lane); continue; } r -= I_FF;
            if (r < I_FF) { const int kb = r / 88, nb = r % 88; p0_transpose_item(IN(26), DFF, DM, kb, nb * 32, WSB(WS_WUG), 256 * (nb >> 2) + 128 + (nb & 3) * 32, IN(24), scr, lane); continue; } r -= I_FF;
            p0_transpose_item(IN(28), DM, DFF, r / 32, (r % 32) * 32, WSB(WS_WDN), (r % 32) * 32, nullptr, scr, lane);
        }
        for (int m = 2 * gw; m < RT + MMEM; m += 2 * NGW) {
            const float* src; bf16_t* dst; float* sq;
            if (m < MP) { src = IN(0) + (size_t)m * DM; dst = WSB(WS_XA) + (size_t)m * DM; sq = WSF(WS_SSQ0) + m; }
            else if (m < RT) { src = IN(1) + (size_t)(m - MP) * DM; dst = WSB(WS_XA) + (size_t)m * DM; sq = WSF(WS_SSQ0) + m; }
            else { src = IN(8) + (size_t)(m - RT) * DM; dst = WSB(WS_MN) + (size_t)(m - RT) * DM; sq = WSF(WS_SSQM) + (m - RT); }
            rows2_to_bf16(src, src + DM, dst, dst + DM, sq, sq + 1, lane);
        }
    }
    GRID_BAR();

    {
        PHASE_ARGS();
        pg8::Gemm g{DM, DM, DM};
        { SchedGrid S; S.init(WSB(WS_XA), (size_t)256 * DM * 2, WSB(WS_WIN), (size_t)256 * DM * 2, NTILE, INP / 256, G, bx);
          epi::EpiInProj E{WSF(WS_SSQ0), WSB(WS_P1), out};
          pg8::gemm_phase(lds, g, S, E); }
        { SchedGrid S; S.init(WSB(WS_MN), (size_t)256 * DM * 2, WSB(WS_WXKV), (size_t)256 * DM * 2, MMEM / 256, 8, G, bx);
          epi::EpiMemKV E{WSF(WS_SSQM), WSB(WS_MK), WSB(WS_MV), out};
          pg8::gemm_phase(lds, g, S, E); }
    }
    GRID_BAR();

    {
        PHASE_ARGS();
        float lam;
        { const float a1 = wave_sum(IN(11)[lane] * IN(12)[lane]), a2 = wave_sum(IN(13)[lane] * IN(14)[lane]); lam = __expf(a1) - __expf(a2) + LAM_INIT; }
        for (long L = bx; L < 2048; L += G) {
            const int s = (int)(L >> 8), cc = (int)(L & 255), cv = (cc & 7) * 32 + (cc >> 3), bh = cv >> 1, par = cv & 1, p = 2 * (s >> 1) + par, qb = (s & 1) ? 15 - p : p;
            dattn::unit(bh >> 2, bh & 3, qb, WSB(WS_P1), WSB(WS_A2), lam, IN(15), (LAS char*)lds);
        }
        for (int L = bx; L < 256; L += G) misc::sample_attn_unit(L >> 3, (L >> 1) & 3, L & 1, WSB(WS_P1), IN(2), IN(3), out + O_KS, out + O_VS, WSB(WS_A2), lam, IN(15), (char*)lds_raw);
        for (int it = (vcu * 512 + tid); it < 64 * (RT / 8); it += G * 512) misc::shortconv_item(it, WSB(WS_P1), IN(16), IN(4), WSB(WS_A2));
        __syncthreads();
        { LAS bf16_t* scr = (LAS bf16_t*)(lds + wave * 16384); for (int it = gw; it < 2048; it += NGW) misc::transpose_item(it, WSB(WS_MV), WSB(WS_MVT), scr, lane); }
    }
    GRID_BAR();

    {
        PHASE_ARGS();
        pg8::Gemm g{DM, DM, DM}; SchedGrid S; S.init(WSB(WS_A2), (size_t)256 * DM * 2, WSB(WS_WOUT), (size_t)256 * DM * 2, NTILE, 4, G, bx);
        epi::EpiResidual E{WSB(WS_XA), WSF(WS_SSP1)};
        pg8::gemm_phase(lds, g, S, E);
    }
    GRID_BAR();
    {
        PHASE_ARGS();
        for (int r = bx * 512 + tid; r < RT; r += G * 512) WSF(WS_RS1)[r] = epi::rstd16(WSF(WS_SSP1), r);
    }
    GRID_BAR();
    {
        PHASE_ARGS();
        pg8::Gemm g{DM, DM, DM}; SchedGrid S; S.init(WSB(WS_XA), (size_t)256 * DM * 2, WSB(WS_WXQ), (size_t)256 * DM * 2, NTILE, 4, G, bx);
        epi::EpiScaleBf16 E{WSF(WS_RS1), WSB(WS_HQ), DM};
        pg8::gemm_phase(lds, g, S, E);
    }
    GRID_BAR();
    {
        PHASE_ARGS();
        pg8::Gemm g{DM, DM, 256}; SchedX S{(const char*)WSB(WS_HQ), (const char*)WSB(WS_MK), G, bx, false};
        epi::EpiXScores E{WSB(WS_P), WSF(WS_L4), (LAS float*)(lds + XTRA_OFF)};
        pg8::gemm_phase(lds, g, S, E);
    }
    GRID_BAR();
    {
        PHASE_ARGS();
        pg8::Gemm g{DM, MMEM, 256}; SchedX S{(const char*)WSB(WS_P), (const char*)WSB(WS_MVT), G, bx, true};
        epi::EpiXPV E{WSF(WS_L4), WSB(WS_HQ)};
        pg8::gemm_phase(lds, g, S, E);
        __syncthreads();
        for (int L = G - 1 - bx; L < NB * NH; L += G) misc::sample_xattn_unit(L >> 2, L & 3, WSB(WS_HQ), IN(6), IN(7), WSB(WS_HQ), (char*)lds_raw);
    }
    GRID_BAR();
    {
        PHASE_ARGS();
        pg8::Gemm g{DM, DM, DM}; SchedGrid S; S.init(WSB(WS_HQ), (size_t)256 * DM * 2, WSB(WS_WXO), (size_t)256 * DM * 2, NTILE, 4, G, bx);
        epi::EpiResidual E{WSB(WS_XA), WSF(WS_SSP2)};
        pg8::gemm_phase(lds, g, S, E);
    }
    GRID_BAR();
    {
        PHASE_ARGS();
        for (int r = bx * 512 + tid; r < RT; r += G * 512) WSF(WS_RS2)[r] = epi::rstd16(WSF(WS_SSP2), r);
    }
    GRID_BAR();
    {
        PHASE_ARGS();
        pg8::Gemm g{DM, DM, DM}; SchedGrid S; S.init(WSB(WS_XA), (size_t)256 * DM * 2, WSB(WS_WUG), (size_t)256 * DM * 2, NTILE, 22, G, bx);
        epi::EpiUpGate E{WSF(WS_RS2), IN(27), IN(5), WSB(WS_H), out, WSF(WS_UH), WSF(WS_U01), WSF(WS_G01), (LAS float*)(lds + XTRA_OFF)};
        pg8::gemm_phase(lds, g, S, E);
    }
    GRID_BAR();
    {
        PHASE_ARGS();
        pg8::Gemm g{DFF, DFF, DFF}; SchedGrid S; S.init(WSB(WS_H), (size_t)256 * DFF * 2, WSB(WS_WDN), (size_t)256 * DFF * 2, NTILE_P, 4, G, bx);
        { const float* UH = WSF(WS_UH); const float* U01 = WSF(WS_U01); const float* G01 = WSF(WS_G01); const float* w_ffc = IN(27); bf16_t* HB = WSB(WS_H); pg8::Unit uu;
          for (int i = 0; S.next(i, uu); ++i) { const int pm = uu.pm; if (pm >= NTILE_P || (pm & 7) == 0) continue;
            for (int it = tid; it < 2 * DFF; it += 512) {
                const int r = it / DFF, c = it - r * DFF;
                const float um2 = UH[((size_t)(pm - 1) * 2 + r) * DFF + c];
                const float um1 = (r == 0) ? UH[((size_t)(pm - 1) * 2 + 1) * DFF + c] : U01[((size_t)pm * 2) * DFF + c];
                const float u0 = U01[((size_t)pm * 2 + r) * DFF + c];
                const float y = w_ffc[c] * um2 + w_ffc[DFF + c] * um1 + w_ffc[2 * DFF + c] * u0;
                const float hv = y * __builtin_amdgcn_rcpf(1.0f + __builtin_amdgcn_exp2f(-1.4426950408889634f * y)) * G01[((size_t)pm * 2 + r) * DFF + c];
                HB[(size_t)(pm * 256 + r) * DFF + c] = (bf16_t)(cvt_pk_bf16(hv, 0.f) & 0xffffu);
            } }
          asm volatile("s_waitcnt vmcnt(0)" ::: "memory"); __syncthreads(); }
        epi::EpiResidual E{WSB(WS_XA), WSF(WS_SSP3)};
        pg8::gemm_phase(lds, g, S, E);
        { pg8::Gemm g2{DFF, DFF, DFF / 2}; SchedSplitK S2{(const char*)WSB(WS_H), (const char*)WSB(WS_WDN), G, bx};
          epi::EpiPartialF32 E2{WSF(WS_SPART)};
          pg8::gemm_phase(lds, g2, S2, E2); }
    }
    GRID_BAR();
    {
        PHASE_ARGS();
        const float* g_fin = IN(29); const bf16_t* XB = WSB(WS_XA);
        f32x4 gg[4];
#pragma unroll
        for (int j = 0; j < 4; ++j) gg[j] = *((const f32x4*)g_fin + lane + 64 * j);
        for (int m = 2 * gw; m < MP; m += 2 * NGW) {
            const float rs0 = epi::rstd16(WSF(WS_SSP3), m), rs1 = epi::rstd16(WSF(WS_SSP3), m + 1);
            const u32x2* x0 = (const u32x2*)(XB + (size_t)m * DM) + lane; const u32x2* x1 = x0 + DM / 4;
            u32x2 a[4], b[4];
#pragma unroll
            for (int j = 0; j < 4; ++j) { a[j] = __builtin_nontemporal_load(x0 + 64 * j); b[j] = __builtin_nontemporal_load(x1 + 64 * j); }
            f32x4* y0 = (f32x4*)(out + O_Y + (size_t)m * DM) + lane; f32x4* y1 = y0 + DM / 4;
#pragma unroll
            for (int j = 0; j < 4; ++j) {
                f32x4 v = {__uint_as_float(a[j].x << 16), __uint_as_float(a[j].x & 0xffff0000u), __uint_as_float(a[j].y << 16), __uint_as_float(a[j].y & 0xffff0000u)};
                f32x4 w = {__uint_as_float(b[j].x << 16), __uint_as_float(b[j].x & 0xffff0000u), __uint_as_float(b[j].y << 16), __uint_as_float(b[j].y & 0xffff0000u)};
                __builtin_nontemporal_store(v * gg[j] * rs0, y0 + 64 * j); __builtin_nontemporal_store(w * gg[j] * rs1, y1 + 64 * j);
            }
        }
        for (int r = gw; r < MS; r += NGW) {
            const u32x2* x0 = (const u32x2*)(XB + (size_t)(MP + r) * DM) + lane; const f32x4* sa = (const f32x4*)(WSF(WS_SPART) + (size_t)r * DM) + lane; const f32x4* sb = sa + (size_t)MS * DM / 4;
            f32x4 v[4]; float ss = 0.f;
#pragma unroll
            for (int j = 0; j < 4; ++j) { const u32x2 a = x0[64 * j];
                v[j] = (f32x4){__uint_as_float(a.x << 16), __uint_as_float(a.x & 0xffff0000u), __uint_as_float(a.y << 16), __uint_as_float(a.y & 0xffff0000u)} + sa[64 * j] + sb[64 * j];
                ss += (v[j][0] * v[j][0] + v[j][1] * v[j][1]) + (v[j][2] * v[j][2] + v[j][3] * v[j][3]); }
            const float rs = rsqrtf(wave_sum(ss) * (1.0f / DM) + EPS);
            f32x4* y0 = (f32x4*)(out + O_Y + (size_t)(MP + r) * DM) + lane;
#pragma unroll
            for (int j = 0; j < 4; ++j) y0[64 * j] = v[j] * gg[j] * rs;
        }
    }
}

extern "C" void kernel_launch(void* const* d_in, const int* in_sizes, int n_in, void* d_out, int out_size, void* d_ws, size_t ws_size, hipStream_t stream) {
    static int grid = 0;
    if (grid == 0) {
        if (n_in != 30 || (size_t)out_size != O_END || ws_size < WS_END) { fprintf(stderr, "kernel_launch: unexpected shapes: n_in %d out %d ws %zu (need %zu, %zu)\n", n_in, out_size, ws_size, (size_t)O_END, (size_t)WS_END); grid = -1; return; }
        int dev = 0, cus = 0, per_cu = 0;
        if (hipGetDevice(&dev) != hipSuccess || hipDeviceGetAttribute(&cus, hipDeviceAttributeMultiprocessorCount, dev) != hipSuccess) { grid = -1; return; }
        if (hipFuncSetAttribute((const void*)fwd_kernel, hipFuncAttributeMaxDynamicSharedMemorySize, LDS_BYTES) != hipSuccess) { fprintf(stderr, "kernel_launch: hipFuncSetAttribute failed\n"); grid = -1; return; }
        if (hipOccupancyMaxActiveBlocksPerMultiprocessor(&per_cu, (const void*)fwd_kernel, 512, LDS_BYTES) != hipSuccess || per_cu < 1) { fprintf(stderr, "kernel_launch: occupancy query says %d\n", per_cu); grid = -1; return; }
        grid = cus;
        fprintf(stderr, "kernel_launch: %d CUs, %d blocks/CU by the occupancy query, grid %d\n", cus, per_cu, grid);
    }
    if (grid < 0) return;
    if (hipMemsetAsync(d_ws, 0, 16384, stream) != hipSuccess) { fprintf(stderr, "kernel_launch: memset failed\n"); return; }
    Args a{};
    for (int i = 0; i < 30; ++i) a.in[i] = (const float*)d_in[i];
    a.out = (float*)d_out; a.ws = (unsigned char*)d_ws;
    void* args[] = {&a};
    const hipError_t e = hipLaunchCooperativeKernel((const void*)fwd_kernel, dim3(grid), dim3(512), args, LDS_BYTES, stream);
    if (e != hipSuccess) fprintf(stderr, "kernel_launch: cooperative launch failed: %s (grid %d)\n", hipGetErrorString(e), grid);
}
```

```cpp
#include <hip/hip_runtime.h>
#include <hip/hip_cooperative_groups.h>
#include <cstdio>
#include <cstdint>
namespace cg = cooperative_groups;

#define LAS __attribute__((address_space(3)))
typedef unsigned short bf16_t;
typedef short bf16x8 __attribute__((ext_vector_type(8)));
typedef short s16x4 __attribute__((ext_vector_type(4)));
typedef float f32x4 __attribute__((ext_vector_type(4)));
typedef float f32x2 __attribute__((ext_vector_type(2)));
typedef float f32x16 __attribute__((ext_vector_type(16)));
typedef unsigned u32x4 __attribute__((ext_vector_type(4)));
typedef unsigned u32x2 __attribute__((ext_vector_type(2)));

constexpr int DM = 1024, NB = 32, SEQ = 2048, DECT = 16, PAST = 1024;
constexpr int MP = NB * SEQ, MS = NB * DECT, RT = MP + MS;
constexpr int NTILE_P = MP / 256, NTILE = RT / 256;
constexpr int NH = 4, QKD = 64, VD = 128, NMEM = 256, XD = 256, DFF = 2816, INP = 3072, CW = 512;
constexpr int MMEM = NB * NMEM;
constexpr float EPS = 1e-6f;
constexpr float LAM_INIT = 0.2f;
constexpr int P1W = 2560;

constexpr size_t O_Y = 0;
constexpr size_t O_KP = (size_t)RT * DM;
constexpr size_t O_VP = O_KP + (size_t)MP * 512;
constexpr size_t O_SCP = O_VP + (size_t)MP * 512;
constexpr size_t O_FFP = O_SCP + (size_t)NB * 2 * CW;
constexpr size_t O_MK = O_FFP + (size_t)NB * 2 * DFF;
constexpr size_t O_MV = O_MK + (size_t)MMEM * DM;
constexpr size_t O_KS = O_MV + (size_t)MMEM * DM;
constexpr size_t O_VS = O_KS + (size_t)MS * 512;
constexpr size_t O_SCS = O_VS + (size_t)MS * 512;
constexpr size_t O_FFS = O_SCS + (size_t)NB * 2 * CW;
constexpr size_t O_END = O_FFS + (size_t)NB * 2 * DFF;

__device__ __forceinline__ unsigned cvt_pk_bf16(float lo, float hi) { unsigned r; asm volatile("v_cvt_pk_bf16_f32 %0, %1, %2" : "=v"(r) : "v"(lo), "v"(hi)); return r; }
__device__ __forceinline__ float bf2f(unsigned short h) { return __uint_as_float((unsigned)h << 16); }
#define DPPF(v, ctrl) __int_as_float(__builtin_amdgcn_update_dpp(0, __float_as_int(v), (ctrl), 0xf, 0xf, true))
__device__ __forceinline__ float xor16_sum(float v) { auto r = __builtin_amdgcn_permlane16_swap(__float_as_uint(v), __float_as_uint(v), false, false); return __uint_as_float(r[0]) + __uint_as_float(r[1]); }
__device__ __forceinline__ float xor32_sum(float v) { auto r = __builtin_amdgcn_permlane32_swap(__float_as_uint(v), __float_as_uint(v), false, false); return __uint_as_float(r[0]) + __uint_as_float(r[1]); }
__device__ __forceinline__ float xor16_max(float v) { auto r = __builtin_amdgcn_permlane16_swap(__float_as_uint(v), __float_as_uint(v), false, false); return fmaxf(__uint_as_float(r[0]), __uint_as_float(r[1])); }
__device__ __forceinline__ float xor32_max(float v) { auto r = __builtin_amdgcn_permlane32_swap(__float_as_uint(v), __float_as_uint(v), false, false); return fmaxf(__uint_as_float(r[0]), __uint_as_float(r[1])); }
__device__ __forceinline__ float other16(float v, int odd) { auto r = __builtin_amdgcn_permlane16_swap(__float_as_uint(v), __float_as_uint(v), false, false); return __uint_as_float(odd ? r[0] : r[1]); }
__device__ __forceinline__ float wave_sum(float v) {
    v += DPPF(v, 0xB1); v += DPPF(v, 0x4E); v += DPPF(v, 0x141); v += DPPF(v, 0x140);
    return xor32_sum(xor16_sum(v));
}
__device__ __forceinline__ float wave_max(float v) {
    v = fmaxf(v, DPPF(v, 0xB1)); v = fmaxf(v, DPPF(v, 0x4E)); v = fmaxf(v, DPPF(v, 0x141)); v = fmaxf(v, DPPF(v, 0x140));
    return xor32_max(xor16_max(v));
}
__device__ __forceinline__ float row_shr1(float v) { return __int_as_float(__builtin_amdgcn_update_dpp(__float_as_int(v), __float_as_int(v), 0x111, 0xf, 0xf, false)); }
__device__ __forceinline__ float row_shr2(float v) { return __int_as_float(__builtin_amdgcn_update_dpp(__float_as_int(v), __float_as_int(v), 0x112, 0xf, 0xf, false)); }

namespace pg8 {
constexpr int BM = 256, BK = 64, HALF = 128, HTB = HALF * BK * 2, STAGE_BYTES = 8 * HTB;
__host__ __device__ __forceinline__ int lds_byte(int r, int c) { const int st = (r >> 4) * 2 + (c >> 5), rr = r & 15, cc = c & 31, ob = rr * 64 + cc * 2; return st * 1024 + (ob ^ (((ob >> 9) & 1) << 5)); }
__host__ __device__ __forceinline__ void stage_rc(int b, int& R, int& C) { const int st = b / 1024, sb = b % 1024, swz = sb ^ (((sb >> 9) & 1) << 5); R = (st >> 1) * 16 + swz / 64; C = (st & 1) * 32 + (swz % 64) / 2; }
__host__ __device__ __forceinline__ int perm32(int rho) { const int n = rho >> 4, i = rho & 15; return 8 * (i >> 2) + 4 * n + (i & 3); }

struct Unit { const char* A; const char* B; int pm, pn; };
struct Gemm { int lda, ldb, K; };

template <class Epi, class Sched>
__device__ __forceinline__ void gemm_phase(LAS unsigned char* lds, const Gemm g, const Sched& S, const Epi& E) {
    int tid = threadIdx.x; asm volatile("" : "+v"(tid));
    const int wid = __builtin_amdgcn_readfirstlane(tid >> 6), lane = tid & 63, wr = wid >> 2, wc = wid & 3, fr = lane & 15, fq = lane >> 4;
    const int K = g.K, nt = K / BK;
    unsigned voffA[2], voffB[2];
#pragma unroll
    for (int i = 0; i < 2; ++i) { int R, C; stage_rc(tid * 16 + i * 8192, R, C); const int Rb = Epi::PERM ? ((R & ~31) + perm32(R & 31)) : R;
        voffA[i] = (unsigned)(R * g.lda + C) * 2u; voffB[i] = (unsigned)(Rb * g.ldb + C) * 2u; }
    const size_t kstep = (size_t)(BK * 2);
    const size_t hstepA = (size_t)HALF * g.lda * 2, hstepB = (size_t)HALF * g.ldb * 2;
    const unsigned ldsw = (unsigned)wid * 1024u;
    const int aoff = lds_byte(wr * 64 + fr, fq * 8), boff = lds_byte(wc * 32 + fr, fq * 8);
#define PG8_SA(b, h) (((b) * 2 + (h)) * HTB)
#define PG8_SB(b, h) ((4 + (b) * 2 + (h)) * HTB)
#define PG8_STAGE(bufoff, gbase, voff) do { _Pragma("unroll") for (int _i = 0; _i < 2; ++_i) \
        __builtin_amdgcn_global_load_lds((const unsigned*)((const char*)(gbase) + (voff)[_i]), (LAS unsigned*)(lds + (bufoff) + ldsw + _i * 8192), 16, 0, 0); } while (0)
#define PG8_LDA(dst, b, h) do { _Pragma("unroll") for (int m = 0; m < 4; ++m) _Pragma("unroll") for (int k = 0; k < 2; ++k) dst[m][k] = *(const LAS bf16x8*)(lds + PG8_SA(b, h) + aoff + m * 2048 + k * 1024); } while (0)
#define PG8_LDB(dst, b, h) do { _Pragma("unroll") for (int n = 0; n < 2; ++n) _Pragma("unroll") for (int k = 0; k < 2; ++k) dst[n][k] = *(const LAS bf16x8*)(lds + PG8_SB(b, h) + boff + n * 2048 + k * 1024); } while (0)
#define PG8_MMA(ai, bj, At, Bt) do { __builtin_amdgcn_s_setprio(1); _Pragma("unroll") for (int m = 0; m < 4; ++m) _Pragma("unroll") for (int n = 0; n < 2; ++n) _Pragma("unroll") for (int k = 0; k < 2; ++k) \
        acc[ai][bj][m][n] = __builtin_amdgcn_mfma_f32_16x16x32_bf16(Bt[n][k], At[m][k], acc[ai][bj][m][n], 0, 0, 0); __builtin_amdgcn_s_setprio(0); } while (0)
#define PG8_WAIT_V(n) asm volatile("s_waitcnt vmcnt(" #n ")" ::: "memory")
#define PG8_WAIT_L(n) asm volatile("s_waitcnt lgkmcnt(" #n ")" ::: "memory")
#define PG8_BAR __builtin_amdgcn_s_barrier()
#define PG8_SCHED __builtin_amdgcn_sched_barrier(0)
    Unit cur, nxt; int ui = 0;
    if (!S.next(0, cur)) return;
    f32x4 acc[2][2][4][2];
#pragma unroll
    for (int a = 0; a < 2; ++a)
#pragma unroll
        for (int b = 0; b < 2; ++b)
#pragma unroll
            for (int m = 0; m < 4; ++m)
#pragma unroll
                for (int n = 0; n < 2; ++n) acc[a][b][m][n] = (f32x4){0.f, 0.f, 0.f, 0.f};
    bf16x8 At[4][2], B0[2][2], B1[2][2];
    typename Epi::Pre pre{};
    const char* cA = cur.A; const char* cB = cur.B;
    PG8_STAGE(PG8_SB(0, 0), cB, voffB); PG8_STAGE(PG8_SB(0, 1), cB + hstepB, voffB); PG8_STAGE(PG8_SA(0, 0), cA, voffA); PG8_STAGE(PG8_SA(0, 1), cA + hstepA, voffA);
    if (wr == 1) PG8_BAR;
    PG8_WAIT_V(2); PG8_BAR;
    PG8_STAGE(PG8_SB(1, 0), cB + kstep, voffB); PG8_STAGE(PG8_SA(1, 0), cA + kstep, voffA); PG8_STAGE(PG8_SB(1, 1), cB + hstepB + kstep, voffB);
    PG8_WAIT_V(6); PG8_BAR;
    for (;;) {
        const bool has_next = S.next(ui + 1, nxt);
        const char* nA = has_next ? nxt.A : cA; const char* nB = has_next ? nxt.B : cB;
        for (int t = 0; t < nt; t += 2) {
            const bool last = (t == nt - 2);
            if (Epi::EARLY && last) pre = E.prefetch(cur, wr, wc, fr, fq);
            const char* a1 = cA + (size_t)(t + 1) * kstep;
            const char* a2 = last ? nA : cA + (size_t)(t + 2) * kstep; const char* b2 = last ? nB : cB + (size_t)(t + 2) * kstep;
            const char* a3 = a2 + kstep; const char* b3 = b2 + kstep;
            PG8_LDB(B0, 0, 0); PG8_LDB(B1, 0, 1); PG8_SCHED; PG8_LDA(At, 0, 0); PG8_STAGE(PG8_SA(1, 1), a1 + hstepA, voffA);
            PG8_WAIT_V(8); PG8_WAIT_L(0); PG8_BAR; PG8_MMA(0, 0, At, B0); PG8_MMA(0, 1, At, B1); PG8_BAR; PG8_SCHED;
            PG8_LDA(At, 0, 1); PG8_STAGE(PG8_SB(0, 0), b2, voffB); PG8_STAGE(PG8_SB(0, 1), b2 + hstepB, voffB); PG8_STAGE(PG8_SA(0, 0), a2, voffA);
            PG8_WAIT_V(8); PG8_WAIT_L(0); PG8_BAR; PG8_MMA(1, 0, At, B0); PG8_MMA(1, 1, At, B1); PG8_BAR; PG8_SCHED;
            PG8_LDB(B0, 1, 0); PG8_LDB(B1, 1, 1); PG8_SCHED; PG8_LDA(At, 1, 0); PG8_STAGE(PG8_SA(0, 1), a2 + hstepA, voffA);
            PG8_WAIT_V(8); PG8_WAIT_L(0); PG8_BAR; PG8_MMA(0, 0, At, B0); PG8_MMA(0, 1, At, B1); PG8_BAR; PG8_SCHED;
            PG8_LDA(At, 1, 1); PG8_STAGE(PG8_SB(1, 0), b3, voffB); PG8_STAGE(PG8_SB(1, 1), b3 + hstepB, voffB); PG8_STAGE(PG8_SA(1, 0), a3, voffA);
            PG8_WAIT_V(8); PG8_WAIT_L(0); PG8_BAR; PG8_MMA(1, 0, At, B0); PG8_MMA(1, 1, At, B1); PG8_BAR; PG8_SCHED;
        }
        if (wr == 0) PG8_BAR;
        if (!Epi::EARLY) pre = E.prefetch(cur, wr, wc, fr, fq);
        E(acc, cur, pre, wr, wc, fr, fq);
        if (!has_next) break;
#pragma unroll
        for (int a = 0; a < 2; ++a)
#pragma unroll
            for (int b = 0; b < 2; ++b)
#pragma unroll
                for (int m = 0; m < 4; ++m)
#pragma unroll
                    for (int n = 0; n < 2; ++n) acc[a][b][m][n] = (f32x4){0.f, 0.f, 0.f, 0.f};
        cur = nxt; cA = nA; cB = nB; ++ui;
        if (wr == 1) PG8_BAR;
    }
    PG8_WAIT_V(0);
    PG8_BAR;
#undef PG8_SA
#undef PG8_SB
#undef PG8_STAGE
#undef PG8_LDA
#undef PG8_LDB
#undef PG8_MMA
}
}
namespace epi {
using pg8::Unit;
typedef f32x4 Acc[2][2][4][2];
#define EPI_BAR() do { asm volatile("s_waitcnt lgkmcnt(0)" ::: "memory"); __builtin_amdgcn_s_barrier(); asm volatile("" ::: "memory"); } while (0)

__device__ __forceinline__ u32x4 pack8(const f32x4 a, const f32x4 b) { u32x4 w; w.x = cvt_pk_bf16(a[0], a[1]); w.y = cvt_pk_bf16(a[2], a[3]); w.z = cvt_pk_bf16(b[0], b[1]); w.w = cvt_pk_bf16(b[2], b[3]); return w; }
__device__ __forceinline__ u32x2 pack4(const f32x4 a) { u32x2 w; w.x = cvt_pk_bf16(a[0], a[1]); w.y = cvt_pk_bf16(a[2], a[3]); return w; }
__device__ __forceinline__ int row_pos(int row) { return row < MP ? (row & (SEQ - 1)) : PAST + ((row - MP) & (DECT - 1)); }
__device__ __forceinline__ f32x4 oth4(const f32x4 v, int odd) { f32x4 r; r[0] = other16(v[0], odd); r[1] = other16(v[1], odd); r[2] = other16(v[2], odd); r[3] = other16(v[3], odd); return r; }
__device__ __forceinline__ void store8_f32(float* p  , const f32x4 v0, const f32x4 v1, int fq) {
    f32x4 x, y;
#pragma unroll
    for (int j = 0; j < 4; ++j) { auto r = __builtin_amdgcn_permlane16_swap(__float_as_uint(v0[j]), __float_as_uint(v1[j]), false, false); x[j] = __uint_as_float(r[0]); y[j] = __uint_as_float(r[1]); }
    float* q = p + 16 * (fq >> 1) + 4 * (fq & 1);
    __builtin_nontemporal_store(x, (f32x4*)q); __builtin_nontemporal_store(y, (f32x4*)(q + 8));
}
struct PreNone {};
struct Pre8 { float v[8]; };
__device__ __forceinline__ Pre8 load8rows(const float* __restrict__ p, int row0) {
    Pre8 r;
#pragma unroll
    for (int i = 0; i < 8; ++i) r.v[i] = p[row0 + (i >> 2) * 128 + (i & 3) * 16];
    return r;
}
__device__ __forceinline__ void rope_cs(int pos, int n, f32x4& c, f32x4& s) {
    const float fp = (float)pos;
    const f32x4 k = n == 0 ? (f32x4){1.5915494309e-01f, 3.0863763405e-02f, 5.9851857127e-03f, 1.1606636412e-03f} : (f32x4){2.2507907904e-04f, 4.3647952793e-05f, 8.4643308082e-06f, 1.6414262628e-06f};
#pragma unroll
    for (int j = 0; j < 4; ++j) { const float r = __builtin_amdgcn_fractf(fp * k[j]); c[j] = __builtin_amdgcn_cosf(r); s[j] = __builtin_amdgcn_sinf(r); }
}

struct EpiInProj {
    static constexpr bool PERM = true, EARLY = true;
    typedef Pre8 Pre;
    const float* ssq;
    bf16_t* p1;
    float* out;
    __device__ __forceinline__ Pre prefetch(const Unit& u, int wr, int wc, int fr, int fq) const { return load8rows(ssq, u.pm * 256 + wr * 64 + fr); }
    __device__ __forceinline__ void operator()(Acc& acc, const Unit& u, const Pre& pre, int wr, int wc, int fr, int fq) const {
        const int pn = u.pn, row0 = u.pm * 256 + wr * 64 + fr;
        const int cl = 32 * wc + 8 * fq;
#pragma unroll
        for (int ai = 0; ai < 2; ++ai)
#pragma unroll
            for (int m = 0; m < 4; ++m) {
                const int row = row0 + ai * 128 + m * 16;
                const float rs = rsqrtf(pre.v[ai * 4 + m] * (1.0f / DM) + EPS);
                bf16_t* prow = p1 + (size_t)row * P1W;
                if (pn < 4) {
                    f32x4 c0, c1, s0, s1; const int pos = row_pos(row);
                    if ((wc & 1) == 0) { rope_cs(pos, 0, c0, s0); rope_cs(pos, 1, c1, s1); }
                    float* orow = (pn >= 2) ? (row < MP ? out + O_KP + (size_t)row * 512 : out + O_KS + (size_t)(row - MP) * 512) : nullptr;
#pragma unroll
                    for (int bj = 0; bj < 2; ++bj) {
                        f32x4 v0 = acc[ai][bj][m][0] * rs, v1 = acc[ai][bj][m][1] * rs;
                        if ((wc & 1) == 0) {
                            const f32x4 o0 = oth4(v0, fq & 1), o1 = oth4(v1, fq & 1);
                            if (fq == 0) { v0 = v0 * c0 - o0 * s0; v1 = v1 * c1 - o1 * s1; }
                            else if (fq == 1) { v0 = v0 * c0 + o0 * s0; v1 = v1 * c1 + o1 * s1; }
                        }
                        const int c = (pn & 1) * 256 + bj * 128 + cl;
                        if (pn >= 2) store8_f32(orow + c - 8 * fq, v0, v1, fq);
                        *(u32x4*)(prow + (pn >> 1) * 512 + c) = pack8(v0, v1);
                    }
                } else if (pn < 6) {
                    float* orow = row < MP ? out + O_VP + (size_t)row * 512 : out + O_VS + (size_t)(row - MP) * 512;
#pragma unroll
                    for (int bj = 0; bj < 2; ++bj) {
                        const f32x4 v0 = acc[ai][bj][m][0] * rs, v1 = acc[ai][bj][m][1] * rs;
                        const int c = (pn & 1) * 256 + bj * 128 + cl;
                        store8_f32(orow + c - 8 * fq, v0, v1, fq);
                        *(u32x4*)(prow + 1024 + c) = pack8(v0, v1);
                    }
                } else if (pn < 8) {
#pragma unroll
                    for (int bj = 0; bj < 2; ++bj) {
                        const f32x4 v0 = acc[ai][bj][m][0] * rs, v1 = acc[ai][bj][m][1] * rs;
                        const int c = (pn & 1) * 256 + bj * 128 + cl;
                        *(u32x4*)(prow + 1536 + c) = pack8(v0, v1);
                    }
                } else {
                    const float rs2 = rs * rs;
                    const f32x4 v0 = acc[ai][0][m][0] * acc[ai][1][m][0] * rs2, v1 = acc[ai][0][m][1] * acc[ai][1][m][1] * rs2;
                    const int c = (pn - 8) * 128 + cl;
                    *(u32x4*)(prow + 2048 + c) = pack8(v0, v1);
                    if (row < MP) { const int t = row & (SEQ - 1); if (t >= SEQ - 2) { float* o = out + O_SCP + ((size_t)(row >> 11) * 2 + (t - (SEQ - 2))) * CW + c; *(f32x4*)o = v0; *(f32x4*)(o + 4) = v1; } }
                    else { const int t = (row - MP) & (DECT - 1); if (t >= DECT - 2) { float* o = out + O_SCS + ((size_t)((row - MP) >> 4) * 2 + (t - (DECT - 2))) * CW + c; *(f32x4*)o = v0; *(f32x4*)(o + 4) = v1; } }
                }
            }
    }
};

struct EpiMemKV {
    static constexpr bool PERM = true, EARLY = true;
    typedef Pre8 Pre;
    const float* ssq; bf16_t* mk; bf16_t* mv; float* out;
    __device__ __forceinline__ Pre prefetch(const Unit& u, int wr, int wc, int fr, int fq) const { return load8rows(ssq, u.pm * 256 + wr * 64 + fr); }
    __device__ __forceinline__ void operator()(Acc& acc, const Unit& u, const Pre& pre, int wr, int wc, int fr, int fq) const {
        const int pn = u.pn, row0 = u.pm * 256 + wr * 64 + fr, cl = 32 * wc + 8 * fq;
        float* ob = out + (pn < 4 ? O_MK : O_MV); bf16_t* bb = pn < 4 ? mk : mv;
#pragma unroll
        for (int ai = 0; ai < 2; ++ai)
#pragma unroll
            for (int m = 0; m < 4; ++m) {
                const int row = row0 + ai * 128 + m * 16;
                const float rs = rsqrtf(pre.v[ai * 4 + m] * (1.0f / DM) + EPS);
#pragma unroll
                for (int bj = 0; bj < 2; ++bj) {
                    const f32x4 v0 = acc[ai][bj][m][0] * rs, v1 = acc[ai][bj][m][1] * rs;
                    const int c = (pn & 3) * 256 + bj * 128 + cl;
                    store8_f32(ob + (size_t)row * DM + c - 8 * fq, v0, v1, fq);
                    *(u32x4*)(bb + (size_t)row * DM + c) = pack8(v0, v1);
                }
            }
    }
};

struct EpiResidual {
    static constexpr bool PERM = true, EARLY = false;
    typedef PreNone Pre;
    bf16_t* XB; float* ssp;
    __device__ __forceinline__ Pre prefetch(const Unit&, int, int, int, int) const { return Pre{}; }
    __device__ __forceinline__ void operator()(Acc& acc, const Unit& u, const Pre&, int wr, int wc, int fr, int fq) const {
        const int row0 = u.pm * 256 + wr * 64 + fr, col0 = u.pn * 256 + wc * 32 + 8 * fq;
        bf16_t* xb = XB + (size_t)row0 * DM + col0;
        u32x4 old[8][2];
#pragma unroll
        for (int g = 0; g < 8; ++g)
#pragma unroll
            for (int bj = 0; bj < 2; ++bj) old[g][bj] = *(const u32x4*)(xb + (size_t)((g >> 2) * 128 + (g & 3) * 16) * DM + bj * 128);
#pragma unroll
        for (int g = 0; g < 8; ++g) {
            const int ai = g >> 2, m = g & 3, row = row0 + ai * 128 + m * 16; float ss = 0.f;
#pragma unroll
            for (int bj = 0; bj < 2; ++bj) {
                const u32x4 o = old[g][bj]; f32x4 v0, v1;
                v0[0] = __uint_as_float(o.x << 16) + acc[ai][bj][m][0][0]; v0[1] = __uint_as_float(o.x & 0xffff0000u) + acc[ai][bj][m][0][1]; v0[2] = __uint_as_float(o.y << 16) + acc[ai][bj][m][0][2]; v0[3] = __uint_as_float(o.y & 0xffff0000u) + acc[ai][bj][m][0][3];
                v1[0] = __uint_as_float(o.z << 16) + acc[ai][bj][m][1][0]; v1[1] = __uint_as_float(o.z & 0xffff0000u) + acc[ai][bj][m][1][1]; v1[2] = __uint_as_float(o.w << 16) + acc[ai][bj][m][1][2]; v1[3] = __uint_as_float(o.w & 0xffff0000u) + acc[ai][bj][m][1][3];
                ss += ((v0[0] * v0[0] + v0[1] * v0[1]) + (v0[2] * v0[2] + v0[3] * v0[3])) + ((v1[0] * v1[0] + v1[1] * v1[1]) + (v1[2] * v1[2] + v1[3] * v1[3]));
                *(u32x4*)(xb + (size_t)(ai * 128 + m * 16) * DM + bj * 128) = pack8(v0, v1);
            }
            ss = xor32_sum(xor16_sum(ss));
            if (fq == 0) ssp[(size_t)row * 16 + u.pn * 4 + wc] = ss;
        }
    }
};
struct EpiResidualOut {
    static constexpr bool PERM = false, EARLY = false;
    typedef PreNone Pre;
    const bf16_t* XB; float* X; float* ssp;
    __device__ __forceinline__ Pre prefetch(const Unit&, int, int, int, int) const { return Pre{}; }
    __device__ __forceinline__ void operator()(Acc& acc, const Unit& u, const Pre&, int wr, int wc, int fr, int fq) const {
        const int row0 = u.pm * 256 + wr * 64 + fr, col0 = u.pn * 256 + wc * 32 + 4 * fq;
        const bf16_t* xb = XB + (size_t)row0 * DM + col0;
        u32x2 old[8][2][2];
#pragma unroll
        for (int g = 0; g < 8; ++g)
#pragma unroll
            for (int bj = 0; bj < 2; ++bj)
#pragma unroll
                for (int n = 0; n < 2; ++n) old[g][bj][n] = *(const u32x2*)(xb + (size_t)((g >> 2) * 128 + (g & 3) * 16) * DM + bj * 128 + n * 16);
#pragma unroll
        for (int g = 0; g < 8; ++g) {
            const int ai = g >> 2, m = g & 3, row = row0 + ai * 128 + m * 16; float* xrow = X + (size_t)row * DM + col0; float ss = 0.f;
#pragma unroll
            for (int bj = 0; bj < 2; ++bj)
#pragma unroll
                for (int n = 0; n < 2; ++n) {
                    const u32x2 o = old[g][bj][n]; f32x4 v;
                    v[0] = __uint_as_float(o.x << 16) + acc[ai][bj][m][n][0]; v[1] = __uint_as_float(o.x & 0xffff0000u) + acc[ai][bj][m][n][1]; v[2] = __uint_as_float(o.y << 16) + acc[ai][bj][m][n][2]; v[3] = __uint_as_float(o.y & 0xffff0000u) + acc[ai][bj][m][n][3];
                    ss += (v[0] * v[0] + v[1] * v[1]) + (v[2] * v[2] + v[3] * v[3]);
                    *(f32x4*)(xrow + bj * 128 + n * 16) = v;
                }
            ss = xor32_sum(xor16_sum(ss));
            if (fq == 0) ssp[(size_t)row * 16 + u.pn * 4 + wc] = ss;
        }
    }
};
__device__ __forceinline__ float rstd16(const float* ssp, int row) {
    const f32x4* p = (const f32x4*)(ssp + (size_t)row * 16); const f32x4 a = p[0], b = p[1], c = p[2], d = p[3];
    const float s = ((a[0] + a[1]) + (a[2] + a[3])) + ((b[0] + b[1]) + (b[2] + b[3])) + ((c[0] + c[1]) + (c[2] + c[3])) + ((d[0] + d[1]) + (d[2] + d[3]));
    return rsqrtf(s * (1.0f / DM) + EPS);
}
struct EpiScaleBf16 {
    static constexpr bool PERM = true, EARLY = true;
    typedef Pre8 Pre;
    const float* rs; bf16_t* O; int ldo;
    __device__ __forceinline__ Pre prefetch(const Unit& u, int wr, int wc, int fr, int fq) const { return load8rows(rs, u.pm * 256 + wr * 64 + fr); }
    __device__ __forceinline__ void operator()(Acc& acc, const Unit& u, const Pre& pre, int wr, int wc, int fr, int fq) const {
        const int row0 = u.pm * 256 + wr * 64 + fr, col0 = u.pn * 256 + 32 * wc + 8 * fq;
#pragma unroll
        for (int ai = 0; ai < 2; ++ai)
#pragma unroll
            for (int m = 0; m < 4; ++m) {
                const int row = row0 + ai * 128 + m * 16; const float r = pre.v[ai * 4 + m];
#pragma unroll
                for (int bj = 0; bj < 2; ++bj) *(u32x4*)(O + (size_t)row * ldo + col0 + bj * 128) = pack8(acc[ai][bj][m][0] * r, acc[ai][bj][m][1] * r);
            }
    }
};
struct EpiXScores {
    static constexpr bool PERM = true, EARLY = false;
    typedef PreNone Pre;
    __device__ __forceinline__ Pre prefetch(const Unit&, int, int, int, int) const { return Pre{}; }
    bf16_t* P; float* lp; LAS float* red;
    __device__ __forceinline__ void operator()(Acc& acc, const Unit& u, const Pre&, int wr, int wc, int fr, int fq) const {
        constexpr float C = 0.0625f * 1.4426950408889634f;
        float mx[2][4];
#pragma unroll
        for (int ai = 0; ai < 2; ++ai)
#pragma unroll
            for (int m = 0; m < 4; ++m) {
                float a = -3.0e38f;
#pragma unroll
                for (int bj = 0; bj < 2; ++bj)
#pragma unroll
                    for (int n = 0; n < 2; ++n) { const f32x4 v = acc[ai][bj][m][n]; a = fmaxf(a, fmaxf(fmaxf(v[0], v[1]), fmaxf(v[2], v[3]))); }
                a = xor32_max(xor16_max(a));
                if (fq == 0) red[(ai * 128 + wr * 64 + m * 16 + fr) * 4 + wc] = a;
            }
        EPI_BAR();
#pragma unroll
        for (int ai = 0; ai < 2; ++ai)
#pragma unroll
            for (int m = 0; m < 4; ++m) { const f32x4 r = *(const LAS f32x4*)(red + (ai * 128 + wr * 64 + m * 16 + fr) * 4); mx[ai][m] = fmaxf(fmaxf(r[0], r[1]), fmaxf(r[2], r[3])); }
        const int row0 = u.pm * 256 + wr * 64 + fr, col0 = u.pn * 256 + 32 * wc + 8 * fq;
#pragma unroll
        for (int ai = 0; ai < 2; ++ai)
#pragma unroll
            for (int m = 0; m < 4; ++m) {
                const int row = row0 + ai * 128 + m * 16; const float mc = mx[ai][m] * C; float s = 0.f;
#pragma unroll
                for (int bj = 0; bj < 2; ++bj) {
#pragma unroll
                    for (int j = 0; j < 4; ++j) { acc[ai][bj][m][0][j] = __builtin_amdgcn_exp2f(acc[ai][bj][m][0][j] * C - mc); acc[ai][bj][m][1][j] = __builtin_amdgcn_exp2f(acc[ai][bj][m][1][j] * C - mc); }
                    const u32x4 w = pack8(acc[ai][bj][m][0], acc[ai][bj][m][1]);
                    s += (__uint_as_float(w.x << 16) + __uint_as_float(w.x & 0xffff0000u)) + (__uint_as_float(w.y << 16) + __uint_as_float(w.y & 0xffff0000u))
                       + (__uint_as_float(w.z << 16) + __uint_as_float(w.z & 0xffff0000u)) + (__uint_as_float(w.w << 16) + __uint_as_float(w.w & 0xffff0000u));
                    *(u32x4*)(P + (size_t)row * DM + col0 + bj * 128) = w;
                }
                s = xor32_sum(xor16_sum(s));
                if (fq == 0) lp[(size_t)row * 16 + u.pn * 4 + wc] = s;
                asm volatile("" ::: "memory");
            }
        EPI_BAR();
    }
};
struct EpiXPV {
    static constexpr bool PERM = true, EARLY = false;
    typedef PreNone Pre;
    __device__ __forceinline__ Pre prefetch(const Unit&, int, int, int, int) const { return Pre{}; }
    const float* lp; bf16_t* O;
    __device__ __forceinline__ void operator()(Acc& acc, const Unit& u, const Pre&, int wr, int wc, int fr, int fq) const {
        const int row0 = u.pm * 256 + wr * 64 + fr, col0 = u.pn * 256 + 32 * wc + 8 * fq;
#pragma unroll
        for (int ai = 0; ai < 2; ++ai)
#pragma unroll
            for (int m = 0; m < 4; ++m) {
                const int row = row0 + ai * 128 + m * 16; const f32x4 l4 = *(const f32x4*)(lp + (size_t)row * 16 + u.pn * 4);
                const float rl = 1.0f / ((l4[0] + l4[1]) + (l4[2] + l4[3]));
#pragma unroll
                for (int bj = 0; bj < 2; ++bj) *(u32x4*)(O + (size_t)row * DM + col0 + bj * 128) = pack8(acc[ai][bj][m][0] * rl, acc[ai][bj][m][1] * rl);
            }
    }
};
struct EpiUpGate {
    static constexpr bool PERM = true, EARLY = false;
    typedef Pre8 Pre;
    const float* rs; const float* wconv;
    const float* state;
    bf16_t* H; float* out;
    float* uh; float* u01; float* g01;
    LAS float* tail;
    __device__ __forceinline__ Pre prefetch(const Unit& u, int wr, int wc, int fr, int fq) const { return load8rows(rs, u.pm * 256 + wr * 64 + fr); }
    __device__ __forceinline__ void operator()(Acc& acc, const Unit& u, const Pre& pre, int wr, int wc, int fr, int fq) const {
        const int pm = u.pm, pn = u.pn, row0 = pm * 256 + wr * 64 + fr, cl = 32 * wc + 8 * fq, gc = pn * 128 + cl;
        const bool sample = pm >= NTILE_P;
        const f32x4 w00 = *(const f32x4*)(wconv + gc), w01 = *(const f32x4*)(wconv + gc + 4), w10 = *(const f32x4*)(wconv + DFF + gc), w11 = *(const f32x4*)(wconv + DFF + gc + 4),
                    w20 = *(const f32x4*)(wconv + 2 * DFF + gc), w21 = *(const f32x4*)(wconv + 2 * DFF + gc + 4);
#pragma unroll
        for (int ai = 0; ai < 2; ++ai)
#pragma unroll
            for (int m = 0; m < 4; ++m) {
                const int g = ai * 8 + wr * 4 + m; const float r = pre.v[ai * 4 + m];
#pragma unroll
                for (int bj = 0; bj < 2; ++bj)
#pragma unroll
                    for (int n = 0; n < 2; ++n) acc[ai][bj][m][n] *= r;
                if (fr >= 14) {
                    LAS float* t = tail + (g * 2 + (fr - 14)) * 128 + cl; *(LAS f32x4*)t = acc[ai][0][m][0]; *(LAS f32x4*)(t + 4) = acc[ai][0][m][1];
                    if (sample) { float* o = out + O_FFS + ((size_t)((pm - NTILE_P) * 16 + g) * 2 + (fr - 14)) * DFF + gc; *(f32x4*)o = acc[ai][0][m][0]; *(f32x4*)(o + 4) = acc[ai][0][m][1]; }
                    else if (g == 15) {
                        float* o = uh + ((size_t)pm * 2 + (fr - 14)) * DFF + gc; *(f32x4*)o = acc[ai][0][m][0]; *(f32x4*)(o + 4) = acc[ai][0][m][1];
                        if ((pm & 7) == 7) { float* q = out + O_FFP + ((size_t)(pm >> 3) * 2 + (fr - 14)) * DFF + gc; *(f32x4*)q = acc[ai][0][m][0]; *(f32x4*)(q + 4) = acc[ai][0][m][1]; }
                    }
                }
                if (!sample && g == 0 && fr < 2) {
                    float* o = u01 + ((size_t)pm * 2 + fr) * DFF + gc; *(f32x4*)o = acc[ai][0][m][0]; *(f32x4*)(o + 4) = acc[ai][0][m][1];
                    float* q = g01 + ((size_t)pm * 2 + fr) * DFF + gc; *(f32x4*)q = acc[ai][1][m][0]; *(f32x4*)(q + 4) = acc[ai][1][m][1];
                }
            }
        EPI_BAR();
#pragma unroll
        for (int ai = 0; ai < 2; ++ai)
#pragma unroll
            for (int m = 0; m < 4; ++m) {
                const int row = row0 + ai * 128 + m * 16, g = ai * 8 + wr * 4 + m;
                f32x4 h1[2] = {(f32x4){0.f, 0.f, 0.f, 0.f}, (f32x4){0.f, 0.f, 0.f, 0.f}}, h2[2] = {(f32x4){0.f, 0.f, 0.f, 0.f}, (f32x4){0.f, 0.f, 0.f, 0.f}};
                if (fr < 2) {
                    if (sample) { const float* s = state + (size_t)((pm - NTILE_P) * 16 + g) * 2 * DFF + gc; h2[0] = *(const f32x4*)(s + fr * DFF); h2[1] = *(const f32x4*)(s + fr * DFF + 4); h1[0] = *(const f32x4*)(s + DFF); h1[1] = *(const f32x4*)(s + DFF + 4); }
                    else if (g > 0) { const LAS float* t = tail + ((g - 1) * 2) * 128 + cl; h2[0] = *(const LAS f32x4*)(t + fr * 128); h2[1] = *(const LAS f32x4*)(t + fr * 128 + 4); h1[0] = *(const LAS f32x4*)(t + 128); h1[1] = *(const LAS f32x4*)(t + 132); }
                }
                f32x4 hv[2];
#pragma unroll
                for (int n = 0; n < 2; ++n) {
                    const f32x4 uc = acc[ai][0][m][n]; f32x4 p1, p2;
#pragma unroll
                    for (int j = 0; j < 4; ++j) {
                        p1[j] = __int_as_float(__builtin_amdgcn_update_dpp(__float_as_int(h1[n][j]), __float_as_int(uc[j]), 0x111, 0xf, 0xf, false));
                        p2[j] = __int_as_float(__builtin_amdgcn_update_dpp(__float_as_int(h2[n][j]), __float_as_int(uc[j]), 0x112, 0xf, 0xf, false)); }
                    const f32x4 y = (n == 0 ? w00 : w01) * p2 + (n == 0 ? w10 : w11) * p1 + (n == 0 ? w20 : w21) * uc;
                    const f32x4 t = y * (-1.4426950408889634f); f32x4 d;
#pragma unroll
                    for (int j = 0; j < 4; ++j) d[j] = __builtin_amdgcn_exp2f(t[j]);
                    d = d + 1.0f;
#pragma unroll
                    for (int j = 0; j < 4; ++j) d[j] = __builtin_amdgcn_rcpf(d[j]);
                    hv[n] = (y * d) * acc[ai][1][m][n];
                }
                *(u32x4*)(H + (size_t)row * DFF + gc) = pack8(hv[0], hv[1]);
            }
        EPI_BAR();
    }
};
struct EpiPartialF32 {
    static constexpr bool PERM = false, EARLY = false;
    typedef PreNone Pre;
    float* S;
    __device__ __forceinline__ Pre prefetch(const Unit&, int, int, int, int) const { return Pre{}; }
    __device__ __forceinline__ void operator()(Acc& acc, const Unit& u, const Pre&, int wr, int wc, int fr, int fq) const {
        const int kh = u.pn >> 4, pn = u.pn & 15, row0 = (u.pm - NTILE_P) * 256 + wr * 64 + fr, col0 = pn * 256 + wc * 32 + 4 * fq;
        float* b = S + (size_t)kh * MS * DM + (size_t)row0 * DM + col0;
#pragma unroll
        for (int ai = 0; ai < 2; ++ai)
#pragma unroll
            for (int m = 0; m < 4; ++m)
#pragma unroll
                for (int bj = 0; bj < 2; ++bj)
#pragma unroll
                    for (int n = 0; n < 2; ++n) *(f32x4*)(b + (size_t)(ai * 128 + m * 16) * DM + bj * 128 + n * 16) = acc[ai][bj][m][n];
    }
};
}
namespace dattn {
constexpr int NW = 8, QBLK = 32, KVBLK = 64;
constexpr float SCALE = 0.125f, THR = 8.f;
constexpr int SHM_V = KVBLK * 128 * 2, SHM_K = KVBLK * 128 * 2, SHM_ATTN = 2 * SHM_V + 2 * SHM_K + NW * 64 * 4;
#define KSWZ(row, colB) ((row) * 256 + ((colB) ^ (((row) & 7) << 4)))
#define SBAR() __builtin_amdgcn_sched_barrier(0)
__device__ __forceinline__ int crow(int r, int hi) { return (r & 3) + 8 * (r >> 2) + 4 * hi; }
__device__ __forceinline__ void partialSM(f32x16& p0, f32x16& p1, float& m_reg, float& mn, float& alpha) {
  constexpr float C = SCALE * 1.4426950408889634f;
  float pmax = p0[0];
#pragma unroll
  for (int r = 1; r < 16; ++r) pmax = fmaxf(pmax, p0[r]);
#pragma unroll
  for (int r = 0; r < 16; ++r) pmax = fmaxf(pmax, p1[r]);
  { auto rr = __builtin_amdgcn_permlane32_swap(__float_as_uint(pmax), __float_as_uint(pmax), false, false);
    pmax = fmaxf(__uint_as_float(rr[0]), __uint_as_float(rr[1])); }
  if (__builtin_expect(__all(pmax - m_reg <= THR / SCALE), 1)) { mn = m_reg; alpha = 1.f; }
  else { mn = fmaxf(m_reg, pmax); alpha = __builtin_amdgcn_exp2f((m_reg - mn) * C); m_reg = mn; }
  const float mnC = -mn * C;
#pragma unroll
  for (int r = 0; r < 16; ++r) p0[r] = fmaf(p0[r], C, mnC);
#pragma unroll
  for (int r = 0; r < 16; ++r) p1[r] = fmaf(p1[r], C, mnC);
#pragma unroll
  for (int r = 0; r < 16; ++r) p0[r] = __builtin_amdgcn_exp2f(p0[r]);
}
__device__ __forceinline__ void finishSM(f32x16& p0, f32x16& p1, float alpha, float& l_reg, bf16x8& pa0, bf16x8& pa1, bf16x8& pa2, bf16x8& pa3) {
#pragma unroll
  for (int r = 0; r < 16; ++r) p1[r] = __builtin_amdgcn_exp2f(p1[r]);
  float ps = 0;
#pragma unroll
  for (int r = 0; r < 16; ++r) ps += p0[r];
#pragma unroll
  for (int r = 0; r < 16; ++r) ps += p1[r];
  { auto rr = __builtin_amdgcn_permlane32_swap(__float_as_uint(ps), __float_as_uint(ps), false, false);
    ps = __uint_as_float(rr[0]) + __uint_as_float(rr[1]); }
  l_reg = l_reg * alpha + ps;
#define PK4(P, BASE, OUT) do { unsigned a0 = cvt_pk_bf16(P[BASE + 0], P[BASE + 1]), a1 = cvt_pk_bf16(P[BASE + 2], P[BASE + 3]);   \
    unsigned b0 = cvt_pk_bf16(P[BASE + 4], P[BASE + 5]), b1 = cvt_pk_bf16(P[BASE + 6], P[BASE + 7]);                              \
    auto r0 = __builtin_amdgcn_permlane32_swap(a0, b0, false, false); auto r1 = __builtin_amdgcn_permlane32_swap(a1, b1, false, false); \
    u32x4 w = {r0[0], r1[0], r0[1], r1[1]}; OUT = *reinterpret_cast<bf16x8*>(&w); } while (0)
  PK4(p0, 0, pa0); PK4(p0, 8, pa1); PK4(p1, 0, pa2); PK4(p1, 8, pa3);
#undef PK4
}
__device__ __forceinline__ void qkt(f32x16& p0, f32x16& p1, const char* Ks, const bf16x8* qr, int r32, int hi, int mp) {
  p0 = f32x16{}; p1 = f32x16{};
#pragma unroll
  for (int d0 = 0; d0 < 4; ++d0) { const int cb = (mp * 64 + d0 * 16 + hi * 8) * 2;
    const bf16x8 b0 = *reinterpret_cast<const bf16x8*>(Ks + KSWZ(r32, cb));
    const bf16x8 b1 = *reinterpret_cast<const bf16x8*>(Ks + KSWZ(32 + r32, cb));
    p0 = __builtin_amdgcn_mfma_f32_32x32x16_bf16(b0, qr[d0], p0, 0, 0, 0);
    p1 = __builtin_amdgcn_mfma_f32_32x32x16_bf16(b1, qr[d0], p1, 0, 0, 0); }
}
__device__ __forceinline__ int v_st(int k, int c) { const int kk = (k & ~0xC) | ((k & 4) << 1) | ((k & 8) >> 1); return ((kk >> 3) * 4 + (c >> 5)) * 512 + ((kk & 7) * 32 + (c & 31)) * 2; }
__device__ __forceinline__ int v_rd_base(int lane) { return ((lane & 3) << 3) | (((lane >> 2) & 3) << 6) | (((lane >> 4) & 1) << 5) | (((lane >> 5) & 1) << 8); }
constexpr int v_rd_off(int d0, int ks, int half) { return d0 * 512 + ks * 4096 + half * 2048; }
template <int OFF> __device__ __forceinline__ s16x4 tr_read(int vb) {
  s16x4 r; asm volatile("ds_read_b64_tr_b16 %0, %1 offset:%2" : "=&v"(r) : "v"(vb), "i"(OFF) : "memory"); return r;
}
template <int D0> __device__ __forceinline__ void pv_one(f32x16& od, int vb, bf16x8 pa0, bf16x8 pa1, bf16x8 pa2, bf16x8 pa3) {
  const s16x4 l0 = tr_read<v_rd_off(D0, 0, 0)>(vb), h0 = tr_read<v_rd_off(D0, 0, 1)>(vb), l1 = tr_read<v_rd_off(D0, 1, 0)>(vb), h1 = tr_read<v_rd_off(D0, 1, 1)>(vb);
  const s16x4 l2 = tr_read<v_rd_off(D0, 2, 0)>(vb), h2 = tr_read<v_rd_off(D0, 2, 1)>(vb), l3 = tr_read<v_rd_off(D0, 3, 0)>(vb), h3 = tr_read<v_rd_off(D0, 3, 1)>(vb);
  asm volatile("s_waitcnt lgkmcnt(0)" ::: "memory"); SBAR();
#define PK(L, H) (bf16x8){L[0], L[1], L[2], L[3], H[0], H[1], H[2], H[3]}
  od = __builtin_amdgcn_mfma_f32_32x32x16_bf16(pa0, PK(l0, h0), od, 0, 0, 0);
  od = __builtin_amdgcn_mfma_f32_32x32x16_bf16(pa1, PK(l1, h1), od, 0, 0, 0);
  od = __builtin_amdgcn_mfma_f32_32x32x16_bf16(pa2, PK(l2, h2), od, 0, 0, 0);
  od = __builtin_amdgcn_mfma_f32_32x32x16_bf16(pa3, PK(l3, h3), od, 0, 0, 0);
#undef PK
}
__device__ __forceinline__ void pv_d0(f32x16* o, int vb, bf16x8 pa0, bf16x8 pa1, bf16x8 pa2, bf16x8 pa3) {
  pv_one<0>(o[0], vb, pa0, pa1, pa2, pa3); pv_one<1>(o[1], vb, pa0, pa1, pa2, pa3); pv_one<2>(o[2], vb, pa0, pa1, pa2, pa3); pv_one<3>(o[3], vb, pa0, pa1, pa2, pa3);
}

__device__ __forceinline__ void qkt3(f32x16& p0, f32x16& p1, const LAS char* Ks, const bf16x8* qr, int r32, int hi, int mp) {
  p0 = f32x16{}; p1 = f32x16{};
#pragma unroll
  for (int d0 = 0; d0 < 4; ++d0) { const int cb = (mp * 64 + d0 * 16 + hi * 8) * 2;
    const bf16x8 b0 = *reinterpret_cast<const LAS bf16x8*>(Ks + KSWZ(r32, cb));
    const bf16x8 b1 = *reinterpret_cast<const LAS bf16x8*>(Ks + KSWZ(32 + r32, cb));
    p0 = __builtin_amdgcn_mfma_f32_32x32x16_bf16(b0, qr[d0], p0, 0, 0, 0);
    p1 = __builtin_amdgcn_mfma_f32_32x32x16_bf16(b1, qr[d0], p1, 0, 0, 0); }
}
__device__ __forceinline__ void unit(int b, int h, int qb, const bf16_t* __restrict__ p1, bf16_t* __restrict__ A2, float lam, const float* __restrict__ gsub, LAS char* lds3) {
  int tid = threadIdx.x; asm volatile("" : "+v"(tid));
  const int wid = __builtin_amdgcn_readfirstlane(tid >> 6), lane = tid & 63, r32 = lane & 31, hi = lane >> 5, wq = wid & 3, mp = wid >> 2;
  LAS float* ws = (LAS float*)(lds3 + 131072) + wid * 64; LAS float* li_l = ws; LAS float* al_l = ws + 32;
  float m_reg = -1e30f, l_reg = 0; f32x16 o[4] = {}; bf16x8 qr[4];
  const size_t rowb = (size_t)b * SEQ;
  const char* Kh = (const char*)(p1 + rowb * P1W + 512 + h * 128); const char* Vh = (const char*)(p1 + rowb * P1W + 1024 + h * 128);
  unsigned koff[2], voff[2];
#pragma unroll
  for (int i = 0; i < 2; ++i) {
    const int krow = wid * 8 + i * 4 + (lane >> 4), kch = (lane & 15) ^ (krow & 7); koff[i] = (unsigned)(krow * P1W * 2 + kch * 16);
    const int sub = wid * 4 + i * 2 + (lane >> 5), kk = (sub >> 2) * 8 + ((lane & 31) >> 2), key = (kk & ~0xC) | ((kk & 4) << 1) | ((kk & 8) >> 1), c = (sub & 3) * 32 + (lane & 3) * 8;
    voff[i] = (unsigned)(key * P1W * 2 + c * 2);
  }
  const unsigned dmaw = (unsigned)wid * 2048u;
#define DMA(t, slot) do { const char* kb_ = Kh + (size_t)(t) * (KVBLK * P1W * 2); const char* vb_ = Vh + (size_t)(t) * (KVBLK * P1W * 2); _Pragma("unroll") for (int i_ = 0; i_ < 2; ++i_) { \
    __builtin_amdgcn_global_load_lds((const unsigned*)(kb_ + koff[i_]), (LAS unsigned*)(lds3 + (slot) * 32768 + dmaw + i_ * 1024), 16, 0, 0); \
    __builtin_amdgcn_global_load_lds((const unsigned*)(vb_ + voff[i_]), (LAS unsigned*)(lds3 + (slot) * 32768 + 16384 + dmaw + i_ * 1024), 16, 0, 0); } } while (0)
#define WAITV(n) asm volatile("s_waitcnt vmcnt(" #n ")" ::: "memory")
#define LBAR() do { asm volatile("s_waitcnt lgkmcnt(0)" ::: "memory"); __builtin_amdgcn_s_barrier(); asm volatile("" ::: "memory"); } while (0)
#define KS(t) (lds3 + ((t) & 3) * 32768)
#define VB(t) (vrd + ((t) & 3) * 32768)
  const int NT = 2 * qb + 2;
  const bool vis_last = (wq >= 2);
  DMA(0, 0); DMA(1, 1);
  const bf16_t* Qw = p1 + (rowb + qb * 128 + wq * QBLK + r32) * P1W + h * 128 + mp * 64 + hi * 8;
#pragma unroll
  for (int d0 = 0; d0 < 4; ++d0) qr[d0] = *reinterpret_cast<const bf16x8*>(Qw + d0 * 16);
  const int vrd = (int)(uintptr_t)lds3 + 16384 + v_rd_base(lane);
#define RESC(a) do { if (__any((a) < 1.f)) { if (hi == 0) al_l[r32] = (a); asm volatile("s_waitcnt lgkmcnt(0)" ::: "memory"); \
    _Pragma("unroll") for (int d = 0; d < 4; ++d) _Pragma("unroll") for (int r = 0; r < 16; ++r) o[d][r] *= al_l[crow(r, hi)]; } } while (0)
  f32x16 pA0, pA1, pB0, pB1; float mnA, mnB, alA, alB; bf16x8 pa0, pa1, pa2, pa3;
  WAITV(4); LBAR();
  if (2 < NT) DMA(2, 2);
  qkt3(pA0, pA1, KS(0), qr, r32, hi, mp); partialSM(pA0, pA1, m_reg, mnA, alA);
  for (int j = 1; j + 1 < NT; j += 2) {
    WAITV(4); LBAR(); DMA(j + 2, (j + 2) & 3);
    SBAR(); qkt3(pB0, pB1, KS(j), qr, r32, hi, mp);
    finishSM(pA0, pA1, alA, l_reg, pa0, pa1, pa2, pa3); SBAR();
    pv_d0(o, VB(j - 1), pa0, pa1, pa2, pa3); partialSM(pB0, pB1, m_reg, mnB, alB);
    RESC(alB);
    WAITV(4); LBAR(); if (j + 3 < NT) DMA(j + 3, (j + 3) & 3);
    SBAR(); qkt3(pA0, pA1, KS(j + 1), qr, r32, hi, mp);
    finishSM(pB0, pB1, alB, l_reg, pa0, pa1, pa2, pa3); SBAR();
    pv_d0(o, VB(j), pa0, pa1, pa2, pa3); partialSM(pA0, pA1, m_reg, mnA, alA);
    RESC(alA);
  }
  WAITV(0); LBAR();
  SBAR();
  if (vis_last) qkt3(pB0, pB1, KS(NT - 1), qr, r32, hi, mp);
  finishSM(pA0, pA1, alA, l_reg, pa0, pa1, pa2, pa3); SBAR();
  pv_d0(o, VB(NT - 2), pa0, pa1, pa2, pa3);
  if (vis_last) {
    partialSM(pB0, pB1, m_reg, mnB, alB);
    RESC(alB);
    finishSM(pB0, pB1, alB, l_reg, pa0, pa1, pa2, pa3); SBAR();
    pv_d0(o, VB(NT - 1), pa0, pa1, pa2, pa3);
  }
  if (hi == 0) li_l[r32] = l_reg; asm volatile("s_waitcnt lgkmcnt(0)" ::: "memory");
  float rli[16];
#pragma unroll
  for (int r = 0; r < 16; ++r) rli[r] = __builtin_amdgcn_rcpf(li_l[crow(r, hi)]);
  LBAR();
  LAS float* X = (LAS float*)lds3 + wq * (32 * 132);
  if (mp == 1) {
#pragma unroll
    for (int r = 0; r < 16; ++r) { const int orow = crow(r, hi);
#pragma unroll
      for (int d0 = 0; d0 < 4; ++d0) X[orow * 132 + d0 * 32 + r32] = o[d0][r] * rli[r]; }
  }
  LBAR();
  if (mp == 0) {
#pragma unroll
    for (int r = 0; r < 16; ++r) { const int orow = crow(r, hi);
#pragma unroll
      for (int d0 = 0; d0 < 4; ++d0) { LAS float* p = &X[orow * 132 + d0 * 32 + r32]; *p = o[d0][r] * rli[r] - lam * (*p); } }
    asm volatile("s_waitcnt lgkmcnt(0)" ::: "memory");
    const int row = lane >> 1, half = lane & 1; const LAS float* xr = X + row * 132 + half * 64;
    f32x4 v[16]; float ss = 0.f;
#pragma unroll
    for (int i = 0; i < 16; ++i) { v[i] = *(const LAS f32x4*)(xr + 4 * i); ss += (v[i][0] * v[i][0] + v[i][1] * v[i][1]) + (v[i][2] * v[i][2] + v[i][3] * v[i][3]); }
    ss += DPPF(ss, 0xB1);
    const float rs = rsqrtf(ss * (1.0f / 128.0f) + EPS) * (1.0f - LAM_INIT);
    bf16_t* orow = A2 + (rowb + qb * 128 + wq * QBLK + row) * DM + h * 128 + half * 64; const float* g = gsub + half * 64;
#pragma unroll
    for (int i = 0; i < 16; i += 2) { const f32x4 g0 = *(const f32x4*)(g + 4 * i), g1 = *(const f32x4*)(g + 4 * i + 4);
      *(u32x4*)(orow + 4 * i) = epi::pack8(v[i] * g0 * rs, v[i + 1] * g1 * rs); }
  }
  asm volatile("s_waitcnt vmcnt(0)" ::: "memory");
  LBAR();
#undef DMA
#undef WAITV
#undef LBAR
#undef KS
#undef VB
#undef RESC
}
#undef KSWZ
#undef SBAR
}
namespace misc {
constexpr int SK = PAST + DECT;
__device__ __forceinline__ void sample_attn_unit(int b, int h, int qh, const bf16_t* __restrict__ p1, const float* __restrict__ ck, const float* __restrict__ cv,
                                                 const float* __restrict__ nk, const float* __restrict__ nv, bf16_t* __restrict__ A2, float lam, const float* __restrict__ gsub, char* lds) {
  int tid = threadIdx.x; asm volatile("" : "+v"(tid)); const int lane = tid & 63, wid = tid >> 6;
  float* S = (float*)lds; float* red = (float*)(lds + 66560); float* q = (float*)(lds + 132096); float* st = (float*)(lds + 136192);
  for (int i = tid; i < 1024; i += 512) { const int mp = i >> 9, r = (i >> 6) & 7, d = i & 63;
    q[i] = bf2f(p1[(size_t)(MP + b * DECT + qh * 8 + r) * P1W + h * 128 + mp * 64 + d]); }
  __syncthreads();
  for (int it = tid; it < 2 * SK; it += 512) {
    const int mp = it / SK, key = it - mp * SK;
    const float* kp = key < PAST ? ck + (((size_t)b * PAST + key) * NH + h) * 128 + mp * 64 : nk + ((size_t)(b * DECT + key - PAST)) * 512 + h * 128 + mp * 64;
    float a[8] = {0.f, 0.f, 0.f, 0.f, 0.f, 0.f, 0.f, 0.f};
#pragma unroll 4
    for (int d = 0; d < 64; d += 4) { const f32x4 kv = *(const f32x4*)(kp + d);
#pragma unroll
      for (int r = 0; r < 8; ++r) { const f32x4 qv = *(const f32x4*)(q + (mp * 8 + r) * 64 + d); a[r] += (kv[0] * qv[0] + kv[1] * qv[1]) + (kv[2] * qv[2] + kv[3] * qv[3]); } }
#pragma unroll
    for (int r = 0; r < 8; ++r) S[(mp * 8 + r) * SK + key] = a[r] * 0.125f;
  }
  __syncthreads();
  for (int rr = 0; rr < 2; ++rr) { const int row = wid * 2 + rr; float* s = S + row * SK;
    float mx = -3.0e38f; for (int k = lane; k < SK; k += 64) mx = fmaxf(mx, s[k]); mx = wave_max(mx);
    float sum = 0.f; for (int k = lane; k < SK; k += 64) { const float e = __expf(s[k] - mx); s[k] = e; sum += e; } sum = wave_sum(sum);
    if (lane == 0) st[row] = 1.0f / sum; }
  __syncthreads();
  for (int i = tid; i < 8 * SK; i += 512) { const int r = i / SK, k = i - r * SK; S[r * SK + k] = S[r * SK + k] * st[r] - lam * S[(8 + r) * SK + k] * st[8 + r]; }
  __syncthreads();
  { const int eg = tid & 31, ks = tid >> 5; f32x4 o[8];
#pragma unroll
    for (int r = 0; r < 8; ++r) o[r] = (f32x4){0.f, 0.f, 0.f, 0.f};
    for (int key = ks; key < SK; key += 16) {
      const float* vp = key < PAST ? cv + (((size_t)b * PAST + key) * NH + h) * 128 + eg * 4 : nv + ((size_t)(b * DECT + key - PAST)) * 512 + h * 128 + eg * 4;
      const f32x4 vv = *(const f32x4*)vp;
#pragma unroll
      for (int r = 0; r < 8; ++r) o[r] += vv * S[r * SK + key]; }
#pragma unroll
    for (int r = 0; r < 8; ++r) *(f32x4*)(red + (ks * 8 + r) * 128 + eg * 4) = o[r]; }
  __syncthreads();
  { const int r = wid; float x0 = 0.f, x1 = 0.f;
#pragma unroll
    for (int ks = 0; ks < 16; ++ks) { const f32x2 t = *(const f32x2*)(red + (ks * 8 + r) * 128 + 2 * lane); x0 += t[0]; x1 += t[1]; }
    const float ss = wave_sum(x0 * x0 + x1 * x1); const float rs = rsqrtf(ss * (1.0f / 128.0f) + EPS) * (1.0f - LAM_INIT);
    const unsigned w = cvt_pk_bf16(x0 * rs * gsub[2 * lane], x1 * rs * gsub[2 * lane + 1]);
    *(unsigned*)(A2 + (size_t)(MP + b * DECT + qh * 8 + r) * DM + h * 128 + 2 * lane) = w; }
  __syncthreads();
}

__device__ __forceinline__ void sample_xattn_unit(int b, int h, const bf16_t* __restrict__ HQ, const float* __restrict__ mk, const float* __restrict__ mv, bf16_t* __restrict__ XO, char* lds) {
  int tid = threadIdx.x; asm volatile("" : "+v"(tid)); const int lane = tid & 63, wid = tid >> 6;
  float* q = (float*)lds; float* S = (float*)(lds + 16384);
  for (int i = tid; i < 16 * 256; i += 512) { const int r = i >> 8, d = i & 255; q[i] = bf2f(HQ[(size_t)(MP + b * DECT + r) * DM + h * 256 + d]); }
  __syncthreads();
  { const int key = tid >> 1, qh = tid & 1; const float* kp = mk + (((size_t)b * NMEM + key) * NH + h) * 256;
    float a[8] = {0.f, 0.f, 0.f, 0.f, 0.f, 0.f, 0.f, 0.f};
    for (int d0 = 0; d0 < 256; d0 += 32) {
      f32x4 kv[8];
#pragma unroll
      for (int i = 0; i < 8; ++i) kv[i] = *(const f32x4*)(kp + d0 + 4 * i);
#pragma unroll
      for (int i = 0; i < 8; ++i) {
#pragma unroll
        for (int r = 0; r < 8; ++r) { const f32x4 qv = *(const f32x4*)(q + (qh * 8 + r) * 256 + d0 + 4 * i); a[r] += (kv[i][0] * qv[0] + kv[i][1] * qv[1]) + (kv[i][2] * qv[2] + kv[i][3] * qv[3]); } } }
#pragma unroll
    for (int r = 0; r < 8; ++r) S[(qh * 8 + r) * 256 + key] = a[r] * 0.0625f; }
  __syncthreads();
  for (int rr = 0; rr < 2; ++rr) { const int row = wid * 2 + rr; float* s = S + row * 256;
    float v[4]; float mx = -3.0e38f;
#pragma unroll
    for (int i = 0; i < 4; ++i) { v[i] = s[lane + 64 * i]; mx = fmaxf(mx, v[i]); } mx = wave_max(mx);
    float sum = 0.f;
#pragma unroll
    for (int i = 0; i < 4; ++i) { v[i] = __expf(v[i] - mx); sum += v[i]; } sum = wave_sum(sum); const float rl = 1.0f / sum;
#pragma unroll
    for (int i = 0; i < 4; ++i) s[lane + 64 * i] = v[i] * rl; }
  __syncthreads();
  { const int r = tid >> 5, dg = tid & 31; const float* vp = mv + ((size_t)b * NMEM * NH + h) * 256 + dg * 8; f32x4 o0 = {0.f, 0.f, 0.f, 0.f}, o1 = {0.f, 0.f, 0.f, 0.f};
    for (int kb = 0; kb < NMEM; kb += 8) {
      f32x4 va[8], vc[8];
#pragma unroll
      for (int u = 0; u < 8; ++u) { va[u] = *(const f32x4*)(vp + (size_t)(kb + u) * NH * 256); vc[u] = *(const f32x4*)(vp + (size_t)(kb + u) * NH * 256 + 4); }
#pragma unroll
      for (int u = 0; u < 8; ++u) { const float p = S[r * 256 + kb + u]; o0 += va[u] * p; o1 += vc[u] * p; } }
    *(u32x4*)(XO + (size_t)(MP + b * DECT + r) * DM + h * 256 + dg * 8) = epi::pack8(o0, o1); }
  __syncthreads();
}

__device__ __forceinline__ void shortconv_item(int item, const bf16_t* __restrict__ p1, const float* __restrict__ wsc, const float* __restrict__ state, bf16_t* __restrict__ A2) {
  const int cgp = item & 63, chunk = item >> 6, c = cgp * 8, r0 = chunk * 8;
  const bool sample = r0 >= MP;
  const bool seq_start = sample ? (((r0 - MP) & (DECT - 1)) == 0) : ((r0 & (SEQ - 1)) == 0);
  u32x4 uu[10], gg[8];
#pragma unroll
  for (int r = 0; r < 10; ++r) { const int row = r0 - 2 + r; uu[r] = (r >= 2 || !seq_start) ? *(const u32x4*)(p1 + (size_t)row * P1W + 2048 + c) : (u32x4){0u, 0u, 0u, 0u}; }
#pragma unroll
  for (int r = 0; r < 8; ++r) gg[r] = *(const u32x4*)(p1 + (size_t)(r0 + r) * P1W + 1536 + c);
  float w0[8], w1[8], w2[8], um2[8], um1[8];
#pragma unroll
  for (int j = 0; j < 8; ++j) { w0[j] = wsc[c + j]; w1[j] = wsc[CW + c + j]; w2[j] = wsc[2 * CW + c + j]; }
  if (sample && seq_start) { const float* s = state + (size_t)((r0 - MP) >> 4) * 2 * CW + c;
#pragma unroll
    for (int j = 0; j < 8; ++j) { um2[j] = s[j]; um1[j] = s[CW + j]; } }
  else {
#pragma unroll
    for (int j = 0; j < 4; ++j) { um2[2 * j] = __uint_as_float(uu[0][j] << 16); um2[2 * j + 1] = __uint_as_float(uu[0][j] & 0xffff0000u); um1[2 * j] = __uint_as_float(uu[1][j] << 16); um1[2 * j + 1] = __uint_as_float(uu[1][j] & 0xffff0000u); } }
#pragma unroll
  for (int r = 0; r < 8; ++r) {
    float y[8];
#pragma unroll
    for (int j = 0; j < 4; ++j) {
      const float u0 = __uint_as_float(uu[r + 2][j] << 16), u1 = __uint_as_float(uu[r + 2][j] & 0xffff0000u), g0 = __uint_as_float(gg[r][j] << 16), g1 = __uint_as_float(gg[r][j] & 0xffff0000u);
      y[2 * j] = g0 * (w0[2 * j] * um2[2 * j] + w1[2 * j] * um1[2 * j] + w2[2 * j] * u0); y[2 * j + 1] = g1 * (w0[2 * j + 1] * um2[2 * j + 1] + w1[2 * j + 1] * um1[2 * j + 1] + w2[2 * j + 1] * u1);
      um2[2 * j] = um1[2 * j]; um2[2 * j + 1] = um1[2 * j + 1]; um1[2 * j] = u0; um1[2 * j + 1] = u1; }
    u32x4 w; w.x = cvt_pk_bf16(y[0], y[1]); w.y = cvt_pk_bf16(y[2], y[3]); w.z = cvt_pk_bf16(y[4], y[5]); w.w = cvt_pk_bf16(y[6], y[7]);
    *(u32x4*)(A2 + (size_t)(r0 + r) * DM + 512 + c) = w;
  }
}
__device__ __forceinline__ void transpose_item(int item, const bf16_t* __restrict__ src, bf16_t* __restrict__ dst, LAS bf16_t* scr, int lane) {
  const int bi = item >> 4, bj = item & 15, r0 = bi * 64, c0 = bj * 64;
  for (int i = 0; i < 64; ++i) scr[i * 66 + lane] = src[(size_t)(r0 + i) * DM + c0 + lane];
  asm volatile("s_waitcnt lgkmcnt(0)" ::: "memory");
  for (int i = 0; i < 64; ++i) dst[(size_t)(c0 + i) * MMEM + r0 + lane] = scr[lane * 66 + i];
  asm volatile("s_waitcnt lgkmcnt(0)" ::: "memory");
}
}
constexpr size_t MiB = 1u << 20;
constexpr size_t WS_SSQ0 = 1 * MiB, WS_SSQM = WS_SSQ0 + 288 * 1024, WS_RS1 = WS_SSQ0 + 320 * 1024, WS_RS2 = WS_SSQ0 + 640 * 1024;
constexpr size_t WS_SSP1 = 2 * MiB, WS_SSP2 = 7 * MiB, WS_SSP3 = 12 * MiB, WS_L4 = 17 * MiB;
constexpr size_t WS_UH = 22 * MiB, WS_U01 = 28 * MiB, WS_G01 = 34 * MiB;
constexpr size_t WS_WIN = 40 * MiB, WS_WOUT = 46 * MiB, WS_WXQ = 48 * MiB, WS_WXKV = 50 * MiB, WS_WXO = 54 * MiB, WS_WUG = 56 * MiB, WS_WDN = 67 * MiB;
constexpr size_t WS_MN = 74 * MiB, WS_MK = 90 * MiB, WS_MV = 106 * MiB, WS_MVT = 122 * MiB;
constexpr size_t WS_XA = 138 * MiB;
constexpr size_t WS_P1 = 268 * MiB;
constexpr size_t WS_A2 = 591 * MiB;
constexpr size_t WS_SPART = WS_MN;
constexpr size_t WS_HQ = WS_P1, WS_P = WS_P1 + 129 * MiB, WS_H = WS_P1;
constexpr size_t WS_END = 720 * MiB;
static_assert(WS_XA + (size_t)RT * DM * 2 <= WS_P1 && WS_P1 + (size_t)RT * P1W * 2 <= WS_A2 && WS_A2 + (size_t)RT * DM * 2 <= WS_END && WS_H + (size_t)RT * DFF * 2 <= WS_END, "ws map");
static_assert(WS_WDN + (size_t)DM * DFF * 2 <= WS_MN && WS_WUG + (size_t)2 * DFF * DM * 2 <= WS_WDN && WS_G01 + (size_t)NTILE_P * 2 * DFF * 4 <= WS_WIN && WS_L4 + (size_t)RT * 16 <= WS_UH && WS_RS2 + (size_t)RT * 4 <= WS_SSP1, "ws map 2");

constexpr int RING_BYTES = 131072, XTRA_OFF = RING_BYTES, BARST_OFF = XTRA_OFF + 20480, LDS_BYTES = 155648;

struct SchedGrid {
    const char* A; const char* B; size_t a_tile, b_tile; int nM, nN, nwg, G, c;
    __device__ __forceinline__ void init(const void* A_, size_t a_tile_, const void* B_, size_t b_tile_, int nM_, int nN_, int G_, int c_) { A = (const char*)A_; B = (const char*)B_; a_tile = a_tile_; b_tile = b_tile_; nM = nM_; nN = nN_; nwg = nM * nN; G = G_; c = c_; }
    __device__ __forceinline__ bool next(int i, pg8::Unit& u) const {
        const long L = (long)i * G + c; if (L >= nwg) return false;
        int wgid = (int)L; { const int q = nwg / 8, r = nwg % 8, xcd = wgid % 8, off = wgid / 8; wgid = (xcd < r ? xcd * (q + 1) : r * (q + 1) + (xcd - r) * q) + off; }
        const int nig = 8 * nN, gid = wgid / nig, fm = gid * 8, gsz = (nM - fm) < 8 ? (nM - fm) : 8;
        u.pm = fm + ((wgid % nig) % gsz); u.pn = (wgid % nig) / gsz; u.A = A + (size_t)u.pm * a_tile; u.B = B + (size_t)u.pn * b_tile; return true;
    }
};
struct SchedX {
    const char* A; const char* B; int G, c; bool pv;
    __device__ __forceinline__ bool next(int i, pg8::Unit& u) const {
        const long L = (long)i * G + c; if (L >= 4 * NTILE_P) return false;
        const int h = (int)(L >> 8), idx = (int)(L & 255), pm = (idx & 7) * 32 + (idx >> 3), b = pm >> 3;
        u.pm = pm; u.pn = h; u.A = A + ((size_t)pm * 256 * DM + h * 256) * 2;
        u.B = pv ? B + ((size_t)h * 256 * MMEM + b * 256) * 2 : B + ((size_t)b * 256 * DM + h * 256) * 2; return true;
    }
};

struct SchedSplitK {
    const char* A; const char* B; int G, c;
    __device__ __forceinline__ bool next(int i, pg8::Unit& u) const {
        const long L = (long)i * G + c; if (L >= 16) return false;
        const int t = (int)(L >> 3), pn = (int)(L >> 1) & 3, kh = (int)L & 1;
        u.pm = NTILE_P + t; u.pn = pn | (kh << 4);
        u.A = A + ((size_t)(NTILE_P + t) * 256 * DFF + kh * (DFF / 2)) * 2; u.B = B + ((size_t)pn * 256 * DFF + kh * (DFF / 2)) * 2; return true;
    }
};

__device__ __forceinline__ void p0_transpose_item(const float* __restrict__ W, int ldw, int K, int kb, int ns, bf16_t* __restrict__ WT, int nd, const float* __restrict__ gain, LAS float* scr, int lane) {
    const int k0 = 64 * kb;
    float wv[32];
#pragma unroll
    for (int i = 0; i < 32; ++i) wv[i] = W[(size_t)(k0 + 2 * i + (lane >> 5)) * ldw + ns + (lane & 31)];
    if (gain) {
#pragma unroll
        for (int i = 0; i < 32; ++i) wv[i] *= gain[k0 + 2 * i + (lane >> 5)]; }
#pragma unroll
    for (int i = 0; i < 32; ++i) scr[(2 * i + (lane >> 5)) * 33 + (lane & 31)] = wv[i];
    asm volatile("s_waitcnt lgkmcnt(0)" ::: "memory");
    const int cc = lane & 7;
#pragma unroll
    for (int j = 0; j < 4; ++j) { const int n = (lane >> 3) + 8 * j; const LAS float* s = scr + (8 * cc) * 33 + n;
        u32x4 o; o.x = cvt_pk_bf16(s[0 * 33], s[1 * 33]); o.y = cvt_pk_bf16(s[2 * 33], s[3 * 33]); o.z = cvt_pk_bf16(s[4 * 33], s[5 * 33]); o.w = cvt_pk_bf16(s[6 * 33], s[7 * 33]);
        *(u32x4*)(WT + (size_t)(nd + n) * K + k0 + 8 * cc) = o; }
    asm volatile("s_waitcnt lgkmcnt(0)" ::: "memory");
}
__device__ __forceinline__ void rows2_to_bf16(const float* __restrict__ x0, const float* __restrict__ x1, bf16_t* __restrict__ o0, bf16_t* __restrict__ o1, float* q0, float* q1, int lane) {
    const f32x4* r0 = (const f32x4*)x0 + lane; const f32x4* r1 = (const f32x4*)x1 + lane; f32x4 v[4], w[4]; float s = 0.f, t = 0.f;
#pragma unroll
    for (int j = 0; j < 4; ++j) { v[j] = __builtin_nontemporal_load(r0 + 64 * j); w[j] = __builtin_nontemporal_load(r1 + 64 * j); }
#pragma unroll
    for (int j = 0; j < 4; ++j) { s += (v[j][0] * v[j][0] + v[j][1] * v[j][1]) + (v[j][2] * v[j][2] + v[j][3] * v[j][3]); t += (w[j][0] * w[j][0] + w[j][1] * w[j][1]) + (w[j][2] * w[j][2] + w[j][3] * w[j][3]); }
    s = wave_sum(s); t = wave_sum(t);
    u32x2* p0 = (u32x2*)o0 + lane; u32x2* p1 = (u32x2*)o1 + lane;
#pragma unroll
    for (int j = 0; j < 4; ++j) { p0[64 * j] = epi::pack4(v[j]); p1[64 * j] = epi::pack4(w[j]); }
    if (lane == 0) { *q0 = s; *q1 = t; }
}

#define XB_TMO      128
#define XB_XCNT(j)  (256  + 64 * (j))
#define XB_XSUB(j)  (1280 + 64 * (j))
#define XB_XGEN(j)  (2304 + 64 * (j))
#define XB_TOP      3328
#define XB_TOPGEN   3392
#define XCD_BAR_WORDS 3456
#define XB_SPIN_CAP (1u << 22)
__device__ __forceinline__ unsigned xb_ld(unsigned* p)              { return __hip_atomic_load(p, __ATOMIC_RELAXED, __HIP_MEMORY_SCOPE_AGENT); }
__device__ __forceinline__ unsigned xb_add(unsigned* p, unsigned v) { return __hip_atomic_fetch_add(p, v, __ATOMIC_RELAXED, __HIP_MEMORY_SCOPE_AGENT); }
__device__ __forceinline__ unsigned xb_xcc_id() { return (unsigned)__builtin_amdgcn_s_getreg((3 << 11) | 20) & 0xFu; }
#define XB_SPIN(cond, bar) do { unsigned _sp = 0; while (cond) { __builtin_amdgcn_s_sleep(1); \
    if ((++_sp & 255u) == 0u) { if (xb_ld(&(bar)[XB_TMO])) break; if (_sp > XB_SPIN_CAP) { atomicAdd(&(bar)[XB_TMO], 1u); break; } } } } while (0)
__device__ __forceinline__ void xcd_barrier_complete(unsigned* bar, unsigned x, unsigned& nloc, unsigned& nx) {
    const unsigned G = gridDim.x * gridDim.y * gridDim.z;
    unsigned sum, cnt, mine, sp = 0u;
    for (;;) {
        sum = 0u; cnt = 0u; mine = 0u;
#pragma unroll
        for (unsigned j = 0; j < 16; ++j) { const unsigned c = xb_ld(&bar[XB_XCNT(j)]); sum += c; cnt += (c > 0u) ? 1u : 0u; mine = (j == x) ? c : mine; }
        if (sum == G) break;
        __builtin_amdgcn_s_sleep(1);
        if ((++sp & 255u) == 0u) { if (xb_ld(&bar[XB_TMO])) break; if (sp > XB_SPIN_CAP) { atomicAdd(&bar[XB_TMO], 1u); break; } }
    }
    nloc = mine > 0u ? mine : 1u; nx = cnt > 0u ? cnt : 1u;
}
__device__ __forceinline__ void xcd_barrier(unsigned* bar, volatile LAS unsigned* st) {
    asm volatile("s_waitcnt vmcnt(0)" ::: "memory");
    __syncthreads();
    if (threadIdx.x == 0) {
        const unsigned x = xb_xcc_id();
        __builtin_amdgcn_s_waitcnt(0);
        unsigned nloc = st[0], nx = st[1];
        if (nloc == 0u) { xcd_barrier_complete(bar, x, nloc, nx); st[0] = nloc; st[1] = nx; }
        const unsigned old = xb_add(&bar[XB_XSUB(x)], 1u);
        const unsigned gen = old / nloc;
        if (old + 1u == (gen + 1u) * nloc) {
            __builtin_amdgcn_fence(__ATOMIC_RELEASE, "agent");
            asm volatile("s_waitcnt vmcnt(0)" ::: "memory");
            const unsigned og = xb_add(&bar[XB_TOP], 1u);
            const unsigned tg = og / nx;
            if (og + 1u == (tg + 1u) * nx) xb_add(&bar[XB_TOPGEN], 1u);
            else XB_SPIN(xb_ld(&bar[XB_TOPGEN]) == tg, bar);
            __builtin_amdgcn_fence(__ATOMIC_ACQUIRE, "agent");
            xb_add(&bar[XB_XGEN(x)], 1u);
            asm volatile("s_waitcnt vmcnt(0)" ::: "memory");
        } else {
            XB_SPIN(xb_ld(&bar[XB_XGEN(x)]) == gen, bar);
            __builtin_amdgcn_fence(__ATOMIC_ACQUIRE, "agent");
            asm volatile("s_waitcnt vmcnt(0)" ::: "memory");
        }
    }
    __syncthreads();
}

struct Args { const float* in[30]; float* out; unsigned char* ws; };
#define PHASE_ARGS() \
    const __attribute__((address_space(4))) Args* ap_ = (const __attribute__((address_space(4))) Args*)__builtin_amdgcn_kernarg_segment_ptr(); asm volatile("" : "+s"(ap_)); \
    unsigned char* const ws = ap_->ws; float* const out = ap_->out; (void)ws; (void)out; \
    int tid = threadIdx.x; asm volatile("" : "+v"(tid)); const int lane = tid & 63, wave = __builtin_amdgcn_readfirstlane(tid >> 6); (void)lane; (void)wave; \
    const int G = gridDim.x, bx = blockIdx.x, vcu = (G % 8 == 0) ? (bx % 8) * (G / 8) + bx / 8 : bx; (void)vcu; \
    const int gw = vcu * 8 + wave, NGW = G * 8; (void)gw; (void)NGW
#define IN(k) (ap_->in[k])
#define WSF(off) ((float*)(ws + (off)))
#define WSB(off) ((bf16_t*)(ws + (off)))

__global__ void __launch_bounds__(512, 2) fwd_kernel(Args a) {
    extern __shared__ __attribute__((aligned(16))) unsigned char lds_raw[];
    LAS unsigned char* const lds = (LAS unsigned char*)lds_raw;
    volatile LAS unsigned* const bst = (volatile LAS unsigned*)(lds + BARST_OFF);
    if (threadIdx.x < 2) bst[threadIdx.x] = 0u;
    __syncthreads();
    { PHASE_ARGS(); if (threadIdx.x == 0) (void)xb_add(&((unsigned*)ws)[XB_XCNT(xb_xcc_id())], 1u); }
#define GRID_BAR() do { PHASE_ARGS(); xcd_barrier((unsigned*)ws, bst); } while (0)

    {
        PHASE_ARGS();
        LAS float* scr = (LAS float*)(lds + wave * 16384);
        constexpr int I_IN = 16 * 96, I_SQ = 16 * 32, I_FF = 16 * 88, I_DN = 44 * 32;
        constexpr int NITEMS = I_IN + 5 * I_SQ + 2 * I_FF + I_DN;
        for (int it = gw; it < NITEMS; it += NGW) {
            int r = it;
            if (r < I_IN) { const int kb = r / 96, nb = r % 96, nd = nb * 32; int ns = nd;
                if (nd >= 2048) { const int T = (nd - 2048) >> 8, w = (nd - 2048) & 255; ns = (w < 128) ? 2048 + 128 * T + w : 2560 + 128 * T + (w - 128); }
                p0_transpose_item(IN(10), INP, DM, kb, ns, WSB(WS_WIN), nd, IN(9), scr, lane); continue; } r -= I_IN;
            if (r < I_SQ) { p0_transpose_item(IN(17), DM, DM, r / 32, (r % 32) * 32, WSB(WS_WOUT), (r % 32) * 32, nullptr, scr, lane); continue; } r -= I_SQ;
            if (r < I_SQ) { p0_transpose_item(IN(20), DM, DM, r / 32, (r % 32) * 32, WSB(WS_WXQ), (r % 32) * 32, IN(19), scr, lane); continue; } r -= I_SQ;
            if (r < I_SQ) { p0_transpose_item(IN(21), DM, DM, r / 32, (r % 32) * 32, WSB(WS_WXKV), (r % 32) * 32, IN(18), scr, lane); continue; } r -= I_SQ;
            if (r < I_SQ) { p0_transpose_item(IN(22), DM, DM, r / 32, (r % 32) * 32, WSB(WS_WXKV), 1024 + (r % 32) * 32, IN(18), scr, lane); continue; } r -= I_SQ;
            if (r < I_SQ) { p0_transpose_item(IN(23), DM, DM, r / 32, (r % 32) * 32, WSB(WS_WXO), (r % 32) * 32, nullptr, scr, lane); continue; } r -= I_SQ;
            if (r < I_FF) { const int kb = r / 88, nb = r % 88; p0_transpose_item(IN(25), DFF, DM, kb, nb * 32, WSB(WS_WUG), 256 * (nb >> 2) + (nb & 3) * 32, IN(24), scr, lane); continue; } r -= I_FF;
            if (r < I_FF) { const int kb = r / 88, nb = r % 88; p0_transpose_item(IN(26), DFF, DM, kb, nb * 32, WSB(WS_WUG), 256 * (nb >> 2) + 128 + (nb & 3) * 32, IN(24), scr, lane); continue; } r -= I_FF;
            p0_transpose_item(IN(28), DM, DFF, r / 32, (r % 32) * 32, WSB(WS_WDN), (r % 32) * 32, nullptr, scr, lane);
        }
        for (int m = 2 * gw; m < RT + MMEM; m += 2 * NGW) {
            const float* src; bf16_t* dst; float* sq;
            if (m < MP) { src = IN(0) + (size_t)m * DM; dst = WSB(WS_XA) + (size_t)m * DM; sq = WSF(WS_SSQ0) + m; }
            else if (m < RT) { src = IN(1) + (size_t)(m - MP) * DM; dst = WSB(WS_XA) + (size_t)m * DM; sq = WSF(WS_SSQ0) + m; }
            else { src = IN(8) + (size_t)(m - RT) * DM; dst = WSB(WS_MN) + (size_t)(m - RT) * DM; sq = WSF(WS_SSQM) + (m - RT); }
            rows2_to_bf16(src, src + DM, dst, dst + DM, sq, sq + 1, lane);
        }
    }
    GRID_BAR();

    {
        PHASE_ARGS();
        pg8::Gemm g{DM, DM, DM};
        { SchedGrid S; S.init(WSB(WS_XA), (size_t)256 * DM * 2, WSB(WS_WIN), (size_t)256 * DM * 2, NTILE, INP / 256, G, bx);
          epi::EpiInProj E{WSF(WS_SSQ0), WSB(WS_P1), out};
          pg8::gemm_phase(lds, g, S, E); }
        { SchedGrid S; S.init(WSB(WS_MN), (size_t)256 * DM * 2, WSB(WS_WXKV), (size_t)256 * DM * 2, MMEM / 256, 8, G, bx);
          epi::EpiMemKV E{WSF(WS_SSQM), WSB(WS_MK), WSB(WS_MV), out};
          pg8::gemm_phase(lds, g, S, E); }
    }
    GRID_BAR();

    {
        PHASE_ARGS();
        float lam;
        { const float a1 = wave_sum(IN(11)[lane] * IN(12)[lane]), a2 = wave_sum(IN(13)[lane] * IN(14)[lane]); lam = __expf(a1) - __expf(a2) + LAM_INIT; }
        for (long L = bx; L < 2048; L += G) {
            const int s = (int)(L >> 8), cc = (int)(L & 255), cv = (cc & 7) * 32 + (cc >> 3), bh = cv >> 1, par = cv & 1, p = 2 * (s >> 1) + par, qb = (s & 1) ? 15 - p : p;
            dattn::unit(bh >> 2, bh & 3, qb, WSB(WS_P1), WSB(WS_A2), lam, IN(15), (LAS char*)lds);
        }
        for (int L = bx; L < 256; L += G) misc::sample_attn_unit(L >> 3, (L >> 1) & 3, L & 1, WSB(WS_P1), IN(2), IN(3), out + O_KS, out + O_VS, WSB(WS_A2), lam, IN(15), (char*)lds_raw);
        for (int it = (vcu * 512 + tid); it < 64 * (RT / 8); it += G * 512) misc::shortconv_item(it, WSB(WS_P1), IN(16), IN(4), WSB(WS_A2));
        __syncthreads();
        { LAS bf16_t* scr = (LAS bf16_t*)(lds + wave * 16384); for (int it = gw; it < 2048; it += NGW) misc::transpose_item(it, WSB(WS_MV), WSB(WS_MVT), scr, lane); }
    }
    GRID_BAR();

    {
        PHASE_ARGS();
        pg8::Gemm g{DM, DM, DM}; SchedGrid S; S.init(WSB(WS_A2), (size_t)256 * DM * 2, WSB(WS_WOUT), (size_t)256 * DM * 2, NTILE, 4, G, bx);
        epi::EpiResidual E{WSB(WS_XA), WSF(WS_SSP1)};
        pg8::gemm_phase(lds, g, S, E);
    }
    GRID_BAR();
    {
        PHASE_ARGS();
        for (int r = bx * 512 + tid; r < RT; r += G * 512) WSF(WS_RS1)[r] = epi::rstd16(WSF(WS_SSP1), r);
    }
    GRID_BAR();
    {
        PHASE_ARGS();
        pg8::Gemm g{DM, DM, DM}; SchedGrid S; S.init(WSB(WS_XA), (size_t)256 * DM * 2, WSB(WS_WXQ), (size_t)256 * DM * 2, NTILE, 4, G, bx);
        epi::EpiScaleBf16 E{WSF(WS_RS1), WSB(WS_HQ), DM};
        pg8::gemm_phase(lds, g, S, E);
    }
    GRID_BAR();
    {
        PHASE_ARGS();
        pg8::Gemm g{DM, DM, 256}; SchedX S{(const char*)WSB(WS_HQ), (const char*)WSB(WS_MK), G, bx, false};
        epi::EpiXScores E{WSB(WS_P), WSF(WS_L4), (LAS float*)(lds + XTRA_OFF)};
        pg8::gemm_phase(lds, g, S, E);
    }
    GRID_BAR();
    {
        PHASE_ARGS();
        pg8::Gemm g{DM, MMEM, 256}; SchedX S{(const char*)WSB(WS_P), (const char*)WSB(WS_MVT), G, bx, true};
        epi::EpiXPV E{WSF(WS_L4), WSB(WS_HQ)};
        pg8::gemm_phase(lds, g, S, E);
        __syncthreads();
        for (int L = G - 1 - bx; L < NB * NH; L += G) misc::sample_xattn_unit(L >> 2, L & 3, WSB(WS_HQ), IN(6), IN(7), WSB(WS_HQ), (char*)lds_raw);
    }
    GRID_BAR();
    {
        PHASE_ARGS();
        pg8::Gemm g{DM, DM, DM}; SchedGrid S; S.init(WSB(WS_HQ), (size_t)256 * DM * 2, WSB(WS_WXO), (size_t)256 * DM * 2, NTILE, 4, G, bx);
        epi::EpiResidual E{WSB(WS_XA), WSF(WS_SSP2)};
        pg8::gemm_phase(lds, g, S, E);
    }
    GRID_BAR();
    {
        PHASE_ARGS();
        for (int r = bx * 512 + tid; r < RT; r += G * 512) WSF(WS_RS2)[r] = epi::rstd16(WSF(WS_SSP2), r);
    }
    GRID_BAR();
    {
        PHASE_ARGS();
        pg8::Gemm g{DM, DM, DM}; SchedGrid S; S.init(WSB(WS_XA), (size_t)256 * DM * 2, WSB(WS_WUG), (size_t)256 * DM * 2, NTILE, 22, G, bx);
        epi::EpiUpGate E{WSF(WS_RS2), IN(27), IN(5), WSB(WS_H), out, WSF(WS_UH), WSF(WS_U01), WSF(WS_G01), (LAS float*)(lds + XTRA_OFF)};
        pg8::gemm_phase(lds, g, S, E);
    }
    GRID_BAR();
    {
        PHASE_ARGS();
        pg8::Gemm g{DFF, DFF, DFF}; SchedGrid S; S.init(WSB(WS_H), (size_t)256 * DFF * 2, WSB(WS_WDN), (size_t)256 * DFF * 2, NTILE_P, 4, G, bx);
        { const float* UH = WSF(WS_UH); const float* U01 = WSF(WS_U01); const float* G01 = WSF(WS_G01); const float* w_ffc = IN(27); bf16_t* HB = WSB(WS_H); pg8::Unit uu;
          for (int i = 0; S.next(i, uu); ++i) { const int pm = uu.pm; if (pm >= NTILE_P || (pm & 7) == 0) continue;
            for (int it = tid; it < 2 * DFF; it += 512) {
                const int r = it / DFF, c = it - r * DFF;
                const float um2 = UH[((size_t)(pm - 1) * 2 + r) * DFF + c];
                const float um1 = (r == 0) ? UH[((size_t)(pm - 1) * 2 + 1) * DFF + c] : U01[((size_t)pm * 2) * DFF + c];
                const float u0 = U01[((size_t)pm * 2 + r) * DFF + c];
                const float y = w_ffc[c] * um2 + w_ffc[DFF + c] * um1 + w_ffc[2 * DFF + c] * u0;
                const float hv = y * __builtin_amdgcn_rcpf(1.0f + __builtin_amdgcn_exp2f(-1.4426950408889634f * y)) * G01[((size_t)pm * 2 + r) * DFF + c];
                HB[(size_t)(pm * 256 + r) * DFF + c] = (bf16_t)(cvt_pk_bf16(hv, 0.f) & 0xffffu);
            } }
          asm volatile("s_waitcnt vmcnt(0)" ::: "memory"); __syncthreads(); }
        epi::EpiResidual E{WSB(WS_XA), WSF(WS_SSP3)};
        pg8::gemm_phase(lds, g, S, E);
        { pg8::Gemm g2{DFF, DFF, DFF / 2}; SchedSplitK S2{(const char*)WSB(WS_H), (const char*)WSB(WS_WDN), G, bx};
          epi::EpiPartialF32 E2{WSF(WS_SPART)};
          pg8::gemm_phase(lds, g2, S2, E2); }
    }
    GRID_BAR();
    {
        PHASE_ARGS();
        const float* g_fin = IN(29); const bf16_t* XB = WSB(WS_XA);
        f32x4 gg[4];
#pragma unroll
        for (int j = 0; j < 4; ++j) gg[j] = *((const f32x4*)g_fin + lane + 64 * j);
        for (int m = 2 * gw; m < MP; m += 2 * NGW) {
            const float rs0 = epi::rstd16(WSF(WS_SSP3), m), rs1 = epi::rstd16(WSF(WS_SSP3), m + 1);
            const u32x2* x0 = (const u32x2*)(XB + (size_t)m * DM) + lane; const u32x2* x1 = x0 + DM / 4;
            u32x2 a[4], b[4];
#pragma unroll
            for (int j = 0; j < 4; ++j) { a[j] = __builtin_nontemporal_load(x0 + 64 * j); b[j] = __builtin_nontemporal_load(x1 + 64 * j); }
            f32x4* y0 = (f32x4*)(out + O_Y + (size_t)m * DM) + lane; f32x4* y1 = y0 + DM / 4;
#pragma unroll
            for (int j = 0; j < 4; ++j) {
                f32x4 v = {__uint_as_float(a[j].x << 16), __uint_as_float(a[j].x & 0xffff0000u), __uint_as_float(a[j].y << 16), __uint_as_float(a[j].y & 0xffff0000u)};
                f32x4 w = {__uint_as_float(b[j].x << 16), __uint_as_float(b[j].x & 0xffff0000u), __uint_as_float(b[j].y << 16), __uint_as_float(b[j].y & 0xffff0000u)};
                __builtin_nontemporal_store(v * gg[j] * rs0, y0 + 64 * j); __builtin_nontemporal_store(w * gg[j] * rs1, y1 + 64 * j);
            }
        }
        for (int r = gw; r < MS; r += NGW) {
            const u32x2* x0 = (const u32x2*)(XB + (size_t)(MP + r) * DM) + lane; const f32x4* sa = (const f32x4*)(WSF(WS_SPART) + (size_t)r * DM) + lane; const f32x4* sb = sa + (size_t)MS * DM / 4;
            f32x4 v[4]; float ss = 0.f;
#pragma unroll
            for (int j = 0; j < 4; ++j) { const u32x2 a = x0[64 * j];
                v[j] = (f32x4){__uint_as_float(a.x << 16), __uint_as_float(a.x & 0xffff0000u), __uint_as_float(a.y << 16), __uint_as_float(a.y & 0xffff0000u)} + sa[64 * j] + sb[64 * j];
                ss += (v[j][0] * v[j][0] + v[j][1] * v[j][1]) + (v[j][2] * v[j][2] + v[j][3] * v[j][3]); }
            const float rs = rsqrtf(wave_sum(ss) * (1.0f / DM) + EPS);
            f32x4* y0 = (f32x4*)(out + O_Y + (size_t)(MP + r) * DM) + lane;
#pragma unroll
            for (int j = 0; j < 4; ++j) y0[64 * j] = v[j] * gg[j] * rs;
        }
    }
}

extern "C" void kernel_launch(void* const* d_in, const int* in_sizes, int n_in, void* d_out, int out_size, void* d_ws, size_t ws_size, hipStream_t stream) {
    static int grid = 0;
    if (grid == 0) {
        if (n_in != 30 || (size_t)out_size != O_END || ws_size < WS_END) { fprintf(stderr, "kernel_launch: unexpected shapes: n_in %d out %d ws %zu (need %zu, %zu)\n", n_in, out_size, ws_size, (size_t)O_END, (size_t)WS_END); grid = -1; return; }
        int dev = 0, cus = 0, per_cu = 0;
        if (hipGetDevice(&dev) != hipSuccess || hipDeviceGetAttribute(&cus, hipDeviceAttributeMultiprocessorCount, dev) != hipSuccess) { grid = -1; return; }
        if (hipFuncSetAttribute((const void*)fwd_kernel, hipFuncAttributeMaxDynamicSharedMemorySize, LDS_BYTES) != hipSuccess) { fprintf(stderr, "kernel_launch: hipFuncSetAttribute failed\n"); grid = -1; return; }
        if (hipOccupancyMaxActiveBlocksPerMultiprocessor(&per_cu, (const void*)fwd_kernel, 512, LDS_BYTES) != hipSuccess || per_cu < 1) { fprintf(stderr, "kernel_launch: occupancy query says %d\n", per_cu); grid = -1; return; }
        grid = cus;
        fprintf(stderr, "kernel_launch: %d CUs, %d blocks/CU by the occupancy query, grid %d\n", cus, per_cu, grid);
    }
    if (grid < 0) return;
    if (hipMemsetAsync(d_ws, 0, 16384, stream) != hipSuccess) { fprintf(stderr, "kernel_launch: memset failed\n"); return; }
    Args a{};
    for (int i = 0; i < 30; ++i) a.in[i] = (const float*)d_in[i];
    a.out = (float*)d_out; a.ws = (unsigned char*)d_ws;
    void* args[] = {&a};
    const hipError_t e = hipLaunchCooperativeKernel((const void*)fwd_kernel, dim3(grid), dim3(512), args, LDS_BYTES, stream);
    if (e != hipSuccess) fprintf(stderr, "kernel_launch: cooperative launch failed: %s (grid %d)\n", hipGetErrorString(e), grid);
}
```

```cpp
#include <hip/hip_runtime.h>
#include <hip/hip_cooperative_groups.h>
#include <cstdio>
#include <cstdint>
namespace cg = cooperative_groups;

#define LAS __attribute__((address_space(3)))
typedef unsigned short bf16_t;
typedef short bf16x8 __attribute__((ext_vector_type(8)));
typedef short s16x4 __attribute__((ext_vector_type(4)));
typedef float f32x4 __attribute__((ext_vector_type(4)));
typedef float f32x2 __attribute__((ext_vector_type(2)));
typedef float f32x16 __attribute__((ext_vector_type(16)));
typedef unsigned u32x4 __attribute__((ext_vector_type(4)));
typedef unsigned u32x2 __attribute__((ext_vector_type(2)));

constexpr int DM = 1024, NB = 32, SEQ = 2048, DECT = 16, PAST = 1024;
constexpr int MP = NB * SEQ, MS = NB * DECT, RT = MP + MS;
constexpr int NTILE_P = MP / 256, NTILE = RT / 256;
constexpr int NH = 4, QKD = 64, VD = 128, NMEM = 256, XD = 256, DFF = 2816, INP = 3072, CW = 512;
constexpr int MMEM = NB * NMEM;
constexpr float EPS = 1e-6f;
constexpr float LAM_INIT = 0.2f;
constexpr int P1W = 2560;

constexpr size_t O_Y = 0;
constexpr size_t O_KP = (size_t)RT * DM;
constexpr size_t O_VP = O_KP + (size_t)MP * 512;
constexpr size_t O_SCP = O_VP + (size_t)MP * 512;
constexpr size_t O_FFP = O_SCP + (size_t)NB * 2 * CW;
constexpr size_t O_MK = O_FFP + (size_t)NB * 2 * DFF;
constexpr size_t O_MV = O_MK + (size_t)MMEM * DM;
constexpr size_t O_KS = O_MV + (size_t)MMEM * DM;
constexpr size_t O_VS = O_KS + (size_t)MS * 512;
constexpr size_t O_SCS = O_VS + (size_t)MS * 512;
constexpr size_t O_FFS = O_SCS + (size_t)NB * 2 * CW;
constexpr size_t O_END = O_FFS + (size_t)NB * 2 * DFF;

__device__ __forceinline__ unsigned cvt_pk_bf16(float lo, float hi) { unsigned r; asm volatile("v_cvt_pk_bf16_f32 %0, %1, %2" : "=v"(r) : "v"(lo), "v"(hi)); return r; }
__device__ __forceinline__ float bf2f(unsigned short h) { return __uint_as_float((unsigned)h << 16); }
#define DPPF(v, ctrl) __int_as_float(__builtin_amdgcn_update_dpp(0, __float_as_int(v), (ctrl), 0xf, 0xf, true))
__device__ __forceinline__ float xor16_sum(float v) { auto r = __builtin_amdgcn_permlane16_swap(__float_as_uint(v), __float_as_uint(v), false, false); return __uint_as_float(r[0]) + __uint_as_float(r[1]); }
__device__ __forceinline__ float xor32_sum(float v) { auto r = __builtin_amdgcn_permlane32_swap(__float_as_uint(v), __float_as_uint(v), false, false); return __uint_as_float(r[0]) + __uint_as_float(r[1]); }
__device__ __forceinline__ float xor16_max(float v) { auto r = __builtin_amdgcn_permlane16_swap(__float_as_uint(v), __float_as_uint(v), false, false); return fmaxf(__uint_as_float(r[0]), __uint_as_float(r[1])); }
__device__ __forceinline__ float xor32_max(float v) { auto r = __builtin_amdgcn_permlane32_swap(__float_as_uint(v), __float_as_uint(v), false, false); return fmaxf(__uint_as_float(r[0]), __uint_as_float(r[1])); }
__device__ __forceinline__ float other16(float v, int odd) { auto r = __builtin_amdgcn_permlane16_swap(__float_as_uint(v), __float_as_uint(v), false, false); return __uint_as_float(odd ? r[0] : r[1]); }
__device__ __forceinline__ float wave_sum(float v) {
    v += DPPF(v, 0xB1); v += DPPF(v, 0x4E); v += DPPF(v, 0x141); v += DPPF(v, 0x140);
    return xor32_sum(xor16_sum(v));
}
__device__ __forceinline__ float wave_max(float v) {
    v = fmaxf(v, DPPF(v, 0xB1)); v = fmaxf(v, DPPF(v, 0x4E)); v = fmaxf(v, DPPF(v, 0x141)); v = fmaxf(v, DPPF(v, 0x140));
    return xor32_max(xor16_max(v));
}
__device__ __forceinline__ float row_shr1(float v) { return __int_as_float(__builtin_amdgcn_update_dpp(__float_as_int(v), __float_as_int(v), 0x111, 0xf, 0xf, false)); }
__device__ __forceinline__ float row_shr2(float v) { return __int_as_float(__builtin_amdgcn_update_dpp(__float_as_int(v), __float_as_int(v), 0x112, 0xf, 0xf, false)); }

namespace pg8 {
constexpr int BM = 256, BK = 64, HALF = 128, HTB = HALF * BK * 2, STAGE_BYTES = 8 * HTB;
__host__ __device__ __forceinline__ int lds_byte(int r, int c) { const int st = (r >> 4) * 2 + (c >> 5), rr = r & 15, cc = c & 31, ob = rr * 64 + cc * 2; return st * 1024 + (ob ^ (((ob >> 9) & 1) << 5)); }
__host__ __device__ __forceinline__ void stage_rc(int b, int& R, int& C) { const int st = b / 1024, sb = b % 1024, swz = sb ^ (((sb >> 9) & 1) << 5); R = (st >> 1) * 16 + swz / 64; C = (st & 1) * 32 + (swz % 64) / 2; }
__host__ __device__ __forceinline__ int perm32(int rho) { const int n = rho >> 4, i = rho & 15; return 8 * (i >> 2) + 4 * n + (i & 3); }

struct Unit { const char* A; const char* B; int pm, pn; };
struct Gemm { int lda, ldb, K; };

template <class Epi, class Sched>
__device__ __forceinline__ void gemm_phase(LAS unsigned char* lds, const Gemm g, const Sched& S, const Epi& E) {
    int tid = threadIdx.x; asm volatile("" : "+v"(tid));
    const int wid = __builtin_amdgcn_readfirstlane(tid >> 6), lane = tid & 63, wr = wid >> 2, wc = wid & 3, fr = lane & 15, fq = lane >> 4;
    const int K = g.K, nt = K / BK;
    unsigned voffA[2], voffB[2];
#pragma unroll
    for (int i = 0; i < 2; ++i) { int R, C; stage_rc(tid * 16 + i * 8192, R, C); const int Rb = Epi::PERM ? ((R & ~31) + perm32(R & 31)) : R;
        voffA[i] = (unsigned)(R * g.lda + C) * 2u; voffB[i] = (unsigned)(Rb * g.ldb + C) * 2u; }
    const size_t kstep = (size_t)(BK * 2);
    const size_t hstepA = (size_t)HALF * g.lda * 2, hstepB = (size_t)HALF * g.ldb * 2;
    const unsigned ldsw = (unsigned)wid * 1024u;
    const int aoff = lds_byte(wr * 64 + fr, fq * 8), boff = lds_byte(wc * 32 + fr, fq * 8);
#define PG8_SA(b, h) (((b) * 2 + (h)) * HTB)
#define PG8_SB(b, h) ((4 + (b) * 2 + (h)) * HTB)
#define PG8_STAGE(bufoff, gbase, voff) do { _Pragma("unroll") for (int _i = 0; _i < 2; ++_i) \
        __builtin_amdgcn_global_load_lds((const unsigned*)((const char*)(gbase) + (voff)[_i]), (LAS unsigned*)(lds + (bufoff) + ldsw + _i * 8192), 16, 0, 0); } while (0)
#define PG8_LDA(dst, b, h) do { _Pragma("unroll") for (int m = 0; m < 4; ++m) _Pragma("unroll") for (int k = 0; k < 2; ++k) dst[m][k] = *(const LAS bf16x8*)(lds + PG8_SA(b, h) + aoff + m * 2048 + k * 1024); } while (0)
#define PG8_LDB(dst, b, h) do { _Pragma("unroll") for (int n = 0; n < 2; ++n) _Pragma("unroll") for (int k = 0; k < 2; ++k) dst[n][k] = *(const LAS bf16x8*)(lds + PG8_SB(b, h) + boff + n * 2048 + k * 1024); } while (0)
#define PG8_MMA(ai, bj, At, Bt) do { __builtin_amdgcn_s_setprio(1); _Pragma("unroll") for (int m = 0; m < 4; ++m) _Pragma("unroll") for (int n = 0; n < 2; ++n) _Pragma("unroll") for (int k = 0; k < 2; ++k) \
        acc[ai][bj][m][n] = __builtin_amdgcn_mfma_f32_16x16x32_bf16(Bt[n][k], At[m][k], acc[ai][bj][m][n], 0, 0, 0); __builtin_amdgcn_s_setprio(0); } while (0)
#define PG8_WAIT_V(n) asm volatile("s_waitcnt vmcnt(" #n ")" ::: "memory")
#define PG8_WAIT_L(n) asm volatile("s_waitcnt lgkmcnt(" #n ")" ::: "memory")
#define PG8_BAR __builtin_amdgcn_s_barrier()
#define PG8_SCHED __builtin_amdgcn_sched_barrier(0)
    Unit cur, nxt; int ui = 0;
    if (!S.next(0, cur)) return;
    f32x4 acc[2][2][4][2];
#pragma unroll
    for (int a = 0; a < 2; ++a)
#pragma unroll
        for (int b = 0; b < 2; ++b)
#pragma unroll
            for (int m = 0; m < 4; ++m)
#pragma unroll
                for (int n = 0; n < 2; ++n) acc[a][b][m][n] = (f32x4){0.f, 0.f, 0.f, 0.f};
    bf16x8 At[4][2], B0[2][2], B1[2][2];
    typename Epi::Pre pre{};
    const char* cA = cur.A; const char* cB = cur.B;
    PG8_STAGE(PG8_SB(0, 0), cB, voffB); PG8_STAGE(PG8_SB(0, 1), cB + hstepB, voffB); PG8_STAGE(PG8_SA(0, 0), cA, voffA); PG8_STAGE(PG8_SA(0, 1), cA + hstepA, voffA);
    if (wr == 1) PG8_BAR;
    PG8_WAIT_V(2); PG8_BAR;
    PG8_STAGE(PG8_SB(1, 0), cB + kstep, voffB); PG8_STAGE(PG8_SA(1, 0), cA + kstep, voffA); PG8_STAGE(PG8_SB(1, 1), cB + hstepB + kstep, voffB);
    PG8_WAIT_V(6); PG8_BAR;
    for (;;) {
        const bool has_next = S.next(ui + 1, nxt);
        const char* nA = has_next ? nxt.A : cA; const char* nB = has_next ? nxt.B : cB;
        for (int t = 0; t < nt; t += 2) {
            const bool last = (t == nt - 2);
            if (Epi::EARLY && last) pre = E.prefetch(cur, wr, wc, fr, fq);
            const char* a1 = cA + (size_t)(t + 1) * kstep;
            const char* a2 = last ? nA : cA + (size_t)(t + 2) * kstep; const char* b2 = last ? nB : cB + (size_t)(t + 2) * kstep;
            const char* a3 = a2 + kstep; const char* b3 = b2 + kstep;
            PG8_LDB(B0, 0, 0); PG8_LDB(B1, 0, 1); PG8_SCHED; PG8_LDA(At, 0, 0); PG8_STAGE(PG8_SA(1, 1), a1 + hstepA, voffA);
            PG8_WAIT_V(8); PG8_WAIT_L(0); PG8_BAR; PG8_MMA(0, 0, At, B0); PG8_MMA(0, 1, At, B1); PG8_BAR; PG8_SCHED;
            PG8_LDA(At, 0, 1); PG8_STAGE(PG8_SB(0, 0), b2, voffB); PG8_STAGE(PG8_SB(0, 1), b2 + hstepB, voffB); PG8_STAGE(PG8_SA(0, 0), a2, voffA);
            PG8_WAIT_V(8); PG8_WAIT_L(0); PG8_BAR; PG8_MMA(1, 0, At, B0); PG8_MMA(1, 1, At, B1); PG8_BAR; PG8_SCHED;
            PG8_LDB(B0, 1, 0); PG8_LDB(B1, 1, 1); PG8_SCHED; PG8_LDA(At, 1, 0); PG8_STAGE(PG8_SA(0, 1), a2 + hstepA, voffA);
            PG8_WAIT_V(8); PG8_WAIT_L(0); PG8_BAR; PG8_MMA(0, 0, At, B0); PG8_MMA(0, 1, At, B1); PG8_BAR; PG8_SCHED;
            PG8_LDA(At, 1, 1); PG8_STAGE(PG8_SB(1, 0), b3, voffB); PG8_STAGE(PG8_SB(1, 1), b3 + hstepB, voffB); PG8_STAGE(PG8_SA(1, 0), a3, voffA);
            PG8_WAIT_V(8); PG8_WAIT_L(0); PG8_BAR; PG8_MMA(1, 0, At, B0); PG8_MMA(1, 1, At, B1); PG8_BAR; PG8_SCHED;
        }
        if (wr == 0) PG8_BAR;
        if (!Epi::EARLY) pre = E.prefetch(cur, wr, wc, fr, fq);
        E(acc, cur, pre, wr, wc, fr, fq);
        if (!has_next) break;
#pragma unroll
        for (int a = 0; a < 2; ++a)
#pragma unroll
            for (int b = 0; b < 2; ++b)
#pragma unroll
                for (int m = 0; m < 4; ++m)
#pragma unroll
                    for (int n = 0; n < 2; ++n) acc[a][b][m][n] = (f32x4){0.f, 0.f, 0.f, 0.f};
        cur = nxt; cA = nA; cB = nB; ++ui;
        if (wr == 1) PG8_BAR;
    }
    PG8_WAIT_V(0);
    PG8_BAR;
#undef PG8_SA
#undef PG8_SB
#undef PG8_STAGE
#undef PG8_LDA
#undef PG8_LDB
#undef PG8_MMA
}
}
namespace epi {
using pg8::Unit;
typedef f32x4 Acc[2][2][4][2];
#define EPI_BAR() do { asm volatile("s_waitcnt lgkmcnt(0)" ::: "memory"); __builtin_amdgcn_s_barrier(); asm volatile("" ::: "memory"); } while (0)

__device__ __forceinline__ u32x4 pack8(const f32x4 a, const f32x4 b) { u32x4 w; w.x = cvt_pk_bf16(a[0], a[1]); w.y = cvt_pk_bf16(a[2], a[3]); w.z = cvt_pk_bf16(b[0], b[1]); w.w = cvt_pk_bf16(b[2], b[3]); return w; }
__device__ __forceinline__ u32x2 pack4(const f32x4 a) { u32x2 w; w.x = cvt_pk_bf16(a[0], a[1]); w.y = cvt_pk_bf16(a[2], a[3]); return w; }
__device__ __forceinline__ int row_pos(int row) { return row < MP ? (row & (SEQ - 1)) : PAST + ((row - MP) & (DECT - 1)); }
__device__ __forceinline__ f32x4 oth4(const f32x4 v, int odd) { f32x4 r; r[0] = other16(v[0], odd); r[1] = other16(v[1], odd); r[2] = other16(v[2], odd); r[3] = other16(v[3], odd); return r; }
__device__ __forceinline__ void store8_f32(float* p  , const f32x4 v0, const f32x4 v1, int fq) {
    f32x4 x, y;
#pragma unroll
    for (int j = 0; j < 4; ++j) { auto r = __builtin_amdgcn_permlane16_swap(__float_as_uint(v0[j]), __float_as_uint(v1[j]), false, false); x[j] = __uint_as_float(r[0]); y[j] = __uint_as_float(r[1]); }
    float* q = p + 16 * (fq >> 1) + 4 * (fq & 1);
    __builtin_nontemporal_store(x, (f32x4*)q); __builtin_nontemporal_store(y, (f32x4*)(q + 8));
}
struct PreNone {};
struct Pre8 { float v[8]; };
__device__ __forceinline__ Pre8 load8rows(const float* __restrict__ p, int row0) {
    Pre8 r;
#pragma unroll
    for (int i = 0; i < 8; ++i) r.v[i] = p[row0 + (i >> 2) * 128 + (i & 3) * 16];
    return r;
}
__device__ __forceinline__ void rope_cs(int pos, int n, f32x4& c, f32x4& s) {
    const float fp = (float)pos;
    const f32x4 k = n == 0 ? (f32x4){1.5915494309e-01f, 3.0863763405e-02f, 5.9851857127e-03f, 1.1606636412e-03f} : (f32x4){2.2507907904e-04f, 4.3647952793e-05f, 8.4643308082e-06f, 1.6414262628e-06f};
#pragma unroll
    for (int j = 0; j < 4; ++j) { const float r = __builtin_amdgcn_fractf(fp * k[j]); c[j] = __builtin_amdgcn_cosf(r); s[j] = __builtin_amdgcn_sinf(r); }
}

struct EpiInProj {
    static constexpr bool PERM = true, EARLY = true;
    typedef Pre8 Pre;
    const float* ssq;
    bf16_t* p1;
    float* out;
    __device__ __forceinline__ Pre prefetch(const Unit& u, int wr, int wc, int fr, int fq) const { return load8rows(ssq, u.pm * 256 + wr * 64 + fr); }
    __device__ __forceinline__ void operator()(Acc& acc, const Unit& u, const Pre& pre, int wr, int wc, int fr, int fq) const {
        const int pn = u.pn, row0 = u.pm * 256 + wr * 64 + fr;
        const int cl = 32 * wc + 8 * fq;
#pragma unroll
        for (int ai = 0; ai < 2; ++ai)
#pragma unroll
            for (int m = 0; m < 4; ++m) {
                const int row = row0 + ai * 128 + m * 16;
                const float rs = rsqrtf(pre.v[ai * 4 + m] * (1.0f / DM) + EPS);
                bf16_t* prow = p1 + (size_t)row * P1W;
                if (pn < 4) {
                    f32x4 c0, c1, s0, s1; const int pos = row_pos(row);
                    if ((wc & 1) == 0) { rope_cs(pos, 0, c0, s0); rope_cs(pos, 1, c1, s1); }
                    float* orow = (pn >= 2) ? (row < MP ? out + O_KP + (size_t)row * 512 : out + O_KS + (size_t)(row - MP) * 512) : nullptr;
#pragma unroll
                    for (int bj = 0; bj < 2; ++bj) {
                        f32x4 v0 = acc[ai][bj][m][0] * rs, v1 = acc[ai][bj][m][1] * rs;
                        if ((wc & 1) == 0) {
                            const f32x4 o0 = oth4(v0, fq & 1), o1 = oth4(v1, fq & 1);
                            if (fq == 0) { v0 = v0 * c0 - o0 * s0; v1 = v1 * c1 - o1 * s1; }
                            else if (fq == 1) { v0 = v0 * c0 + o0 * s0; v1 = v1 * c1 + o1 * s1; }
                        }
                        const int c = (pn & 1) * 256 + bj * 128 + cl;
                        if (pn >= 2) store8_f32(orow + c - 8 * fq, v0, v1, fq);
                        *(u32x4*)(prow + (pn >> 1) * 512 + c) = pack8(v0, v1);
                    }
                } else if (pn < 6) {
                    float* orow = row < MP ? out + O_VP + (size_t)row * 512 : out + O_VS + (size_t)(row - MP) * 512;
#pragma unroll
                    for (int bj = 0; bj < 2; ++bj) {
                        const f32x4 v0 = acc[ai][bj][m][0] * rs, v1 = acc[ai][bj][m][1] * rs;
                        const int c = (pn & 1) * 256 + bj * 128 + cl;
                        store8_f32(orow + c - 8 * fq, v0, v1, fq);
                        *(u32x4*)(prow + 1024 + c) = pack8(v0, v1);
                    }
                } else if (pn < 8) {
#pragma unroll
                    for (int bj = 0; bj < 2; ++bj) {
                        const f32x4 v0 = acc[ai][bj][m][0] * rs, v1 = acc[ai][bj][m][1] * rs;
                        const int c = (pn & 1) * 256 + bj * 128 + cl;
                        *(u32x4*)(prow + 1536 + c) = pack8(v0, v1);
                    }
                } else {
                    const float rs2 = rs * rs;
                    const f32x4 v0 = acc[ai][0][m][0] * acc[ai][1][m][0] * rs2, v1 = acc[ai][0][m][1] * acc[ai][1][m][1] * rs2;
                    const int c = (pn - 8) * 128 + cl;
                    *(u32x4*)(prow + 2048 + c) = pack8(v0, v1);
                    if (row < MP) { const int t = row & (SEQ - 1); if (t >= SEQ - 2) { float* o = out + O_SCP + ((size_t)(row >> 11) * 2 + (t - (SEQ - 2))) * CW + c; *(f32x4*)o = v0; *(f32x4*)(o + 4) = v1; } }
                    else { const int t = (row - MP) & (DECT - 1); if (t >= DECT - 2) { float* o = out + O_SCS + ((size_t)((row - MP) >> 4) * 2 + (t - (DECT - 2))) * CW + c; *(f32x4*)o = v0; *(f32x4*)(o + 4) = v1; } }
                }
            }
    }
};

struct EpiMemKV {
    static constexpr bool PERM = true, EARLY = true;
    typedef Pre8 Pre;
    const float* ssq; bf16_t* mk; bf16_t* mv; float* out;
    __device__ __forceinline__ Pre prefetch(const Unit& u, int wr, int wc, int fr, int fq) const { return load8rows(ssq, u.pm * 256 + wr * 64 + fr); }
    __device__ __forceinline__ void operator()(Acc& acc, const Unit& u, const Pre& pre, int wr, int wc, int fr, int fq) const {
        const int pn = u.pn, row0 = u.pm * 256 + wr * 64 + fr, cl = 32 * wc + 8 * fq;
        float* ob = out + (pn < 4 ? O_MK : O_MV); bf16_t* bb = pn < 4 ? mk : mv;
#pragma unroll
        for (int ai = 0; ai < 2; ++ai)
#pragma unroll
            for (int m = 0; m < 4; ++m) {
                const int row = row0 + ai * 128 + m * 16;
                const float rs = rsqrtf(pre.v[ai * 4 + m] * (1.0f / DM) + EPS);
#pragma unroll
                for (int bj = 0; bj < 2; ++bj) {
                    const f32x4 v0 = acc[ai][bj][m][0] * rs, v1 = acc[ai][bj][m][1] * rs;
                    const int c = (pn & 3) * 256 + bj * 128 + cl;
                    store8_f32(ob + (size_t)row * DM + c - 8 * fq, v0, v1, fq);
                    *(u32x4*)(bb + (size_t)row * DM + c) = pack8(v0, v1);
                }
            }
    }
};

struct EpiResidual {
    static constexpr bool PERM = true, EARLY = false;
    typedef PreNone Pre;
    bf16_t* XB; float* ssp;
    __device__ __forceinline__ Pre prefetch(const Unit&, int, int, int, int) const { return Pre{}; }
    __device__ __forceinline__ void operator()(Acc& acc, const Unit& u, const Pre&, int wr, int wc, int fr, int fq) const {
        const int row0 = u.pm * 256 + wr * 64 + fr, col0 = u.pn * 256 + wc * 32 + 8 * fq;
        bf16_t* xb = XB + (size_t)row0 * DM + col0;
        u32x4 old[8][2];
#pragma unroll
        for (int g = 0; g < 8; ++g)
#pragma unroll
            for (int bj = 0; bj < 2; ++bj) old[g][bj] = *(const u32x4*)(xb + (size_t)((g >> 2) * 128 + (g & 3) * 16) * DM + bj * 128);
#pragma unroll
        for (int g = 0; g < 8; ++g) {
            const int ai = g >> 2, m = g & 3, row = row0 + ai * 128 + m * 16; float ss = 0.f;
#pragma unroll
            for (int bj = 0; bj < 2; ++bj) {
                const u32x4 o = old[g][bj]; f32x4 v0, v1;
                v0[0] = __uint_as_float(o.x << 16) + acc[ai][bj][m][0][0]; v0[1] = __uint_as_float(o.x & 0xffff0000u) + acc[ai][bj][m][0][1]; v0[2] = __uint_as_float(o.y << 16) + acc[ai][bj][m][0][2]; v0[3] = __uint_as_float(o.y & 0xffff0000u) + acc[ai][bj][m][0][3];
                v1[0] = __uint_as_float(o.z << 16) + acc[ai][bj][m][1][0]; v1[1] = __uint_as_float(o.z & 0xffff0000u) + acc[ai][bj][m][1][1]; v1[2] = __uint_as_float(o.w << 16) + acc[ai][bj][m][1][2]; v1[3] = __uint_as_float(o.w & 0xffff0000u) + acc[ai][bj][m][1][3];
                ss += ((v0[0] * v0[0] + v0[1] * v0[1]) + (v0[2] * v0[2] + v0[3] * v0[3])) + ((v1[0] * v1[0] + v1[1] * v1[1]) + (v1[2] * v1[2] + v1[3] * v1[3]));
                *(u32x4*)(xb + (size_t)(ai * 128 + m * 16) * DM + bj * 128) = pack8(v0, v1);
            }
            ss = xor32_sum(xor16_sum(ss));
            if (fq == 0) ssp[(size_t)row * 16 + u.pn * 4 + wc] = ss;
        }
    }
};
struct EpiResidualOut {
    static constexpr bool PERM = false, EARLY = false;
    typedef PreNone Pre;
    const bf16_t* XB; float* X; float* ssp;
    __device__ __forceinline__ Pre prefetch(const Unit&, int, int, int, int) const { return Pre{}; }
    __device__ __forceinline__ void operator()(Acc& acc, const Unit& u, const Pre&, int wr, int wc, int fr, int fq) const {
        const int row0 = u.pm * 256 + wr * 64 + fr, col0 = u.pn * 256 + wc * 32 + 4 * fq;
        const bf16_t* xb = XB + (size_t)row0 * DM + col0;
        u32x2 old[8][2][2];
#pragma unroll
        for (int g = 0; g < 8; ++g)
#pragma unroll
            for (int bj = 0; bj < 2; ++bj)
#pragma unroll
                for (int n = 0; n < 2; ++n) old[g][bj][n] = *(const u32x2*)(xb + (size_t)((g >> 2) * 128 + (g & 3) * 16) * DM + bj * 128 + n * 16);
#pragma unroll
        for (int g = 0; g < 8; ++g) {
            const int ai = g >> 2, m = g & 3, row = row0 + ai * 128 + m * 16; float* xrow = X + (size_t)row * DM + col0; float ss = 0.f;
#pragma unroll
            for (int bj = 0; bj < 2; ++bj)
#pragma unroll
                for (int n = 0; n < 2; ++n) {
                    const u32x2 o = old[g][bj][n]; f32x4 v;
                    v[0] = __uint_as_float(o.x << 16) + acc[ai][bj][m][n][0]; v[1] = __uint_as_float(o.x & 0xffff0000u) + acc[ai][bj][m][n][1]; v[2] = __uint_as_float(o.y << 16) + acc[ai][bj][m][n][2]; v[3] = __uint_as_float(o.y & 0xffff0000u) + acc[ai][bj][m][n][3];
                    ss += (v[0] * v[0] + v[1] * v[1]) + (v[2] * v[2] + v[3] * v[3]);
                    *(f32x4*)(xrow + bj * 128 + n * 16) = v;
                }
            ss = xor32_sum(xor16_sum(ss));
            if (fq == 0) ssp[(size_t)row * 16 + u.pn * 4 + wc] = ss;
        }
    }
};
__device__ __forceinline__ float rstd16(const float* ssp, int row) {
    const f32x4* p = (const f32x4*)(ssp + (size_t)row * 16); const f32x4 a = p[0], b = p[1], c = p[2], d = p[3];
    const float s = ((a[0] + a[1]) + (a[2] + a[3])) + ((b[0] + b[1]) + (b[2] + b[3])) + ((c[0] + c[1]) + (c[2] + c[3])) + ((d[0] + d[1]) + (d[2] + d[3]));
    return rsqrtf(s * (1.0f / DM) + EPS);
}
struct EpiScaleBf16 {
    static constexpr bool PERM = true, EARLY = true;
    typedef Pre8 Pre;
    const float* rs; bf16_t* O; int ldo;
    __device__ __forceinline__ Pre prefetch(const Unit& u, int wr, int wc, int fr, int fq) const { return load8rows(rs, u.pm * 256 + wr * 64 + fr); }
    __device__ __forceinline__ void operator()(Acc& acc, const Unit& u, const Pre& pre, int wr, int wc, int fr, int fq) const {
        const int row0 = u.pm * 256 + wr * 64 + fr, col0 = u.pn * 256 + 32 * wc + 8 * fq;
#pragma unroll
        for (int ai = 0; ai < 2; ++ai)
#pragma unroll
            for (int m = 0; m < 4; ++m) {
                const int row = row0 + ai * 128 + m * 16; const float r = pre.v[ai * 4 + m];
#pragma unroll
                for (int bj = 0; bj < 2; ++bj) *(u32x4*)(O + (size_t)row * ldo + col0 + bj * 128) = pack8(acc[ai][bj][m][0] * r, acc[ai][bj][m][1] * r);
            }
    }
};
struct EpiXScores {
    static constexpr bool PERM = true, EARLY = false;
    typedef PreNone Pre;
    __device__ __forceinline__ Pre prefetch(const Unit&, int, int, int, int) const { return Pre{}; }
    bf16_t* P; float* lp; LAS float* red;
    __device__ __forceinline__ void operator()(Acc& acc, const Unit& u, const Pre&, int wr, int wc, int fr, int fq) const {
        constexpr float C = 0.0625f * 1.4426950408889634f;
        float mx[2][4];
#pragma unroll
        for (int ai = 0; ai < 2; ++ai)
#pragma unroll
            for (int m = 0; m < 4; ++m) {
                float a = -3.0e38f;
#pragma unroll
                for (int bj = 0; bj < 2; ++bj)
#pragma unroll
                    for (int n = 0; n < 2; ++n) { const f32x4 v = acc[ai][bj][m][n]; a = fmaxf(a, fmaxf(fmaxf(v[0], v[1]), fmaxf(v[2], v[3]))); }
                a = xor32_max(xor16_max(a));
                if (fq == 0) red[(ai * 128 + wr * 64 + m * 16 + fr) * 4 + wc] = a;
            }
        EPI_BAR();
#pragma unroll
        for (int ai = 0; ai < 2; ++ai)
#pragma unroll
            for (int m = 0; m < 4; ++m) { const f32x4 r = *(const LAS f32x4*)(red + (ai * 128 + wr * 64 + m * 16 + fr) * 4); mx[ai][m] = fmaxf(fmaxf(r[0], r[1]), fmaxf(r[2], r[3])); }
        const int row0 = u.pm * 256 + wr * 64 + fr, col0 = u.pn * 256 + 32 * wc + 8 * fq;
#pragma unroll
        for (int ai = 0; ai < 2; ++ai)
#pragma unroll
            for (int m = 0; m < 4; ++m) {
                const int row = row0 + ai * 128 + m * 16; const float mc = mx[ai][m] * C; float s = 0.f;
#pragma unroll
                for (int bj = 0; bj < 2; ++bj) {
#pragma unroll
                    for (int j = 0; j < 4; ++j) { acc[ai][bj][m][0][j] = __builtin_amdgcn_exp2f(acc[ai][bj][m][0][j] * C - mc); acc[ai][bj][m][1][j] = __builtin_amdgcn_exp2f(acc[ai][bj][m][1][j] * C - mc); }
                    const u32x4 w = pack8(acc[ai][bj][m][0], acc[ai][bj][m][1]);
                    s += (__uint_as_float(w.x << 16) + __uint_as_float(w.x & 0xffff0000u)) + (__uint_as_float(w.y << 16) + __uint_as_float(w.y & 0xffff0000u))
                       + (__uint_as_float(w.z << 16) + __uint_as_float(w.z & 0xffff0000u)) + (__uint_as_float(w.w << 16) + __uint_as_float(w.w & 0xffff0000u));
                    *(u32x4*)(P + (size_t)row * DM + col0 + bj * 128) = w;
                }
                s = xor32_sum(xor16_sum(s));
                if (fq == 0) lp[(size_t)row * 16 + u.pn * 4 + wc] = s;
                asm volatile("" ::: "memory");
            }
        EPI_BAR();
    }
};
struct EpiXPV {
    static constexpr bool PERM = true, EARLY = false;
    typedef PreNone Pre;
    __device__ __forceinline__ Pre prefetch(const Unit&, int, int, int, int) const { return Pre{}; }
    const float* lp; bf16_t* O;
    __device__ __forceinline__ void operator()(Acc& acc, const Unit& u, const Pre&, int wr, int wc, int fr, int fq) const {
        const int row0 = u.pm * 256 + wr * 64 + fr, col0 = u.pn * 256 + 32 * wc + 8 * fq;
#pragma unroll
        for (int ai = 0; ai < 2; ++ai)
#pragma unroll
            for (int m = 0; m < 4; ++m) {
                const int row = row0 + ai * 128 + m * 16; const f32x4 l4 = *(const f32x4*)(lp + (size_t)row * 16 + u.pn * 4);
                const float rl = 1.0f / ((l4[0] + l4[1]) + (l4[2] + l4[3]));
#pragma unroll
                for (int bj = 0; bj < 2; ++bj) *(u32x4*)(O + (size_t)row * DM + col0 + bj * 128) = pack8(acc[ai][bj][m][0] * rl, acc[ai][bj][m][1] * rl);
            }
    }
};
struct EpiUpGate {
    static constexpr bool PERM = true, EARLY = false;
    typedef Pre8 Pre;
    const float* rs; const float* wconv;
    const float* state;
    bf16_t* H; float* out;
    float* uh; float* u01; float* g01;
    LAS float* tail;
    __device__ __forceinline__ Pre prefetch(const Unit& u, int wr, int wc, int fr, int fq) const { return load8rows(rs, u.pm * 256 + wr * 64 + fr); }
    __device__ __forceinline__ void operator()(Acc& acc, const Unit& u, const Pre& pre, int wr, int wc, int fr, int fq) const {
        const int pm = u.pm, pn = u.pn, row0 = pm * 256 + wr * 64 + fr, cl = 32 * wc + 8 * fq, gc = pn * 128 + cl;
        const bool sample = pm >= NTILE_P;
        const f32x4 w00 = *(const f32x4*)(wconv + gc), w01 = *(const f32x4*)(wconv + gc + 4), w10 = *(const f32x4*)(wconv + DFF + gc), w11 = *(const f32x4*)(wconv + DFF + gc + 4),
                    w20 = *(const f32x4*)(wconv + 2 * DFF + gc), w21 = *(const f32x4*)(wconv + 2 * DFF + gc + 4);
#pragma unroll
        for (int ai = 0; ai < 2; ++ai)
#pragma unroll
            for (int m = 0; m < 4; ++m) {
                const int g = ai * 8 + wr * 4 + m; const float r = pre.v[ai * 4 + m];
#pragma unroll
                for (int bj = 0; bj < 2; ++bj)
#pragma unroll
                    for (int n = 0; n < 2; ++n) acc[ai][bj][m][n] *= r;
                if (fr >= 14) {
                    LAS float* t = tail + (g * 2 + (fr - 14)) * 128 + cl; *(LAS f32x4*)t = acc[ai][0][m][0]; *(LAS f32x4*)(t + 4) = acc[ai][0][m][1];
                    if (sample) { float* o = out + O_FFS + ((size_t)((pm - NTILE_P) * 16 + g) * 2 + (fr - 14)) * DFF + gc; *(f32x4*)o = acc[ai][0][m][0]; *(f32x4*)(o + 4) = acc[ai][0][m][1]; }
                    else if (g == 15) {
                        float* o = uh + ((size_t)pm * 2 + (fr - 14)) * DFF + gc; *(f32x4*)o = acc[ai][0][m][0]; *(f32x4*)(o + 4) = acc[ai][0][m][1];
                        if ((pm & 7) == 7) { float* q = out + O_FFP + ((size_t)(pm >> 3) * 2 + (fr - 14)) * DFF + gc; *(f32x4*)q = acc[ai][0][m][0]; *(f32x4*)(q + 4) = acc[ai][0][m][1]; }
                    }
                }
                if (!sample && g == 0 && fr < 2) {
                    float* o = u01 + ((size_t)pm * 2 + fr) * DFF + gc; *(f32x4*)o = acc[ai][0][m][0]; *(f32x4*)(o + 4) = acc[ai][0][m][1];
                    float* q = g01 + ((size_t)pm * 2 + fr) * DFF + gc; *(f32x4*)q = acc[ai][1][m][0]; *(f32x4*)(q + 4) = acc[ai][1][m][1];
                }
            }
        EPI_BAR();
#pragma unroll
        for (int ai = 0; ai < 2; ++ai)
#pragma unroll
            for (int m = 0; m < 4; ++m) {
                const int row = row0 + ai * 128 + m * 16, g = ai * 8 + wr * 4 + m;
                f32x4 h1[2] = {(f32x4){0.f, 0.f, 0.f, 0.f}, (f32x4){0.f, 0.f, 0.f, 0.f}}, h2[2] = {(f32x4){0.f, 0.f, 0.f, 0.f}, (f32x4){0.f, 0.f, 0.f, 0.f}};
                if (fr < 2) {
                    if (sample) { const float* s = state + (size_t)((pm - NTILE_P) * 16 + g) * 2 * DFF + gc; h2[0] = *(const f32x4*)(s + fr * DFF); h2[1] = *(const f32x4*)(s + fr * DFF + 4); h1[0] = *(const f32x4*)(s + DFF); h1[1] = *(const f32x4*)(s + DFF + 4); }
                    else if (g > 0) { const LAS float* t = tail + ((g - 1) * 2) * 128 + cl; h2[0] = *(const LAS f32x4*)(t + fr * 128); h2[1] = *(const LAS f32x4*)(t + fr * 128 + 4); h1[0] = *(const LAS f32x4*)(t + 128); h1[1] = *(const LAS f32x4*)(t + 132); }
                }
                f32x4 hv[2];
#pragma unroll
                for (int n = 0; n < 2; ++n) {
                    const f32x4 uc = acc[ai][0][m][n]; f32x4 p1, p2;
#pragma unroll
                    for (int j = 0; j < 4; ++j) {
                        p1[j] = __int_as_float(__builtin_amdgcn_update_dpp(__float_as_int(h1[n][j]), __float_as_int(uc[j]), 0x111, 0xf, 0xf, false));
                        p2[j] = __int_as_float(__builtin_amdgcn_update_dpp(__float_as_int(h2[n][j]), __float_as_int(uc[j]), 0x112, 0xf, 0xf, false)); }
                    const f32x4 y = (n == 0 ? w00 : w01) * p2 + (n == 0 ? w10 : w11) * p1 + (n == 0 ? w20 : w21) * uc;
                    const f32x4 t = y * (-1.4426950408889634f); f32x4 d;
#pragma unroll
                    for (int j = 0; j < 4; ++j) d[j] = __builtin_amdgcn_exp2f(t[j]);
                    d = d + 1.0f;
#pragma unroll
                    for (int j = 0; j < 4; ++j) d[j] = __builtin_amdgcn_rcpf(d[j]);
                    hv[n] = (y * d) * acc[ai][1][m][n];
                }
                *(u32x4*)(H + (size_t)row * DFF + gc) = pack8(hv[0], hv[1]);
            }
        EPI_BAR();
    }
};
struct EpiPartialF32 {
    static constexpr bool PERM = false, EARLY = false;
    typedef PreNone Pre;
    float* S;
    __device__ __forceinline__ Pre prefetch(const Unit&, int, int, int, int) const { return Pre{}; }
    __device__ __forceinline__ void operator()(Acc& acc, const Unit& u, const Pre&, int wr, int wc, int fr, int fq) const {
        const int kh = u.pn >> 4, pn = u.pn & 15, row0 = (u.pm - NTILE_P) * 256 + wr * 64 + fr, col0 = pn * 256 + wc * 32 + 4 * fq;
        float* b = S + (size_t)kh * MS * DM + (size_t)row0 * DM + col0;
#pragma unroll
        for (int ai = 0; ai < 2; ++ai)
#pragma unroll
            for (int m = 0; m < 4; ++m)
#pragma unroll
                for (int bj = 0; bj < 2; ++bj)
#pragma unroll
                    for (int n = 0; n < 2; ++n) *(f32x4*)(b + (size_t)(ai * 128 + m * 16) * DM + bj * 128 + n * 16) = acc[ai][bj][m][n];
    }
};
}
namespace dattn {
constexpr int NW = 8, QBLK = 32, KVBLK = 64;
constexpr float SCALE = 0.125f, THR = 8.f;
constexpr int SHM_V = KVBLK * 128 * 2, SHM_K = KVBLK * 128 * 2, SHM_ATTN = 2 * SHM_V + 2 * SHM_K + NW * 64 * 4;
#define KSWZ(row, colB) ((row) * 256 + ((colB) ^ (((row) & 7) << 4)))
#define SBAR() __builtin_amdgcn_sched_barrier(0)
__device__ __forceinline__ int crow(int r, int hi) { return (r & 3) + 8 * (r >> 2) + 4 * hi; }
__device__ __forceinline__ void partialSM(f32x16& p0, f32x16& p1, float& m_reg, float& mn, float& alpha) {
  constexpr float C = SCALE * 1.4426950408889634f;
  float pmax = p0[0];
#pragma unroll
  for (int r = 1; r < 16; ++r) pmax = fmaxf(pmax, p0[r]);
#pragma unroll
  for (int r = 0; r < 16; ++r) pmax = fmaxf(pmax, p1[r]);
  { auto rr = __builtin_amdgcn_permlane32_swap(__float_as_uint(pmax), __float_as_uint(pmax), false, false);
    pmax = fmaxf(__uint_as_float(rr[0]), __uint_as_float(rr[1])); }
  if (__builtin_expect(__all(pmax - m_reg <= THR / SCALE), 1)) { mn = m_reg; alpha = 1.f; }
  else { mn = fmaxf(m_reg, pmax); alpha = __builtin_amdgcn_exp2f((m_reg - mn) * C); m_reg = mn; }
  const float mnC = -mn * C;
#pragma unroll
  for (int r = 0; r < 16; ++r) p0[r] = fmaf(p0[r], C, mnC);
#pragma unroll
  for (int r = 0; r < 16; ++r) p1[r] = fmaf(p1[r], C, mnC);
#pragma unroll
  for (int r = 0; r < 16; ++r) p0[r] = __builtin_amdgcn_exp2f(p0[r]);
}
__device__ __forceinline__ void finishSM(f32x16& p0, f32x16& p1, float alpha, float& l_reg, bf16x8& pa0, bf16x8& pa1, bf16x8& pa2, bf16x8& pa3) {
#pragma unroll
  for (int r = 0; r < 16; ++r) p1[r] = __builtin_amdgcn_exp2f(p1[r]);
  float ps = 0;
#pragma unroll
  for (int r = 0; r < 16; ++r) ps += p0[r];
#pragma unroll
  for (int r = 0; r < 16; ++r) ps += p1[r];
  { auto rr = __builtin_amdgcn_permlane32_swap(__float_as_uint(ps), __float_as_uint(ps), false, false);
    ps = __uint_as_float(rr[0]) + __uint_as_float(rr[1]); }
  l_reg = l_reg * alpha + ps;
#define PK4(P, BASE, OUT) do { unsigned a0 = cvt_pk_bf16(P[BASE + 0], P[BASE + 1]), a1 = cvt_pk_bf16(P[BASE + 2], P[BASE + 3]);   \
    unsigned b0 = cvt_pk_bf16(P[BASE + 4], P[BASE + 5]), b1 = cvt_pk_bf16(P[BASE + 6], P[BASE + 7]);                              \
    auto r0 = __builtin_amdgcn_permlane32_swap(a0, b0, false, false); auto r1 = __builtin_amdgcn_permlane32_swap(a1, b1, false, false); \
    u32x4 w = {r0[0], r1[0], r0[1], r1[1]}; OUT = *reinterpret_cast<bf16x8*>(&w); } while (0)
  PK4(p0, 0, pa0); PK4(p0, 8, pa1); PK4(p1, 0, pa2); PK4(p1, 8, pa3);
#undef PK4
}
__device__ __forceinline__ void qkt(f32x16& p0, f32x16& p1, const char* Ks, const bf16x8* qr, int r32, int hi, int mp) {
  p0 = f32x16{}; p1 = f32x16{};
#pragma unroll
  for (int d0 = 0; d0 < 4; ++d0) { const int cb = (mp * 64 + d0 * 16 + hi * 8) * 2;
    const bf16x8 b0 = *reinterpret_cast<const bf16x8*>(Ks + KSWZ(r32, cb));
    const bf16x8 b1 = *reinterpret_cast<const bf16x8*>(Ks + KSWZ(32 + r32, cb));
    p0 = __builtin_amdgcn_mfma_f32_32x32x16_bf16(b0, qr[d0], p0, 0, 0, 0);
    p1 = __builtin_amdgcn_mfma_f32_32x32x16_bf16(b1, qr[d0], p1, 0, 0, 0); }
}
__device__ __forceinline__ int v_st(int k, int c) { const int kk = (k & ~0xC) | ((k & 4) << 1) | ((k & 8) >> 1); return ((kk >> 3) * 4 + (c >> 5)) * 512 + ((kk & 7) * 32 + (c & 31)) * 2; }
__device__ __forceinline__ int v_rd_base(int lane) { return ((lane & 3) << 3) | (((lane >> 2) & 3) << 6) | (((lane >> 4) & 1) << 5) | (((lane >> 5) & 1) << 8); }
constexpr int v_rd_off(int d0, int ks, int half) { return d0 * 512 + ks * 4096 + half * 2048; }
template <int OFF> __device__ __forceinline__ s16x4 tr_read(int vb) {
  s16x4 r; asm volatile("ds_read_b64_tr_b16 %0, %1 offset:%2" : "=&v"(r) : "v"(vb), "i"(OFF) : "memory"); return r;
}
template <int D0> __device__ __forceinline__ void pv_one(f32x16& od, int vb, bf16x8 pa0, bf16x8 pa1, bf16x8 pa2, bf16x8 pa3) {
  const s16x4 l0 = tr_read<v_rd_off(D0, 0, 0)>(vb), h0 = tr_read<v_rd_off(D0, 0, 1)>(vb), l1 = tr_read<v_rd_off(D0, 1, 0)>(vb), h1 = tr_read<v_rd_off(D0, 1, 1)>(vb);
  const s16x4 l2 = tr_read<v_rd_off(D0, 2, 0)>(vb), h2 = tr_read<v_rd_off(D0, 2, 1)>(vb), l3 = tr_read<v_rd_off(D0, 3, 0)>(vb), h3 = tr_read<v_rd_off(D0, 3, 1)>(vb);
  asm volatile("s_waitcnt lgkmcnt(0)" ::: "memory"); SBAR();
#define PK(L, H) (bf16x8){L[0], L[1], L[2], L[3], H[0], H[1], H[2], H[3]}
  od = __builtin_amdgcn_mfma_f32_32x32x16_bf16(pa0, PK(l0, h0), od, 0, 0, 0);
  od = __builtin_amdgcn_mfma_f32_32x32x16_bf16(pa1, PK(l1, h1), od, 0, 0, 0);
  od = __builtin_amdgcn_mfma_f32_32x32x16_bf16(pa2, PK(l2, h2), od, 0, 0, 0);
  od = __builtin_amdgcn_mfma_f32_32x32x16_bf16(pa3, PK(l3, h3), od, 0, 0, 0);
#undef PK
}
__device__ __forceinline__ void pv_d0(f32x16* o, int vb, bf16x8 pa0, bf16x8 pa1, bf16x8 pa2, bf16x8 pa3) {
  pv_one<0>(o[0], vb, pa0, pa1, pa2, pa3); pv_one<1>(o[1], vb, pa0, pa1, pa2, pa3); pv_one<2>(o[2], vb, pa0, pa1, pa2, pa3); pv_one<3>(o[3], vb, pa0, pa1, pa2, pa3);
}

__device__ __forceinline__ void qkt3(f32x16& p0, f32x16& p1, const LAS char* Ks, const bf16x8* qr, int r32, int hi, int mp) {
  p0 = f32x16{}; p1 = f32x16{};
#pragma unroll
  for (int d0 = 0; d0 < 4; ++d0) { const int cb = (mp * 64 + d0 * 16 + hi * 8) * 2;
    const bf16x8 b0 = *reinterpret_cast<const LAS bf16x8*>(Ks + KSWZ(r32, cb));
    const bf16x8 b1 = *reinterpret_cast<const LAS bf16x8*>(Ks + KSWZ(32 + r32, cb));
    p0 = __builtin_amdgcn_mfma_f32_32x32x16_bf16(b0, qr[d0], p0, 0, 0, 0);
    p1 = __builtin_amdgcn_mfma_f32_32x32x16_bf16(b1, qr[d0], p1, 0, 0, 0); }
}
__device__ __forceinline__ void unit(int b, int h, int qb, const bf16_t* __restrict__ p1, bf16_t* __restrict__ A2, float lam, const float* __restrict__ gsub, LAS char* lds3) {
  int tid = threadIdx.x; asm volatile("" : "+v"(tid));
  const int wid = __builtin_amdgcn_readfirstlane(tid >> 6), lane = tid & 63, r32 = lane & 31, hi = lane >> 5, wq = wid & 3, mp = wid >> 2;
  LAS float* ws = (LAS float*)(lds3 + 131072) + wid * 64; LAS float* li_l = ws; LAS float* al_l = ws + 32;
  float m_reg = -1e30f, l_reg = 0; f32x16 o[4] = {}; bf16x8 qr[4];
  const size_t rowb = (size_t)b * SEQ;
  const char* Kh = (const char*)(p1 + rowb * P1W + 512 + h * 128); const char* Vh = (const char*)(p1 + rowb * P1W + 1024 + h * 128);
  unsigned koff[2], voff[2];
#pragma unroll
  for (int i = 0; i < 2; ++i) {
    const int krow = wid * 8 + i * 4 + (lane >> 4), kch = (lane & 15) ^ (krow & 7); koff[i] = (unsigned)(krow * P1W * 2 + kch * 16);
    const int sub = wid * 4 + i * 2 + (lane >> 5), kk = (sub >> 2) * 8 + ((lane & 31) >> 2), key = (kk & ~0xC) | ((kk & 4) << 1) | ((kk & 8) >> 1), c = (sub & 3) * 32 + (lane & 3) * 8;
    voff[i] = (unsigned)(key * P1W * 2 + c * 2);
  }
  const unsigned dmaw = (unsigned)wid * 2048u;
#define DMA(t, slot) do { const char* kb_ = Kh + (size_t)(t) * (KVBLK * P1W * 2); const char* vb_ = Vh + (size_t)(t) * (KVBLK * P1W * 2); _Pragma("unroll") for (int i_ = 0; i_ < 2; ++i_) { \
    __builtin_amdgcn_global_load_lds((const unsigned*)(kb_ + koff[i_]), (LAS unsigned*)(lds3 + (slot) * 32768 + dmaw + i_ * 1024), 16, 0, 0); \
    __builtin_amdgcn_global_load_lds((const unsigned*)(vb_ + voff[i_]), (LAS unsigned*)(lds3 + (slot) * 32768 + 16384 + dmaw + i_ * 1024), 16, 0, 0); } } while (0)
#define WAITV(n) asm volatile("s_waitcnt vmcnt(" #n ")" ::: "memory")
#define LBAR() do { asm volatile("s_waitcnt lgkmcnt(0)" ::: "memory"); __builtin_amdgcn_s_barrier(); asm volatile("" ::: "memory"); } while (0)
#define KS(t) (lds3 + ((t) & 3) * 32768)
#define VB(t) (vrd + ((t) & 3) * 32768)
  const int NT = 2 * qb + 2;
  const bool vis_last = (wq >= 2);
  DMA(0, 0); DMA(1, 1);
  const bf16_t* Qw = p1 + (rowb + qb * 128 + wq * QBLK + r32) * P1W + h * 128 + mp * 64 + hi * 8;
#pragma unroll
  for (int d0 = 0; d0 < 4; ++d0) qr[d0] = *reinterpret_cast<const bf16x8*>(Qw + d0 * 16);
  const int vrd = (int)(uintptr_t)lds3 + 16384 + v_rd_base(lane);
#define RESC(a) do { if (__any((a) < 1.f)) { if (hi == 0) al_l[r32] = (a); asm volatile("s_waitcnt lgkmcnt(0)" ::: "memory"); \
    _Pragma("unroll") for (int d = 0; d < 4; ++d) _Pragma("unroll") for (int r = 0; r < 16; ++r) o[d][r] *= al_l[crow(r, hi)]; } } while (0)
  f32x16 pA0, pA1, pB0, pB1; float mnA, mnB, alA, alB; bf16x8 pa0, pa1, pa2, pa3;
  WAITV(4); LBAR();
  if (2 < NT) DMA(2, 2);
  qkt3(pA0, pA1, KS(0), qr, r32, hi, mp); partialSM(pA0, pA1, m_reg, mnA, alA);
  for (int j = 1; j + 1 < NT; j += 2) {
    WAITV(4); LBAR(); DMA(j + 2, (j + 2) & 3);
    SBAR(); qkt3(pB0, pB1, KS(j), qr, r32, hi, mp);
    finishSM(pA0, pA1, alA, l_reg, pa0, pa1, pa2, pa3); SBAR();
    pv_d0(o, VB(j - 1), pa0, pa1, pa2, pa3); partialSM(pB0, pB1, m_reg, mnB, alB);
    RESC(alB);
    WAITV(4); LBAR(); if (j + 3 < NT) DMA(j + 3, (j + 3) & 3);
    SBAR(); qkt3(pA0, pA1, KS(j + 1), qr, r32, hi, mp);
    finishSM(pB0, pB1, alB, l_reg, pa0, pa1, pa2, pa3); SBAR();
    pv_d0(o, VB(j), pa0, pa1, pa2, pa3); partialSM(pA0, pA1, m_reg, mnA, alA);
    RESC(alA);
  }
  WAITV(0); LBAR();
  SBAR();
  if (vis_last) qkt3(pB0, pB1, KS(NT - 1), qr, r32, hi, mp);
  finishSM(pA0, pA1, alA, l_reg, pa0, pa1, pa2, pa3); SBAR();
  pv_d0(o, VB(NT - 2), pa0, pa1, pa2, pa3);
  if (vis_last) {
    partialSM(pB0, pB1, m_reg, mnB, alB);
    RESC(alB);
    finishSM(pB0, pB1, alB, l_reg, pa0, pa1, pa2, pa3); SBAR();
    pv_d0(o, VB(NT - 1), pa0, pa1, pa2, pa3);
  }
  if (hi == 0) li_l[r32] = l_reg; asm volatile("s_waitcnt lgkmcnt(0)" ::: "memory");
  float rli[16];
#pragma unroll
  for (int r = 0; r < 16; ++r) rli[r] = __builtin_amdgcn_rcpf(li_l[crow(r, hi)]);
  LBAR();
  LAS float* X = (LAS float*)lds3 + wq * (32 * 132);
  if (mp == 1) {
#pragma unroll
    for (int r = 0; r < 16; ++r) { const int orow = crow(r, hi);
#pragma unroll
      for (int d0 = 0; d0 < 4; ++d0) X[orow * 132 + d0 * 32 + r32] = o[d0][r] * rli[r]; }
  }
  LBAR();
  if (mp == 0) {
#pragma unroll
    for (int r = 0; r < 16; ++r) { const int orow = crow(r, hi);
#pragma unroll
      for (int d0 = 0; d0 < 4; ++d0) { LAS float* p = &X[orow * 132 + d0 * 32 + r32]; *p = o[d0][r] * rli[r] - lam * (*p); } }
    asm volatile("s_waitcnt lgkmcnt(0)" ::: "memory");
    const int row = lane >> 1, half = lane & 1; const LAS float* xr = X + row * 132 + half * 64;
    f32x4 v[16]; float ss = 0.f;
#pragma unroll
    for (int i = 0; i < 16; ++i) { v[i] = *(const LAS f32x4*)(xr + 4 * i); ss += (v[i][0] * v[i][0] + v[i][1] * v[i][1]) + (v[i][2] * v[i][2] + v[i][3] * v[i][3]); }
    ss += DPPF(ss, 0xB1);
    const float rs = rsqrtf(ss * (1.0f / 128.0f) + EPS) * (1.0f - LAM_INIT);
    bf16_t* orow = A2 + (rowb + qb * 128 + wq * QBLK + row) * DM + h * 128 + half * 64; const float* g = gsub + half * 64;
#pragma unroll
    for (int i = 0; i < 16; i += 2) { const f32x4 g0 = *(const f32x4*)(g + 4 * i), g1 = *(const f32x4*)(g + 4 * i + 4);
      *(u32x4*)(orow + 4 * i) = epi::pack8(v[i] * g0 * rs, v[i + 1] * g1 * rs); }
  }
  asm volatile("s_waitcnt vmcnt(0)" ::: "memory");
  LBAR();
#undef DMA
#undef WAITV
#undef LBAR
#undef KS
#undef VB
#undef RESC
}
#undef KSWZ
#undef SBAR
}
namespace misc {
constexpr int SK = PAST + DECT;
__device__ __forceinline__ void sample_attn_unit(int b, int h, int qh, const bf16_t* __restrict__ p1, const float* __restrict__ ck, const float* __restrict__ cv,
                                                 const float* __restrict__ nk, const float* __restrict__ nv, bf16_t* __restrict__ A2, float lam, const float* __restrict__ gsub, char* lds) {
  int tid = threadIdx.x; asm volatile("" : "+v"(tid)); const int lane = tid & 63, wid = tid >> 6;
  float* S = (float*)lds; float* red = (float*)(lds + 66560); float* q = (float*)(lds + 132096); float* st = (float*)(lds + 136192);
  for (int i = tid; i < 1024; i += 512) { const int mp = i >> 9, r = (i >> 6) & 7, d = i & 63;
    q[i] = bf2f(p1[(size_t)(MP + b * DECT + qh * 8 + r) * P1W + h * 128 + mp * 64 + d]); }
  __syncthreads();
  for (int it = tid; it < 2 * SK; it += 512) {
    const int mp = it / SK, key = it - mp * SK;
    const float* kp = key < PAST ? ck + (((size_t)b * PAST + key) * NH + h) * 128 + mp * 64 : nk + ((size_t)(b * DECT + key - PAST)) * 512 + h * 128 + mp * 64;
    float a[8] = {0.f, 0.f, 0.f, 0.f, 0.f, 0.f, 0.f, 0.f};
#pragma unroll 4
    for (int d = 0; d < 64; d += 4) { const f32x4 kv = *(const f32x4*)(kp + d);
#pragma unroll
      for (int r = 0; r < 8; ++r) { const f32x4 qv = *(const f32x4*)(q + (mp * 8 + r) * 64 + d); a[r] += (kv[0] * qv[0] + kv[1] * qv[1]) + (kv[2] * qv[2] + kv[3] * qv[3]); } }
#pragma unroll
    for (int r = 0; r < 8; ++r) S[(mp * 8 + r) * SK + key] = a[r] * 0.125f;
  }
  __syncthreads();
  for (int rr = 0; rr < 2; ++rr) { const int row = wid * 2 + rr; float* s = S + row * SK;
    float mx = -3.0e38f; for (int k = lane; k < SK; k += 64) mx = fmaxf(mx, s[k]); mx = wave_max(mx);
    float sum = 0.f; for (int k = lane; k < SK; k += 64) { const float e = __expf(s[k] - mx); s[k] = e; sum += e; } sum = wave_sum(sum);
    if (lane == 0) st[row] = 1.0f / sum; }
  __syncthreads();
  for (int i = tid; i < 8 * SK; i += 512) { const int r = i / SK, k = i - r * SK; S[r * SK + k] = S[r * SK + k] * st[r] - lam * S[(8 + r) * SK + k] * st[8 + r]; }
  __syncthreads();
  { const int eg = tid & 31, ks = tid >> 5; f32x4 o[8];
#pragma unroll
    for (int r = 0; r < 8; ++r) o[r] = (f32x4){0.f, 0.f, 0.f, 0.f};
    for (int key = ks; key < SK; key += 16) {
      const float* vp = key < PAST ? cv + (((size_t)b * PAST + key) * NH + h) * 128 + eg * 4 : nv + ((size_t)(b * DECT + key - PAST)) * 512 + h * 128 + eg * 4;
      const f32x4 vv = *(const f32x4*)vp;
#pragma unroll
      for (int r = 0; r < 8; ++r) o[r] += vv * S[r * SK + key]; }
#pragma unroll
    for (int r = 0; r < 8; ++r) *(f32x4*)(red + (ks * 8 + r) * 128 + eg * 4) = o[r]; }
  __syncthreads();
  { const int r = wid; float x0 = 0.f, x1 = 0.f;
#pragma unroll
    for (int ks = 0; ks < 16; ++ks) { const f32x2 t = *(const f32x2*)(red + (ks * 8 + r) * 128 + 2 * lane); x0 += t[0]; x1 += t[1]; }
    const float ss = wave_sum(x0 * x0 + x1 * x1); const float rs = rsqrtf(ss * (1.0f / 128.0f) + EPS) * (1.0f - LAM_INIT);
    const unsigned w = cvt_pk_bf16(x0 * rs * gsub[2 * lane], x1 * rs * gsub[2 * lane + 1]);
    *(unsigned*)(A2 + (size_t)(MP + b * DECT + qh * 8 + r) * DM + h * 128 + 2 * lane) = w; }
  __syncthreads();
}

__device__ __forceinline__ void sample_xattn_unit(int b, int h, const bf16_t* __restrict__ HQ, const float* __restrict__ mk, const float* __restrict__ mv, bf16_t* __restrict__ XO, char* lds) {
  int tid = threadIdx.x; asm volatile("" : "+v"(tid)); const int lane = tid & 63, wid = tid >> 6;
  float* q = (float*)lds; float* S = (float*)(lds + 16384);
  for (int i = tid; i < 16 * 256; i += 512) { const int r = i >> 8, d = i & 255; q[i] = bf2f(HQ[(size_t)(MP + b * DECT + r) * DM + h * 256 + d]); }
  __syncthreads();
  { const int key = tid >> 1, qh = tid & 1; const float* kp = mk + (((size_t)b * NMEM + key) * NH + h) * 256;
    float a[8] = {0.f, 0.f, 0.f, 0.f, 0.f, 0.f, 0.f, 0.f};
#pragma unroll 4
    for (int d = 0; d < 256; d += 4) { const f32x4 kv = *(const f32x4*)(kp + d);
#pragma unroll
      for (int r = 0; r < 8; ++r) { const f32x4 qv = *(const f32x4*)(q + (qh * 8 + r) * 256 + d); a[r] += (kv[0] * qv[0] + kv[1] * qv[1]) + (kv[2] * qv[2] + kv[3] * qv[3]); } }
#pragma unroll
    for (int r = 0; r < 8; ++r) S[(qh * 8 + r) * 256 + key] = a[r] * 0.0625f; }
  __syncthreads();
  for (int rr = 0; rr < 2; ++rr) { const int row = wid * 2 + rr; float* s = S + row * 256;
    float v[4]; float mx = -3.0e38f;
#pragma unroll
    for (int i = 0; i < 4; ++i) { v[i] = s[lane + 64 * i]; mx = fmaxf(mx, v[i]); } mx = wave_max(mx);
    float sum = 0.f;
#pragma unroll
    for (int i = 0; i < 4; ++i) { v[i] = __expf(v[i] - mx); sum += v[i]; } sum = wave_sum(sum); const float rl = 1.0f / sum;
#pragma unroll
    for (int i = 0; i < 4; ++i) s[lane + 64 * i] = v[i] * rl; }
  __syncthreads();
  { const int r = tid >> 5, dg = tid & 31; const float* vp = mv + ((size_t)b * NMEM * NH + h) * 256 + dg * 8; f32x4 o0 = {0.f, 0.f, 0.f, 0.f}, o1 = {0.f, 0.f, 0.f, 0.f};
    for (int key = 0; key < NMEM; ++key) { const float p = S[r * 256 + key]; const f32x4 a = *(const f32x4*)(vp + (size_t)key * NH * 256), c = *(const f32x4*)(vp + (size_t)key * NH * 256 + 4); o0 += a * p; o1 += c * p; }
    *(u32x4*)(XO + (size_t)(MP + b * DECT + r) * DM + h * 256 + dg * 8) = epi::pack8(o0, o1); }
  __syncthreads();
}

__device__ __forceinline__ void shortconv_item(int item, const bf16_t* __restrict__ p1, const float* __restrict__ wsc, const float* __restrict__ state, bf16_t* __restrict__ A2) {
  const int cgp = item & 63, chunk = item >> 6, c = cgp * 8, r0 = chunk * 8;
  const bool sample = r0 >= MP;
  const bool seq_start = sample ? (((r0 - MP) & (DECT - 1)) == 0) : ((r0 & (SEQ - 1)) == 0);
  u32x4 uu[10], gg[8];
#pragma unroll
  for (int r = 0; r < 10; ++r) { const int row = r0 - 2 + r; uu[r] = (r >= 2 || !seq_start) ? *(const u32x4*)(p1 + (size_t)row * P1W + 2048 + c) : (u32x4){0u, 0u, 0u, 0u}; }
#pragma unroll
  for (int r = 0; r < 8; ++r) gg[r] = *(const u32x4*)(p1 + (size_t)(r0 + r) * P1W + 1536 + c);
  float w0[8], w1[8], w2[8], um2[8], um1[8];
#pragma unroll
  for (int j = 0; j < 8; ++j) { w0[j] = wsc[c + j]; w1[j] = wsc[CW + c + j]; w2[j] = wsc[2 * CW + c + j]; }
  if (sample && seq_start) { const float* s = state + (size_t)((r0 - MP) >> 4) * 2 * CW + c;
#pragma unroll
    for (int j = 0; j < 8; ++j) { um2[j] = s[j]; um1[j] = s[CW + j]; } }
  else {
#pragma unroll
    for (int j = 0; j < 4; ++j) { um2[2 * j] = __uint_as_float(uu[0][j] << 16); um2[2 * j + 1] = __uint_as_float(uu[0][j] & 0xffff0000u); um1[2 * j] = __uint_as_float(uu[1][j] << 16); um1[2 * j + 1] = __uint_as_float(uu[1][j] & 0xffff0000u); } }
#pragma unroll
  for (int r = 0; r < 8; ++r) {
    float y[8];
#pragma unroll
    for (int j = 0; j < 4; ++j) {
      const float u0 = __uint_as_float(uu[r + 2][j] << 16), u1 = __uint_as_float(uu[r + 2][j] & 0xffff0000u), g0 = __uint_as_float(gg[r][j] << 16), g1 = __uint_as_float(gg[r][j] & 0xffff0000u);
      y[2 * j] = g0 * (w0[2 * j] * um2[2 * j] + w1[2 * j] * um1[2 * j] + w2[2 * j] * u0); y[2 * j + 1] = g1 * (w0[2 * j + 1] * um2[2 * j + 1] + w1[2 * j + 1] * um1[2 * j + 1] + w2[2 * j + 1] * u1);
      um2[2 * j] = um1[2 * j]; um2[2 * j + 1] = um1[2 * j + 1]; um1[2 * j] = u0; um1[2 * j + 1] = u1; }
    u32x4 w; w.x = cvt_pk_bf16(y[0], y[1]); w.y = cvt_pk_bf16(y[2], y[3]); w.z = cvt_pk_bf16(y[4], y[5]); w.w = cvt_pk_bf16(y[6], y[7]);
    *(u32x4*)(A2 + (size_t)(r0 + r) * DM + 512 + c) = w;
  }
}
__device__ __forceinline__ void transpose_item(int item, const bf16_t* __restrict__ src, bf16_t* __restrict__ dst, LAS bf16_t* scr, int lane) {
  const int bi = item >> 4, bj = item & 15, r0 = bi * 64, c0 = bj * 64;
  for (int i = 0; i < 64; ++i) scr[i * 66 + lane] = src[(size_t)(r0 + i) * DM + c0 + lane];
  asm volatile("s_waitcnt lgkmcnt(0)" ::: "memory");
  for (int i = 0; i < 64; ++i) dst[(size_t)(c0 + i) * MMEM + r0 + lane] = scr[lane * 66 + i];
  asm volatile("s_waitcnt lgkmcnt(0)" ::: "memory");
}
}
constexpr size_t MiB = 1u << 20;
constexpr size_t WS_SSQ0 = 1 * MiB, WS_SSQM = WS_SSQ0 + 288 * 1024, WS_RS1 = WS_SSQ0 + 320 * 1024, WS_RS2 = WS_SSQ0 + 640 * 1024;
constexpr size_t WS_SSP1 = 2 * MiB, WS_SSP2 = 7 * MiB, WS_SSP3 = 12 * MiB, WS_L4 = 17 * MiB;
constexpr size_t WS_UH = 22 * MiB, WS_U01 = 28 * MiB, WS_G01 = 34 * MiB;
constexpr size_t WS_WIN = 40 * MiB, WS_WOUT = 46 * MiB, WS_WXQ = 48 * MiB, WS_WXKV = 50 * MiB, WS_WXO = 54 * MiB, WS_WUG = 56 * MiB, WS_WDN = 67 * MiB;
constexpr size_t WS_MN = 74 * MiB, WS_MK = 90 * MiB, WS_MV = 106 * MiB, WS_MVT = 122 * MiB;
constexpr size_t WS_XA = 138 * MiB;
constexpr size_t WS_P1 = 268 * MiB;
constexpr size_t WS_A2 = 591 * MiB;
constexpr size_t WS_SPART = WS_MN;
constexpr size_t WS_HQ = WS_P1, WS_P = WS_P1 + 129 * MiB, WS_H = WS_P1;
constexpr size_t WS_END = 720 * MiB;
static_assert(WS_XA + (size_t)RT * DM * 2 <= WS_P1 && WS_P1 + (size_t)RT * P1W * 2 <= WS_A2 && WS_A2 + (size_t)RT * DM * 2 <= WS_END && WS_H + (size_t)RT * DFF * 2 <= WS_END, "ws map");
static_assert(WS_WDN + (size_t)DM * DFF * 2 <= WS_MN && WS_WUG + (size_t)2 * DFF * DM * 2 <= WS_WDN && WS_G01 + (size_t)NTILE_P * 2 * DFF * 4 <= WS_WIN && WS_L4 + (size_t)RT * 16 <= WS_UH && WS_RS2 + (size_t)RT * 4 <= WS_SSP1, "ws map 2");

constexpr int RING_BYTES = 131072, XTRA_OFF = RING_BYTES, BARST_OFF = XTRA_OFF + 20480, LDS_BYTES = 155648;

struct SchedGrid {
    const char* A; const char* B; size_t a_tile, b_tile; int nM, nN, nwg, G, c;
    __device__ __forceinline__ void init(const void* A_, size_t a_tile_, const void* B_, size_t b_tile_, int nM_, int nN_, int G_, int c_) { A = (const char*)A_; B = (const char*)B_; a_tile = a_tile_; b_tile = b_tile_; nM = nM_; nN = nN_; nwg = nM * nN; G = G_; c = c_; }
    __device__ __forceinline__ bool next(int i, pg8::Unit& u) const {
        const long L = (long)i * G + c; if (L >= nwg) return false;
        int wgid = (int)L; { const int q = nwg / 8, r = nwg % 8, xcd = wgid % 8, off = wgid / 8; wgid = (xcd < r ? xcd * (q + 1) : r * (q + 1) + (xcd - r) * q) + off; }
        const int nig = 8 * nN, gid = wgid / nig, fm = gid * 8, gsz = (nM - fm) < 8 ? (nM - fm) : 8;
        u.pm = fm + ((wgid % nig) % gsz); u.pn = (wgid % nig) / gsz; u.A = A + (size_t)u.pm * a_tile; u.B = B + (size_t)u.pn * b_tile; return true;
    }
};
struct SchedX {
    const char* A; const char* B; int G, c; bool pv;
    __device__ __forceinline__ bool next(int i, pg8::Unit& u) const {
        const long L = (long)i * G + c; if (L >= 4 * NTILE_P) return false;
        const int h = (int)(L >> 8), idx = (int)(L & 255), pm = (idx & 7) * 32 + (idx >> 3), b = pm >> 3;
        u.pm = pm; u.pn = h; u.A = A + ((size_t)pm * 256 * DM + h * 256) * 2;
        u.B = pv ? B + ((size_t)h * 256 * MMEM + b * 256) * 2 : B + ((size_t)b * 256 * DM + h * 256) * 2; return true;
    }
};

struct SchedSplitK {
    const char* A; const char* B; int G, c;
    __device__ __forceinline__ bool next(int i, pg8::Unit& u) const {
        const long L = (long)i * G + c; if (L >= 16) return false;
        const int t = (int)(L >> 3), pn = (int)(L >> 1) & 3, kh = (int)L & 1;
        u.pm = NTILE_P + t; u.pn = pn | (kh << 4);
        u.A = A + ((size_t)(NTILE_P + t) * 256 * DFF + kh * (DFF / 2)) * 2; u.B = B + ((size_t)pn * 256 * DFF + kh * (DFF / 2)) * 2; return true;
    }
};

__device__ __forceinline__ void p0_transpose_item(const float* __restrict__ W, int ldw, int K, int kb, int ns, bf16_t* __restrict__ WT, int nd, const float* __restrict__ gain, LAS float* scr, int lane) {
    const int k0 = 64 * kb;
    float wv[32];
#pragma unroll
    for (int i = 0; i < 32; ++i) wv[i] = W[(size_t)(k0 + 2 * i + (lane >> 5)) * ldw + ns + (lane & 31)];
    if (gain) {
#pragma unroll
        for (int i = 0; i < 32; ++i) wv[i] *= gain[k0 + 2 * i + (lane >> 5)]; }
#pragma unroll
    for (int i = 0; i < 32; ++i) scr[(2 * i + (lane >> 5)) * 33 + (lane & 31)] = wv[i];
    asm volatile("s_waitcnt lgkmcnt(0)" ::: "memory");
    const int cc = lane & 7;
#pragma unroll
    for (int j = 0; j < 4; ++j) { const int n = (lane >> 3) + 8 * j; const LAS float* s = scr + (8 * cc) * 33 + n;
        u32x4 o; o.x = cvt_pk_bf16(s[0 * 33], s[1 * 33]); o.y = cvt_pk_bf16(s[2 * 33], s[3 * 33]); o.z = cvt_pk_bf16(s[4 * 33], s[5 * 33]); o.w = cvt_pk_bf16(s[6 * 33], s[7 * 33]);
        *(u32x4*)(WT + (size_t)(nd + n) * K + k0 + 8 * cc) = o; }
    asm volatile("s_waitcnt lgkmcnt(0)" ::: "memory");
}
__device__ __forceinline__ void rows4_to_bf16(const float* __restrict__ x, bf16_t* __restrict__ o, float* q, int lane) {
    f32x4 v[4][4]; float s[4] = {0.f, 0.f, 0.f, 0.f};
#pragma unroll
    for (int r = 0; r < 4; ++r)
#pragma unroll
        for (int j = 0; j < 4; ++j) v[r][j] = __builtin_nontemporal_load((const f32x4*)(x + (size_t)r * DM) + lane + 64 * j);
#pragma unroll
    for (int r = 0; r < 4; ++r) {
#pragma unroll
        for (int j = 0; j < 4; ++j) s[r] += (v[r][j][0] * v[r][j][0] + v[r][j][1] * v[r][j][1]) + (v[r][j][2] * v[r][j][2] + v[r][j][3] * v[r][j][3]);
        s[r] = wave_sum(s[r]);
#pragma unroll
        for (int j = 0; j < 4; ++j) *((u32x2*)(o + (size_t)r * DM) + lane + 64 * j) = epi::pack4(v[r][j]);
    }
    if (lane == 0) { q[0] = s[0]; q[1] = s[1]; q[2] = s[2]; q[3] = s[3]; }
}

__device__ __forceinline__ void rows2_to_bf16(const float* __restrict__ x0, const float* __restrict__ x1, bf16_t* __restrict__ o0, bf16_t* __restrict__ o1, float* q0, float* q1, int lane) {
    const f32x4* r0 = (const f32x4*)x0 + lane; const f32x4* r1 = (const f32x4*)x1 + lane; f32x4 v[4], w[4]; float s = 0.f, t = 0.f;
#pragma unroll
    for (int j = 0; j < 4; ++j) { v[j] = __builtin_nontemporal_load(r0 + 64 * j); w[j] = __builtin_nontemporal_load(r1 + 64 * j); }
#pragma unroll
    for (int j = 0; j < 4; ++j) { s += (v[j][0] * v[j][0] + v[j][1] * v[j][1]) + (v[j][2] * v[j][2] + v[j][3] * v[j][3]); t += (w[j][0] * w[j][0] + w[j][1] * w[j][1]) + (w[j][2] * w[j][2] + w[j][3] * w[j][3]); }
    s = wave_sum(s); t = wave_sum(t);
    u32x2* p0 = (u32x2*)o0 + lane; u32x2* p1 = (u32x2*)o1 + lane;
#pragma unroll
    for (int j = 0; j < 4; ++j) { p0[64 * j] = epi::pack4(v[j]); p1[64 * j] = epi::pack4(w[j]); }
    if (lane == 0) { *q0 = s; *q1 = t; }
}

#define XB_TMO      128
#define XB_XCNT(j)  (256  + 64 * (j))
#define XB_XSUB(j)  (1280 + 64 * (j))
#define XB_XGEN(j)  (2304 + 64 * (j))
#define XB_TOP      3328
#define XB_TOPGEN   3392
#define XCD_BAR_WORDS 3456
#define XB_SPIN_CAP (1u << 22)
__device__ __forceinline__ unsigned xb_ld(unsigned* p)              { return __hip_atomic_load(p, __ATOMIC_RELAXED, __HIP_MEMORY_SCOPE_AGENT); }
__device__ __forceinline__ unsigned xb_add(unsigned* p, unsigned v) { return __hip_atomic_fetch_add(p, v, __ATOMIC_RELAXED, __HIP_MEMORY_SCOPE_AGENT); }
__device__ __forceinline__ unsigned xb_xcc_id() { return (unsigned)__builtin_amdgcn_s_getreg((3 << 11) | 20) & 0xFu; }
#define XB_SPIN(cond, bar) do { unsigned _sp = 0; while (cond) { __builtin_amdgcn_s_sleep(1); \
    if ((++_sp & 255u) == 0u) { if (xb_ld(&(bar)[XB_TMO])) break; if (_sp > XB_SPIN_CAP) { atomicAdd(&(bar)[XB_TMO], 1u); break; } } } } while (0)
__device__ __forceinline__ void xcd_barrier_complete(unsigned* bar, unsigned x, unsigned& nloc, unsigned& nx) {
    const unsigned G = gridDim.x * gridDim.y * gridDim.z;
    unsigned sum, cnt, mine, sp = 0u;
    for (;;) {
        sum = 0u; cnt = 0u; mine = 0u;
#pragma unroll
        for (unsigned j = 0; j < 16; ++j) { const unsigned c = xb_ld(&bar[XB_XCNT(j)]); sum += c; cnt += (c > 0u) ? 1u : 0u; mine = (j == x) ? c : mine; }
        if (sum == G) break;
        __builtin_amdgcn_s_sleep(1);
        if ((++sp & 255u) == 0u) { if (xb_ld(&bar[XB_TMO])) break; if (sp > XB_SPIN_CAP) { atomicAdd(&bar[XB_TMO], 1u); break; } }
    }
    nloc = mine > 0u ? mine : 1u; nx = cnt > 0u ? cnt : 1u;
}
__device__ __forceinline__ void xcd_barrier(unsigned* bar, volatile LAS unsigned* st) {
    asm volatile("s_waitcnt vmcnt(0)" ::: "memory");
    __syncthreads();
    if (threadIdx.x == 0) {
        const unsigned x = xb_xcc_id();
        __builtin_amdgcn_s_waitcnt(0);
        unsigned nloc = st[0], nx = st[1];
        if (nloc == 0u) { xcd_barrier_complete(bar, x, nloc, nx); st[0] = nloc; st[1] = nx; }
        const unsigned old = xb_add(&bar[XB_XSUB(x)], 1u);
        const unsigned gen = old / nloc;
        if (old + 1u == (gen + 1u) * nloc) {
            __builtin_amdgcn_fence(__ATOMIC_RELEASE, "agent");
            asm volatile("s_waitcnt vmcnt(0)" ::: "memory");
            const unsigned og = xb_add(&bar[XB_TOP], 1u);
            const unsigned tg = og / nx;
            if (og + 1u == (tg + 1u) * nx) xb_add(&bar[XB_TOPGEN], 1u);
            else XB_SPIN(xb_ld(&bar[XB_TOPGEN]) == tg, bar);
            __builtin_amdgcn_fence(__ATOMIC_ACQUIRE, "agent");
            xb_add(&bar[XB_XGEN(x)], 1u);
            asm volatile("s_waitcnt vmcnt(0)" ::: "memory");
        } else {
            XB_SPIN(xb_ld(&bar[XB_XGEN(x)]) == gen, bar);
            __builtin_amdgcn_fence(__ATOMIC_ACQUIRE, "agent");
            asm volatile("s_waitcnt vmcnt(0)" ::: "memory");
        }
    }
    __syncthreads();
}

struct Args { const float* in[30]; float* out; unsigned char* ws; };
#define PHASE_ARGS() \
    const __attribute__((address_space(4))) Args* ap_ = (const __attribute__((address_space(4))) Args*)__builtin_amdgcn_kernarg_segment_ptr(); asm volatile("" : "+s"(ap_)); \
    unsigned char* const ws = ap_->ws; float* const out = ap_->out; (void)ws; (void)out; \
    int tid = threadIdx.x; asm volatile("" : "+v"(tid)); const int lane = tid & 63, wave = __builtin_amdgcn_readfirstlane(tid >> 6); (void)lane; (void)wave; \
    const int G = gridDim.x, bx = blockIdx.x, vcu = (G % 8 == 0) ? (bx % 8) * (G / 8) + bx / 8 : bx; (void)vcu; \
    const int gw = vcu * 8 + wave, NGW = G * 8; (void)gw; (void)NGW
#define IN(k) (ap_->in[k])
#define WSF(off) ((float*)(ws + (off)))
#define WSB(off) ((bf16_t*)(ws + (off)))

__global__ void __launch_bounds__(512, 2) fwd_kernel(Args a) {
    extern __shared__ __attribute__((aligned(16))) unsigned char lds_raw[];
    LAS unsigned char* const lds = (LAS unsigned char*)lds_raw;
    volatile LAS unsigned* const bst = (volatile LAS unsigned*)(lds + BARST_OFF);
    if (threadIdx.x < 2) bst[threadIdx.x] = 0u;
    __syncthreads();
    { PHASE_ARGS(); if (threadIdx.x == 0) (void)xb_add(&((unsigned*)ws)[XB_XCNT(xb_xcc_id())], 1u); }
#define GRID_BAR() do { PHASE_ARGS(); xcd_barrier((unsigned*)ws, bst); } while (0)

    {
        PHASE_ARGS();
        LAS float* scr = (LAS float*)(lds + wave * 16384);
        constexpr int I_IN = 16 * 96, I_SQ = 16 * 32, I_FF = 16 * 88, I_DN = 44 * 32;
        constexpr int NITEMS = I_IN + 5 * I_SQ + 2 * I_FF + I_DN;
        for (int it = gw; it < NITEMS; it += NGW) {
            int r = it;
            if (r < I_IN) { const int kb = r / 96, nb = r % 96, nd = nb * 32; int ns = nd;
                if (nd >= 2048) { const int T = (nd - 2048) >> 8, w = (nd - 2048) & 255; ns = (w < 128) ? 2048 + 128 * T + w : 2560 + 128 * T + (w - 128); }
                p0_transpose_item(IN(10), INP, DM, kb, ns, WSB(WS_WIN), nd, IN(9), scr, lane); continue; } r -= I_IN;
            if (r < I_SQ) { p0_transpose_item(IN(17), DM, DM, r / 32, (r % 32) * 32, WSB(WS_WOUT), (r % 32) * 32, nullptr, scr, lane); continue; } r -= I_SQ;
            if (r < I_SQ) { p0_transpose_item(IN(20), DM, DM, r / 32, (r % 32) * 32, WSB(WS_WXQ), (r % 32) * 32, IN(19), scr, lane); continue; } r -= I_SQ;
            if (r < I_SQ) { p0_transpose_item(IN(21), DM, DM, r / 32, (r % 32) * 32, WSB(WS_WXKV), (r % 32) * 32, IN(18), scr, lane); continue; } r -= I_SQ;
            if (r < I_SQ) { p0_transpose_item(IN(22), DM, DM, r / 32, (r % 32) * 32, WSB(WS_WXKV), 1024 + (r % 32) * 32, IN(18), scr, lane); continue; } r -= I_SQ;
            if (r < I_SQ) { p0_transpose_item(IN(23), DM, DM, r / 32, (r % 32) * 32, WSB(WS_WXO), (r % 32) * 32, nullptr, scr, lane); continue; } r -= I_SQ;
            if (r < I_FF) { const int kb = r / 88, nb = r % 88; p0_transpose_item(IN(25), DFF, DM, kb, nb * 32, WSB(WS_WUG), 256 * (nb >> 2) + (nb & 3) * 32, IN(24), scr, lane); continue; } r -= I_FF;
            if (r < I_FF) { const int kb = r / 88, nb = r % 88; p0_transpose_item(IN(26), DFF, DM, kb, nb * 32, WSB(WS_WUG), 256 * (nb >> 2) + 128 + (nb & 3) * 32, IN(24), scr, lane); continue; } r -= I_FF;
            p0_transpose_item(IN(28), DM, DFF, r / 32, (r % 32) * 32, WSB(WS_WDN), (r % 32) * 32, nullptr, scr, lane);
        }
        for (int m = 4 * gw; m < RT + MMEM; m += 4 * NGW) {
            const float* src; bf16_t* dst; float* sq;
            if (m < MP) { src = IN(0) + (size_t)m * DM; dst = WSB(WS_XA) + (size_t)m * DM; sq = WSF(WS_SSQ0) + m; }
            else if (m < RT) { src = IN(1) + (size_t)(m - MP) * DM; dst = WSB(WS_XA) + (size_t)m * DM; sq = WSF(WS_SSQ0) + m; }
            else { src = IN(8) + (size_t)(m - RT) * DM; dst = WSB(WS_MN) + (size_t)(m - RT) * DM; sq = WSF(WS_SSQM) + (m - RT); }
            rows4_to_bf16(src, dst, sq, lane);
        }
    }
    GRID_BAR();

    {
        PHASE_ARGS();
        pg8::Gemm g{DM, DM, DM};
        { SchedGrid S; S.init(WSB(WS_XA), (size_t)256 * DM * 2, WSB(WS_WIN), (size_t)256 * DM * 2, NTILE, INP / 256, G, bx);
          epi::EpiInProj E{WSF(WS_SSQ0), WSB(WS_P1), out};
          pg8::gemm_phase(lds, g, S, E); }
        { SchedGrid S; S.init(WSB(WS_MN), (size_t)256 * DM * 2, WSB(WS_WXKV), (size_t)256 * DM * 2, MMEM / 256, 8, G, bx);
          epi::EpiMemKV E{WSF(WS_SSQM), WSB(WS_MK), WSB(WS_MV), out};
          pg8::gemm_phase(lds, g, S, E); }
    }
    GRID_BAR();

    {
        PHASE_ARGS();
        float lam;
        { const float a1 = wave_sum(IN(11)[lane] * IN(12)[lane]), a2 = wave_sum(IN(13)[lane] * IN(14)[lane]); lam = __expf(a1) - __expf(a2) + LAM_INIT; }
        for (long L = bx; L < 2048; L += G) {
            const int s = (int)(L >> 8), cc = (int)(L & 255), cv = (cc & 7) * 32 + (cc >> 3), bh = cv >> 1, par = cv & 1, p = 2 * (s >> 1) + par, qb = (s & 1) ? 15 - p : p;
            dattn::unit(bh >> 2, bh & 3, qb, WSB(WS_P1), WSB(WS_A2), lam, IN(15), (LAS char*)lds);
        }
        for (int L = bx; L < 256; L += G) misc::sample_attn_unit(L >> 3, (L >> 1) & 3, L & 1, WSB(WS_P1), IN(2), IN(3), out + O_KS, out + O_VS, WSB(WS_A2), lam, IN(15), (char*)lds_raw);
        for (int it = (vcu * 512 + tid); it < 64 * (RT / 8); it += G * 512) misc::shortconv_item(it, WSB(WS_P1), IN(16), IN(4), WSB(WS_A2));
        __syncthreads();
        { LAS bf16_t* scr = (LAS bf16_t*)(lds + wave * 16384); for (int it = gw; it < 2048; it += NGW) misc::transpose_item(it, WSB(WS_MV), WSB(WS_MVT), scr, lane); }
    }
    GRID_BAR();

    {
        PHASE_ARGS();
        pg8::Gemm g{DM, DM, DM}; SchedGrid S; S.init(WSB(WS_A2), (size_t)256 * DM * 2, WSB(WS_WOUT), (size_t)256 * DM * 2, NTILE, 4, G, bx);
        epi::EpiResidual E{WSB(WS_XA), WSF(WS_SSP1)};
        pg8::gemm_phase(lds, g, S, E);
    }
    GRID_BAR();
    {
        PHASE_ARGS();
        for (int r = bx * 512 + tid; r < RT; r += G * 512) WSF(WS_RS1)[r] = epi::rstd16(WSF(WS_SSP1), r);
    }
    GRID_BAR();
    {
        PHASE_ARGS();
        pg8::Gemm g{DM, DM, DM}; SchedGrid S; S.init(WSB(WS_XA), (size_t)256 * DM * 2, WSB(WS_WXQ), (size_t)256 * DM * 2, NTILE, 4, G, bx);
        epi::EpiScaleBf16 E{WSF(WS_RS1), WSB(WS_HQ), DM};
        pg8::gemm_phase(lds, g, S, E);
    }
    GRID_BAR();
    {
        PHASE_ARGS();
        pg8::Gemm g{DM, DM, 256}; SchedX S{(const char*)WSB(WS_HQ), (const char*)WSB(WS_MK), G, bx, false};
        epi::EpiXScores E{WSB(WS_P), WSF(WS_L4), (LAS float*)(lds + XTRA_OFF)};
        pg8::gemm_phase(lds, g, S, E);
    }
    GRID_BAR();
    {
        PHASE_ARGS();
        pg8::Gemm g{DM, MMEM, 256}; SchedX S{(const char*)WSB(WS_P), (const char*)WSB(WS_MVT), G, bx, true};
        epi::EpiXPV E{WSF(WS_L4), WSB(WS_HQ)};
        pg8::gemm_phase(lds, g, S, E);
        __syncthreads();
        for (int L = G - 1 - bx; L < NB * NH; L += G) misc::sample_xattn_unit(L >> 2, L & 3, WSB(WS_HQ), IN(6), IN(7), WSB(WS_HQ), (char*)lds_raw);
    }
    GRID_BAR();
    {
        PHASE_ARGS();
        pg8::Gemm g{DM, DM, DM}; SchedGrid S; S.init(WSB(WS_HQ), (size_t)256 * DM * 2, WSB(WS_WXO), (size_t)256 * DM * 2, NTILE, 4, G, bx);
        epi::EpiResidual E{WSB(WS_XA), WSF(WS_SSP2)};
        pg8::gemm_phase(lds, g, S, E);
    }
    GRID_BAR();
    {
        PHASE_ARGS();
        for (int r = bx * 512 + tid; r < RT; r += G * 512) WSF(WS_RS2)[r] = epi::rstd16(WSF(WS_SSP2), r);
    }
    GRID_BAR();
    {
        PHASE_ARGS();
        pg8::Gemm g{DM, DM, DM}; SchedGrid S; S.init(WSB(WS_XA), (size_t)256 * DM * 2, WSB(WS_WUG), (size_t)256 * DM * 2, NTILE, 22, G, bx);
        epi::EpiUpGate E{WSF(WS_RS2), IN(27), IN(5), WSB(WS_H), out, WSF(WS_UH), WSF(WS_U01), WSF(WS_G01), (LAS float*)(lds + XTRA_OFF)};
        pg8::gemm_phase(lds, g, S, E);
    }
    GRID_BAR();
    {
        PHASE_ARGS();
        pg8::Gemm g{DFF, DFF, DFF}; SchedGrid S; S.init(WSB(WS_H), (size_t)256 * DFF * 2, WSB(WS_WDN), (size_t)256 * DFF * 2, NTILE_P, 4, G, bx);
        { const float* UH = WSF(WS_UH); const float* U01 = WSF(WS_U01); const float* G01 = WSF(WS_G01); const float* w_ffc = IN(27); bf16_t* HB = WSB(WS_H); pg8::Unit uu;
          for (int i = 0; S.next(i, uu); ++i) { const int pm = uu.pm; if (pm >= NTILE_P || (pm & 7) == 0) continue;
            for (int it = tid; it < 2 * DFF; it += 512) {
                const int r = it / DFF, c = it - r * DFF;
                const float um2 = UH[((size_t)(pm - 1) * 2 + r) * DFF + c];
                const float um1 = (r == 0) ? UH[((size_t)(pm - 1) * 2 + 1) * DFF + c] : U01[((size_t)pm * 2) * DFF + c];
                const float u0 = U01[((size_t)pm * 2 + r) * DFF + c];
                const float y = w_ffc[c] * um2 + w_ffc[DFF + c] * um1 + w_ffc[2 * DFF + c] * u0;
                const float hv = y * __builtin_amdgcn_rcpf(1.0f + __builtin_amdgcn_exp2f(-1.4426950408889634f * y)) * G01[((size_t)pm * 2 + r) * DFF + c];
                HB[(size_t)(pm * 256 + r) * DFF + c] = (bf16_t)(cvt_pk_bf16(hv, 0.f) & 0xffffu);
            } }
          asm volatile("s_waitcnt vmcnt(0)" ::: "memory"); __syncthreads(); }
        epi::EpiResidual E{WSB(WS_XA), WSF(WS_SSP3)};
        pg8::gemm_phase(lds, g, S, E);
        { pg8::Gemm g2{DFF, DFF, DFF / 2}; SchedSplitK S2{(const char*)WSB(WS_H), (const char*)WSB(WS_WDN), G, bx};
          epi::EpiPartialF32 E2{WSF(WS_SPART)};
          pg8::gemm_phase(lds, g2, S2, E2); }
    }
    GRID_BAR();
    {
        PHASE_ARGS();
        const float* g_fin = IN(29); const bf16_t* XB = WSB(WS_XA);
        f32x4 gg[4];
#pragma unroll
        for (int j = 0; j < 4; ++j) gg[j] = *((const f32x4*)g_fin + lane + 64 * j);
        for (int m = 2 * gw; m < MP; m += 2 * NGW) {
            const float rs0 = epi::rstd16(WSF(WS_SSP3), m), rs1 = epi::rstd16(WSF(WS_SSP3), m + 1);
            const u32x2* x0 = (const u32x2*)(XB + (size_t)m * DM) + lane; const u32x2* x1 = x0 + DM / 4;
            u32x2 a[4], b[4];
#pragma unroll
            for (int j = 0; j < 4; ++j) { a[j] = __builtin_nontemporal_load(x0 + 64 * j); b[j] = __builtin_nontemporal_load(x1 + 64 * j); }
            f32x4* y0 = (f32x4*)(out + O_Y + (size_t)m * DM) + lane; f32x4* y1 = y0 + DM / 4;
#pragma unroll
            for (int j = 0; j < 4; ++j) {
                f32x4 v = {__uint_as_float(a[j].x << 16), __uint_as_float(a[j].x & 0xffff0000u), __uint_as_float(a[j].y << 16), __uint_as_float(a[j].y & 0xffff0000u)};
                f32x4 w = {__uint_as_float(b[j].x << 16), __uint_as_float(b[j].x & 0xffff0000u), __uint_as_float(b[j].y << 16), __uint_as_float(b[j].y & 0xffff0000u)};
                __builtin_nontemporal_store(v * gg[j] * rs0, y0 + 64 * j); __builtin_nontemporal_store(w * gg[j] * rs1, y1 + 64 * j);
            }
        }
        for (int r = gw; r < MS; r += NGW) {
            const u32x2* x0 = (const u32x2*)(XB + (size_t)(MP + r) * DM) + lane; const f32x4* sa = (const f32x4*)(WSF(WS_SPART) + (size_t)r * DM) + lane; const f32x4* sb = sa + (size_t)MS * DM / 4;
            f32x4 v[4]; float ss = 0.f;
#pragma unroll
            for (int j = 0; j < 4; ++j) { const u32x2 a = x0[64 * j];
                v[j] = (f32x4){__uint_as_float(a.x << 16), __uint_as_float(a.x & 0xffff0000u), __uint_as_float(a.y << 16), __uint_as_float(a.y & 0xffff0000u)} + sa[64 * j] + sb[64 * j];
                ss += (v[j][0] * v[j][0] + v[j][1] * v[j][1]) + (v[j][2] * v[j][2] + v[j][3] * v[j][3]); }
            const float rs = rsqrtf(wave_sum(ss) * (1.0f / DM) + EPS);
            f32x4* y0 = (f32x4*)(out + O_Y + (size_t)(MP + r) * DM) + lane;
#pragma unroll
            for (int j = 0; j < 4; ++j) y0[64 * j] = v[j] * gg[j] * rs;
        }
    }
}

extern "C" void kernel_launch(void* const* d_in, const int* in_sizes, int n_in, void* d_out, int out_size, void* d_ws, size_t ws_size, hipStream_t stream) {
    static int grid = 0;
    if (grid == 0) {
        if (n_in != 30 || (size_t)out_size != O_END || ws_size < WS_END) { fprintf(stderr, "kernel_launch: unexpected shapes: n_in %d out %d ws %zu (need %zu, %zu)\n", n_in, out_size, ws_size, (size_t)O_END, (size_t)WS_END); grid = -1; return; }
        int dev = 0, cus = 0, per_cu = 0;
        if (hipGetDevice(&dev) != hipSuccess || hipDeviceGetAttribute(&cus, hipDeviceAttributeMultiprocessorCount, dev) != hipSuccess) { grid = -1; return; }
        if (hipFuncSetAttribute((const void*)fwd_kernel, hipFuncAttributeMaxDynamicSharedMemorySize, LDS_BYTES) != hipSuccess) { fprintf(stderr, "kernel_launch: hipFuncSetAttribute failed\n"); grid = -1; return; }
        if (hipOccupancyMaxActiveBlocksPerMultiprocessor(&per_cu, (const void*)fwd_kernel, 512, LDS_BYTES) != hipSuccess || per_cu < 1) { fprintf(stderr, "kernel_launch: occupancy query says %d\n", per_cu); grid = -1; return; }
        grid = cus;
        fprintf(stderr, "kernel_launch: %d CUs, %d blocks/CU by the occupancy query, grid %d\n", cus, per_cu, grid);
    }
    if (grid < 0) return;
    if (hipMemsetAsync(d_ws, 0, 16384, stream) != hipSuccess) { fprintf(stderr, "kernel_launch: memset failed\n"); return; }
    Args a{};
    for (int i = 0; i < 30; ++i) a.in[i] = (const float*)d_in[i];
    a.out = (float*)d_out; a.ws = (unsigned char*)d_ws;
    void* args[] = {&a};
    const hipError_t e = hipLaunchCooperativeKernel((const void*)fwd_kernel, dim3(grid), dim3(512), args, LDS_BYTES, stream);
    if (e != hipSuccess) fprintf(stderr, "kernel_launch: cooperative launch failed: %s (grid %d)\n", hipGetErrorString(e), grid);
}
```
